# Optimizing an MI355X kernel written in HIP

```python
import math
import jax, jax.numpy as jnp
from jax import lax
import numpy as np

D_MODEL = 1024
BATCH = 2
SEQ = 8192
DEPTH = 1

D_MIX = D_MODEL
SSM_WIDTH = D_MIX // 2
SSM_GROUP = 16
SSM_GROUPS = SSM_WIDTH // SSM_GROUP
SSM_STATE = 64
DT_MIN = 1e-3
DT_MAX = 1e-1

MLA_HEADS = 8
QK_NOPE = 64
QK_ROPE = 32
QK_HEAD = QK_NOPE + QK_ROPE
V_HEAD = 64
MLA_WIDTH = MLA_HEADS * V_HEAD
Q_LORA = 384
KV_LORA = 256
ROPE_THETA = 10000.0
Q_BLOCK = 128
EPS = 1e-6
NEG_INF = -1e30

D_IN = SSM_WIDTH + SSM_WIDTH + Q_LORA + KV_LORA + QK_ROPE + MLA_WIDTH

kernel_name = "hymba_s5_mla_hybrid_block"


def rms_norm(x, g):
    xf = x.astype(jnp.float32)
    y = xf * lax.rsqrt(jnp.mean(xf * xf, axis=-1, keepdims=True) + EPS)
    return (y * g.astype(jnp.float32)).astype(x.dtype)


def rope_tables(positions):
    half = QK_ROPE // 2
    inv_freq = ROPE_THETA ** (-jnp.arange(half, dtype=jnp.float32) * 2.0 / QK_ROPE)
    ang = positions.astype(jnp.float32)[..., None] * inv_freq
    return jnp.cos(ang), jnp.sin(ang)


def apply_rope(x, cos, sin):
    half = x.shape[-1] // 2
    xf = x.astype(jnp.float32)
    x1, x2 = xf[..., :half], xf[..., half:]
    out = jnp.concatenate([x1 * cos - x2 * sin, x2 * cos + x1 * sin], axis=-1)
    return out.astype(x.dtype)


def s5_mixer(u, log_dt, lam_re, lam_im, b_re, b_im, c_re, c_im, d_skip, w_glu, b_glu):
    bsz, seq, _ = u.shape
    uf = u.astype(jnp.float32).reshape(bsz, seq, SSM_GROUPS, SSM_GROUP)
    lam = lax.complex(lam_re.astype(jnp.float32), lam_im.astype(jnp.float32))
    dt = jnp.exp(log_dt.astype(jnp.float32))[:, None]
    lam_bar = jnp.exp(lam * dt)
    b_c = lax.complex(b_re.astype(jnp.float32), b_im.astype(jnp.float32))
    b_bar = ((lam_bar - 1.0) / lam)[..., None] * b_c
    c_c = lax.complex(c_re.astype(jnp.float32), c_im.astype(jnp.float32))
    bu = jnp.einsum('blgh,gph->blgp', uf.astype(jnp.complex64), b_bar)
    a = jnp.broadcast_to(lam_bar, bu.shape)

    def combine(left, right):
        a_l, b_l = left
        a_r, b_r = right
        return a_r * a_l, a_r * b_l + b_r

    _, states = lax.associative_scan(combine, (a, bu), axis=1)
    y = jnp.real(jnp.einsum('blgp,ghp->blgh', states, c_c)) + d_skip.astype(jnp.float32) * uf
    y = jax.nn.gelu(y.reshape(bsz, seq, SSM_WIDTH))
    y = y * jax.nn.sigmoid(y @ w_glu.astype(jnp.float32) + b_glu.astype(jnp.float32))
    return y.astype(u.dtype)


def mla_mixer(c_q, c_kv, k_r, cos, sin, q_a_g, w_q_b, kv_a_g, w_kv_b, q_norm_g, k_norm_g):
    bsz, seq, _ = c_q.shape
    q = (rms_norm(c_q, q_a_g) @ w_q_b).reshape(bsz, seq, MLA_HEADS, QK_HEAD)
    kv = (rms_norm(c_kv, kv_a_g) @ w_kv_b).reshape(bsz, seq, MLA_HEADS, QK_NOPE + V_HEAD)
    k_nope, v = kv[..., :QK_NOPE], kv[..., QK_NOPE:]
    k_rope = jnp.broadcast_to(k_r[:, :, None, :], (bsz, seq, MLA_HEADS, QK_ROPE))
    k = jnp.concatenate([k_nope, k_rope.astype(k_nope.dtype)], axis=-1)
    q = rms_norm(q, q_norm_g)
    k = rms_norm(k, k_norm_g)
    cos_h, sin_h = cos[:, :, None, :], sin[:, :, None, :]
    q = jnp.concatenate([q[..., :QK_NOPE], apply_rope(q[..., QK_NOPE:], cos_h, sin_h)], axis=-1)
    k = jnp.concatenate([k[..., :QK_NOPE], apply_rope(k[..., QK_NOPE:], cos_h, sin_h)], axis=-1)

    qh = q.transpose(0, 2, 1, 3)
    kh = k.transpose(0, 2, 1, 3)
    vh = v.transpose(0, 2, 1, 3)
    n_blocks = seq // Q_BLOCK
    qb = qh.reshape(bsz, MLA_HEADS, n_blocks, Q_BLOCK, QK_HEAD).transpose(2, 0, 1, 3, 4)
    scale = 1.0 / math.sqrt(QK_HEAD)
    k_idx = jnp.arange(seq)

    def one_block(args):
        qi, bi = args
        s = jnp.einsum('bhqd,bhkd->bhqk', qi, kh).astype(jnp.float32) * scale
        q_idx = bi * Q_BLOCK + jnp.arange(Q_BLOCK)
        mask = k_idx[None, :] <= q_idx[:, None]
        p = jax.nn.softmax(jnp.where(mask, s, NEG_INF), axis=-1)
        return jnp.einsum('bhqk,bhkd->bhqd', p.astype(vh.dtype), vh)

    ob = lax.map(one_block, (qb, jnp.arange(n_blocks)))
    return ob.transpose(1, 0, 3, 2, 4).reshape(bsz, seq, MLA_WIDTH)


def setup_inputs(seed: int = 0) -> dict:
    key = jax.random.key(seed)
    ks = jax.random.split(key, 32)
    f32 = jnp.float32

    def nrm(k, shape, std):
        return jax.random.normal(k, shape, f32) * std

    x = nrm(ks[0], (BATCH, SEQ, D_MODEL), 1.0)
    c = nrm(ks[1], (BATCH, D_MODEL), 1.0)
    offsets = jax.random.randint(ks[2], (BATCH, 1), 0, 1024, dtype=jnp.int32)
    positions = offsets + jnp.arange(SEQ, dtype=jnp.int32)[None, :]

    w_ada = nrm(ks[3], (DEPTH, D_MODEL, 3 * D_MODEL), 0.5 * D_MODEL ** -0.5)
    b_ada = nrm(ks[4], (DEPTH, 3 * D_MODEL), 0.02)
    norm_g = 1.0 + nrm(ks[5], (DEPTH, D_MODEL), 0.02)
    w_in = nrm(ks[6], (DEPTH, D_MODEL, D_IN), D_MODEL ** -0.5)

    log_dt = jax.random.uniform(ks[7], (DEPTH, SSM_GROUPS), f32, math.log(DT_MIN), math.log(DT_MAX))
    n_idx = jnp.arange(SSM_STATE, dtype=f32)
    lam_re = -0.5 + nrm(ks[8], (DEPTH, SSM_GROUPS, SSM_STATE), 0.01)
    lam_im = math.pi * n_idx + nrm(ks[9], (DEPTH, SSM_GROUPS, SSM_STATE), 0.01)
    b_std = (2.0 * SSM_GROUP) ** -0.5
    c_std = (2.0 * SSM_STATE) ** -0.5
    b_re = nrm(ks[10], (DEPTH, SSM_GROUPS, SSM_STATE, SSM_GROUP), b_std)
    b_im = nrm(ks[11], (DEPTH, SSM_GROUPS, SSM_STATE, SSM_GROUP), b_std)
    c_re = nrm(ks[12], (DEPTH, SSM_GROUPS, SSM_GROUP, SSM_STATE), c_std)
    c_im = nrm(ks[13], (DEPTH, SSM_GROUPS, SSM_GROUP, SSM_STATE), c_std)
    d_skip = nrm(ks[14], (DEPTH, SSM_GROUPS, SSM_GROUP), 1.0)
    w_glu = nrm(ks[15], (DEPTH, SSM_WIDTH, SSM_WIDTH), SSM_WIDTH ** -0.5)
    b_glu = nrm(ks[16], (DEPTH, SSM_WIDTH), 0.02)

    q_a_g = 1.0 + nrm(ks[17], (DEPTH, Q_LORA), 0.02)
    w_q_b = nrm(ks[18], (DEPTH, Q_LORA, MLA_HEADS * QK_HEAD), Q_LORA ** -0.5)
    kv_a_g = 1.0 + nrm(ks[19], (DEPTH, KV_LORA), 0.02)
    w_kv_b = nrm(ks[20], (DEPTH, KV_LORA, MLA_HEADS * (QK_NOPE + V_HEAD)), KV_LORA ** -0.5)
    q_norm_g = 1.0 + nrm(ks[21], (DEPTH, QK_HEAD), 0.02)
    k_norm_g = 1.0 + nrm(ks[22], (DEPTH, QK_HEAD), 0.02)

    w_out = nrm(ks[23], (DEPTH, D_MIX, D_MODEL), D_MIX ** -0.5)

    return {"x": x, "c": c, "positions": positions,
            "w_ada": w_ada, "b_ada": b_ada, "norm_g": norm_g, "w_in": w_in,
            "log_dt": log_dt, "lam_re": lam_re, "lam_im": lam_im,
            "b_re": b_re, "b_im": b_im, "c_re": c_re, "c_im": c_im,
            "d_skip": d_skip, "w_glu": w_glu, "b_glu": b_glu,
            "q_a_g": q_a_g, "w_q_b": w_q_b, "kv_a_g": kv_a_g, "w_kv_b": w_kv_b,
            "q_norm_g": q_norm_g, "k_norm_g": k_norm_g, "w_out": w_out}


def reference(x, c, positions, w_ada, b_ada, norm_g, w_in,
              log_dt, lam_re, lam_im, b_re, b_im, c_re, c_im, d_skip, w_glu, b_glu,
              q_a_g, w_q_b, kv_a_g, w_kv_b, q_norm_g, k_norm_g, w_out):
    cos, sin = rope_tables(positions)
    c_act = jax.nn.silu(c)
    o1 = SSM_WIDTH
    o2 = o1 + SSM_WIDTH
    o3 = o2 + Q_LORA
    o4 = o3 + KV_LORA
    o5 = o4 + QK_ROPE
    for l in range(DEPTH):
        mod = c_act @ w_ada[l] + b_ada[l]
        shift, scale, gate = jnp.split(mod, 3, axis=-1)
        h = rms_norm(x, norm_g[l]) * (1.0 + scale[:, None, :]) + shift[:, None, :]
        proj = h @ w_in[l]
        u_ssm = proj[..., :o1]
        z_ssm = proj[..., o1:o2]
        c_q = proj[..., o2:o3]
        c_kv = proj[..., o3:o4]
        k_r = proj[..., o4:o5]
        z_mla = proj[..., o5:]
        y_ssm = s5_mixer(u_ssm, log_dt[l], lam_re[l], lam_im[l], b_re[l], b_im[l],
                         c_re[l], c_im[l], d_skip[l], w_glu[l], b_glu[l]) * jax.nn.silu(z_ssm)
        y_mla = mla_mixer(c_q, c_kv, k_r, cos, sin, q_a_g[l], w_q_b[l], kv_a_g[l], w_kv_b[l],
                          q_norm_g[l], k_norm_g[l]) * jax.nn.silu(z_mla)
        y = jnp.concatenate([y_ssm, y_mla], axis=-1) @ w_out[l]
        x = x + gate[:, None, :] * y
    return x
```

```cpp
#include <hip/hip_runtime.h>
#include <cstdio>
#include <cstdint>

constexpr int BATCH = 2, SEQ = 8192, DM = 1024, M = BATCH * SEQ;
constexpr int SSM_W = 512, SSM_G = 32, SSM_GC = 16, SSM_P = 64;
constexpr int NH = 8, QK_NOPE = 64, QK_ROPE = 32, QK_HEAD = 96, V_HEAD = 64, MLA_W = 512, Q_LORA = 384, KV_LORA = 256;
constexpr int D_IN = 2208;
constexpr float EPS = 1e-6f;
constexpr int NPROJ = 2304;
constexpr int PC_U = 0, PC_ZS = 512, PC_ZM = 1024, PC_CKV = 1536, PC_CQ = 1792, PC_KR = 2176;
constexpr int SC_U = 0, SC_ZS = 512, SC_CQ = 1024, SC_CKV = 1408, SC_KR = 1664, SC_ZM = 1696;

constexpr size_t MiB = 1u << 20;
constexpr size_t WS_CTL = 0, CTL_ZERO_BYTES = 1 * MiB;
constexpr size_t WS_MOD = 1 * MiB;
constexpr size_t WS_AC = 1 * MiB + 64 * 1024;
constexpr size_t WS_BB = 1 * MiB + 128 * 1024;
constexpr size_t WS_CB = 1 * MiB + 256 * 1024;
constexpr size_t WS_E = 2 * MiB;
constexpr size_t WS_WIN = 4 * MiB;
constexpr size_t WS_WQ = 9 * MiB;
constexpr size_t WS_WKV = 10 * MiB;
constexpr size_t WS_WGLU = 11 * MiB;
constexpr size_t WS_WOUT = 12 * MiB;
constexpr size_t WS_PROJ = 16 * MiB;
constexpr size_t WS_HB = 88 * MiB;
constexpr size_t WS_KVRAW = 120 * MiB;
constexpr size_t WS_Q = 152 * MiB;
constexpr size_t WS_K = 176 * MiB;
constexpr size_t WS_V = 208 * MiB;
constexpr size_t WS_CQN = 224 * MiB;
constexpr size_t WS_CKVN = 236 * MiB;
constexpr size_t WS_YPRE = 224 * MiB;
constexpr size_t WS_END = 244 * MiB;

typedef unsigned short bf16;
__device__ __forceinline__ unsigned f2bf(float f) { return (unsigned)__builtin_bit_cast(unsigned short, (_Float16)f); }
__device__ __forceinline__ float bf2f(bf16 b) { return (float)__builtin_bit_cast(_Float16, b); }
__device__ __forceinline__ float silu_f(float v) { return v / (1.f + __expf(-v)); }
__device__ __forceinline__ float sigmoid_f(float v) { return 1.f / (1.f + __expf(-v)); }
__device__ __forceinline__ float gelu_tanh(float v) { const float z = 0.7978845608028654f * (v + 0.044715f * v * v * v); return v / (1.f + __expf(-2.f * z)); }

__device__ __forceinline__ float block_sum_256(float v, float* red) {
    for (int o = 32; o > 0; o >>= 1) v += __shfl_xor(v, o);
    const int w = threadIdx.x >> 6;
    __syncthreads();
    if ((threadIdx.x & 63) == 0) red[w] = v;
    __syncthreads();
    float s = 0.f; for (int i = 0; i < (int)(blockDim.x >> 6); ++i) s += red[i];
    return s;
}

__global__ void v0_mod(const float* c, const float* w_ada, const float* b_ada, float* mod) {
    const int idx = blockIdx.x * blockDim.x + threadIdx.x; if (idx >= BATCH * 3 * DM) return;
    const int b = idx / (3 * DM), n = idx % (3 * DM);
    float acc = b_ada[n];
    for (int k = 0; k < DM; ++k) acc += silu_f(c[b * DM + k]) * w_ada[(size_t)k * 3 * DM + n];
    mod[idx] = acc;
}
__global__ void v0_h(const float* x, const float* norm_g, const float* mod, bf16* hb) {
    __shared__ float red[8];
    const int m = blockIdx.x, b = m / SEQ, t = threadIdx.x;
    float v[4], ss = 0.f;
    for (int j = 0; j < 4; ++j) { v[j] = x[(size_t)m * DM + t + 256 * j]; ss += v[j] * v[j]; }
    ss = block_sum_256(ss, red);
    const float rstd = 1.f / sqrtf(ss / DM + EPS);
    for (int j = 0; j < 4; ++j) { const int e = t + 256 * j;
        const float hv = v[j] * rstd * norm_g[e] * (1.f + mod[b * 3 * DM + DM + e]) + mod[b * 3 * DM + e];
        hb[(size_t)m * DM + e] = (bf16)f2bf(hv); }
}
__global__ void v0_gemm(const bf16* A, int lda, int K, const float* W, int ldw, int src0, bf16* C, int ldc, int dst0, int width) {
    extern __shared__ float arow[];
    const int m = blockIdx.x;
    for (int k = threadIdx.x; k < K; k += blockDim.x) arow[k] = bf2f(A[(size_t)m * lda + k]);
    __syncthreads();
    for (int j = threadIdx.x; j < width; j += blockDim.x) {
        float acc = 0.f;
        for (int k = 0; k < K; ++k) acc += arow[k] * W[(size_t)k * ldw + src0 + j];
        C[(size_t)m * ldc + dst0 + j] = (bf16)f2bf(acc);
    }
}
__global__ void v0_cqn(const bf16* proj, const float* q_a_g, const float* kv_a_g, bf16* cqn, bf16* ckvn) {
    __shared__ float red[8];
    const int m = blockIdx.x, t = threadIdx.x;
    float a = 0.f, b2 = 0.f, ss = 0.f;
    if (t < 192) { a = bf2f(proj[(size_t)m * NPROJ + PC_CQ + t]); b2 = bf2f(proj[(size_t)m * NPROJ + PC_CQ + 192 + t]); ss = a * a + b2 * b2; }
    ss = block_sum_256(ss, red);
    float rstd = 1.f / sqrtf(ss / Q_LORA + EPS);
    if (t < 192) { cqn[(size_t)m * Q_LORA + t] = (bf16)f2bf(a * rstd * q_a_g[t]); cqn[(size_t)m * Q_LORA + 192 + t] = (bf16)f2bf(b2 * rstd * q_a_g[192 + t]); }
    const float cv = bf2f(proj[(size_t)m * NPROJ + PC_CKV + t]);
    ss = block_sum_256(cv * cv, red);
    rstd = 1.f / sqrtf(ss / KV_LORA + EPS);
    ckvn[(size_t)m * KV_LORA + t] = (bf16)f2bf(cv * rstd * kv_a_g[t]);
}
__global__ void __launch_bounds__(256) v0_qkv(const bf16* qraw, const bf16* kvraw, const bf16* proj, const int* positions, const float* q_norm_g, const float* k_norm_g, bf16* Q, bf16* K, bf16* V) {
    const int idx = blockIdx.x * blockDim.x + threadIdx.x; if (idx >= M * NH * 2) return;
    const int which = idx & 1, m = (idx >> 1) / NH, h = (idx >> 1) % NH;
    const float pos = (float)positions[m];
    const float* gn = which ? k_norm_g : q_norm_g;
    float q[96];
    float sq = 0.f;
    if (which == 0) {
#pragma unroll
        for (int d = 0; d < 96; ++d) q[d] = bf2f(qraw[(size_t)m * 1024 + h * 128 + d]);
    } else {
#pragma unroll
        for (int d = 0; d < 64; ++d) q[d] = bf2f(kvraw[(size_t)m * 1024 + h * 128 + d]);
#pragma unroll
        for (int d = 0; d < 32; ++d) q[64 + d] = bf2f(proj[(size_t)m * NPROJ + PC_KR + d]);
    }
#pragma unroll
    for (int d = 0; d < 96; ++d) sq += q[d] * q[d];
    const float rq = 1.f / sqrtf(sq / 96.f + EPS);
#pragma unroll
    for (int d = 0; d < 96; ++d) q[d] = q[d] * rq * gn[d];
#pragma unroll
    for (int i = 0; i < 16; ++i) {
        const float inv_freq = (float)pow(10000.0, -(double)i / 16.0);
        const float ang = pos * inv_freq;
        const double TWO_PI = 6.283185307179586476925286766559;
        const double r = (double)ang - TWO_PI * rint((double)ang / TWO_PI);
        const float rf = (float)r; const float cs = __cosf(rf), sn = __sinf(rf);
        const float q1 = q[64 + i], q2 = q[80 + i]; q[64 + i] = q1 * cs - q2 * sn; q[80 + i] = q2 * cs + q1 * sn;
    }
    if (which == 0) {
#pragma unroll
        for (int d = 0; d < 96; ++d) Q[(size_t)m * 768 + h * 96 + d] = (bf16)f2bf(q[d]);
    } else {
#pragma unroll
        for (int d = 0; d < 96; ++d) K[(size_t)m * 1024 + h * 128 + d] = (bf16)f2bf(q[d]);
        for (int d = 0; d < 64; ++d) V[(size_t)m * 512 + h * 64 + d] = kvraw[(size_t)m * 1024 + h * 128 + 64 + d];
    }
}
__global__ void __launch_bounds__(64) v0_ssm(const bf16* proj, const float* log_dt, const float* lam_re, const float* lam_im, const float* b_re, const float* b_im,
                       const float* c_re, const float* c_im, const float* d_skip, bf16* ypre) {
    __shared__ float sre[64], sim[64], us[16];
    const int b = blockIdx.x / SSM_G, g = blockIdx.x % SSM_G, p = threadIdx.x;
    const double dt = exp((double)log_dt[g]);
    const double lr = lam_re[g * 64 + p], li = lam_im[g * 64 + p];
    const double er = exp(lr * dt), ar = er * cos(li * dt), ai = er * sin(li * dt);
    const double nr = ar - 1.0, ni = ai, den = lr * lr + li * li;
    const double cr = (nr * lr + ni * li) / den, ci = (ni * lr - nr * li) / den;
    float Br[16], Bi[16];
#pragma unroll
    for (int j = 0; j < 16; ++j) { const double br = b_re[(g * 64 + p) * 16 + j], bi = b_im[(g * 64 + p) * 16 + j];
        Br[j] = (float)(cr * br - ci * bi); Bi[j] = (float)(cr * bi + ci * br); }
    const float far = (float)ar, fai = (float)ai;
    float s_r = 0.f, s_i = 0.f;
    const float dsk = p < 16 ? d_skip[g * 16 + p] : 0.f;
    for (int t = 0; t < SEQ; ++t) {
        const size_t row = (size_t)(b * SEQ + t);
        if (p < 16) us[p] = bf2f(proj[row * NPROJ + PC_U + g * 16 + p]);
        __syncthreads();
        float bur = 0.f, bui = 0.f;
#pragma unroll
        for (int j = 0; j < 16; ++j) { bur += Br[j] * us[j]; bui += Bi[j] * us[j]; }
        const float nr2 = far * s_r - fai * s_i + bur, ni2 = far * s_i + fai * s_r + bui;
        s_r = nr2; s_i = ni2; sre[p] = s_r; sim[p] = s_i;
        __syncthreads();
        if (p < 16) {
            float y = 0.f;
            for (int q = 0; q < 64; ++q) y += c_re[(g * 16 + p) * 64 + q] * sre[q] - c_im[(g * 16 + p) * 64 + q] * sim[q];
            y += dsk * us[p];
            ypre[row * SSM_W + g * 16 + p] = (bf16)f2bf(gelu_tanh(y));
        }
        __syncthreads();
    }
}
__global__ void __launch_bounds__(256) v0_attn(const bf16* Q, const bf16* K, const bf16* V, const bf16* proj, bf16* ycat) {
    const int qb = blockIdx.x % (SEQ / 256), bh = blockIdx.x / (SEQ / 256), b = bh / NH, h = bh % NH;
    const int qi = qb * 256 + threadIdx.x;
    const size_t qrow = (size_t)b * SEQ + qi;
    float q[96], o[64];
    const float sc = 0.10206207261596575f;
#pragma unroll
    for (int d = 0; d < 96; ++d) q[d] = bf2f(Q[qrow * 768 + h * 96 + d]) * sc;
#pragma unroll
    for (int d = 0; d < 64; ++d) o[d] = 0.f;
    float mx = -1e30f, l = 0.f;
    const int jmax = qb * 256 + 255;
    for (int j = 0; j <= jmax; ++j) {
        const size_t krow = (size_t)b * SEQ + j;
        const bf16* kp = K + krow * 1024 + h * 128; const bf16* vp = V + krow * 512 + h * 64;
        float s = 0.f;
#pragma unroll
        for (int d = 0; d < 96; ++d) s += q[d] * bf2f(kp[d]);
        if (j <= qi) {
            const float mn = fmaxf(mx, s); const float al = __expf(mx - mn), pp = __expf(s - mn);
            l = l * al + pp;
#pragma unroll
            for (int d = 0; d < 64; ++d) o[d] = o[d] * al + pp * bf2f(vp[d]);
            mx = mn;
        }
    }
    const float rl = 1.f / l;
#pragma unroll
    for (int d = 0; d < 64; ++d) {
        const float z = bf2f(proj[qrow * NPROJ + PC_ZM + h * 64 + d]);
        ycat[qrow * 1024 + 512 + h * 64 + d] = (bf16)f2bf(o[d] * rl * silu_f(z));
    }
}
__global__ void v0_glu(const bf16* ypre, const float* w_glu, const float* b_glu, const bf16* proj, bf16* ycat) {
    __shared__ float arow[512];
    const int m = blockIdx.x;
    for (int k = threadIdx.x; k < 512; k += blockDim.x) arow[k] = bf2f(ypre[(size_t)m * 512 + k]);
    __syncthreads();
    for (int j = threadIdx.x; j < 512; j += blockDim.x) {
        float acc = b_glu[j];
        for (int k = 0; k < 512; ++k) acc += arow[k] * w_glu[(size_t)k * 512 + j];
        const float z = bf2f(proj[(size_t)m * NPROJ + PC_ZS + j]);
        ycat[(size_t)m * 1024 + j] = (bf16)f2bf(arow[j] * sigmoid_f(acc) * silu_f(z));
    }
}
__global__ void v0_out(const bf16* ycat, const float* w_out, const float* x, const float* mod, float* out) {
    __shared__ float arow[1024];
    const int m = blockIdx.x, b = m / SEQ;
    for (int k = threadIdx.x; k < 1024; k += blockDim.x) arow[k] = bf2f(ycat[(size_t)m * 1024 + k]);
    __syncthreads();
    for (int j = threadIdx.x; j < 1024; j += blockDim.x) {
        float acc = 0.f;
        for (int k = 0; k < 1024; ++k) acc += arow[k] * w_out[(size_t)k * 1024 + j];
        out[(size_t)m * DM + j] = x[(size_t)m * DM + j] + mod[b * 3 * DM + 2 * DM + j] * acc;
    }
}


namespace pg8 {
#define PG8_LAS __attribute__((address_space(3)))
typedef unsigned short bf16_t;
typedef _Float16 bf16x8 __attribute__((ext_vector_type(8)));
typedef float f32x4 __attribute__((ext_vector_type(4)));
typedef unsigned u32x4 __attribute__((ext_vector_type(4)));
constexpr int BM = 256, BK = 64, HALF = 128, HTB = HALF * BK * 2  , STAGE_BYTES = 8 * HTB, NXCD = 8, WGM = 8;

__host__ __device__ __forceinline__ int lds_byte(int r, int c) { const int st = (r >> 4) * 2 + (c >> 5), rr = r & 15, cc = c & 31, ob = rr * 64 + cc * 2; return st * 1024 + (ob ^ (((ob >> 9) & 1) << 5)); }
__host__ __device__ __forceinline__ void stage_rc(int b, int& R, int& C) { const int st = b / 1024, sb = b % 1024, swz = sb ^ (((sb >> 9) & 1) << 5); R = (st >> 1) * 16 + swz / 64; C = (st & 1) * 32 + (swz % 64) / 2; }
__host__ __device__ __forceinline__ int perm32(int rho) { const int n = rho >> 4, i = rho & 15; return 8 * (i >> 2) + 4 * n + (i & 3); }

struct Unit { int pm, pn; };
struct Gemm { const bf16_t* A; const bf16_t* Bt; int M, N, K; };

struct StaticOrder {
    int nM, nN, nwg, G, c;
    __host__ __device__ void init(int M, int N, int G_, int c_) { nM = M / BM; nN = N / BM; nwg = nM * nN; G = G_; c = c_; }
    __host__ __device__ bool next(int i, Unit& u) const {
        const long L = (long)i * G + c; if (L >= nwg) return false;
        int wgid = (int)L; { const int q = nwg / NXCD, r = nwg % NXCD, xcd = wgid % NXCD, off = wgid / NXCD; wgid = (xcd < r ? xcd * (q + 1) : r * (q + 1) + (xcd - r) * q) + off; }
        const int nig = WGM * nN, gid = wgid / nig, fm = gid * WGM, gsz = (nM - fm) < WGM ? (nM - fm) : WGM;
        u.pm = fm + ((wgid % nig) % gsz); u.pn = (wgid % nig) / gsz; return true;
    }
    __device__ __forceinline__ void a_ready(const Unit&) const {}
    __device__ __forceinline__ void done(const Unit&) const {}
};


typedef float f32x2 __attribute__((ext_vector_type(2)));
typedef _Float16 f16x2 __attribute__((ext_vector_type(2)));
__device__ __forceinline__ unsigned cvt_pk_h(float lo, float hi) { const f16x2 v = __builtin_convertvector((f32x2){lo, hi}, f16x2); return __builtin_bit_cast(unsigned, v); }
__device__ __forceinline__ float h_lo(unsigned w) { return (float)__builtin_bit_cast(f16x2, w)[0]; }
__device__ __forceinline__ float h_hi(unsigned w) { return (float)__builtin_bit_cast(f16x2, w)[1]; }
__device__ __forceinline__ float fsilu(float v) { return v * __builtin_amdgcn_rcpf(1.f + __builtin_amdgcn_exp2f(-1.4426950408889634f * v)); }
__device__ __forceinline__ float fsigm(float v) { return __builtin_amdgcn_rcpf(1.f + __builtin_amdgcn_exp2f(-1.4426950408889634f * v)); }

struct EpiH16 {
    static constexpr bool PERM = true, AFTER_DRAIN = false;
    bf16_t* O; int ldc;
    __device__ __forceinline__ void operator()(const f32x4 (&acc)[2][2][4][2], const Unit& u, int wr, int wc, int fr, int fq) const {
        const int row0 = u.pm * BM + wr * 64 + fr, col0 = u.pn * BM + wc * 32 + 8 * fq;
#pragma unroll
        for (int ai = 0; ai < 2; ++ai)
#pragma unroll
            for (int m = 0; m < 4; ++m) { bf16_t* rowp = O + (size_t)(row0 + ai * HALF + m * 16) * ldc + col0;
#pragma unroll
                for (int bj = 0; bj < 2; ++bj) { const f32x4 v0 = acc[ai][bj][m][0], v1 = acc[ai][bj][m][1];
                    u32x4 w; w.x = cvt_pk_h(v0[0], v0[1]); w.y = cvt_pk_h(v0[2], v0[3]); w.z = cvt_pk_h(v1[0], v1[1]); w.w = cvt_pk_h(v1[2], v1[3]);
                    *(u32x4*)(rowp + bj * HALF) = w; } }
    }
};
struct EpiGlu {
    static constexpr bool PERM = true, AFTER_DRAIN = false;
    const bf16_t* ypre; const bf16_t* proj; int ldp, zcol0; const float* bglu; bf16_t* ycat;
    __device__ __forceinline__ void operator()(const f32x4 (&acc)[2][2][4][2], const Unit& u, int wr, int wc, int fr, int fq) const {
        const int row0 = u.pm * BM + wr * 64 + fr, col0 = u.pn * BM + wc * 32 + 8 * fq;
        f32x4 bv[2][2];
#pragma unroll
        for (int bj = 0; bj < 2; ++bj)
#pragma unroll
            for (int n = 0; n < 2; ++n) bv[bj][n] = *(const f32x4*)(bglu + col0 + bj * HALF + 4 * n);
#pragma unroll
        for (int ai = 0; ai < 2; ++ai)
#pragma unroll
            for (int m = 0; m < 4; ++m) { const size_t row = (size_t)(row0 + ai * HALF + m * 16);
#pragma unroll
                for (int bj = 0; bj < 2; ++bj) { const int col = col0 + bj * HALF;
                    const u32x4 yv = *(const u32x4*)(ypre + row * 512 + col); const u32x4 zv = *(const u32x4*)(proj + row * ldp + zcol0 + col);
                    const f32x4 t0 = acc[ai][bj][m][0] + bv[bj][0], t1 = acc[ai][bj][m][1] + bv[bj][1];
                    u32x4 w;
                    w.x = cvt_pk_h(h_lo(yv.x) * fsigm(t0[0]) * fsilu(h_lo(zv.x)), h_hi(yv.x) * fsigm(t0[1]) * fsilu(h_hi(zv.x)));
                    w.y = cvt_pk_h(h_lo(yv.y) * fsigm(t0[2]) * fsilu(h_lo(zv.y)), h_hi(yv.y) * fsigm(t0[3]) * fsilu(h_hi(zv.y)));
                    w.z = cvt_pk_h(h_lo(yv.z) * fsigm(t1[0]) * fsilu(h_lo(zv.z)), h_hi(yv.z) * fsigm(t1[1]) * fsilu(h_hi(zv.z)));
                    w.w = cvt_pk_h(h_lo(yv.w) * fsigm(t1[2]) * fsilu(h_lo(zv.w)), h_hi(yv.w) * fsigm(t1[3]) * fsilu(h_hi(zv.w)));
                    *(u32x4*)(ycat + row * 1024 + col) = w; } }
    }
};
struct EpiOut {
    static constexpr bool PERM = false, AFTER_DRAIN = false;
    const float* x; const float* gate; int gate_stride, rows_per_batch; float* out;
    __device__ __forceinline__ void operator()(const f32x4 (&acc)[2][2][4][2], const Unit& u, int wr, int wc, int fr, int fq) const {
        const int col0 = u.pn * BM + wc * 32 + 4 * fq; const int b = (u.pm * BM) / rows_per_batch;
        f32x4 gv[2][2];
#pragma unroll
        for (int bj = 0; bj < 2; ++bj)
#pragma unroll
            for (int n = 0; n < 2; ++n) gv[bj][n] = *(const f32x4*)(gate + (size_t)b * gate_stride + col0 + bj * HALF + n * 16);
#pragma unroll
        for (int ai = 0; ai < 2; ++ai)
#pragma unroll
            for (int m = 0; m < 4; ++m) { const size_t off = (size_t)(u.pm * BM + ai * HALF + wr * 64 + m * 16 + fr) * 1024 + col0;
#pragma unroll
                for (int bj = 0; bj < 2; ++bj)
#pragma unroll
                    for (int n = 0; n < 2; ++n) { const f32x4 xs = *(const f32x4*)(x + off + bj * HALF + n * 16);
                        *(f32x4*)(out + off + bj * HALF + n * 16) = xs + gv[bj][n] * acc[ai][bj][m][n]; } }
    }
};

template <class Epi, class Sched, bool ALIGN_EPI = false, bool SP2 = false>
__device__ __forceinline__ void gemm_phase(PG8_LAS unsigned char* lds, const Gemm g, const Sched& S, const Epi& E) {
    const int tid = threadIdx.x, wid = __builtin_amdgcn_readfirstlane(tid >> 6), lane = tid & 63, wr = wid >> 2, wc = wid & 3, fr = lane & 15, fq = lane >> 4;
    const int K = g.K, nt = K / BK;
    unsigned voffA[2], voffB[2];
#pragma unroll
    for (int i = 0; i < 2; ++i) { int R, C; stage_rc(tid * 16 + i * 8192, R, C); const int Rb = Epi::PERM ? ((R & ~31) + perm32(R & 31)) : R;
        voffA[i] = (unsigned)(R * K + C) * 2u; voffB[i] = (unsigned)(Rb * K + C) * 2u; }
    const size_t kstep = (size_t)(BK * 2);
    const size_t hstep = (size_t)HALF * K * 2;
    const size_t tstep = 2 * hstep;
    const unsigned ldsw = (unsigned)wid * 1024u;
    const int aoff = lds_byte(wr * 64 + fr, fq * 8), boff = lds_byte(wc * 32 + fr, fq * 8);
#define PG8_SA(b, h) (((b) * 2 + (h)) * HTB)
#define PG8_SB(b, h) ((4 + (b) * 2 + (h)) * HTB)
#define PG8_STAGE(bufoff, gbase, voff) do { _Pragma("unroll") for (int _i = 0; _i < 2; ++_i) \
        __builtin_amdgcn_global_load_lds((const unsigned*)((const char*)(gbase) + (voff)[_i]), (PG8_LAS unsigned*)(lds + (bufoff) + ldsw + _i * 8192), 16, 0, 0); } while (0)
#define PG8_LDA(dst, b, h) do { _Pragma("unroll") for (int m = 0; m < 4; ++m) _Pragma("unroll") for (int k = 0; k < 2; ++k) dst[m][k] = *(const PG8_LAS bf16x8*)(lds + PG8_SA(b, h) + aoff + m * 2048 + k * 1024); } while (0)
#define PG8_LDB(dst, b, h) do { _Pragma("unroll") for (int n = 0; n < 2; ++n) _Pragma("unroll") for (int k = 0; k < 2; ++k) dst[n][k] = *(const PG8_LAS bf16x8*)(lds + PG8_SB(b, h) + boff + n * 2048 + k * 1024); } while (0)
#define PG8_MMA(ai, bj, At, Bt) do { __builtin_amdgcn_s_setprio(1); _Pragma("unroll") for (int m = 0; m < 4; ++m) _Pragma("unroll") for (int n = 0; n < 2; ++n) _Pragma("unroll") for (int k = 0; k < 2; ++k) \
        acc[ai][bj][m][n] = __builtin_amdgcn_mfma_f32_16x16x32_f16(Bt[n][k], At[m][k], acc[ai][bj][m][n], 0, 0, 0); __builtin_amdgcn_s_setprio(0); } while (0)
#define PG8_WAIT_V(n) asm volatile("s_waitcnt vmcnt(" #n ")" ::: "memory")
#define PG8_WAIT_L(n) asm volatile("s_waitcnt lgkmcnt(" #n ")" ::: "memory")
#define PG8_BAR __builtin_amdgcn_s_barrier()
#define PG8_SCHED __builtin_amdgcn_sched_barrier(0)
    Unit cur, nxt; int ui = 0;
    if (!S.next(0, cur)) return;
    f32x4 acc[2][2][4][2];
#pragma unroll
    for (int a = 0; a < 2; ++a)
#pragma unroll
        for (int b = 0; b < 2; ++b)
#pragma unroll
            for (int m = 0; m < 4; ++m)
#pragma unroll
                for (int n = 0; n < 2; ++n) acc[a][b][m][n] = (f32x4){0.f, 0.f, 0.f, 0.f};
    bf16x8 At[4][2], B0[2][2], B1[2][2];
    const char* cA = (const char*)g.A + (size_t)cur.pm * tstep; const char* cB = (const char*)g.Bt + (size_t)cur.pn * tstep;
    S.a_ready(cur);
    if constexpr (SP2) {
        PG8_STAGE(PG8_SB(0, 0), cB, voffB); PG8_STAGE(PG8_SB(0, 1), cB + hstep, voffB); PG8_STAGE(PG8_SA(0, 0), cA, voffA); PG8_STAGE(PG8_SA(0, 1), cA + hstep, voffA);
        if (wr == 1) PG8_BAR;
        PG8_WAIT_V(2); PG8_BAR;
        PG8_STAGE(PG8_SB(1, 0), cB + kstep, voffB); PG8_STAGE(PG8_SA(1, 0), cA + kstep, voffA); PG8_STAGE(PG8_SB(1, 1), cB + hstep + kstep, voffB);
        PG8_WAIT_V(6); PG8_BAR;
    } else {
        PG8_STAGE(PG8_SB(0, 0), cB, voffB); PG8_STAGE(PG8_SA(0, 0), cA, voffA); PG8_STAGE(PG8_SB(0, 1), cB + hstep, voffB); PG8_STAGE(PG8_SA(0, 1), cA + hstep, voffA);
        if (wr == 1) PG8_BAR;
        PG8_WAIT_V(4); PG8_BAR;
        PG8_STAGE(PG8_SB(1, 0), cB + kstep, voffB); PG8_STAGE(PG8_SA(1, 0), cA + kstep, voffA); PG8_STAGE(PG8_SB(1, 1), cB + hstep + kstep, voffB);
        PG8_WAIT_V(6); PG8_BAR;
    }
    for (;;) {
        const bool has_next = S.next(ui + 1, nxt);
        const char* nA = has_next ? (const char*)g.A + (size_t)nxt.pm * tstep : cA; const char* nB = has_next ? (const char*)g.Bt + (size_t)nxt.pn * tstep : cB;
        for (int t = 0; t < nt; t += 2) {
            const bool last = (t == nt - 2);
            const char* a1 = cA + (size_t)(t + 1) * kstep;
            const char* a2 = last ? nA : cA + (size_t)(t + 2) * kstep; const char* b2 = last ? nB : cB + (size_t)(t + 2) * kstep;
            const char* a3 = a2 + kstep; const char* b3 = b2 + kstep;
            if (last && has_next) S.a_ready(nxt);
            if constexpr (SP2) {
            PG8_LDB(B0, 0, 0); PG8_LDB(B1, 0, 1); PG8_SCHED; PG8_LDA(At, 0, 0); PG8_STAGE(PG8_SA(1, 1), a1 + hstep, voffA);
            PG8_WAIT_V(8); PG8_WAIT_L(0); PG8_BAR; PG8_MMA(0, 0, At, B0); PG8_MMA(0, 1, At, B1); PG8_BAR; PG8_SCHED;
            PG8_LDA(At, 0, 1); PG8_STAGE(PG8_SB(0, 0), b2, voffB); PG8_STAGE(PG8_SB(0, 1), b2 + hstep, voffB); PG8_STAGE(PG8_SA(0, 0), a2, voffA);
            PG8_WAIT_V(8); PG8_WAIT_L(0); PG8_BAR; PG8_MMA(1, 0, At, B0); PG8_MMA(1, 1, At, B1); PG8_BAR; PG8_SCHED;
            PG8_LDB(B0, 1, 0); PG8_LDB(B1, 1, 1); PG8_SCHED; PG8_LDA(At, 1, 0); PG8_STAGE(PG8_SA(0, 1), a2 + hstep, voffA);
            PG8_WAIT_V(8); PG8_WAIT_L(0); PG8_BAR; PG8_MMA(0, 0, At, B0); PG8_MMA(0, 1, At, B1); PG8_BAR; PG8_SCHED;
            PG8_LDA(At, 1, 1); PG8_STAGE(PG8_SB(1, 0), b3, voffB); PG8_STAGE(PG8_SB(1, 1), b3 + hstep, voffB); PG8_STAGE(PG8_SA(1, 0), a3, voffA);
            PG8_WAIT_V(8); PG8_WAIT_L(0); PG8_BAR; PG8_MMA(1, 0, At, B0); PG8_MMA(1, 1, At, B1); PG8_BAR; PG8_SCHED;
            } else {
            PG8_LDB(B0, 0, 0); PG8_SCHED; PG8_LDA(At, 0, 0); PG8_STAGE(PG8_SA(1, 1), a1 + hstep, voffA);
            PG8_WAIT_L(8); PG8_BAR; PG8_WAIT_L(0); PG8_MMA(0, 0, At, B0); PG8_BAR; PG8_SCHED;
            PG8_LDB(B1, 0, 1); PG8_STAGE(PG8_SB(0, 0), b2, voffB);
            PG8_BAR; PG8_WAIT_L(0); PG8_MMA(0, 1, At, B1); PG8_BAR;
            PG8_LDA(At, 0, 1); PG8_STAGE(PG8_SA(0, 0), a2, voffA);
            PG8_BAR; PG8_WAIT_L(0); PG8_MMA(1, 0, At, B0); PG8_BAR; PG8_SCHED;
            PG8_STAGE(PG8_SB(0, 1), b2 + hstep, voffB);
            PG8_WAIT_V(6); PG8_BAR; PG8_MMA(1, 1, At, B1); PG8_BAR;
            PG8_LDB(B0, 1, 0); PG8_SCHED; PG8_LDA(At, 1, 0); PG8_STAGE(PG8_SA(0, 1), a2 + hstep, voffA);
            PG8_WAIT_L(8); PG8_BAR; PG8_WAIT_L(0); PG8_MMA(0, 0, At, B0); PG8_BAR; PG8_SCHED;
            PG8_LDB(B1, 1, 1); PG8_STAGE(PG8_SB(1, 0), b3, voffB);
            PG8_BAR; PG8_WAIT_L(0); PG8_MMA(0, 1, At, B1); PG8_BAR;
            PG8_LDA(At, 1, 1); PG8_STAGE(PG8_SA(1, 0), a3, voffA);
            PG8_BAR; PG8_WAIT_L(0); PG8_MMA(1, 0, At, B0); PG8_BAR; PG8_SCHED;
            PG8_STAGE(PG8_SB(1, 1), b3 + hstep, voffB);
            PG8_WAIT_V(6); PG8_BAR; PG8_MMA(1, 1, At, B1); PG8_BAR;
            }
        }
        if constexpr (ALIGN_EPI) { if (wr == 0) PG8_BAR; }
        if constexpr (!Epi::AFTER_DRAIN) { E(acc, cur, wr, wc, fr, fq); S.done(cur); }
        if (!has_next) break;
#pragma unroll
        for (int a = 0; a < 2; ++a)
#pragma unroll
            for (int b = 0; b < 2; ++b)
#pragma unroll
                for (int m = 0; m < 4; ++m)
#pragma unroll
                    for (int n = 0; n < 2; ++n) acc[a][b][m][n] = (f32x4){0.f, 0.f, 0.f, 0.f};
        cur = nxt; cA = nA; cB = nB; ++ui;
        if constexpr (ALIGN_EPI) { if (wr == 1) PG8_BAR; }
    }
    PG8_WAIT_V(0);
    if constexpr (!ALIGN_EPI) { if (wr == 0) PG8_BAR; }
    PG8_BAR;
    if constexpr (Epi::AFTER_DRAIN) { E.fused(acc, cur, wr, wc, fr, fq, lds, wid, lane); S.done(cur); }
#undef PG8_SA
#undef PG8_SB
#undef PG8_STAGE
#undef PG8_LDA
#undef PG8_LDB
#undef PG8_MMA
#undef PG8_WAIT_V
#undef PG8_WAIT_L
#undef PG8_BAR
#undef PG8_SCHED
}
}

namespace att {
using h16x8 = __attribute__((ext_vector_type(8))) _Float16;
using s16x4 = __attribute__((ext_vector_type(4))) short;
using f32x16 = __attribute__((ext_vector_type(16))) float;
using u32x4 = __attribute__((ext_vector_type(4))) unsigned;
typedef float f32x2_t __attribute__((ext_vector_type(2))); typedef _Float16 f16x2_t __attribute__((ext_vector_type(2)));
constexpr int NW = 8, QBLK = 32, KVBLK = 64, QB = 256, ASEQ = 8192;
constexpr int LDQ = 768, LDK = 1024, LDV = 512;
constexpr float SCALE = 0.10206207261596575f;
constexpr float THR = 8.f;
constexpr int SHM_K = KVBLK * 256, SHM_V = KVBLK * 64 * 2;
constexpr int LDS_ATT = 2 * SHM_V + 2 * SHM_K + NW * 64 * 4;
#define KSWZ(row, colB) ((row) * 256 + ((colB) ^ (((row) & 7) << 4)))
#define SBAR() __builtin_amdgcn_sched_barrier(0)
__device__ __forceinline__ int crow(int r, int hi) { return (r & 3) + 8 * (r >> 2) + 4 * hi; }
__device__ __forceinline__ unsigned cvtpk(float lo, float hi) { const f16x2_t v = __builtin_convertvector((f32x2_t){lo, hi}, f16x2_t); return __builtin_bit_cast(unsigned, v); }

__device__ __forceinline__ void partialSM(f32x16& p0, f32x16& p1, float& m_reg, float& mn, float& alpha) {
  constexpr float C = SCALE * 1.4426950408889634f;
  float pmax = p0[0];
#pragma unroll
  for (int r = 1; r < 16; ++r) pmax = fmaxf(pmax, p0[r]);
#pragma unroll
  for (int r = 0; r < 16; ++r) pmax = fmaxf(pmax, p1[r]);
  { auto rr = __builtin_amdgcn_permlane32_swap(__float_as_uint(pmax), __float_as_uint(pmax), false, false);
    pmax = fmaxf(__uint_as_float(rr[0]), __uint_as_float(rr[1])); }
  if (__builtin_expect(__all(pmax - m_reg <= THR / SCALE), 1)) { mn = m_reg; alpha = 1.f; }
  else { mn = fmaxf(m_reg, pmax); alpha = __builtin_amdgcn_exp2f((m_reg - mn) * C); m_reg = mn; }
  const float mnC = -mn * C;
#pragma unroll
  for (int r = 0; r < 16; ++r) p0[r] = fmaf(p0[r], C, mnC);
#pragma unroll
  for (int r = 0; r < 16; ++r) p1[r] = fmaf(p1[r], C, mnC);
#pragma unroll
  for (int r = 0; r < 16; ++r) p0[r] = __builtin_amdgcn_exp2f(p0[r]);
}
__device__ __forceinline__ void finishSM(f32x16& p0, f32x16& p1, float alpha, float& l_reg, h16x8& pa0, h16x8& pa1, h16x8& pa2, h16x8& pa3) {
#pragma unroll
  for (int r = 0; r < 16; ++r) p1[r] = __builtin_amdgcn_exp2f(p1[r]);
  float ps = 0;
#pragma unroll
  for (int r = 0; r < 16; ++r) ps += p0[r];
#pragma unroll
  for (int r = 0; r < 16; ++r) ps += p1[r];
  { auto rr = __builtin_amdgcn_permlane32_swap(__float_as_uint(ps), __float_as_uint(ps), false, false);
    ps = __uint_as_float(rr[0]) + __uint_as_float(rr[1]); }
  l_reg = l_reg * alpha + ps;
#define PK4(P, BASE, OUT) do { unsigned a0 = cvtpk(P[BASE + 0], P[BASE + 1]), a1 = cvtpk(P[BASE + 2], P[BASE + 3]);   \
    unsigned b0 = cvtpk(P[BASE + 4], P[BASE + 5]), b1 = cvtpk(P[BASE + 6], P[BASE + 7]);                              \
    auto r0 = __builtin_amdgcn_permlane32_swap(a0, b0, false, false); auto r1 = __builtin_amdgcn_permlane32_swap(a1, b1, false, false); \
    u32x4 w = {r0[0], r1[0], r0[1], r1[1]}; OUT = __builtin_bit_cast(h16x8, w); } while (0)
  PK4(p0, 0, pa0); PK4(p0, 8, pa1); PK4(p1, 0, pa2); PK4(p1, 8, pa3);
#undef PK4
}
__device__ __forceinline__ void qkt(f32x16& p0, f32x16& p1, const char* Ks, const h16x8* qr, int r32, int hi) {
  p0 = f32x16{}; p1 = f32x16{};
#pragma unroll
  for (int d0 = 0; d0 < 6; ++d0) { const int cb = (d0 * 16 + hi * 8) * 2;
    const h16x8 b0 = *reinterpret_cast<const h16x8*>(Ks + KSWZ(r32, cb));
    const h16x8 b1 = *reinterpret_cast<const h16x8*>(Ks + KSWZ(32 + r32, cb));
    p0 = __builtin_amdgcn_mfma_f32_32x32x16_f16(b0, qr[d0], p0, 0, 0, 0);
    p1 = __builtin_amdgcn_mfma_f32_32x32x16_f16(b1, qr[d0], p1, 0, 0, 0); }
}
__device__ __forceinline__ void cmask(f32x16& p0, f32x16& p1, int jb, int qrel, int hi) {
  const float NEG = -INFINITY; const int kb = 64 * jb + 4 * hi;
#pragma unroll
  for (int r = 0; r < 16; ++r) { const int kv = kb + (r & 3) + 8 * (r >> 2); if (kv > qrel) p0[r] = NEG; if (kv + 32 > qrel) p1[r] = NEG; }
}
__device__ __forceinline__ int v_st(int k, int c) { const int kk = (k & ~0xC) | ((k & 4) << 1) | ((k & 8) >> 1); return ((kk >> 3) * 2 + (c >> 5)) * 512 + ((kk & 7) * 32 + (c & 31)) * 2; }
__device__ __forceinline__ int v_rd_base(int lane) { return ((lane & 3) << 3) | (((lane >> 2) & 3) << 6) | (((lane >> 4) & 1) << 5) | (((lane >> 5) & 1) << 8); }
constexpr int v_rd_off(int d0, int ks, int half) { return d0 * 512 + ks * 2048 + half * 1024; }
template <int OFF> __device__ __forceinline__ s16x4 tr_read(int vb) {
  s16x4 r; asm volatile("ds_read_b64_tr_b16 %0, %1 offset:%2" : "=&v"(r) : "v"(vb), "i"(OFF) : "memory"); return r;
}
template <int D0> __device__ __forceinline__ void pv_one(f32x16& od, int vb, h16x8 pa0, h16x8 pa1, h16x8 pa2, h16x8 pa3) {
  const s16x4 l0 = tr_read<v_rd_off(D0, 0, 0)>(vb), h0 = tr_read<v_rd_off(D0, 0, 1)>(vb), l1 = tr_read<v_rd_off(D0, 1, 0)>(vb), h1 = tr_read<v_rd_off(D0, 1, 1)>(vb);
  const s16x4 l2 = tr_read<v_rd_off(D0, 2, 0)>(vb), h2 = tr_read<v_rd_off(D0, 2, 1)>(vb), l3 = tr_read<v_rd_off(D0, 3, 0)>(vb), h3 = tr_read<v_rd_off(D0, 3, 1)>(vb);
  asm volatile("s_waitcnt lgkmcnt(0)" ::: "memory"); SBAR();
#define PK(L, H) __builtin_bit_cast(h16x8, (__attribute__((ext_vector_type(8))) short){L[0], L[1], L[2], L[3], H[0], H[1], H[2], H[3]})
  od = __builtin_amdgcn_mfma_f32_32x32x16_f16(pa0, PK(l0, h0), od, 0, 0, 0);
  od = __builtin_amdgcn_mfma_f32_32x32x16_f16(pa1, PK(l1, h1), od, 0, 0, 0);
  od = __builtin_amdgcn_mfma_f32_32x32x16_f16(pa2, PK(l2, h2), od, 0, 0, 0);
  od = __builtin_amdgcn_mfma_f32_32x32x16_f16(pa3, PK(l3, h3), od, 0, 0, 0);
#undef PK
}
__device__ __forceinline__ void pv_d0(f32x16* o, int vb, h16x8 pa0, h16x8 pa1, h16x8 pa2, h16x8 pa3) {
  pv_one<0>(o[0], vb, pa0, pa1, pa2, pa3); pv_one<1>(o[1], vb, pa0, pa1, pa2, pa3);
}

__device__ __forceinline__ void attn_unit(int b, int h, int qb, const unsigned short* __restrict__ Q, const unsigned short* __restrict__ K, const unsigned short* __restrict__ V,
                                          const unsigned short* __restrict__ PROJ, int ldp, int zcol0, unsigned short* __restrict__ YCAT, char* lds) {
  const int tid = threadIdx.x, wid = tid >> 6, lane = tid & 63, r32 = lane & 31, hi = lane >> 5;
  char* V_lds = lds; char* K_lds = lds + 2 * SHM_V;
  float* ws = (float*)(lds + 2 * SHM_V + 2 * SHM_K) + wid * 64; float* li_l = ws; float* al_l = ws + 32;
  const long rowbase = (long)b * ASEQ; const int q0 = qb * QB;
  const unsigned short* Kh = K + rowbase * LDK + h * 128; const unsigned short* Vh = V + rowbase * LDV + h * 64;
  float m_reg = -1e30f, l_reg = 0; f32x16 o[2] = {}; h16x8 qr[6];
  const unsigned short* Qw = Q + (rowbase + q0 + wid * QBLK + r32) * LDQ + h * 96 + hi * 8;
#pragma unroll
  for (int d0 = 0; d0 < 6; ++d0) qr[d0] = *reinterpret_cast<const h16x8*>(Qw + d0 * 16);
  const int sr = tid >> 4, kc = tid & 15; const bool kact = kc < 12;
  const int vr = tid >> 3, vc = (tid & 7) * 8, vst = v_st(vr, vc);
  const int kst0 = KSWZ(sr, kc * 16), kst1 = KSWZ(32 + sr, kc * 16);
  const int vb0 = (int)(uintptr_t)V_lds + v_rd_base(lane);
  struct { h16x8 vs0, ks0, ks1; } sr_[2];
#define SLOAD(i, k0) do { sr_[i].vs0 = *reinterpret_cast<const h16x8*>(&Vh[(long)((k0) + vr) * LDV + vc]); \
    if (kact) { sr_[i].ks0 = *reinterpret_cast<const h16x8*>(&Kh[(long)((k0) + sr) * LDK + kc * 8]); sr_[i].ks1 = *reinterpret_cast<const h16x8*>(&Kh[(long)((k0) + 32 + sr) * LDK + kc * 8]); } } while (0)
#define SWRITE(bb, i) do { *(h16x8*)(V_lds + (bb) * SHM_V + vst) = sr_[i].vs0;          \
    if (kact) { *(h16x8*)(K_lds + (bb) * SHM_K + kst0) = sr_[i].ks0; *(h16x8*)(K_lds + (bb) * SHM_K + kst1) = sr_[i].ks1; } } while (0)
#define SWAIT() asm volatile("s_waitcnt vmcnt(3)" ::: "memory")
#define RESC(a) do { if (__any((a) < 1.f)) { if (hi == 0) al_l[r32] = (a); asm volatile("s_waitcnt lgkmcnt(0)" ::: "memory"); \
    _Pragma("unroll") for (int d = 0; d < 2; ++d) _Pragma("unroll") for (int r = 0; r < 16; ++r) o[d][r] *= al_l[crow(r, hi)]; } } while (0)
  f32x16 pA0, pA1, pB0, pB1; float mnA, mnB, alA, alB; h16x8 pa0, pa1, pa2, pa3;
  const int NT = (q0 + QB) / KVBLK;
  const int qrel = wid * QBLK + r32;
#define CMASK(P0, P1, t) do { const int jb_ = (t) - (NT - 4); if (jb_ >= 0) cmask(P0, P1, jb_, qrel, hi); } while (0)
  constexpr int SE = 0, SO = 1;
  SLOAD(SE, 0); asm volatile("s_waitcnt vmcnt(0)" ::: "memory"); SWRITE(0, SE); __syncthreads();
  qkt(pA0, pA1, K_lds, qr, r32, hi); CMASK(pA0, pA1, 0); partialSM(pA0, pA1, m_reg, mnA, alA);
  SLOAD(SO, KVBLK); if (2 < NT) SLOAD(SE, 2 * KVBLK);
  SWAIT(); SWRITE(1, SO); __syncthreads();
  for (int j = 1; j + 1 < NT; j += 2) {
    SBAR(); qkt(pB0, pB1, K_lds + SHM_K, qr, r32, hi); CMASK(pB0, pB1, j);
    finishSM(pA0, pA1, alA, l_reg, pa0, pa1, pa2, pa3); SBAR();
    SLOAD(SO, (j + 2) * KVBLK); SBAR();
    pv_d0(o, vb0, pa0, pa1, pa2, pa3); partialSM(pB0, pB1, m_reg, mnB, alB);
    __syncthreads(); SWAIT(); SWRITE(0, SE);
    RESC(alB); __syncthreads();
    SBAR(); qkt(pA0, pA1, K_lds, qr, r32, hi); CMASK(pA0, pA1, j + 1);
    finishSM(pB0, pB1, alB, l_reg, pa0, pa1, pa2, pa3); SBAR();
    if (j + 3 < NT) SLOAD(SE, (j + 3) * KVBLK); SBAR();
    pv_d0(o, vb0 + SHM_V, pa0, pa1, pa2, pa3); partialSM(pA0, pA1, m_reg, mnA, alA);
    __syncthreads(); SWAIT(); SWRITE(1, SO);
    RESC(alA); __syncthreads();
  }
  SBAR(); qkt(pB0, pB1, K_lds + SHM_K, qr, r32, hi); CMASK(pB0, pB1, NT - 1);
  finishSM(pA0, pA1, alA, l_reg, pa0, pa1, pa2, pa3); SBAR();
  pv_d0(o, vb0, pa0, pa1, pa2, pa3); partialSM(pB0, pB1, m_reg, mnB, alB);
  __syncthreads(); RESC(alB);
  finishSM(pB0, pB1, alB, l_reg, pa0, pa1, pa2, pa3); SBAR();
  pv_d0(o, vb0 + SHM_V, pa0, pa1, pa2, pa3);
  if (hi == 0) li_l[r32] = l_reg; asm volatile("s_waitcnt lgkmcnt(0)" ::: "memory");
  float rli[16];
#pragma unroll
  for (int r = 0; r < 16; ++r) rli[r] = __builtin_amdgcn_rcpf(li_l[crow(r, hi)]);
  const long orow0 = rowbase + q0 + wid * QBLK;
#pragma unroll
  for (int r = 0; r < 16; ++r) { const long row = orow0 + crow(r, hi);
#pragma unroll
    for (int d0 = 0; d0 < 2; ++d0) { const int col = h * 64 + d0 * 32 + r32;
      const float z = (float)__builtin_bit_cast(_Float16, PROJ[row * ldp + zcol0 + col]);
      const float g = z * __builtin_amdgcn_rcpf(1.f + __builtin_amdgcn_exp2f(-1.4426950408889634f * z));
      YCAT[row * 1024 + 512 + col] = __builtin_bit_cast(unsigned short, (_Float16)(o[d0][r] * rli[r] * g)); } }
  __syncthreads();
#undef SLOAD
#undef SWRITE
#undef SWAIT
#undef RESC
#undef CMASK
}
#undef KSWZ
#undef SBAR
}

namespace ssm {
using h16x8 = __attribute__((ext_vector_type(8))) _Float16;
using f32x16 = __attribute__((ext_vector_type(16))) float;
using f32x4v = __attribute__((ext_vector_type(4))) float;
typedef float f32x2_t __attribute__((ext_vector_type(2))); typedef _Float16 f16x2_t __attribute__((ext_vector_type(2)));
constexpr int SEGLEN = 256, NSEG = 32, TILE = 32, SPITCH = 272;
constexpr int LDS_PER_WAVE = TILE * SPITCH;
__device__ __forceinline__ unsigned pkh(float lo, float hi) { const f16x2_t v = __builtin_convertvector((f32x2_t){lo, hi}, f16x2_t); return __builtin_bit_cast(unsigned, v); }
__device__ __forceinline__ float gelu_t(float v) { const float z = 0.7978845608028654f * (v + 0.044715f * v * v * v); return v * __builtin_amdgcn_rcpf(1.f + __builtin_amdgcn_exp2f(-2.885390081777927f * z)); }

template <bool FIX>
__device__ __forceinline__ void scan_block(f32x16& R, f32x16& I, float ar, float ai, float& cr, float& ci, bool h0) {
  const float a2r = ar * ar - ai * ai, a2i = 2.f * ar * ai;
  const float a3r = a2r * ar - a2i * ai, a3i = a2r * ai + a2i * ar;
  const float a4r = a2r * a2r - a2i * a2i, a4i = 2.f * a2r * a2i;
  float er[4], ei[4];
#pragma unroll
  for (int gi = 0; gi < 4; ++gi) {
    float xr = R[4 * gi], xi = I[4 * gi];
#pragma unroll
    for (int i = 1; i < 4; ++i) { const float nr = ar * xr - ai * xi + R[4 * gi + i], ni = ar * xi + ai * xr + I[4 * gi + i]; xr = nr; xi = ni; R[4 * gi + i] = xr; I[4 * gi + i] = xi; }
    er[gi] = xr; ei[gi] = xi;
  }
  float oer[4], oei[4];
#pragma unroll
  for (int gi = 0; gi < 4; ++gi) { oer[gi] = __shfl_xor(er[gi], 32); oei[gi] = __shfl_xor(ei[gi], 32); }
  float Er = cr, Ei = ci, inr[4], ini[4];
#pragma unroll
  for (int k = 0; k < 8; ++k) { const int gi = k >> 1; const bool own = ((k & 1) == 0) ? h0 : !h0;
    if ((k & 1) == 0) { inr[gi] = Er; ini[gi] = Ei; } else { inr[gi] = h0 ? inr[gi] : Er; ini[gi] = h0 ? ini[gi] : Ei; }
    const float gr = own ? er[gi] : oer[gi], gim = own ? ei[gi] : oei[gi];
    const float nr = a4r * Er - a4i * Ei + gr, ni = a4r * Ei + a4i * Er + gim; Er = nr; Ei = ni; }
  cr = Er; ci = Ei;
  if (FIX) {
#pragma unroll
    for (int gi = 0; gi < 4; ++gi) { const float sr = inr[gi], si = ini[gi];
      R[4 * gi + 0] += ar * sr - ai * si;   I[4 * gi + 0] += ar * si + ai * sr;
      R[4 * gi + 1] += a2r * sr - a2i * si; I[4 * gi + 1] += a2r * si + a2i * sr;
      R[4 * gi + 2] += a3r * sr - a3i * si; I[4 * gi + 2] += a3r * si + a3i * sr;
      R[4 * gi + 3] += a4r * sr - a4i * si; I[4 * gi + 3] += a4r * si + a4i * sr; }
  }
}

struct Consts { const float* AC; const unsigned short* BB; const unsigned short* CB; const float* dskip; };

template <bool OUT>
__device__ __forceinline__ void ssm_pass(int b, int g, int seg, const unsigned short* __restrict__ PROJ, int ldp, int ucol0, const Consts& C, float* __restrict__ E,
                                         unsigned short* __restrict__ YPRE, char* slds) {
  const int lane = threadIdx.x & 63, c = lane & 31, hi = lane >> 5; const bool h0 = hi == 0;
  const int bg = b * 32 + g;
  const f32x4v ac0 = *(const f32x4v*)(C.AC + ((size_t)g * 64 + c) * 4), ac1 = *(const f32x4v*)(C.AC + ((size_t)g * 64 + 32 + c) * 4);
  h16x8 bb[4];
#pragma unroll
  for (int q = 0; q < 4; ++q) bb[q] = *(const h16x8*)(C.BB + (((size_t)g * 4 + q) * 64 + lane) * 8);
  float s0r = 0.f, s0i = 0.f, s1r = 0.f, s1i = 0.f;
  if (OUT) {
    for (int k = 0; k < seg; ++k) { const f32x2_t e0 = *(const f32x2_t*)(E + (((size_t)bg * NSEG + k) * 64 + c) * 2), e1 = *(const f32x2_t*)(E + (((size_t)bg * NSEG + k) * 64 + 32 + c) * 2);
      float nr = ac0[2] * s0r - ac0[3] * s0i + e0[0], ni = ac0[2] * s0i + ac0[3] * s0r + e0[1]; s0r = nr; s0i = ni;
      nr = ac1[2] * s1r - ac1[3] * s1i + e1[0]; ni = ac1[2] * s1i + ac1[3] * s1r + e1[1]; s1r = nr; s1i = ni; }
  }
  h16x8 cb[4]; float dsk = 0.f;
  if (OUT) {
#pragma unroll
    for (int ks = 0; ks < 4; ++ks) cb[ks] = *(const h16x8*)(C.CB + (((size_t)g * 4 + ks) * 64 + lane) * 8);
    dsk = C.dskip[g * 16 + (lane & 15)];
  }
  const size_t tok0 = (size_t)b * 8192 + (size_t)seg * SEGLEN;
  const unsigned short* up = PROJ + (tok0 + c) * ldp + ucol0 + g * 16 + hi * 8;
  h16x8 ua = *(const h16x8*)up;
  for (int tile = 0; tile < SEGLEN / TILE; ++tile) {
    h16x8 un = ua; if (tile + 1 < SEGLEN / TILE) un = *(const h16x8*)(up + (size_t)(tile + 1) * TILE * ldp);
    f32x16 R0 = __builtin_amdgcn_mfma_f32_32x32x16_f16(ua, bb[0], f32x16{}, 0, 0, 0);
    f32x16 I0 = __builtin_amdgcn_mfma_f32_32x32x16_f16(ua, bb[1], f32x16{}, 0, 0, 0);
    f32x16 R1 = __builtin_amdgcn_mfma_f32_32x32x16_f16(ua, bb[2], f32x16{}, 0, 0, 0);
    f32x16 I1 = __builtin_amdgcn_mfma_f32_32x32x16_f16(ua, bb[3], f32x16{}, 0, 0, 0);
    scan_block<OUT>(R0, I0, ac0[0], ac0[1], s0r, s0i, h0);
    scan_block<OUT>(R1, I1, ac1[0], ac1[1], s1r, s1i, h0);
    if (OUT) {
#pragma unroll
      for (int r = 0; r < 16; ++r) { const int t = (r & 3) + 8 * (r >> 2) + 4 * hi;
        *(unsigned*)(slds + t * SPITCH + c * 4) = pkh(R0[r], I0[r]); *(unsigned*)(slds + t * SPITCH + (32 + c) * 4) = pkh(R1[r], I1[r]); }
      asm volatile("s_waitcnt lgkmcnt(0)" ::: "memory");
      f32x4v y0 = {0.f, 0.f, 0.f, 0.f}, y1 = {0.f, 0.f, 0.f, 0.f};
#pragma unroll
      for (int ks = 0; ks < 4; ++ks) {
        const h16x8 a0 = *(const h16x8*)(slds + (lane & 15) * SPITCH + ks * 64 + (lane >> 4) * 16);
        const h16x8 a1 = *(const h16x8*)(slds + (16 + (lane & 15)) * SPITCH + ks * 64 + (lane >> 4) * 16);
        y0 = __builtin_amdgcn_mfma_f32_16x16x32_f16(a0, cb[ks], y0, 0, 0, 0);
        y1 = __builtin_amdgcn_mfma_f32_16x16x32_f16(a1, cb[ks], y1, 0, 0, 0); }
      asm volatile("s_waitcnt lgkmcnt(0)" ::: "memory");
      const int i = lane & 15, q = lane >> 4; const size_t trow = tok0 + (size_t)tile * TILE;
#pragma unroll
      for (int reg = 0; reg < 4; ++reg) {
        const size_t r0 = trow + 4 * q + reg, r1 = r0 + 16;
        const float u0 = (float)__builtin_bit_cast(_Float16, PROJ[r0 * ldp + ucol0 + g * 16 + i]), u1 = (float)__builtin_bit_cast(_Float16, PROJ[r1 * ldp + ucol0 + g * 16 + i]);
        YPRE[r0 * 512 + g * 16 + i] = __builtin_bit_cast(unsigned short, (_Float16)gelu_t(y0[reg] + dsk * u0));
        YPRE[r1 * 512 + g * 16 + i] = __builtin_bit_cast(unsigned short, (_Float16)gelu_t(y1[reg] + dsk * u1)); }
    }
    ua = un;
  }
  if (!OUT) { if (h0) { *(f32x2_t*)(E + (((size_t)bg * NSEG + seg) * 64 + c) * 2) = (f32x2_t){s0r, s0i}; *(f32x2_t*)(E + (((size_t)bg * NSEG + seg) * 64 + 32 + c) * 2) = (f32x2_t){s1r, s1i}; } }
}
}

#define GAS __attribute__((address_space(1)))
#define LAS __attribute__((address_space(3)))
typedef unsigned v4u __attribute__((ext_vector_type(4)));
typedef float f32x4 __attribute__((ext_vector_type(4)));
typedef short bf16x8 __attribute__((ext_vector_type(8)));
typedef GAS unsigned gu32;
typedef GAS unsigned long long gu64;
#define RLX_AGENT __ATOMIC_RELAXED, __HIP_MEMORY_SCOPE_AGENT
#define LDS_WAIT() asm volatile("s_waitcnt lgkmcnt(0)" ::: "memory")
#define VM_WAIT() asm volatile("s_waitcnt vmcnt(0)" ::: "memory")
__device__ __forceinline__ unsigned long long rt() { return __builtin_amdgcn_s_memrealtime(); }

#define XB_TMO      128
#define XB_XCNT(j)  (256  + 64 * (j))
#define XB_XSUB(j)  (1280 + 64 * (j))
#define XB_XGEN(j)  (2304 + 64 * (j))
#define XB_TOP      3328
#define XB_TOPGEN   3392
#define XCD_BAR_WORDS 3456
#define XB_SPIN_CAP (1u << 18)

__device__ __forceinline__ unsigned xb_ld(unsigned* p)              { return __hip_atomic_load(p, __ATOMIC_RELAXED, __HIP_MEMORY_SCOPE_AGENT); }
__device__ __forceinline__ unsigned xb_add(unsigned* p, unsigned v) { return __hip_atomic_fetch_add(p, v, __ATOMIC_RELAXED, __HIP_MEMORY_SCOPE_AGENT); }
__device__ __forceinline__ unsigned xb_xcc_id() { return (unsigned)__builtin_amdgcn_s_getreg((3 << 11) | 20) & 0xFu; }
#define XB_SPIN(cond, bar) do { unsigned _sp = 0; while (cond) { __builtin_amdgcn_s_sleep(1); \
    if ((++_sp & 255u) == 0u) { if (xb_ld(&(bar)[XB_TMO])) break; if (_sp > XB_SPIN_CAP) { atomicAdd(&(bar)[XB_TMO], 1u); break; } } } } while (0)

struct XcdBarrier {
    unsigned* bar; unsigned x;
    volatile LAS unsigned* st;
};

__device__ __forceinline__ XcdBarrier xcd_barrier_post(unsigned* bar, volatile LAS unsigned* st) {
    XcdBarrier b; b.bar = bar; b.x = xb_xcc_id(); b.st = st;
    if (threadIdx.x == 0) (void)xb_add(&bar[XB_XCNT(b.x)], 1u);
    return b;
}
__device__ __forceinline__ void xcd_barrier_complete(unsigned* bar, unsigned x, unsigned& nloc, unsigned& nx) {
    const unsigned G = gridDim.x * gridDim.y * gridDim.z;
    unsigned sum, cnt, mine, sp = 0u;
    for (;;) {
        sum = 0u; cnt = 0u; mine = 0u;
#pragma unroll
        for (unsigned j = 0; j < 16; ++j) { const unsigned c = xb_ld(&bar[XB_XCNT(j)]); sum += c; cnt += (c > 0u) ? 1u : 0u; mine = (j == x) ? c : mine; }
        if (sum == G) break;
        __builtin_amdgcn_s_sleep(1);
        if ((++sp & 255u) == 0u) { if (xb_ld(&bar[XB_TMO])) break; if (sp > XB_SPIN_CAP) { atomicAdd(&bar[XB_TMO], 1u); break; } }
    }
    nloc = mine > 0u ? mine : 1u; nx = cnt > 0u ? cnt : 1u;
}

__device__ __forceinline__ void xcd_barrier(const XcdBarrier& b) {
    asm volatile("s_waitcnt vmcnt(0)" ::: "memory");
    __syncthreads();
    if (threadIdx.x == 0) {
        unsigned* bar = b.bar;
        __builtin_amdgcn_s_waitcnt(0);
        unsigned nloc = b.st[0], nx = b.st[1];
        if (nloc == 0u) { xcd_barrier_complete(bar, b.x, nloc, nx); b.st[0] = nloc; b.st[1] = nx; }
        const unsigned old = xb_add(&bar[XB_XSUB(b.x)], 1u);
        const unsigned gen = old / nloc;
        if (old + 1u == (gen + 1u) * nloc) {
            __builtin_amdgcn_fence(__ATOMIC_RELEASE, "agent");
            asm volatile("s_waitcnt vmcnt(0)" ::: "memory");
            const unsigned og = xb_add(&bar[XB_TOP], 1u);
            const unsigned tg = og / nx;
            if (og + 1u == (tg + 1u) * nx) xb_add(&bar[XB_TOPGEN], 1u);
            else XB_SPIN(xb_ld(&bar[XB_TOPGEN]) == tg, bar);
            __builtin_amdgcn_fence(__ATOMIC_ACQUIRE, "agent");
            xb_add(&bar[XB_XGEN(b.x)], 1u);
            asm volatile("s_waitcnt vmcnt(0)" ::: "memory");
        } else {
            XB_SPIN(xb_ld(&bar[XB_XGEN(b.x)]) == gen, bar);
            __builtin_amdgcn_fence(__ATOMIC_ACQUIRE, "agent");
            asm volatile("s_waitcnt vmcnt(0)" ::: "memory");
        }
    }
    __syncthreads();
}

constexpr int NWAVES = 8;
constexpr int NPHASE = 9;
constexpr int CW_TMO = 0, CW_CODE = 1, CW_BAR = 4096;
constexpr int RING_OFF = 0, RING_BYTES = 131072;
constexpr int LDSCTL_OFF = RING_BYTES, MISC_OFF = LDSCTL_OFF + 320;
constexpr int LDS_BYTES = 147456;
static_assert(MISC_OFF + 128 <= LDS_BYTES, "LDS map");
static_assert(att::LDS_ATT <= RING_BYTES && NWAVES * ssm::LDS_PER_WAVE <= RING_BYTES && pg8::STAGE_BYTES <= RING_BYTES, "phase scratch fits the ring");

struct Frame {
    LAS unsigned char* lds;
    volatile LAS unsigned* MISC;
    gu32* ctl;
    int tid, lane, wave, vcu, G;
};
__device__ __forceinline__ float wave_sum(float v) {
#pragma unroll
    for (int o = 1; o < 64; o <<= 1) v += __shfl_xor(v, o);
    return v;
}
__device__ __forceinline__ unsigned pk2h(float lo, float hi) { return pg8::cvt_pk_h(lo, hi); }

__device__ __forceinline__ void p0_transpose_item(const float* W, int ldw, int K, int src_n0, bf16* WT, int dst_row0, int k0, LAS float* scr, int lane) {
#pragma unroll 8
    for (int i = 0; i < 32; ++i) { const int kk = 2 * i + (lane >> 5); scr[kk * 33 + (lane & 31)] = W[(size_t)(k0 + kk) * ldw + src_n0 + (lane & 31)]; }
    LDS_WAIT(); asm volatile("" ::: "memory");
    const int c = lane & 7;
#pragma unroll
    for (int j = 0; j < 4; ++j) { const int n = (lane >> 3) + 8 * j; const LAS float* s = scr + (8 * c) * 33 + n;
        v4u o; o.x = pk2h(s[0 * 33], s[1 * 33]); o.y = pk2h(s[2 * 33], s[3 * 33]); o.z = pk2h(s[4 * 33], s[5 * 33]); o.w = pk2h(s[6 * 33], s[7 * 33]);
        *(GAS v4u*)(WT + (size_t)(dst_row0 + n) * K + k0 + 8 * c) = o; }
    LDS_WAIT(); asm volatile("" ::: "memory");
}

struct Args {
    const float* in[24]; float* out; unsigned char* ws; int ph_lo, ph_hi;
};

__device__ __forceinline__ void p0_mod_item(const float* c, const float* w_ada, const float* b_ada, float* mod, int j, int lane) {
    const int kk = lane >> 2, c4 = lane & 3, col = 16 * j + 4 * c4;
    f32x4 a0 = {0.f, 0.f, 0.f, 0.f}, a1 = {0.f, 0.f, 0.f, 0.f};
#pragma unroll 4
    for (int s = 0; s < 64; ++s) { const int k = kk + 16 * s;
        const f32x4 w = *(const GAS f32x4*)(w_ada + (size_t)k * 3072 + col);
        const float c0 = c[k], c1 = c[1024 + k];
        const float s0 = c0 / (1.f + __expf(-c0)), s1 = c1 / (1.f + __expf(-c1));
        a0 += w * s0; a1 += w * s1; }
#pragma unroll
    for (int o = 4; o < 64; o <<= 1) {
#pragma unroll
        for (int e = 0; e < 4; ++e) { a0[e] += __shfl_xor(a0[e], o); a1[e] += __shfl_xor(a1[e], o); } }
    if (lane < 4) { const f32x4 bb = *(const f32x4*)(b_ada + col); *(f32x4*)(mod + col) = a0 + bb; *(f32x4*)(mod + 3072 + col) = a1 + bb; }
}
__device__ __forceinline__ void p0_ssm_item(const float* log_dt, const float* lam_re, const float* lam_im, const float* b_re, const float* b_im, const float* c_re, const float* c_im,
                                            float* AC, bf16* BB, bf16* CB, int g, int lane) {
    const double dt = exp((double)log_dt[g]);
    { const int p = lane; const double lr = lam_re[g * 64 + p], li = lam_im[g * 64 + p];
      const double er = exp(lr * dt), e256 = exp(256.0 * lr * dt);
      f32x4 v; v[0] = (float)(er * cos(li * dt)); v[1] = (float)(er * sin(li * dt)); v[2] = (float)(e256 * cos(256.0 * li * dt)); v[3] = (float)(e256 * sin(256.0 * li * dt));
      *(f32x4*)(AC + ((size_t)g * 64 + p) * 4) = v; }
#pragma unroll
    for (int half = 0; half < 2; ++half) { const int p = half * 32 + (lane & 31), h = lane >> 5;
        const double lr = lam_re[g * 64 + p], li = lam_im[g * 64 + p];
        const double er = exp(lr * dt), ar = er * cos(li * dt), ai = er * sin(li * dt);
        const double nr = ar - 1.0, ni = ai, den = lr * lr + li * li;
        const double cr = (nr * lr + ni * li) / den, ci = (ni * lr - nr * li) / den;
        float vr[8], vi[8];
#pragma unroll
        for (int jj = 0; jj < 8; ++jj) { const double br = b_re[(g * 64 + p) * 16 + 8 * h + jj], bi = b_im[(g * 64 + p) * 16 + 8 * h + jj];
            vr[jj] = (float)(cr * br - ci * bi); vi[jj] = (float)(cr * bi + ci * br); }
        v4u o; o.x = pk2h(vr[0], vr[1]); o.y = pk2h(vr[2], vr[3]); o.z = pk2h(vr[4], vr[5]); o.w = pk2h(vr[6], vr[7]);
        *(v4u*)(BB + (((size_t)g * 4 + 2 * half) * 64 + lane) * 8) = o;
        o.x = pk2h(vi[0], vi[1]); o.y = pk2h(vi[2], vi[3]); o.z = pk2h(vi[4], vi[5]); o.w = pk2h(vi[6], vi[7]);
        *(v4u*)(BB + (((size_t)g * 4 + 2 * half + 1) * 64 + lane) * 8) = o; }
#pragma unroll
    for (int ks = 0; ks < 4; ++ks) { const int i = lane & 15, kg = lane >> 4; float v[8];
#pragma unroll
        for (int j = 0; j < 8; ++j) { const int p = 16 * ks + 4 * kg + (j >> 1); v[j] = (j & 1) ? -c_im[(g * 16 + i) * 64 + p] : c_re[(g * 16 + i) * 64 + p]; }
        v4u o; o.x = pk2h(v[0], v[1]); o.y = pk2h(v[2], v[3]); o.z = pk2h(v[4], v[5]); o.w = pk2h(v[6], v[7]);
        *(v4u*)(CB + (((size_t)g * 4 + ks) * 64 + lane) * 8) = o; }
}

__global__ void __launch_bounds__(NWAVES * 64, 2) mega_fwd(Args args) {
    extern __shared__ __attribute__((aligned(16))) unsigned char lds[];
    Frame F;
    F.lds = (LAS unsigned char*)lds;
    F.MISC = (volatile LAS unsigned*)(F.lds + MISC_OFF);
    F.tid = threadIdx.x; F.lane = F.tid & 63; F.wave = __builtin_amdgcn_readfirstlane(F.tid >> 6);
    F.G = gridDim.x; { const int bx = blockIdx.x; F.vcu = (F.G % 8 == 0) ? (bx % 8) * (F.G / 8) + bx / 8 : bx; }
    unsigned char* ws = args.ws;
    F.ctl = (gu32*)(ws + WS_CTL);
    const float* x = args.in[0]; const float* cvec = args.in[1]; const int* positions = (const int*)args.in[2];
    const float* w_ada = args.in[3]; const float* b_ada = args.in[4]; const float* norm_g = args.in[5]; const float* w_in = args.in[6];
    const float* log_dt = args.in[7]; const float* lam_re = args.in[8]; const float* lam_im = args.in[9]; const float* b_re = args.in[10]; const float* b_im = args.in[11];
    const float* c_re = args.in[12]; const float* c_im = args.in[13]; const float* d_skip = args.in[14]; const float* w_glu = args.in[15]; const float* b_glu = args.in[16];
    const float* q_a_g = args.in[17]; const float* w_q_b = args.in[18]; const float* kv_a_g = args.in[19]; const float* w_kv_b = args.in[20];
    const float* q_norm_g = args.in[21]; const float* k_norm_g = args.in[22]; const float* w_out = args.in[23];
    float* MOD = (float*)(ws + WS_MOD); float* AC = (float*)(ws + WS_AC); bf16* BB = (bf16*)(ws + WS_BB); bf16* CB = (bf16*)(ws + WS_CB); float* EST = (float*)(ws + WS_E);
    bf16* WIN_T = (bf16*)(ws + WS_WIN); bf16* WQ_T = (bf16*)(ws + WS_WQ); bf16* WKV_T = (bf16*)(ws + WS_WKV); bf16* WGLU_T = (bf16*)(ws + WS_WGLU); bf16* WOUT_T = (bf16*)(ws + WS_WOUT);
    bf16* PROJ = (bf16*)(ws + WS_PROJ); bf16* HB = (bf16*)(ws + WS_HB); bf16* QRAW = (bf16*)(ws + WS_HB); bf16* YCAT = (bf16*)(ws + WS_HB);
    bf16* KVRAW = (bf16*)(ws + WS_KVRAW); bf16* Qb = (bf16*)(ws + WS_Q); bf16* Kb = (bf16*)(ws + WS_K); bf16* Vb = (bf16*)(ws + WS_V);
    bf16* CQN = (bf16*)(ws + WS_CQN); bf16* CKVN = (bf16*)(ws + WS_CKVN); bf16* YPRE = (bf16*)(ws + WS_YPRE);

    for (int u = F.tid; u < (LDS_BYTES - LDSCTL_OFF) / 4; u += NWAVES * 64) ((LAS unsigned*)(F.lds + LDSCTL_OFF))[u] = 0u;
    __syncthreads();
    const int lo = args.ph_lo, hi = args.ph_hi;
    const bool multi = (hi - lo) > 1;
    XcdBarrier bar; bar.bar = (unsigned*)(F.ctl + CW_BAR); bar.x = 0; bar.st = nullptr;
    if (multi) bar = xcd_barrier_post((unsigned*)(F.ctl + CW_BAR), F.MISC + 8);
#define IN(k) (lo <= (k) && (k) < hi)
#define SEAM(k) do { if (IN(k) && IN((k) + 1)) xcd_barrier(bar); } while (0)
    const int gw = F.vcu * NWAVES + F.wave, NGW = F.G * NWAVES;

    if (IN(0)) {
        LAS float* scr = (LAS float*)(F.lds + RING_OFF + F.wave * 16384);
        constexpr int I_MOD = 192, I_SSM = 32;
        constexpr int T_U = 256, T_ZS = 256, T_ZM = 256, T_CKV = 128, T_CQ = 192, T_KR = 16, T_WQ = 144, T_WKV = 128, T_WGLU = 128, T_WOUT = 512;
        constexpr int I_TR = T_U + T_ZS + T_ZM + T_CKV + T_CQ + T_KR + T_WQ + T_WKV + T_WGLU + T_WOUT;
        constexpr int I_Z1 = 96, I_Z2 = 256;
        constexpr int NITEMS = I_MOD + I_SSM + I_TR + I_Z1 + I_Z2;
        for (int it = gw; it < NITEMS; it += NGW) {
            int r = it;
            if (r < I_MOD) { p0_mod_item(cvec, w_ada, b_ada, MOD, r, F.lane); continue; } r -= I_MOD;
            if (r < I_SSM) { p0_ssm_item(log_dt, lam_re, lam_im, b_re, b_im, c_re, c_im, AC, BB, CB, r, F.lane); continue; } r -= I_SSM;
            if (r < I_TR) {
                if (r < T_U)   { p0_transpose_item(w_in, D_IN, 1024, SC_U + 32 * (r % 16), WIN_T, PC_U + 32 * (r % 16), 64 * (r / 16), scr, F.lane); continue; } r -= T_U;
                if (r < T_ZS)  { p0_transpose_item(w_in, D_IN, 1024, SC_ZS + 32 * (r % 16), WIN_T, PC_ZS + 32 * (r % 16), 64 * (r / 16), scr, F.lane); continue; } r -= T_ZS;
                if (r < T_ZM)  { p0_transpose_item(w_in, D_IN, 1024, SC_ZM + 32 * (r % 16), WIN_T, PC_ZM + 32 * (r % 16), 64 * (r / 16), scr, F.lane); continue; } r -= T_ZM;
                if (r < T_CKV) { p0_transpose_item(w_in, D_IN, 1024, SC_CKV + 32 * (r % 8), WIN_T, PC_CKV + 32 * (r % 8), 64 * (r / 8), scr, F.lane); continue; } r -= T_CKV;
                if (r < T_CQ)  { p0_transpose_item(w_in, D_IN, 1024, SC_CQ + 32 * (r % 12), WIN_T, PC_CQ + 32 * (r % 12), 64 * (r / 12), scr, F.lane); continue; } r -= T_CQ;
                if (r < T_KR)  { p0_transpose_item(w_in, D_IN, 1024, SC_KR, WIN_T, PC_KR, 64 * r, scr, F.lane); continue; } r -= T_KR;
                if (r < T_WQ)  { const int nb = r % 24, kb = r / 24, n0 = 32 * nb;
                                 p0_transpose_item(w_q_b, 768, 384, n0, WQ_T, (n0 / 96) * 128 + (n0 % 96), 64 * kb, scr, F.lane); continue; } r -= T_WQ;
                if (r < T_WKV) { p0_transpose_item(w_kv_b, 1024, 256, 32 * (r % 32), WKV_T, 32 * (r % 32), 64 * (r / 32), scr, F.lane); continue; } r -= T_WKV;
                if (r < T_WGLU){ p0_transpose_item(w_glu, 512, 512, 32 * (r % 16), WGLU_T, 32 * (r % 16), 64 * (r / 16), scr, F.lane); continue; } r -= T_WGLU;
                p0_transpose_item(w_out, 1024, 1024, 32 * (r % 32), WOUT_T, 32 * (r % 32), 64 * (r / 32), scr, F.lane); continue;
            }
            r -= I_TR;
            const v4u z = {0u, 0u, 0u, 0u};
            if (r < I_Z1) { GAS v4u* p = (GAS v4u*)(WIN_T + (size_t)(2208 + r) * 1024); p[F.lane] = z; p[64 + F.lane] = z; continue; } r -= I_Z1;
            { const int hh = r / 32, rr = r % 32; GAS v4u* p = (GAS v4u*)(WQ_T + (size_t)(hh * 128 + 96 + rr) * 384); if (F.lane < 48) p[F.lane] = z; }
        }
    }
    SEAM(0);

    if (IN(1)) {
        for (int m = gw; m < M; m += NGW) {
            const int b = m / SEQ;
            const GAS f32x4* xr = (const GAS f32x4*)(x + (size_t)m * DM) + F.lane;
            f32x4 v[4]; float s = 0.f;
#pragma unroll
            for (int j = 0; j < 4; ++j) { v[j] = xr[64 * j]; s += (v[j].x * v[j].x + v[j].y * v[j].y) + (v[j].z * v[j].z + v[j].w * v[j].w); }
            const float rstd = 1.f / sqrtf(wave_sum(s) * (1.f / DM) + EPS);
            GAS unsigned long long* o8 = (GAS unsigned long long*)(HB + (size_t)m * DM) + F.lane;
#pragma unroll
            for (int j = 0; j < 4; ++j) { const int e = 4 * F.lane + 256 * j;
                const f32x4 g4 = *(const f32x4*)(norm_g + e), sc = *(const f32x4*)(MOD + b * 3072 + 1024 + e), sh = *(const f32x4*)(MOD + b * 3072 + e);
                const f32x4 hv = v[j] * rstd * g4 * (sc + 1.f) + sh;
                o8[64 * j] = (unsigned long long)pk2h(hv.x, hv.y) | ((unsigned long long)pk2h(hv.z, hv.w) << 32); }
        }
    }
    SEAM(1);

    if (IN(2)) {
        pg8::Gemm g{HB, WIN_T, M, NPROJ, 1024}; pg8::StaticOrder S; S.init(M, NPROJ, F.G, (int)blockIdx.x);
        pg8::EpiH16 E{PROJ, NPROJ};
        pg8::gemm_phase<pg8::EpiH16, pg8::StaticOrder, true, true>(F.lds + RING_OFF, g, S, E);
    }
    SEAM(2);

    if (IN(3)) {
        for (int m = gw; m < M; m += NGW) {
            const bf16* pr = PROJ + (size_t)m * NPROJ;
            v4u a = {0u, 0u, 0u, 0u}; if (F.lane < 48) a = *(const GAS v4u*)(pr + PC_CQ + 8 * F.lane);
            float f[8] = {pg8::h_lo(a.x), pg8::h_hi(a.x), pg8::h_lo(a.y), pg8::h_hi(a.y), pg8::h_lo(a.z), pg8::h_hi(a.z), pg8::h_lo(a.w), pg8::h_hi(a.w)};
            float s = 0.f;
#pragma unroll
            for (int e = 0; e < 8; ++e) s += f[e] * f[e];
            float rstd = 1.f / sqrtf(wave_sum(s) * (1.f / Q_LORA) + EPS);
            if (F.lane < 48) { const f32x4 g0 = *(const f32x4*)(q_a_g + 8 * F.lane), g1 = *(const f32x4*)(q_a_g + 8 * F.lane + 4);
                v4u o; o.x = pk2h(f[0] * rstd * g0.x, f[1] * rstd * g0.y); o.y = pk2h(f[2] * rstd * g0.z, f[3] * rstd * g0.w);
                o.z = pk2h(f[4] * rstd * g1.x, f[5] * rstd * g1.y); o.w = pk2h(f[6] * rstd * g1.z, f[7] * rstd * g1.w);
                *(GAS v4u*)(CQN + (size_t)m * Q_LORA + 8 * F.lane) = o; }
            v4u c2 = {0u, 0u, 0u, 0u}; if (F.lane < 32) c2 = *(const GAS v4u*)(pr + PC_CKV + 8 * F.lane);
            float h8[8] = {pg8::h_lo(c2.x), pg8::h_hi(c2.x), pg8::h_lo(c2.y), pg8::h_hi(c2.y), pg8::h_lo(c2.z), pg8::h_hi(c2.z), pg8::h_lo(c2.w), pg8::h_hi(c2.w)};
            s = 0.f;
#pragma unroll
            for (int e = 0; e < 8; ++e) s += h8[e] * h8[e];
            rstd = 1.f / sqrtf(wave_sum(s) * (1.f / KV_LORA) + EPS);
            if (F.lane < 32) { const f32x4 g0 = *(const f32x4*)(kv_a_g + 8 * F.lane), g1 = *(const f32x4*)(kv_a_g + 8 * F.lane + 4);
                v4u o; o.x = pk2h(h8[0] * rstd * g0.x, h8[1] * rstd * g0.y); o.y = pk2h(h8[2] * rstd * g0.z, h8[3] * rstd * g0.w);
                o.z = pk2h(h8[4] * rstd * g1.x, h8[5] * rstd * g1.y); o.w = pk2h(h8[6] * rstd * g1.z, h8[7] * rstd * g1.w);
                *(GAS v4u*)(CKVN + (size_t)m * KV_LORA + 8 * F.lane) = o; }
        }
        { const ssm::Consts C{AC, BB, CB, d_skip};
          for (int it = gw; it < 2048; it += NGW) { const int g = (it & 7) + 8 * ((it >> 3) & 3), seg = (it >> 5) & 31, b = it >> 10;
              ssm::ssm_pass<false>(b, g, seg, PROJ, NPROJ, PC_U, C, EST, YPRE, (char*)lds + RING_OFF + F.wave * ssm::LDS_PER_WAVE); } }
    }
    SEAM(3);

    if (IN(4)) {
        { pg8::Gemm g{CQN, WQ_T, M, 1024, Q_LORA}; pg8::StaticOrder S; S.init(M, 1024, F.G, (int)blockIdx.x);
          pg8::EpiH16 E{QRAW, 1024};
          pg8::gemm_phase<pg8::EpiH16, pg8::StaticOrder, true, true>(F.lds + RING_OFF, g, S, E); }
        { pg8::Gemm g{CKVN, WKV_T, M, 1024, KV_LORA}; pg8::StaticOrder S; S.init(M, 1024, F.G, (int)blockIdx.x);
          pg8::EpiH16 E{KVRAW, 1024};
          pg8::gemm_phase<pg8::EpiH16, pg8::StaticOrder, true, true>(F.lds + RING_OFF, g, S, E); }
    }
    SEAM(4);

    if (IN(5)) {
        { const int h = F.lane >> 3, p = F.lane & 7;
          const float if0 = (float)exp(-(double)(2 * p) / 16.0 * 9.210340371976184), if1 = (float)exp(-(double)(2 * p + 1) / 16.0 * 9.210340371976184);
          const f32x4 qg0 = *(const f32x4*)(q_norm_g + 8 * p), qg1 = *(const f32x4*)(q_norm_g + 8 * p + 4);
          const f32x4 kg0 = *(const f32x4*)(k_norm_g + 8 * p), kg1 = *(const f32x4*)(k_norm_g + 8 * p + 4);
          const float qga = q_norm_g[64 + 2 * p], qgb = q_norm_g[65 + 2 * p], qgc = q_norm_g[80 + 2 * p], qgd = q_norm_g[81 + 2 * p];
          const float kga = k_norm_g[64 + 2 * p], kgb = k_norm_g[65 + 2 * p], kgc = k_norm_g[80 + 2 * p], kgd = k_norm_g[81 + 2 * p];
          for (int m = gw; m < M; m += NGW) {
              const float pos = (float)positions[m];
              float cs0, sn0, cs1, sn1;
              { const double TWO_PI = 6.283185307179586476925286766559;
                const float a0 = pos * if0, a1 = pos * if1;
                const float r0 = (float)((double)a0 - TWO_PI * rint((double)a0 / TWO_PI)), r1 = (float)((double)a1 - TWO_PI * rint((double)a1 / TWO_PI));
                cs0 = __cosf(r0); sn0 = __sinf(r0); cs1 = __cosf(r1); sn1 = __sinf(r1); }
              { const bf16* src = QRAW + (size_t)m * 1024 + h * 128;
                const v4u a = *(const GAS v4u*)(src + 8 * p); const unsigned ra = *(const GAS unsigned*)(src + 64 + 2 * p), rb = *(const GAS unsigned*)(src + 80 + 2 * p);
                float f[8] = {pg8::h_lo(a.x), pg8::h_hi(a.x), pg8::h_lo(a.y), pg8::h_hi(a.y), pg8::h_lo(a.z), pg8::h_hi(a.z), pg8::h_lo(a.w), pg8::h_hi(a.w)};
                float x1a = pg8::h_lo(ra), x1b = pg8::h_hi(ra), x2a = pg8::h_lo(rb), x2b = pg8::h_hi(rb);
                float s = x1a * x1a + x1b * x1b + x2a * x2a + x2b * x2b;
#pragma unroll
                for (int e = 0; e < 8; ++e) s += f[e] * f[e];
                s += __shfl_xor(s, 1); s += __shfl_xor(s, 2); s += __shfl_xor(s, 4);
                const float rs = 1.f / sqrtf(s * (1.f / 96.f) + EPS);
                x1a *= rs * qga; x1b *= rs * qgb; x2a *= rs * qgc; x2b *= rs * qgd;
                bf16* dst = Qb + (size_t)m * 768 + h * 96;
                v4u o; o.x = pk2h(f[0] * rs * qg0.x, f[1] * rs * qg0.y); o.y = pk2h(f[2] * rs * qg0.z, f[3] * rs * qg0.w);
                o.z = pk2h(f[4] * rs * qg1.x, f[5] * rs * qg1.y); o.w = pk2h(f[6] * rs * qg1.z, f[7] * rs * qg1.w);
                *(GAS v4u*)(dst + 8 * p) = o;
                *(GAS unsigned*)(dst + 64 + 2 * p) = pk2h(x1a * cs0 - x2a * sn0, x1b * cs1 - x2b * sn1);
                *(GAS unsigned*)(dst + 80 + 2 * p) = pk2h(x2a * cs0 + x1a * sn0, x2b * cs1 + x1b * sn1); }
              { const bf16* src = KVRAW + (size_t)m * 1024 + h * 128; const bf16* kr = PROJ + (size_t)m * NPROJ + PC_KR;
                const v4u a = *(const GAS v4u*)(src + 8 * p); const unsigned ra = *(const GAS unsigned*)(kr + 2 * p), rb = *(const GAS unsigned*)(kr + 16 + 2 * p);
                const v4u vv = *(const GAS v4u*)(src + 64 + 8 * p);
                float f[8] = {pg8::h_lo(a.x), pg8::h_hi(a.x), pg8::h_lo(a.y), pg8::h_hi(a.y), pg8::h_lo(a.z), pg8::h_hi(a.z), pg8::h_lo(a.w), pg8::h_hi(a.w)};
                float x1a = pg8::h_lo(ra), x1b = pg8::h_hi(ra), x2a = pg8::h_lo(rb), x2b = pg8::h_hi(rb);
                float s = x1a * x1a + x1b * x1b + x2a * x2a + x2b * x2b;
#pragma unroll
                for (int e = 0; e < 8; ++e) s += f[e] * f[e];
                s += __shfl_xor(s, 1); s += __shfl_xor(s, 2); s += __shfl_xor(s, 4);
                const float rs = 1.f / sqrtf(s * (1.f / 96.f) + EPS);
                x1a *= rs * kga; x1b *= rs * kgb; x2a *= rs * kgc; x2b *= rs * kgd;
                bf16* dst = Kb + (size_t)m * 1024 + h * 128;
                v4u o; o.x = pk2h(f[0] * rs * kg0.x, f[1] * rs * kg0.y); o.y = pk2h(f[2] * rs * kg0.z, f[3] * rs * kg0.w);
                o.z = pk2h(f[4] * rs * kg1.x, f[5] * rs * kg1.y); o.w = pk2h(f[6] * rs * kg1.z, f[7] * rs * kg1.w);
                *(GAS v4u*)(dst + 8 * p) = o;
                *(GAS unsigned*)(dst + 64 + 2 * p) = pk2h(x1a * cs0 - x2a * sn0, x1b * cs1 - x2b * sn1);
                *(GAS unsigned*)(dst + 80 + 2 * p) = pk2h(x2a * cs0 + x1a * sn0, x2b * cs1 + x1b * sn1);
                *(GAS v4u*)(Vb + (size_t)m * 512 + h * 64 + 8 * p) = vv; }
          } }
        { const ssm::Consts C{AC, BB, CB, d_skip};
          for (int it = gw; it < 2048; it += NGW) { const int g = (it & 7) + 8 * ((it >> 3) & 3), seg = (it >> 5) & 31, b = it >> 10;
              ssm::ssm_pass<true>(b, g, seg, PROJ, NPROJ, PC_U, C, EST, YPRE, (char*)lds + RING_OFF + F.wave * ssm::LDS_PER_WAVE); } }
    }
    SEAM(5);

    if (IN(6)) {
        __syncthreads();
        if (F.G == 256) {
            const int s = F.vcu & 15, bh = F.vcu >> 4;
            att::attn_unit(bh >> 3, bh & 7, 31 - s, Qb, Kb, Vb, PROJ, NPROJ, PC_ZM, YCAT, (char*)lds + RING_OFF);
            att::attn_unit(bh >> 3, bh & 7, s, Qb, Kb, Vb, PROJ, NPROJ, PC_ZM, YCAT, (char*)lds + RING_OFF);
        } else {
            for (int u = F.vcu; u < 512; u += F.G) { const int bh = u >> 5, qb = u & 31;
                att::attn_unit(bh >> 3, bh & 7, qb, Qb, Kb, Vb, PROJ, NPROJ, PC_ZM, YCAT, (char*)lds + RING_OFF); }
        }
    }
    SEAM(6);

    if (IN(7)) {
        pg8::Gemm g{YPRE, WGLU_T, M, 512, 512}; pg8::StaticOrder S; S.init(M, 512, F.G, (int)blockIdx.x);
        pg8::EpiGlu E{YPRE, PROJ, NPROJ, PC_ZS, b_glu, YCAT};
        pg8::gemm_phase<pg8::EpiGlu, pg8::StaticOrder, true, true>(F.lds + RING_OFF, g, S, E);
    }
    SEAM(7);

    if (IN(8)) {
        pg8::Gemm g{YCAT, WOUT_T, M, 1024, 1024}; pg8::StaticOrder S; S.init(M, 1024, F.G, (int)blockIdx.x);
        pg8::EpiOut E{x, MOD + 2048, 3072, SEQ, args.out};
        pg8::gemm_phase<pg8::EpiOut, pg8::StaticOrder, true, true>(F.lds + RING_OFF, g, S, E);
    }
#undef IN
#undef SEAM
}

#ifndef MK_MODE
#define MK_MODE 2
#endif
#ifndef MK_FAST_MASK
#define MK_FAST_MASK 0x1FF
#endif
extern "C" void kernel_launch(void* const* d_in, const int* in_sizes, int n_in, void* d_out, int out_size, void* d_ws, size_t ws_size, hipStream_t stream) {
    static int grid = 0;
    if (grid == 0) {
        if (n_in != 24 || in_sizes[0] != M * DM || out_size != M * DM || ws_size < WS_END) { fprintf(stderr, "kernel_launch: unexpected shapes (n_in %d, in0 %d, out %d, ws %zu)\n", n_in, n_in > 0 ? in_sizes[0] : -1, out_size, ws_size); grid = -1; return; }
        int dev = 0, cus = 0, per_cu = 0;
        if (hipGetDevice(&dev) != hipSuccess || hipDeviceGetAttribute(&cus, hipDeviceAttributeMultiprocessorCount, dev) != hipSuccess) { fprintf(stderr, "kernel_launch: device query failed\n"); grid = -1; return; }
        if (hipFuncSetAttribute((const void*)mega_fwd, hipFuncAttributeMaxDynamicSharedMemorySize, LDS_BYTES) != hipSuccess) { fprintf(stderr, "kernel_launch: hipFuncSetAttribute failed\n"); grid = -1; return; }
        if (hipOccupancyMaxActiveBlocksPerMultiprocessor(&per_cu, (const void*)mega_fwd, NWAVES * 64, LDS_BYTES) != hipSuccess || per_cu < 1)
            fprintf(stderr, "kernel_launch: note: occupancy query reports %d workgroups per CU\n", per_cu);
        (void)hipGetLastError();
        grid = cus;
    }
    if (grid < 0) return;
    const float* x = (const float*)d_in[0]; const float* c = (const float*)d_in[1]; const int* positions = (const int*)d_in[2];
    const float* w_ada = (const float*)d_in[3]; const float* b_ada = (const float*)d_in[4]; const float* norm_g = (const float*)d_in[5];
    const float* w_in = (const float*)d_in[6]; const float* log_dt = (const float*)d_in[7]; const float* lam_re = (const float*)d_in[8];
    const float* lam_im = (const float*)d_in[9]; const float* b_re = (const float*)d_in[10]; const float* b_im = (const float*)d_in[11];
    const float* c_re = (const float*)d_in[12]; const float* c_im = (const float*)d_in[13]; const float* d_skip = (const float*)d_in[14];
    const float* w_glu = (const float*)d_in[15]; const float* b_glu = (const float*)d_in[16]; const float* q_a_g = (const float*)d_in[17];
    const float* w_q_b = (const float*)d_in[18]; const float* kv_a_g = (const float*)d_in[19]; const float* w_kv_b = (const float*)d_in[20];
    const float* q_norm_g = (const float*)d_in[21]; const float* k_norm_g = (const float*)d_in[22]; const float* w_out = (const float*)d_in[23];
    unsigned char* ws = (unsigned char*)d_ws; float* out = (float*)d_out;
    float* MOD = (float*)(ws + WS_MOD); bf16* PROJ = (bf16*)(ws + WS_PROJ); bf16* HB = (bf16*)(ws + WS_HB); bf16* QRAW = (bf16*)(ws + WS_HB); bf16* YCAT = (bf16*)(ws + WS_HB);
    bf16* KVRAW = (bf16*)(ws + WS_KVRAW); bf16* Qb = (bf16*)(ws + WS_Q); bf16* Kb = (bf16*)(ws + WS_K); bf16* Vb = (bf16*)(ws + WS_V);
    bf16* CQN = (bf16*)(ws + WS_CQN); bf16* CKVN = (bf16*)(ws + WS_CKVN); bf16* YPRE = (bf16*)(ws + WS_YPRE);
    (void)x; (void)c; (void)positions; (void)w_ada; (void)b_ada; (void)norm_g; (void)w_in; (void)log_dt; (void)lam_re; (void)lam_im; (void)b_re; (void)b_im; (void)c_re; (void)c_im; (void)d_skip;
    (void)w_glu; (void)b_glu; (void)q_a_g; (void)w_q_b; (void)kv_a_g; (void)w_kv_b; (void)q_norm_g; (void)k_norm_g; (void)w_out; (void)MOD; (void)PROJ; (void)HB; (void)QRAW; (void)YCAT;
    (void)KVRAW; (void)Qb; (void)Kb; (void)Vb; (void)CQN; (void)CKVN; (void)YPRE; (void)out;

    Args a{};
    for (int i = 0; i < 24; ++i) a.in[i] = (const float*)d_in[i];
    a.out = out; a.ws = ws;
#define MEGA(lo_, hi_) do { a.ph_lo = (lo_); a.ph_hi = (hi_); hipLaunchKernelGGL(mega_fwd, dim3(grid), dim3(NWAVES * 64), LDS_BYTES, stream, a); } while (0)
#if MK_MODE == 2
    if (hipMemsetAsync(ws + WS_CTL, 0, CTL_ZERO_BYTES, stream) != hipSuccess) { fprintf(stderr, "kernel_launch: memset failed\n"); return; }
    MEGA(0, NPHASE);
#else
    const unsigned fast = (MK_MODE == 0) ? 0u : (unsigned)MK_FAST_MASK;
    if (MK_MODE != 0) MEGA(0, 1);
    if (!(fast & 1u)) hipLaunchKernelGGL(v0_mod, dim3(24), dim3(256), 0, stream, c, w_ada, b_ada, MOD);
    if (fast & 2u) MEGA(1, 2); else hipLaunchKernelGGL(v0_h, dim3(M), dim3(256), 0, stream, x, norm_g, MOD, HB);
    if (fast & 4u) MEGA(2, 3); else {
        const int seg[6][3] = {{PC_U, SC_U, 512}, {PC_ZS, SC_ZS, 512}, {PC_ZM, SC_ZM, 512}, {PC_CKV, SC_CKV, 256}, {PC_CQ, SC_CQ, 384}, {PC_KR, SC_KR, 32}};
        for (int s = 0; s < 6; ++s) hipLaunchKernelGGL(v0_gemm, dim3(M), dim3(256), 1024 * 4, stream, HB, 1024, 1024, w_in, D_IN, seg[s][1], PROJ, NPROJ, seg[s][0], seg[s][2]); }
    if (fast & 8u) MEGA(3, 4); else hipLaunchKernelGGL(v0_cqn, dim3(M), dim3(256), 0, stream, PROJ, q_a_g, kv_a_g, CQN, CKVN);
    if (fast & 16u) MEGA(4, 5); else {
        for (int h = 0; h < NH; ++h) hipLaunchKernelGGL(v0_gemm, dim3(M), dim3(128), 384 * 4, stream, CQN, 384, 384, w_q_b, 768, h * 96, QRAW, 1024, h * 128, 96);
        hipLaunchKernelGGL(v0_gemm, dim3(M), dim3(256), 256 * 4, stream, CKVN, 256, 256, w_kv_b, 1024, 0, KVRAW, 1024, 0, 1024); }
    if (fast & 32u) { if (!(fast & 8u)) MEGA(3, 4); MEGA(5, 6); }
    else { hipLaunchKernelGGL(v0_qkv, dim3(M * NH * 2 / 256), dim3(256), 0, stream, QRAW, KVRAW, PROJ, positions, q_norm_g, k_norm_g, Qb, Kb, Vb);
           hipLaunchKernelGGL(v0_ssm, dim3(BATCH * SSM_G), dim3(64), 0, stream, PROJ, log_dt, lam_re, lam_im, b_re, b_im, c_re, c_im, d_skip, YPRE); }
    if (fast & 64u) MEGA(6, 7); else hipLaunchKernelGGL(v0_attn, dim3(BATCH * NH * (SEQ / 256)), dim3(256), 0, stream, Qb, Kb, Vb, PROJ, YCAT);
    if (fast & 128u) MEGA(7, 8); else hipLaunchKernelGGL(v0_glu, dim3(M), dim3(256), 0, stream, YPRE, w_glu, b_glu, PROJ, YCAT);
    if (fast & 256u) MEGA(8, 9); else hipLaunchKernelGGL(v0_out, dim3(M), dim3(256), 0, stream, YCAT, w_out, x, MOD, out);
#endif
    const hipError_t le = hipPeekAtLastError();
    if (le != hipSuccess) fprintf(stderr, "kernel_launch: launch failed: %s\n", hipGetErrorName(le));
}
```

```cpp
#include <hip/hip_runtime.h>
#include <cstdio>
#include <cstdint>
#ifndef MK_CLAIM_BETWEEN
#define MK_CLAIM_BETWEEN 0
#endif
#ifndef MK_DOUBLE
#define MK_DOUBLE (-1)
#endif

constexpr int BATCH = 2, SEQ = 8192, DM = 1024, M = BATCH * SEQ;
constexpr int SSM_W = 512, SSM_G = 32, SSM_GC = 16, SSM_P = 64;
constexpr int NH = 8, QK_NOPE = 64, QK_ROPE = 32, QK_HEAD = 96, V_HEAD = 64, MLA_W = 512, Q_LORA = 384, KV_LORA = 256;
constexpr int D_IN = 2208;
constexpr float EPS = 1e-6f;
constexpr int NPROJ = 1792;
constexpr int LDP = 1280;
constexpr int PC_U = 0, PC_ZS = 0, PC_CKV = 512, PC_CQ = 768, PC_KR = 1152;
constexpr int GC_KR = 1664;
constexpr int WR_ZM = 1792;
constexpr int SC_U = 0, SC_ZS = 512, SC_CQ = 1024, SC_CKV = 1408, SC_KR = 1664, SC_ZM = 1696;

constexpr size_t MiB = 1u << 20;
constexpr size_t WS_CTL = 0, CTL_ZERO_BYTES = 1 * MiB;
constexpr size_t WS_MOD = 1 * MiB;
constexpr size_t WS_AC = 1 * MiB + 64 * 1024;
constexpr size_t WS_BB = 1 * MiB + 128 * 1024;
constexpr size_t WS_CB = 1 * MiB + 256 * 1024;
constexpr size_t WS_E = 2 * MiB;
constexpr size_t WS_WIN = 4 * MiB;
constexpr size_t WS_WQ = 9 * MiB;
constexpr size_t WS_WKV = 10 * MiB;
constexpr size_t WS_WGLU = 11 * MiB;
constexpr size_t WS_WOUT = 12 * MiB;
constexpr size_t WS_PROJ = 16 * MiB;
constexpr size_t WS_USG = 56 * MiB;
constexpr size_t WS_ZM = 80 * MiB;
constexpr size_t WS_HB = 96 * MiB;
constexpr size_t WS_YCAT = 128 * MiB;
constexpr size_t WS_KVRAW = 128 * MiB;
constexpr size_t WS_Q = 160 * MiB;
constexpr size_t WS_CQN = 160 * MiB;
constexpr size_t WS_CKVN = 172 * MiB;
constexpr size_t WS_K = 184 * MiB;
constexpr size_t WS_V = 208 * MiB;
constexpr size_t WS_YPRE = 224 * MiB;
constexpr size_t WS_TQ = 240 * MiB;
constexpr size_t WS_PP = 246 * MiB;
constexpr size_t WS_ROPE = 250 * MiB;
constexpr size_t WS_HAND = 252 * MiB;
constexpr size_t WS_RS = 14 * MiB;
constexpr size_t WS_END = 253 * MiB;

typedef unsigned short bf16;
__device__ __forceinline__ unsigned f2bf(float f) { return (unsigned)__builtin_bit_cast(unsigned short, (_Float16)f); }
__device__ __forceinline__ float bf2f(bf16 b) { return (float)__builtin_bit_cast(_Float16, b); }
__device__ __forceinline__ float silu_f(float v) { return v / (1.f + __expf(-v)); }
__device__ __forceinline__ float sigmoid_f(float v) { return 1.f / (1.f + __expf(-v)); }
__device__ __forceinline__ float gelu_tanh(float v) { const float z = 0.7978845608028654f * (v + 0.044715f * v * v * v); return v / (1.f + __expf(-2.f * z)); }

__device__ __forceinline__ float block_sum_256(float v, float* red) {
    for (int o = 32; o > 0; o >>= 1) v += __shfl_xor(v, o);
    const int w = threadIdx.x >> 6;
    __syncthreads();
    if ((threadIdx.x & 63) == 0) red[w] = v;
    __syncthreads();
    float s = 0.f; for (int i = 0; i < (int)(blockDim.x >> 6); ++i) s += red[i];
    return s;
}

__global__ void v0_mod(const float* c, const float* w_ada, const float* b_ada, float* mod) {
    const int idx = blockIdx.x * blockDim.x + threadIdx.x; if (idx >= BATCH * 3 * DM) return;
    const int b = idx / (3 * DM), n = idx % (3 * DM);
    float acc = b_ada[n];
    for (int k = 0; k < DM; ++k) acc += silu_f(c[b * DM + k]) * w_ada[(size_t)k * 3 * DM + n];
    mod[idx] = acc;
}
__global__ void v0_h(const float* x, const float* norm_g, const float* mod, bf16* hb) {
    __shared__ float red[8];
    const int m = blockIdx.x, b = m / SEQ, t = threadIdx.x;
    float v[4], ss = 0.f;
    for (int j = 0; j < 4; ++j) { v[j] = x[(size_t)m * DM + t + 256 * j]; ss += v[j] * v[j]; }
    ss = block_sum_256(ss, red);
    const float rstd = 1.f / sqrtf(ss / DM + EPS);
    for (int j = 0; j < 4; ++j) { const int e = t + 256 * j;
        const float hv = v[j] * rstd * norm_g[e] * (1.f + mod[b * 3 * DM + DM + e]) + mod[b * 3 * DM + e];
        hb[(size_t)m * DM + e] = (bf16)f2bf(hv); }
}
__global__ void v0_gemm(const bf16* A, int lda, int K, const float* W, int ldw, int src0, bf16* C, int ldc, int dst0, int width) {
    extern __shared__ float arow[];
    const int m = blockIdx.x;
    for (int k = threadIdx.x; k < K; k += blockDim.x) arow[k] = bf2f(A[(size_t)m * lda + k]);
    __syncthreads();
    for (int j = threadIdx.x; j < width; j += blockDim.x) {
        float acc = 0.f;
        for (int k = 0; k < K; ++k) acc += arow[k] * W[(size_t)k * ldw + src0 + j];
        C[(size_t)m * ldc + dst0 + j] = (bf16)f2bf(acc);
    }
}
__global__ void v0_usg(const bf16* A, const float* W, int ldw, bf16* USG) {
    extern __shared__ float arow[];
    const int m = blockIdx.x, b = m / SEQ, t = m % SEQ;
    for (int k = threadIdx.x; k < 1024; k += blockDim.x) arow[k] = bf2f(A[(size_t)m * 1024 + k]);
    __syncthreads();
    for (int c = threadIdx.x; c < 512; c += blockDim.x) { float acc = 0.f;
        for (int k = 0; k < 1024; ++k) acc += arow[k] * W[(size_t)k * ldw + c];
        USG[((size_t)(c >> 4) * 1024 + b * 512 + (t >> 4)) * 384 + (t & 15) * 16 + (c & 15)] = (bf16)f2bf(acc); }
}
__global__ void v0_cqn(const bf16* proj, const float* q_a_g, const float* kv_a_g, bf16* cqn, bf16* ckvn) {
    __shared__ float red[8];
    const int m = blockIdx.x, t = threadIdx.x;
    float a = 0.f, b2 = 0.f, ss = 0.f;
    if (t < 192) { a = bf2f(proj[(size_t)m * LDP + PC_CQ + t]); b2 = bf2f(proj[(size_t)m * LDP + PC_CQ + 192 + t]); ss = a * a + b2 * b2; }
    ss = block_sum_256(ss, red);
    float rstd = 1.f / sqrtf(ss / Q_LORA + EPS);
    if (t < 192) { cqn[(size_t)m * Q_LORA + t] = (bf16)f2bf(a * rstd * q_a_g[t]); cqn[(size_t)m * Q_LORA + 192 + t] = (bf16)f2bf(b2 * rstd * q_a_g[192 + t]); }
    const float cv = bf2f(proj[(size_t)m * LDP + PC_CKV + t]);
    ss = block_sum_256(cv * cv, red);
    rstd = 1.f / sqrtf(ss / KV_LORA + EPS);
    ckvn[(size_t)m * KV_LORA + t] = (bf16)f2bf(cv * rstd * kv_a_g[t]);
}
__device__ __forceinline__ int v0_vst(int k, int c) { const int kk = (k & ~0xC) | ((k & 4) << 1) | ((k & 8) >> 1); return ((kk >> 3) * 2 + (c >> 5)) * 512 + ((kk & 7) * 32 + (c & 31)) * 2; }
__global__ void __launch_bounds__(256) v0_qkv(const bf16* qraw, const bf16* kvraw, const bf16* proj, const int* positions, const float* q_norm_g, const float* k_norm_g, bf16* Q, bf16* K, bf16* V) {
    const int idx = blockIdx.x * blockDim.x + threadIdx.x; if (idx >= M * NH * 2) return;
    const int which = idx & 1, m = (idx >> 1) / NH, h = (idx >> 1) % NH;
    const float pos = (float)positions[m];
    const float* gn = which ? k_norm_g : q_norm_g;
    float q[96];
    float sq = 0.f;
    if (which == 0) {
#pragma unroll
        for (int d = 0; d < 96; ++d) q[d] = bf2f(qraw[(size_t)m * 1024 + h * 128 + d]);
    } else {
#pragma unroll
        for (int d = 0; d < 64; ++d) q[d] = bf2f(kvraw[(size_t)m * 1024 + h * 128 + d]);
#pragma unroll
        for (int d = 0; d < 32; ++d) q[64 + d] = bf2f(proj[(size_t)m * LDP + PC_KR + d]);
    }
#pragma unroll
    for (int d = 0; d < 96; ++d) sq += q[d] * q[d];
    const float rq = 1.f / sqrtf(sq / 96.f + EPS);
#pragma unroll
    for (int d = 0; d < 96; ++d) q[d] = q[d] * rq * gn[d];
#pragma unroll
    for (int i = 0; i < 16; ++i) {
        const float inv_freq = (float)pow(10000.0, -(double)i / 16.0);
        const float ang = pos * inv_freq;
        const double TWO_PI = 6.283185307179586476925286766559;
        const double r = (double)ang - TWO_PI * rint((double)ang / TWO_PI);
        const float rf = (float)r; const float cs = __cosf(rf), sn = __sinf(rf);
        const float q1 = q[64 + i], q2 = q[80 + i]; q[64 + i] = q1 * cs - q2 * sn; q[80 + i] = q2 * cs + q1 * sn;
    }
    if (which == 0) {
#pragma unroll
        for (int d = 0; d < 96; ++d) Q[(size_t)m * 768 + h * 96 + d] = (bf16)f2bf(q[d] * (0.10206207261596575f * 1.4426950408889634f));
    } else {
        const int bb = m / SEQ, tt = m % SEQ; const size_t tix = (size_t)(bb * 8 + h) * 128 + (tt >> 6); const int row = tt & 63;
#pragma unroll
        for (int d = 0; d < 96; ++d) K[tix * 6144 + (d >> 3) * 512 + row * 8 + (d & 7)] = (bf16)f2bf(q[d]);
        for (int d = 0; d < 64; ++d) V[tix * 4096 + v0_vst(row, d) / 2] = kvraw[(size_t)m * 1024 + h * 128 + 64 + d];
    }
}
__global__ void __launch_bounds__(64) v0_ssm(const bf16* proj, const float* log_dt, const float* lam_re, const float* lam_im, const float* b_re, const float* b_im,
                       const float* c_re, const float* c_im, const float* d_skip, bf16* ypre) {
    __shared__ float sre[64], sim[64], us[16];
    const int b = blockIdx.x / SSM_G, g = blockIdx.x % SSM_G, p = threadIdx.x;
    const double dt = exp((double)log_dt[g]);
    const double lr = lam_re[g * 64 + p], li = lam_im[g * 64 + p];
    const double er = exp(lr * dt), ar = er * cos(li * dt), ai = er * sin(li * dt);
    const double nr = ar - 1.0, ni = ai, den = lr * lr + li * li;
    const double cr = (nr * lr + ni * li) / den, ci = (ni * lr - nr * li) / den;
    float Br[16], Bi[16];
#pragma unroll
    for (int j = 0; j < 16; ++j) { const double br = b_re[(g * 64 + p) * 16 + j], bi = b_im[(g * 64 + p) * 16 + j];
        Br[j] = (float)(cr * br - ci * bi); Bi[j] = (float)(cr * bi + ci * br); }
    const float far = (float)ar, fai = (float)ai;
    float s_r = 0.f, s_i = 0.f;
    const float dsk = p < 16 ? d_skip[g * 16 + p] : 0.f;
    for (int t = 0; t < SEQ; ++t) {
        const size_t row = (size_t)(b * SEQ + t);
        if (p < 16) us[p] = bf2f(proj[((size_t)g * 1024 + b * 512 + (t >> 4)) * 384 + (t & 15) * 16 + p]);
        __syncthreads();
        float bur = 0.f, bui = 0.f;
#pragma unroll
        for (int j = 0; j < 16; ++j) { bur += Br[j] * us[j]; bui += Bi[j] * us[j]; }
        const float nr2 = far * s_r - fai * s_i + bur, ni2 = far * s_i + fai * s_r + bui;
        s_r = nr2; s_i = ni2; sre[p] = s_r; sim[p] = s_i;
        __syncthreads();
        if (p < 16) {
            float y = 0.f;
            for (int q = 0; q < 64; ++q) y += c_re[(g * 16 + p) * 64 + q] * sre[q] - c_im[(g * 16 + p) * 64 + q] * sim[q];
            y += dsk * us[p];
            ypre[row * SSM_W + g * 16 + p] = (bf16)f2bf(gelu_tanh(y));
        }
        __syncthreads();
    }
}
__global__ void __launch_bounds__(256) v0_attn(const bf16* Q, const bf16* K, const bf16* V, const bf16* zm, bf16* ycat) {
    const int qb = blockIdx.x % (SEQ / 256), bh = blockIdx.x / (SEQ / 256), b = bh / NH, h = bh % NH;
    const int qi = qb * 256 + threadIdx.x;
    const size_t qrow = (size_t)b * SEQ + qi;
    float q[96], o[64];
    const float sc = 0.10206207261596575f;
#pragma unroll
    for (int d = 0; d < 96; ++d) q[d] = bf2f(Q[qrow * 768 + h * 96 + d]) * sc;
#pragma unroll
    for (int d = 0; d < 64; ++d) o[d] = 0.f;
    float mx = -1e30f, l = 0.f;
    const int jmax = qb * 256 + 255;
    for (int j = 0; j <= jmax; ++j) {
        const size_t tix = (size_t)(b * 8 + h) * 128 + (j >> 6); const int jr = j & 63;
        const bf16* kp = K + tix * 6144 + jr * 8; const bf16* vp = V + tix * 4096;
        float s = 0.f;
#pragma unroll
        for (int d = 0; d < 96; ++d) s += q[d] * bf2f(kp[(d >> 3) * 512 + (d & 7)]);
        if (j <= qi) {
            const float mn = fmaxf(mx, s); const float al = exp2f(mx - mn), pp = exp2f(s - mn);
            l = l * al + pp;
#pragma unroll
            for (int d = 0; d < 64; ++d) o[d] = o[d] * al + pp * bf2f(vp[v0_vst(jr, d) / 2]);
            mx = mn;
        }
    }
    const float rl = 1.f / l;
#pragma unroll
    for (int d = 0; d < 64; ++d) {
        const float z = bf2f(zm[qrow * 512 + h * 64 + d]);
        ycat[qrow * 1024 + 512 + h * 64 + d] = (bf16)f2bf(o[d] * rl * silu_f(z));
    }
}
__global__ void v0_glu(const bf16* ypre, const float* w_glu, const float* b_glu, const bf16* proj, bf16* ycat) {
    __shared__ float arow[512];
    const int m = blockIdx.x;
    for (int k = threadIdx.x; k < 512; k += blockDim.x) arow[k] = bf2f(ypre[(size_t)m * 512 + k]);
    __syncthreads();
    for (int j = threadIdx.x; j < 512; j += blockDim.x) {
        float acc = b_glu[j];
        for (int k = 0; k < 512; ++k) acc += arow[k] * w_glu[(size_t)k * 512 + j];
        const float z = bf2f(proj[(size_t)m * LDP + PC_ZS + j]);
        ycat[(size_t)m * 1024 + j] = (bf16)f2bf(arow[j] * sigmoid_f(acc) * silu_f(z));
    }
}
__global__ void v0_out(const bf16* ycat, const float* w_out, const float* x, const float* mod, float* out) {
    __shared__ float arow[1024];
    const int m = blockIdx.x, b = m / SEQ;
    for (int k = threadIdx.x; k < 1024; k += blockDim.x) arow[k] = bf2f(ycat[(size_t)m * 1024 + k]);
    __syncthreads();
    for (int j = threadIdx.x; j < 1024; j += blockDim.x) {
        float acc = 0.f;
        for (int k = 0; k < 1024; ++k) acc += arow[k] * w_out[(size_t)k * 1024 + j];
        out[(size_t)m * DM + j] = x[(size_t)m * DM + j] + mod[b * 3 * DM + 2 * DM + j] * acc;
    }
}


typedef unsigned wt_u32x4 __attribute__((ext_vector_type(4)));
__device__ __forceinline__ void store16_wt(void* p, wt_u32x4 v) { asm volatile("global_store_dwordx4 %0, %1, off sc1\n\ts_nop 1" :: "v"(p), "v"(v) : "memory"); }

namespace pg8 {
#define PG8_LAS __attribute__((address_space(3)))
typedef unsigned short bf16_t;
typedef _Float16 bf16x8 __attribute__((ext_vector_type(8)));
typedef float f32x4 __attribute__((ext_vector_type(4)));
typedef unsigned u32x4 __attribute__((ext_vector_type(4)));
constexpr int BM = 256, BK = 64, HALF = 128, HTB = HALF * BK * 2  , STAGE_BYTES = 8 * HTB, NXCD = 8, WGM = 8;

__host__ __device__ __forceinline__ int lds_byte(int r, int c) { const int st = (r >> 4) * 2 + (c >> 5), rr = r & 15, cc = c & 31, ob = rr * 64 + cc * 2; return st * 1024 + (ob ^ (((ob >> 9) & 1) << 5)); }
__host__ __device__ __forceinline__ void stage_rc(int b, int& R, int& C) { const int st = b / 1024, sb = b % 1024, swz = sb ^ (((sb >> 9) & 1) << 5); R = (st >> 1) * 16 + swz / 64; C = (st & 1) * 32 + (swz % 64) / 2; }
__host__ __device__ __forceinline__ int perm32(int rho) { const int n = rho >> 4, i = rho & 15; return 8 * (i >> 2) + 4 * n + (i & 3); }

struct Unit { int pm, pn; };
struct Gemm { const bf16_t* A; const bf16_t* Bt; int M, N, K, lda; };

struct StaticOrder {
    int nM, nN, nwg, G, c;
    __host__ __device__ void init(int M, int N, int G_, int c_) { nM = M / BM; nN = N / BM; nwg = nM * nN; G = G_; c = c_; }
    __host__ __device__ bool next(int i, Unit& u) const {
        const long L = (long)i * G + c; if (L >= nwg) return false;
        int wgid = (int)L; { const int q = nwg / NXCD, r = nwg % NXCD, xcd = wgid % NXCD, off = wgid / NXCD; wgid = (xcd < r ? xcd * (q + 1) : r * (q + 1) + (xcd - r) * q) + off; }
        const int nig = WGM * nN, gid = wgid / nig, fm = gid * WGM, gsz = (nM - fm) < WGM ? (nM - fm) : WGM;
        u.pm = fm + ((wgid % nig) % gsz); u.pn = (wgid % nig) / gsz; return true;
    }
    __device__ __forceinline__ void a_ready(const Unit&) const {}
    __device__ __forceinline__ void done(const Unit&) const {}
};


struct DiagOrder {
    int nunits, per, G, c; unsigned* cnt; unsigned want; unsigned* tmo;
    __device__ __forceinline__ bool next(int i, Unit& u) const { const int L = i * G + c; if (L >= nunits) return false; u.pm = L; u.pn = L / per; return true; }
    __device__ __forceinline__ void a_ready(const Unit& u) const {
        if (!cnt) return;
        if (threadIdx.x < 64) { unsigned sp = 0;
            while (__hip_atomic_load(cnt + 64 * u.pm, __ATOMIC_RELAXED, __HIP_MEMORY_SCOPE_AGENT) < want) { __builtin_amdgcn_s_sleep(2);
                if (++sp > (1u << 22)) { if (threadIdx.x == 0) __hip_atomic_store(tmo, 1u, __ATOMIC_RELAXED, __HIP_MEMORY_SCOPE_AGENT); break; } }
            __builtin_amdgcn_fence(__ATOMIC_ACQUIRE, "agent"); asm volatile("s_waitcnt vmcnt(0)" ::: "memory"); }
        __syncthreads();
    }
    __device__ __forceinline__ void done(const Unit&) const {}
};
struct OneUnit { Unit u;
    __device__ __forceinline__ bool next(int i, Unit& x) const { if (i) return false; x = u; return true; }
    __device__ __forceinline__ void a_ready(const Unit&) const {}
    __device__ __forceinline__ void done(const Unit&) const {} };
struct PanelOrder : StaticOrder {
    unsigned* cnt; unsigned want; unsigned* tmo;
    __device__ __forceinline__ void a_ready(const Unit& u) const {
        if (threadIdx.x < 64) { unsigned sp = 0;
            while (__hip_atomic_load(cnt + 64 * u.pm, __ATOMIC_RELAXED, __HIP_MEMORY_SCOPE_AGENT) < want) { __builtin_amdgcn_s_sleep(2);
                if (++sp > (1u << 22)) { if (threadIdx.x == 0) __hip_atomic_store(tmo, 1u, __ATOMIC_RELAXED, __HIP_MEMORY_SCOPE_AGENT); break; } }
            __builtin_amdgcn_fence(__ATOMIC_ACQUIRE, "agent"); asm volatile("s_waitcnt vmcnt(0)" ::: "memory"); }
        __syncthreads();
    }
};

typedef float f32x2 __attribute__((ext_vector_type(2)));
typedef _Float16 f16x2 __attribute__((ext_vector_type(2)));
__device__ __forceinline__ unsigned cvt_pk_h(float lo, float hi) { const f16x2 v = __builtin_convertvector((f32x2){lo, hi}, f16x2); return __builtin_bit_cast(unsigned, v); }
__device__ __forceinline__ float h_lo(unsigned w) { return (float)__builtin_bit_cast(f16x2, w)[0]; }
__device__ __forceinline__ float h_hi(unsigned w) { return (float)__builtin_bit_cast(f16x2, w)[1]; }
__device__ __forceinline__ float fsilu(float v) { return v * __builtin_amdgcn_rcpf(1.f + __builtin_amdgcn_exp2f(-1.4426950408889634f * v)); }
__device__ __forceinline__ float fsigm(float v) { return __builtin_amdgcn_rcpf(1.f + __builtin_amdgcn_exp2f(-1.4426950408889634f * v)); }

struct EpiH16 {
    static constexpr bool PERM = true, AFTER_DRAIN = false;
    bf16_t* O; int ldc;
    __device__ __forceinline__ void operator()(const f32x4 (&acc)[2][2][4][2], const Unit& u, int wr, int wc, int fr, int fq) const {
        const int row0 = u.pm * BM + wr * 64 + fr, col0 = u.pn * BM + wc * 32 + 8 * fq;
#pragma unroll
        for (int ai = 0; ai < 2; ++ai)
#pragma unroll
            for (int m = 0; m < 4; ++m) { bf16_t* rowp = O + (size_t)(row0 + ai * HALF + m * 16) * ldc + col0;
#pragma unroll
                for (int bj = 0; bj < 2; ++bj) { const f32x4 v0 = acc[ai][bj][m][0], v1 = acc[ai][bj][m][1];
                    u32x4 w; w.x = cvt_pk_h(v0[0], v0[1]); w.y = cvt_pk_h(v0[2], v0[3]); w.z = cvt_pk_h(v1[0], v1[1]); w.w = cvt_pk_h(v1[2], v1[3]);
                    store16_wt(rowp + bj * HALF, w); } }
    }
};
struct EpiProj {
    static constexpr bool PERM = true, AFTER_DRAIN = false;
    bf16_t* O; int ldc; float* RS; int rs_pn0; bf16_t* USG; int seq;
    __device__ __forceinline__ void operator()(const f32x4 (&acc)[2][2][4][2], const Unit& u, int wr, int wc, int fr, int fq) const {
        const int row0 = u.pm * BM + wr * 64 + fr, col0 = u.pn * BM + wc * 32 + 8 * fq;
#pragma unroll
        for (int ai = 0; ai < 2; ++ai)
#pragma unroll
            for (int m = 0; m < 4; ++m) { const int grow = row0 + ai * HALF + m * 16; bf16_t* rowp = O + (size_t)grow * ldc + col0 - 512;
                const int bb = grow / seq, tt = grow % seq;
#pragma unroll
                for (int bj = 0; bj < 2; ++bj) { const f32x4 v0 = acc[ai][bj][m][0], v1 = acc[ai][bj][m][1];
                    u32x4 w; w.x = cvt_pk_h(v0[0], v0[1]); w.y = cvt_pk_h(v0[2], v0[3]); w.z = cvt_pk_h(v1[0], v1[1]); w.w = cvt_pk_h(v1[2], v1[3]);
                    if (u.pn < 2) { const int c = col0 + bj * HALF;
                        *(u32x4*)(USG + ((size_t)(c >> 4) * 1024 + bb * 512 + (tt >> 4)) * 384 + (tt & 15) * 16 + (c & 15)) = w;
                    }
                    else *(u32x4*)(rowp + bj * HALF) = w; } }
        if (u.pn >= rs_pn0) {
#pragma unroll
            for (int ai = 0; ai < 2; ++ai)
#pragma unroll
                for (int m = 0; m < 4; ++m)
#pragma unroll
                    for (int bj = 0; bj < 2; ++bj) { const f32x4 v0 = acc[ai][bj][m][0], v1 = acc[ai][bj][m][1];
                        float q = (v0[0] * v0[0] + v0[1] * v0[1]) + (v0[2] * v0[2] + v0[3] * v0[3]) + (v1[0] * v1[0] + v1[1] * v1[1]) + (v1[2] * v1[2] + v1[3] * v1[3]);
                        q += __shfl_xor(q, 16); q += __shfl_xor(q, 32);
                        if (fq == 0) RS[((size_t)(row0 + ai * HALF + m * 16) * 3 + (u.pn - rs_pn0)) * 8 + bj * 4 + wc] = q; }
        }
    }
};
struct MlaAux { const float* RS; const float* rope; const bf16_t* proj; int ldp, krcol0; };
constexpr int MLA_TBL = 8192, MLA_ROPE = 12288, MLA_KR = 45056;
__device__ __forceinline__ void mla_stage_rows(const MlaAux& A, const Unit& u, PG8_LAS unsigned char* lds, int tid, bool want_kr, float eps) {
    const size_t row0 = (size_t)u.pm * BM;
    u32x4 rp[4];
#pragma unroll
    for (int j = 0; j < 4; ++j) rp[j] = *(const u32x4*)((const char*)(A.rope + row0 * 32) + (size_t)(tid + 512 * j) * 16);
    u32x4 kr[2] = {{0u, 0u, 0u, 0u}, {0u, 0u, 0u, 0u}};
    if (want_kr) {
#pragma unroll
        for (int j = 0; j < 2; ++j) { const int c = tid + 512 * j; kr[j] = *(const u32x4*)(A.proj + (row0 + (c >> 2)) * A.ldp + A.krcol0 + 8 * (c & 3)); } }
    if (tid < 256) { const float* rs = A.RS + (row0 + tid) * 24;
        const f32x4 s6a = *(const f32x4*)rs, s6b = *(const f32x4*)(rs + 4), s7a = *(const f32x4*)(rs + 8), s7b = *(const f32x4*)(rs + 12), s8a = *(const f32x4*)(rs + 16); const float skr = rs[20];
        const float sq = ((s7a[0] + s7a[1]) + (s7a[2] + s7a[3])) + ((s7b[0] + s7b[1]) + (s7b[2] + s7b[3])) + ((s8a[0] + s8a[1]) + (s8a[2] + s8a[3]));
        const float skv = ((s6a[0] + s6a[1]) + (s6a[2] + s6a[3])) + ((s6b[0] + s6b[1]) + (s6b[2] + s6b[3]));
        *(PG8_LAS f32x4*)(lds + MLA_TBL + tid * 16) = (f32x4){1.f / sqrtf(sq * (1.f / 384.f) + eps), 1.f / sqrtf(skv * (1.f / 256.f) + eps), skr, 0.f}; }
#pragma unroll
    for (int j = 0; j < 4; ++j) *(PG8_LAS u32x4*)(lds + MLA_ROPE + (tid + 512 * j) * 16) = rp[j];
    if (want_kr) {
#pragma unroll
        for (int j = 0; j < 2; ++j) *(PG8_LAS u32x4*)(lds + MLA_KR + (tid + 512 * j) * 16) = kr[j]; }
}
struct EpiQ {
    static constexpr bool PERM = true, AFTER_DRAIN = true;
    MlaAux A; const float* gq; bf16_t* Q; float qscale, eps; int seq;
    __device__ __forceinline__ void fused(f32x4 (&acc)[2][2][4][2], const Unit& u, int wr, int wc, int fr, int fq, PG8_LAS unsigned char* lds, int wid, int lane) const {
        PG8_LAS float* P = (PG8_LAS float*)lds;
#pragma unroll
        for (int ai = 0; ai < 2; ++ai)
#pragma unroll
            for (int m = 0; m < 4; ++m)
#pragma unroll
                for (int bj = 0; bj < 2; ++bj) { const f32x4 v0 = acc[ai][bj][m][0], v1 = acc[ai][bj][m][1];
                    float q = (v0[0] * v0[0] + v0[1] * v0[1]) + (v0[2] * v0[2] + v0[3] * v0[3]) + (v1[0] * v1[0] + v1[1] * v1[1]) + (v1[2] * v1[2] + v1[3] * v1[3]);
                    q += __shfl_xor(q, 16); q += __shfl_xor(q, 32);
                    if (fq == 0) P[((ai * HALF + wr * 64 + m * 16 + fr) * 2 + bj) * 4 + wc] = q; }
        mla_stage_rows(A, u, lds, wid * 64 + lane, false, eps);
        asm volatile("s_waitcnt lgkmcnt(0)" ::: "memory"); __builtin_amdgcn_s_barrier(); asm volatile("" ::: "memory");
        if (wc == 3) return;
        const int d0 = 32 * wc + 8 * fq;
        const f32x4 g0 = *(const f32x4*)(gq + (wc == 2 ? 64 + 8 * fq : d0)), g1 = *(const f32x4*)(gq + (wc == 2 ? 64 + 8 * fq : d0) + 4);
#pragma unroll
        for (int ai = 0; ai < 2; ++ai)
#pragma unroll
            for (int m = 0; m < 4; ++m) { const int r = ai * HALF + wr * 64 + m * 16 + fr; const size_t grow = (size_t)u.pm * BM + r;
                const float rstd = (*(const PG8_LAS f32x4*)(lds + MLA_TBL + r * 16))[0];
                f32x4 cs0 = {0.f, 0.f, 0.f, 0.f}, cs1 = cs0, cs2 = cs0, cs3 = cs0;
                if (wc == 2) { const PG8_LAS float* rp = (const PG8_LAS float*)(lds + MLA_ROPE) + (r * 16 + 8 * (fq & 1)) * 2; cs0 = *(const PG8_LAS f32x4*)rp; cs1 = *(const PG8_LAS f32x4*)(rp + 4); cs2 = *(const PG8_LAS f32x4*)(rp + 8); cs3 = *(const PG8_LAS f32x4*)(rp + 12); }
#pragma unroll
                for (int bj = 0; bj < 2; ++bj) { const f32x4 pp = *(const PG8_LAS f32x4*)(P + (r * 2 + bj) * 4);
                    const float tot = (pp[0] + pp[1]) + pp[2];
                    const float rs = qscale * rstd * __builtin_amdgcn_rsqf(rstd * rstd * tot * (1.f / 96.f) + eps);
                    f32x4 v0 = acc[ai][bj][m][0] * rs * g0, v1 = acc[ai][bj][m][1] * rs * g1;
                    if (wc == 2) {
                        f32x4 o0, o1;
#pragma unroll
                        for (int e = 0; e < 4; ++e) { o0[e] = __shfl_xor(v0[e], 32); o1[e] = __shfl_xor(v1[e], 32); }
                        const float sg = (fq < 2) ? -1.f : 1.f;
                        v0[0] = v0[0] * cs0[0] + sg * o0[0] * cs0[1]; v0[1] = v0[1] * cs0[2] + sg * o0[1] * cs0[3]; v0[2] = v0[2] * cs1[0] + sg * o0[2] * cs1[1]; v0[3] = v0[3] * cs1[2] + sg * o0[3] * cs1[3];
                        v1[0] = v1[0] * cs2[0] + sg * o1[0] * cs2[1]; v1[1] = v1[1] * cs2[2] + sg * o1[1] * cs2[3]; v1[2] = v1[2] * cs3[0] + sg * o1[2] * cs3[1]; v1[3] = v1[3] * cs3[2] + sg * o1[3] * cs3[3]; }
                    u32x4 w; w.x = cvt_pk_h(v0[0], v0[1]); w.y = cvt_pk_h(v0[2], v0[3]); w.z = cvt_pk_h(v1[0], v1[1]); w.w = cvt_pk_h(v1[2], v1[3]);
                    *(u32x4*)(Q + grow * 768 + (2 * u.pn + bj) * 96 + d0) = w; } }
    }
};
struct EpiKV {
    static constexpr bool PERM = true, AFTER_DRAIN = true;
    MlaAux A; const float* gk; bf16_t* KIMG; bf16_t* VIMG; float eps; int seq;
    __device__ __forceinline__ static int vst(int k, int c) { return (c >> 5) * 4096 + k * 64 + (c & 31) * 2; }
    __device__ __forceinline__ void fused(f32x4 (&acc)[2][2][4][2], const Unit& u, int wr, int wc, int fr, int fq, PG8_LAS unsigned char* lds, int wid, int lane) const {
        PG8_LAS float* P = (PG8_LAS float*)lds;
        if (wc < 2) {
#pragma unroll
            for (int ai = 0; ai < 2; ++ai)
#pragma unroll
                for (int m = 0; m < 4; ++m)
#pragma unroll
                    for (int bj = 0; bj < 2; ++bj) { const f32x4 v0 = acc[ai][bj][m][0], v1 = acc[ai][bj][m][1];
                        float q = (v0[0] * v0[0] + v0[1] * v0[1]) + (v0[2] * v0[2] + v0[3] * v0[3]) + (v1[0] * v1[0] + v1[1] * v1[1]) + (v1[2] * v1[2] + v1[3] * v1[3]);
                        q += __shfl_xor(q, 16); q += __shfl_xor(q, 32);
                        if (fq == 0) P[((ai * HALF + wr * 64 + m * 16 + fr) * 2 + bj) * 2 + wc] = q; }
        }
        mla_stage_rows(A, u, lds, wid * 64 + lane, true, eps);
        asm volatile("s_waitcnt lgkmcnt(0)" ::: "memory"); __builtin_amdgcn_s_barrier(); asm volatile("" ::: "memory");
        const int q8 = 4 * (wc & 1) + fq;
        f32x4 g0 = {0.f, 0.f, 0.f, 0.f}, g1 = g0; float ga = 0.f, gb = 0.f, gc = 0.f, gd = 0.f;
        if (wc < 2) { g0 = *(const f32x4*)(gk + 32 * wc + 8 * fq); g1 = *(const f32x4*)(gk + 32 * wc + 8 * fq + 4); }
        else { ga = gk[64 + 2 * q8]; gb = gk[65 + 2 * q8]; gc = gk[80 + 2 * q8]; gd = gk[81 + 2 * q8]; }
#pragma unroll
        for (int ai = 0; ai < 2; ++ai)
#pragma unroll
            for (int m = 0; m < 4; ++m) { const int r = ai * HALF + wr * 64 + m * 16 + fr; const size_t grow = (size_t)u.pm * BM + r;
                const f32x4 tb = *(const PG8_LAS f32x4*)(lds + MLA_TBL + r * 16); const float rstd = tb[1], skr = tb[2];
                const int bb = (int)(grow / (size_t)seq), tt = (int)(grow % (size_t)seq), trow = tt & 63;
                float cA = 0.f, sA = 0.f, cB = 0.f, sB = 0.f, x1a = 0.f, x1b = 0.f, x2a = 0.f, x2b = 0.f;
                if (wc >= 2) { const f32x4 cs = *(const PG8_LAS f32x4*)((const PG8_LAS float*)(lds + MLA_ROPE) + (r * 16 + 2 * q8) * 2); cA = cs[0]; sA = cs[1]; cB = cs[2]; sB = cs[3];
                    const PG8_LAS bf16_t* krow = (const PG8_LAS bf16_t*)(lds + MLA_KR) + r * 32;
                    const unsigned ra = *(const PG8_LAS unsigned*)(krow + 2 * q8), rb = *(const PG8_LAS unsigned*)(krow + 16 + 2 * q8);
                    x1a = h_lo(ra); x1b = h_hi(ra); x2a = h_lo(rb); x2b = h_hi(rb); }
#pragma unroll
                for (int bj = 0; bj < 2; ++bj) { const f32x2 pp = *(const PG8_LAS f32x2*)(P + (r * 2 + bj) * 2);
                    const float rs = __builtin_amdgcn_rsqf((rstd * rstd * (pp[0] + pp[1]) + skr) * (1.f / 96.f) + eps);
                    const size_t tix = (size_t)(bb * 8 + 2 * u.pn + bj) * 128 + (tt >> 6);
                    if (wc < 2) { const float f = rstd * rs; const f32x4 v0 = acc[ai][bj][m][0] * f * g0, v1 = acc[ai][bj][m][1] * f * g1;
                        u32x4 w; w.x = cvt_pk_h(v0[0], v0[1]); w.y = cvt_pk_h(v0[2], v0[3]); w.z = cvt_pk_h(v1[0], v1[1]); w.w = cvt_pk_h(v1[2], v1[3]);
                        *(u32x4*)(KIMG + tix * 6144 + (4 * wc + fq) * 512 + trow * 8) = w; }
                    else { const f32x4 v0 = acc[ai][bj][m][0] * rstd, v1 = acc[ai][bj][m][1] * rstd;
                        u32x4 w; w.x = cvt_pk_h(v0[0], v0[1]); w.y = cvt_pk_h(v0[2], v0[3]); w.z = cvt_pk_h(v1[0], v1[1]); w.w = cvt_pk_h(v1[2], v1[3]);
                        *(u32x4*)(VIMG + tix * 4096 + vst(trow, 32 * (wc - 2) + 8 * fq) / 2) = w;
                        const float y1a = x1a * rs * ga, y1b = x1b * rs * gb, y2a = x2a * rs * gc, y2b = x2b * rs * gd;
                        bf16_t* kd = KIMG + tix * 6144 + trow * 8;
                        *(unsigned*)(kd + (8 + (q8 >> 2)) * 512 + ((2 * q8) & 7)) = cvt_pk_h(y1a * cA - y2a * sA, y1b * cB - y2b * sB);
                        *(unsigned*)(kd + (10 + (q8 >> 2)) * 512 + ((2 * q8) & 7)) = cvt_pk_h(y2a * cA + y1a * sA, y2b * cB + y1b * sB); } } }
    }
};
struct EpiELds {
    static constexpr bool PERM = true, AFTER_DRAIN = true;
    __device__ __forceinline__ void fused(f32x4 (&acc)[2][2][4][2], const Unit& u, int wr, int wc, int fr, int fq, PG8_LAS unsigned char* lds, int wid, int lane) const {
        PG8_LAS float* El = (PG8_LAS float*)lds;
#pragma unroll
        for (int ai = 0; ai < 2; ++ai)
#pragma unroll
            for (int m = 0; m < 4; ++m) { const int r = ai * HALF + wr * 64 + m * 16 + fr; PG8_LAS float* rp = El + r * 128 + wc * 32 + 8 * fq;
                *(PG8_LAS f32x4*)rp = acc[ai][0][m][0]; *(PG8_LAS f32x4*)(rp + 4) = acc[ai][0][m][1]; }
    }
};
__device__ __forceinline__ void ssm_chain_unit(const Unit& u, const PG8_LAS unsigned char* lds, bf16_t* USG, const float* AC, float* hand, unsigned* cnt, unsigned* tmo, int lane) {
        const PG8_LAS float* El = (const PG8_LAS float*)lds;
        const int g = u.pn, k4 = u.pm & 3, seqi = g * 2 + (k4 >> 1), p = lane;
        const f32x4 ac = *(const f32x4*)(AC + ((size_t)g * 64 + p) * 4);
        float sr = 0.f, si = 0.f;
        if (k4 & 1) { unsigned sp = 0;
            while (__hip_atomic_load(cnt + 64 * seqi, __ATOMIC_RELAXED, __HIP_MEMORY_SCOPE_AGENT) < 1u) { __builtin_amdgcn_s_sleep(2);
                if (++sp > (1u << 22)) { if (lane == 0) __hip_atomic_store(tmo, 1u, __ATOMIC_RELAXED, __HIP_MEMORY_SCOPE_AGENT); break; } }
            const unsigned long long hv = __hip_atomic_load((const unsigned long long*)(hand + ((size_t)seqi * 64 + p) * 2), __ATOMIC_RELAXED, __HIP_MEMORY_SCOPE_AGENT);
            sr = __uint_as_float((unsigned)hv); si = __uint_as_float((unsigned)(hv >> 32)); }
        bf16_t* srow = USG + (size_t)u.pm * BM * 384 + 256 + 2 * p;
#pragma unroll 8
        for (int t = 0; t < 256; ++t) { const f32x2 e = *(const PG8_LAS f32x2*)(El + t * 128 + 2 * p);
            *(unsigned*)(srow + (size_t)t * 384) = cvt_pk_h(sr, si);
            const float nr = ac[2] * sr - ac[3] * si + e[0], ni = ac[2] * si + ac[3] * sr + e[1]; sr = nr; si = ni; }
        if (!(k4 & 1)) { __hip_atomic_store((unsigned long long*)(hand + ((size_t)seqi * 64 + p) * 2), (unsigned long long)__float_as_uint(sr) | ((unsigned long long)__float_as_uint(si) << 32), __ATOMIC_RELAXED, __HIP_MEMORY_SCOPE_AGENT);
            asm volatile("s_waitcnt vmcnt(0)" ::: "memory");
            if (lane == 0) __hip_atomic_fetch_add(cnt + 64 * seqi, 1u, __ATOMIC_RELAXED, __HIP_MEMORY_SCOPE_AGENT); }
}
struct EpiY {
    static constexpr bool PERM = true, AFTER_DRAIN = false;
    const bf16_t* USG; const float* dskip; bf16_t* YPRE; int seq;
    __device__ __forceinline__ static float gelu_t(float v) { const float z = 0.7978845608028654f * (v + 0.044715f * v * v * v); return v * __builtin_amdgcn_rcpf(1.f + __builtin_amdgcn_exp2f(-2.885390081777927f * z)); }
    __device__ __forceinline__ void operator()(const f32x4 (&acc)[2][2][4][2], const Unit& u, int wr, int wc, int fr, int fq) const {
        const int g = u.pn, k4 = u.pm & 3, bb = k4 >> 1;
        const int i0 = (8 * fq) & 15;
        const f32x4 d0 = *(const f32x4*)(dskip + g * 16 + i0), d1 = *(const f32x4*)(dskip + g * 16 + i0 + 4);
#pragma unroll
        for (int ai = 0; ai < 2; ++ai)
#pragma unroll
            for (int m = 0; m < 4; ++m) { const int r = ai * HALF + wr * 64 + m * 16 + fr; const size_t arow = (size_t)u.pm * BM + r; const int tile = (k4 & 1) * 256 + r;
#pragma unroll
                for (int bj = 0; bj < 2; ++bj) { const int col = bj * HALF + wc * 32 + 8 * fq, t = col >> 4;
                    const u32x4 uv = *(const u32x4*)(USG + arow * 384 + col);
                    const f32x4 v0 = acc[ai][bj][m][0], v1 = acc[ai][bj][m][1];
                    u32x4 w;
                    w.x = cvt_pk_h(gelu_t(v0[0] + d0[0] * h_lo(uv.x)), gelu_t(v0[1] + d0[1] * h_hi(uv.x))); w.y = cvt_pk_h(gelu_t(v0[2] + d0[2] * h_lo(uv.y)), gelu_t(v0[3] + d0[3] * h_hi(uv.y)));
                    w.z = cvt_pk_h(gelu_t(v1[0] + d1[0] * h_lo(uv.z)), gelu_t(v1[1] + d1[1] * h_hi(uv.z))); w.w = cvt_pk_h(gelu_t(v1[2] + d1[2] * h_lo(uv.w)), gelu_t(v1[3] + d1[3] * h_hi(uv.w)));
                    store16_wt(YPRE + ((size_t)bb * seq + (size_t)tile * 16 + t) * 512 + g * 16 + i0, w); } }
    }
};
struct EpiGlu {
    static constexpr bool PERM = true, AFTER_DRAIN = false;
    const bf16_t* ypre; const bf16_t* proj; int ldp, zcol0; const float* bglu; bf16_t* ycat;
    __device__ __forceinline__ void operator()(const f32x4 (&acc)[2][2][4][2], const Unit& u, int wr, int wc, int fr, int fq) const {
        const int row0 = u.pm * BM + wr * 64 + fr, col0 = u.pn * BM + wc * 32 + 8 * fq;
        f32x4 bv[2][2];
#pragma unroll
        for (int bj = 0; bj < 2; ++bj)
#pragma unroll
            for (int n = 0; n < 2; ++n) bv[bj][n] = *(const f32x4*)(bglu + col0 + bj * HALF + 4 * n);
#pragma unroll
        for (int ai = 0; ai < 2; ++ai)
#pragma unroll
            for (int m = 0; m < 4; ++m) { const size_t row = (size_t)(row0 + ai * HALF + m * 16);
#pragma unroll
                for (int bj = 0; bj < 2; ++bj) { const int col = col0 + bj * HALF;
                    const u32x4 yv = __builtin_nontemporal_load((const u32x4*)(ypre + row * 512 + col)); const u32x4 zv = __builtin_nontemporal_load((const u32x4*)(proj + row * ldp + zcol0 + col));
                    const f32x4 t0 = acc[ai][bj][m][0] + bv[bj][0], t1 = acc[ai][bj][m][1] + bv[bj][1];
                    u32x4 w;
                    w.x = cvt_pk_h(h_lo(yv.x) * fsigm(t0[0]) * fsilu(h_lo(zv.x)), h_hi(yv.x) * fsigm(t0[1]) * fsilu(h_hi(zv.x)));
                    w.y = cvt_pk_h(h_lo(yv.y) * fsigm(t0[2]) * fsilu(h_lo(zv.y)), h_hi(yv.y) * fsigm(t0[3]) * fsilu(h_hi(zv.y)));
                    w.z = cvt_pk_h(h_lo(yv.z) * fsigm(t1[0]) * fsilu(h_lo(zv.z)), h_hi(yv.z) * fsigm(t1[1]) * fsilu(h_hi(zv.z)));
                    w.w = cvt_pk_h(h_lo(yv.w) * fsigm(t1[2]) * fsilu(h_lo(zv.w)), h_hi(yv.w) * fsigm(t1[3]) * fsilu(h_hi(zv.w)));
                    store16_wt(ycat + row * 1024 + col, w); } }
    }
};
struct EpiOutRows {
    static constexpr bool PERM = false, AFTER_DRAIN = true;
    const float* x; const float* gate; int gate_stride, rows_per_batch; float* out;
    __device__ __forceinline__ static int slot(int r, int s16) { return r * 1024 + ((s16 ^ (r & 15)) << 4); }
    __device__ __forceinline__ void fused(f32x4 (&acc)[2][2][4][2], const Unit& u, int wr, int wc, int fr, int fq, PG8_LAS unsigned char* lds, int wid, int lane) const {
        const int b = (u.pm * BM) / rows_per_batch;
        const f32x4 gv = *(const f32x4*)(gate + (size_t)b * gate_stride + u.pn * BM + 4 * lane);
#pragma unroll
        for (int ai = 0; ai < 2; ++ai) {
#pragma unroll
            for (int m = 0; m < 4; ++m) { const int rl = wr * 64 + m * 16 + fr;
#pragma unroll
                for (int bj = 0; bj < 2; ++bj)
#pragma unroll
                    for (int n = 0; n < 2; ++n) *(PG8_LAS f32x4*)(lds + slot(rl, 32 * bj + 8 * wc + 4 * n + fq)) = acc[ai][bj][m][n]; }
            asm volatile("s_waitcnt lgkmcnt(0)" ::: "memory"); __builtin_amdgcn_s_barrier(); asm volatile("" ::: "memory");
            const size_t g0 = ((size_t)u.pm * BM + ai * HALF + wid * 16) * 1024 + u.pn * BM + 4 * lane;
#pragma unroll
            for (int i0 = 0; i0 < 16; i0 += 8) { f32x4 xs[8];
#pragma unroll
                for (int i = 0; i < 8; ++i) xs[i] = __builtin_nontemporal_load((const f32x4*)(x + g0 + (size_t)(i0 + i) * 1024));
#pragma unroll
                for (int i = 0; i < 8; ++i) { const f32x4 v = *(const PG8_LAS f32x4*)(lds + slot(wid * 16 + i0 + i, lane)); __builtin_nontemporal_store(xs[i] + gv * v, (f32x4*)(out + g0 + (size_t)(i0 + i) * 1024)); } }
            if (ai == 0) { asm volatile("s_waitcnt lgkmcnt(0)" ::: "memory"); __builtin_amdgcn_s_barrier(); asm volatile("" ::: "memory"); }
        }
    }
};
template <class Epi, class Sched, bool ALIGN_EPI = false, bool SP2 = false>
__device__ __forceinline__ void gemm_phase(PG8_LAS unsigned char* lds, const Gemm g, const Sched& S, const Epi& E) {
    int tid_ = threadIdx.x; asm volatile("" : "+v"(tid_));
    const int tid = tid_, wid = __builtin_amdgcn_readfirstlane(tid >> 6), lane = tid & 63, wr = wid >> 2, wc = wid & 3, fr = lane & 15, fq = lane >> 4;
    const int K = g.K, nt = K / BK;
    unsigned voffA[2], voffB[2];
#pragma unroll
    for (int i = 0; i < 2; ++i) { int R, C; stage_rc(tid * 16 + i * 8192, R, C); const int Rb = Epi::PERM ? ((R & ~31) + perm32(R & 31)) : R;
        voffA[i] = (unsigned)(R * g.lda + C) * 2u; voffB[i] = (unsigned)(Rb * K + C) * 2u; }
    const size_t kstep = (size_t)(BK * 2);
    const size_t hstepA = (size_t)HALF * g.lda * 2, hstepB = (size_t)HALF * K * 2;
    const size_t tstepA = 2 * hstepA, tstepB = 2 * hstepB;
    const unsigned ldsw = (unsigned)wid * 1024u;
    const int aoff = lds_byte(wr * 64 + fr, fq * 8), boff = lds_byte(wc * 32 + fr, fq * 8);
#define PG8_SA(b, h) (((b) * 2 + (h)) * HTB)
#define PG8_SB(b, h) ((4 + (b) * 2 + (h)) * HTB)
#define PG8_STAGE(bufoff, gbase, voff) do { _Pragma("unroll") for (int _i = 0; _i < 2; ++_i) \
        __builtin_amdgcn_global_load_lds((const unsigned*)((const char*)(gbase) + (voff)[_i]), (PG8_LAS unsigned*)(lds + (bufoff) + ldsw + _i * 8192), 16, 0, 0); } while (0)
#define PG8_LDA(dst, b, h) do { _Pragma("unroll") for (int m = 0; m < 4; ++m) _Pragma("unroll") for (int k = 0; k < 2; ++k) dst[m][k] = *(const PG8_LAS bf16x8*)(lds + PG8_SA(b, h) + aoff + m * 2048 + k * 1024); } while (0)
#define PG8_LDB(dst, b, h) do { _Pragma("unroll") for (int n = 0; n < 2; ++n) _Pragma("unroll") for (int k = 0; k < 2; ++k) dst[n][k] = *(const PG8_LAS bf16x8*)(lds + PG8_SB(b, h) + boff + n * 2048 + k * 1024); } while (0)
#define PG8_MMA(ai, bj, At, Bt) do { __builtin_amdgcn_s_setprio(1); _Pragma("unroll") for (int m = 0; m < 4; ++m) _Pragma("unroll") for (int n = 0; n < 2; ++n) _Pragma("unroll") for (int k = 0; k < 2; ++k) \
        acc[ai][bj][m][n] = __builtin_amdgcn_mfma_f32_16x16x32_f16(Bt[n][k], At[m][k], acc[ai][bj][m][n], 0, 0, 0); __builtin_amdgcn_s_setprio(0); } while (0)
#define PG8_WAIT_V(n) asm volatile("s_waitcnt vmcnt(" #n ")" ::: "memory")
#define PG8_WAIT_L(n) asm volatile("s_waitcnt lgkmcnt(" #n ")" ::: "memory")
#define PG8_BAR __builtin_amdgcn_s_barrier()
#define PG8_SCHED __builtin_amdgcn_sched_barrier(0)
    Unit cur, nxt; int ui = 0;
    if (!S.next(0, cur)) return;
    f32x4 acc[2][2][4][2];
#pragma unroll
    for (int a = 0; a < 2; ++a)
#pragma unroll
        for (int b = 0; b < 2; ++b)
#pragma unroll
            for (int m = 0; m < 4; ++m)
#pragma unroll
                for (int n = 0; n < 2; ++n) acc[a][b][m][n] = (f32x4){0.f, 0.f, 0.f, 0.f};
    bf16x8 At[4][2], B0[2][2], B1[2][2];
    const char* cA = (const char*)g.A + (size_t)cur.pm * tstepA; const char* cB = (const char*)g.Bt + (size_t)cur.pn * tstepB;
    S.a_ready(cur);
    if constexpr (SP2) {
        PG8_STAGE(PG8_SB(0, 0), cB, voffB); PG8_STAGE(PG8_SB(0, 1), cB + hstepB, voffB); PG8_STAGE(PG8_SA(0, 0), cA, voffA); PG8_STAGE(PG8_SA(0, 1), cA + hstepA, voffA);
        if (wr == 1) PG8_BAR;
        PG8_WAIT_V(2); PG8_BAR;
        PG8_STAGE(PG8_SB(1, 0), cB + kstep, voffB); PG8_STAGE(PG8_SA(1, 0), cA + kstep, voffA); PG8_STAGE(PG8_SB(1, 1), cB + hstepB + kstep, voffB);
        PG8_WAIT_V(6); PG8_BAR;
    } else {
        PG8_STAGE(PG8_SB(0, 0), cB, voffB); PG8_STAGE(PG8_SA(0, 0), cA, voffA); PG8_STAGE(PG8_SB(0, 1), cB + hstepB, voffB); PG8_STAGE(PG8_SA(0, 1), cA + hstepA, voffA);
        if (wr == 1) PG8_BAR;
        PG8_WAIT_V(4); PG8_BAR;
        PG8_STAGE(PG8_SB(1, 0), cB + kstep, voffB); PG8_STAGE(PG8_SA(1, 0), cA + kstep, voffA); PG8_STAGE(PG8_SB(1, 1), cB + hstepB + kstep, voffB);
        PG8_WAIT_V(6); PG8_BAR;
    }
    for (;;) {
        const bool has_next = S.next(ui + 1, nxt);
        const char* nA = has_next ? (const char*)g.A + (size_t)nxt.pm * tstepA : cA; const char* nB = has_next ? (const char*)g.Bt + (size_t)nxt.pn * tstepB : cB;
        for (int t = 0; t < nt; t += 2) {
            const bool last = (t == nt - 2);
            const char* a1 = cA + (size_t)(t + 1) * kstep;
            const char* a2 = last ? nA : cA + (size_t)(t + 2) * kstep; const char* b2 = last ? nB : cB + (size_t)(t + 2) * kstep;
            const char* a3 = a2 + kstep; const char* b3 = b2 + kstep;
            if (last && has_next) S.a_ready(nxt);
            if constexpr (SP2) {
            PG8_LDB(B0, 0, 0); PG8_LDB(B1, 0, 1); PG8_SCHED; PG8_LDA(At, 0, 0); PG8_STAGE(PG8_SA(1, 1), a1 + hstepA, voffA);
            PG8_WAIT_V(8); PG8_WAIT_L(0); PG8_BAR; PG8_MMA(0, 0, At, B0); PG8_MMA(0, 1, At, B1); PG8_BAR; PG8_SCHED;
            PG8_LDA(At, 0, 1); PG8_STAGE(PG8_SB(0, 0), b2, voffB); PG8_STAGE(PG8_SB(0, 1), b2 + hstepB, voffB); PG8_STAGE(PG8_SA(0, 0), a2, voffA);
            PG8_WAIT_V(8); PG8_WAIT_L(0); PG8_BAR; PG8_MMA(1, 0, At, B0); PG8_MMA(1, 1, At, B1); PG8_BAR; PG8_SCHED;
            PG8_LDB(B0, 1, 0); PG8_LDB(B1, 1, 1); PG8_SCHED; PG8_LDA(At, 1, 0); PG8_STAGE(PG8_SA(0, 1), a2 + hstepA, voffA);
            PG8_WAIT_V(8); PG8_WAIT_L(0); PG8_BAR; PG8_MMA(0, 0, At, B0); PG8_MMA(0, 1, At, B1); PG8_BAR; PG8_SCHED;
            PG8_LDA(At, 1, 1); PG8_STAGE(PG8_SB(1, 0), b3, voffB); PG8_STAGE(PG8_SB(1, 1), b3 + hstepB, voffB); PG8_STAGE(PG8_SA(1, 0), a3, voffA);
            PG8_WAIT_V(8); PG8_WAIT_L(0); PG8_BAR; PG8_MMA(1, 0, At, B0); PG8_MMA(1, 1, At, B1); PG8_BAR; PG8_SCHED;
            } else {
            PG8_LDB(B0, 0, 0); PG8_SCHED; PG8_LDA(At, 0, 0); PG8_STAGE(PG8_SA(1, 1), a1 + hstepA, voffA);
            PG8_WAIT_L(8); PG8_BAR; PG8_WAIT_L(0); PG8_MMA(0, 0, At, B0); PG8_BAR; PG8_SCHED;
            PG8_LDB(B1, 0, 1); PG8_STAGE(PG8_SB(0, 0), b2, voffB);
            PG8_BAR; PG8_WAIT_L(0); PG8_MMA(0, 1, At, B1); PG8_BAR;
            PG8_LDA(At, 0, 1); PG8_STAGE(PG8_SA(0, 0), a2, voffA);
            PG8_BAR; PG8_WAIT_L(0); PG8_MMA(1, 0, At, B0); PG8_BAR; PG8_SCHED;
            PG8_STAGE(PG8_SB(0, 1), b2 + hstepB, voffB);
            PG8_WAIT_V(6); PG8_BAR; PG8_MMA(1, 1, At, B1); PG8_BAR;
            PG8_LDB(B0, 1, 0); PG8_SCHED; PG8_LDA(At, 1, 0); PG8_STAGE(PG8_SA(0, 1), a2 + hstepA, voffA);
            PG8_WAIT_L(8); PG8_BAR; PG8_WAIT_L(0); PG8_MMA(0, 0, At, B0); PG8_BAR; PG8_SCHED;
            PG8_LDB(B1, 1, 1); PG8_STAGE(PG8_SB(1, 0), b3, voffB);
            PG8_BAR; PG8_WAIT_L(0); PG8_MMA(0, 1, At, B1); PG8_BAR;
            PG8_LDA(At, 1, 1); PG8_STAGE(PG8_SA(1, 0), a3, voffA);
            PG8_BAR; PG8_WAIT_L(0); PG8_MMA(1, 0, At, B0); PG8_BAR; PG8_SCHED;
            PG8_STAGE(PG8_SB(1, 1), b3 + hstepB, voffB);
            PG8_WAIT_V(6); PG8_BAR; PG8_MMA(1, 1, At, B1); PG8_BAR;
            }
        }
        if constexpr (ALIGN_EPI) { if (wr == 0) PG8_BAR; }
        if constexpr (!Epi::AFTER_DRAIN) { E(acc, cur, wr, wc, fr, fq); S.done(cur); }
        if (!has_next) break;
#pragma unroll
        for (int a = 0; a < 2; ++a)
#pragma unroll
            for (int b = 0; b < 2; ++b)
#pragma unroll
                for (int m = 0; m < 4; ++m)
#pragma unroll
                    for (int n = 0; n < 2; ++n) acc[a][b][m][n] = (f32x4){0.f, 0.f, 0.f, 0.f};
        cur = nxt; cA = nA; cB = nB; ++ui;
        if constexpr (ALIGN_EPI) { if (wr == 1) PG8_BAR; }
    }
    PG8_WAIT_V(0);
    if constexpr (!ALIGN_EPI) { if (wr == 0) PG8_BAR; }
    PG8_BAR;
    if constexpr (Epi::AFTER_DRAIN) { E.fused(acc, cur, wr, wc, fr, fq, lds, wid, lane); S.done(cur); }
#undef PG8_SA
#undef PG8_SB
#undef PG8_STAGE
#undef PG8_LDA
#undef PG8_LDB
#undef PG8_MMA
#undef PG8_WAIT_V
#undef PG8_WAIT_L
#undef PG8_BAR
#undef PG8_SCHED
}
}

namespace att {
using h16x8 = __attribute__((ext_vector_type(8))) _Float16;
using s16x4 = __attribute__((ext_vector_type(4))) short;
using f32x16 = __attribute__((ext_vector_type(16))) float;
using u32x4 = __attribute__((ext_vector_type(4))) unsigned;
typedef float f32x2_t __attribute__((ext_vector_type(2))); typedef _Float16 f16x2_t __attribute__((ext_vector_type(2)));
constexpr int NW = 8, QBLK = 32, KVBLK = 64, QB = 256, ASEQ = 8192;
constexpr int LDQ = 768, LDK = 1024, LDV = 512;
constexpr float SCALE = 0.10206207261596575f;
constexpr float THR = 8.f;
#define SBAR() __builtin_amdgcn_sched_barrier(0)
__device__ __forceinline__ int crow(int r, int hi) { return (r & 3) + 8 * (r >> 2) + 4 * hi; }
__device__ __forceinline__ unsigned cvtpk(float lo, float hi) { const f16x2_t v = __builtin_convertvector((f32x2_t){lo, hi}, f16x2_t); return __builtin_bit_cast(unsigned, v); }

__device__ __forceinline__ void cmask(f32x16& p0, f32x16& p1, int jb, int qrel, int hi) {
  const float NEG = -INFINITY; const int kb = 64 * jb + 4 * hi;
#pragma unroll
  for (int r = 0; r < 16; ++r) { const int kv = kb + (r & 3) + 8 * (r >> 2); if (kv > qrel) p0[r] = NEG; if (kv + 32 > qrel) p1[r] = NEG; }
}
constexpr int KT_BYTES = 12288, VT_BYTES = 8192, NKS = 3, NVS = 4;
constexpr int LDS_V0 = NKS * KT_BYTES, LDS_WSC = LDS_V0 + NVS * VT_BYTES;
constexpr int LDS_OST = LDS_WSC + NW * 64 * 4;
constexpr int LDS_ATT2 = LDS_OST + NW * 4096;
typedef __attribute__((address_space(3))) unsigned char* lds3_t;
__device__ __forceinline__ unsigned gate2(unsigned ow, unsigned zw) {
  const f16x2_t o2 = __builtin_bit_cast(f16x2_t, ow), z2 = __builtin_bit_cast(f16x2_t, zw); const float z0 = (float)z2[0], z1 = (float)z2[1];
  return cvtpk((float)o2[0] * (z0 * __builtin_amdgcn_rcpf(1.f + __builtin_amdgcn_exp2f(-1.4426950408889634f * z0))), (float)o2[1] * (z1 * __builtin_amdgcn_rcpf(1.f + __builtin_amdgcn_exp2f(-1.4426950408889634f * z1))));
}
#define PIN(x) asm volatile("" : "+v"(x))
#define MFMAH(a, b, c) __builtin_amdgcn_mfma_f32_32x32x16_f16(a, b, c, 0, 0, 0)
typedef __attribute__((address_space(3))) const char* lds_cptr;
typedef short v4i16_t __attribute__((ext_vector_type(4)));
__device__ __forceinline__ void kload2(h16x8* kf, lds_cptr kp, int d0) { kf[2 * d0] = *(const __attribute__((address_space(3))) h16x8*)(kp + d0 * 2048); kf[2 * d0 + 1] = *(const __attribute__((address_space(3))) h16x8*)(kp + d0 * 2048 + 512); }
__device__ __forceinline__ s16x4 vtr(lds_cptr p) { return __builtin_bit_cast(s16x4, __builtin_amdgcn_ds_read_tr16_b64_v4i16((__attribute__((address_space(3))) v4i16_t*)p)); }
#define MX3(a, b, c) __builtin_fmaxf(__builtin_fmaxf((a), (b)), (c))
__device__ __forceinline__ float rowmax(const f32x16& p0, const f32x16& p1) {
  float a = MX3(p0[0], p0[1], p1[0]), b = MX3(p0[2], p0[3], p1[1]); a = MX3(a, p1[2], p1[3]);
#pragma unroll
  for (int r = 4; r < 16; r += 4) { a = MX3(a, p0[r], p0[r + 1]); b = MX3(b, p0[r + 2], p0[r + 3]); a = MX3(a, p1[r], p1[r + 1]); b = MX3(b, p1[r + 2], p1[r + 3]); }
  float m = __builtin_fmaxf(a, b); auto rr = __builtin_amdgcn_permlane32_swap(__float_as_uint(m), __float_as_uint(m), false, false);
  return __builtin_fmaxf(__uint_as_float(rr[0]), __uint_as_float(rr[1])); }
__device__ __forceinline__ void attn_unit(int b, int h, int qb, const unsigned short* __restrict__ Q, const unsigned short* __restrict__ KIMG, const unsigned short* __restrict__ VIMG,
                                          const unsigned short* __restrict__ PROJ, int ldp, int zcol0, unsigned short* __restrict__ YCAT, char* lds, lds3_t lds3, unsigned* done_cnt, unsigned* z_cnt, unsigned* tmo) {
  int tid_ = threadIdx.x; asm volatile("" : "+v"(tid_));
  const int tid = tid_, lane = tid & 63, r32 = lane & 31, hi = lane >> 5; const int wid = __builtin_amdgcn_readfirstlane(tid >> 6);
  float* ws = (float*)(lds + LDS_WSC) + wid * 64; float* li_l = ws; float* al_l = ws + 32;
  const long rowbase = (long)b * ASEQ; const int q0 = qb * QB;
  const int NT = (q0 + QB) / KVBLK;
  const char* Kg = (const char*)KIMG + (size_t)(b * 8 + h) * 128 * KT_BYTES + lane * 16;
  const char* Vg = (const char*)VIMG + (size_t)(b * 8 + h) * 128 * VT_BYTES + lane * 16;
  const lds_cptr kp0 = (lds_cptr)lds3 + hi * 1024 + r32 * 16;
  const lds_cptr vp0 = (lds_cptr)lds3 + LDS_V0 + ((lane >> 4) & 1) * 32 + (lane & 3) * 8 + (4 * hi + ((lane & 15) >> 2)) * 64;
  constexpr float THRL = THR * 1.4426950408889634f;
#define GLDS(gp, loff) __builtin_amdgcn_global_load_lds((const unsigned*)(gp), (__attribute__((address_space(3))) unsigned*)(lds3 + (loff)), 16, 0, 0)
#define DMA_K(t, slot) do { const char* kg_ = Kg + (size_t)(t) * KT_BYTES; const int ko_ = (slot) * KT_BYTES; GLDS(kg_ + wid * 1024, ko_ + wid * 1024); if (wid < 4) GLDS(kg_ + (8 + wid) * 1024, ko_ + (8 + wid) * 1024); } while (0)
#define DMA_V(t, slot) do { GLDS(Vg + (size_t)(t) * VT_BYTES + wid * 1024, LDS_V0 + (slot) * VT_BYTES + wid * 1024); } while (0)
#define WAITB(A, B) do { if (wid < 4) asm volatile("s_waitcnt vmcnt(" #A ") lgkmcnt(0)\n\ts_barrier" ::: "memory"); else asm volatile("s_waitcnt vmcnt(" #B ") lgkmcnt(0)\n\ts_barrier" ::: "memory"); } while (0)
  float mhat = 0.f, l_reg = 0.f; f32x16 o[2]; o[0] = f32x16{}; o[1] = f32x16{}; h16x8 qr[6]; f32x16 negm = {}; PIN(negm);
  const int qrel = wid * QBLK + r32; bool resc = false;
  f32x16 pA0, pA1, pB0, pB1; h16x8 kf[12]; s16x4 vlo[8], vhi[8]; u32x4 pw0, pw1, pw2, pw3;
  int s_prev = 0, s_cur = 0, s_next = 1;
#define ROT() do { s_prev = s_cur; s_cur = s_next; s_next = (s_next == 2) ? 0 : s_next + 1; } while (0)
#define RESC() do { if (resc) { _Pragma("unroll") for (int d_ = 0; d_ < 2; ++d_) _Pragma("unroll") for (int r = 0; r < 16; ++r) o[d_][r] *= al_l[crow(r, hi)]; } } while (0)
  DMA_K(0, 0); DMA_V(0, 0); DMA_K(1, 1);
  { const unsigned short* Qw = Q + (rowbase + q0 + wid * QBLK + r32) * LDQ + h * 96 + hi * 8;
#pragma unroll
    for (int d0 = 0; d0 < 6; ++d0) qr[d0] = __builtin_nontemporal_load(reinterpret_cast<const h16x8*>(Qw + d0 * 16)); }
  DMA_K(2, 2);
  WAITB(2, 1);
#pragma unroll
  for (int d0 = 0; d0 < 6; ++d0) kload2(kf, kp0, d0);
  pA0 = MFMAH(kf[0], qr[0], negm); pA1 = MFMAH(kf[1], qr[0], negm);
#pragma unroll
  for (int d0 = 1; d0 < 6; ++d0) { pA0 = MFMAH(kf[2 * d0], qr[d0], pA0); pA1 = MFMAH(kf[2 * d0 + 1], qr[d0], pA1); }
  if (NT == 4) cmask(pA0, pA1, 0, qrel, hi);
  { const float rm = rowmax(pA0, pA1); mhat = rm;
#pragma unroll
    for (int r = 0; r < 16; ++r) negm[r] = -rm;
    PIN(negm);
#pragma unroll
    for (int r = 0; r < 16; ++r) { pA0[r] = __builtin_amdgcn_exp2f(pA0[r] - rm); pA1[r] = __builtin_amdgcn_exp2f(pA1[r] - rm); } }
  WAITB(0, 0);
  DMA_K(3, 0); DMA_V(1, 1); ROT();
#pragma unroll
  for (int d0 = 0; d0 < 6; ++d0) kload2(kf, kp0 + s_cur * KT_BYTES, d0);
  WAITB(3, 2);
#define PKW(P, i) cvtpk(P[i], P[i + 1])
#define PAF(k) __builtin_bit_cast(h16x8, pw##k)
#define VFR(i) __builtin_bit_cast(h16x8, (__attribute__((ext_vector_type(8))) short){vlo[i][0], vlo[i][1], vlo[i][2], vlo[i][3], vhi[i][0], vhi[i][1], vhi[i][2], vhi[i][3]})
#define VRD(i) do { vlo[i] = vtr(vp_ + (((i) >> 2) * 4096 + ((i) & 3) * 1024)); vhi[i] = vtr(vp_ + (((i) >> 2) * 4096 + ((i) & 3) * 1024 + 512)); } while (0)
#define KRD(G, d0) do { if (G) { kload2(kf, kp0 + s_next * KT_BYTES, d0); SBAR(); } } while (0)
#define GAPA(MF, a0, a1, a2, W0, W1, PW) do { MF; sacc += a0; sacc += a1; sacc += a2; W0; W1; PIN(PW); PIN(sacc); SBAR(); } while (0)
#define GAPA3(MF, a0, a1, a2) do { MF; sacc += a0; sacc += a1; sacc += a2; PIN(sacc); SBAR(); } while (0)
#define GAPB(MF, X, i) do { MF; X[i] = __builtin_amdgcn_exp2f(X[i]); X[i + 1] = __builtin_amdgcn_exp2f(X[i + 1]); X[i + 2] = __builtin_amdgcn_exp2f(X[i + 2]); X[i + 3] = __builtin_amdgcn_exp2f(X[i + 3]); PIN(X); SBAR(); } while (0)
#define STEP(C0, C1, P0, P1, t, MASK, GK, GV, GL) do { SBAR(); \
    const lds_cptr vp_ = vp0 + s_prev * VT_BYTES; \
    VRD(0); SBAR(); float sacc = P0[0] + P0[1]; \
                    GAPA(C0 = MFMAH(kf[0], qr[0], negm), P0[2], P0[3], P0[4],     pw0[0] = PKW(P0, 0),  pw0[1] = PKW(P0, 2),  pw0); \
    VRD(4); SBAR(); GAPA(C1 = MFMAH(kf[1], qr[0], negm), P0[5], P0[6], P0[7],     pw0[2] = PKW(P0, 4),  pw0[3] = PKW(P0, 6),  pw0); \
    VRD(1); SBAR(); GAPA(C0 = MFMAH(kf[2], qr[1], C0),   P0[8], P0[9], P0[10],    pw1[0] = PKW(P0, 8),  pw1[1] = PKW(P0, 10), pw1); \
    VRD(5); SBAR(); GAPA(C1 = MFMAH(kf[3], qr[1], C1),   P0[11], P0[12], P0[13],  pw1[2] = PKW(P0, 12), pw1[3] = PKW(P0, 14), pw1); \
    VRD(2); SBAR(); GAPA(C0 = MFMAH(kf[4], qr[2], C0),   P0[14], P0[15], P1[0],   pw2[0] = PKW(P1, 0),  pw2[1] = PKW(P1, 2),  pw2); \
    VRD(6); SBAR(); GAPA(C1 = MFMAH(kf[5], qr[2], C1),   P1[1], P1[2], P1[3],     pw2[2] = PKW(P1, 4),  pw2[3] = PKW(P1, 6),  pw2); \
    VRD(3); SBAR(); GAPA(C0 = MFMAH(kf[6], qr[3], C0),   P1[4], P1[5], P1[6],     pw3[0] = PKW(P1, 8),  pw3[1] = PKW(P1, 10), pw3); \
    VRD(7); SBAR(); GAPA(C1 = MFMAH(kf[7], qr[3], C1),   P1[7], P1[8], P1[9],     pw3[2] = PKW(P1, 12), pw3[3] = PKW(P1, 14), pw3); \
    GAPA3(C0 = MFMAH(kf[8], qr[4], C0), P1[10], P1[11], P1[12]); \
    GAPA3(C1 = MFMAH(kf[9], qr[4], C1), P1[13], P1[14], P1[15]); \
    C0 = MFMAH(kf[10], qr[5], C0); C1 = MFMAH(kf[11], qr[5], C1); \
    l_reg += sacc; \
    if (GK) DMA_K((t) + 3, s_cur); if (GV) DMA_V((t) + 1, s_next);                                                         \
    if (MASK) cmask(C0, C1, (t) - (NT - 4), qrel, hi); \
    { const float rm = rowmax(C0, C1); resc = false;                                                                       \
      if (__builtin_expect(__any(rm > THRL), 0)) { const float dl = __builtin_fmaxf(rm, 0.f); mhat += dl;                  \
          const float f = __builtin_amdgcn_exp2f(-dl); l_reg *= f; if (hi == 0) al_l[r32] = f; resc = true; \
          _Pragma("unroll") for (int r = 0; r < 16; ++r) { C0[r] -= dl; C1[r] -= dl; } \
          _Pragma("unroll") for (int r = 0; r < 16; ++r) negm[r] = -mhat; \
          PIN(negm); } } \
    SBAR(); \
    GAPB(o[0] = MFMAH(PAF(0), VFR(0), o[0]), C0, 0);              GAPB(o[1] = MFMAH(PAF(0), VFR(4), o[1]), C0, 4); \
    KRD(GL, 0); GAPB(o[0] = MFMAH(PAF(1), VFR(1), o[0]), C0, 8);  KRD(GL, 1); GAPB(o[1] = MFMAH(PAF(1), VFR(5), o[1]), C0, 12); \
    KRD(GL, 2); GAPB(o[0] = MFMAH(PAF(2), VFR(2), o[0]), C1, 0);  KRD(GL, 3); GAPB(o[1] = MFMAH(PAF(2), VFR(6), o[1]), C1, 4); \
    KRD(GL, 4); GAPB(o[0] = MFMAH(PAF(3), VFR(3), o[0]), C1, 8);  KRD(GL, 5); GAPB(o[1] = MFMAH(PAF(3), VFR(7), o[1]), C1, 12); \
    } while (0)
  int t = 1;
  for (; t + 5 < NT; t += 2) {
    STEP(pB0, pB1, pA0, pA1, t, false, true, true, true);     WAITB(3, 2); RESC(); ROT();
    STEP(pA0, pA1, pB0, pB1, t + 1, false, true, true, true); WAITB(3, 2); RESC(); ROT();
  }
#define ENDW(tt) do { if ((tt) + 3 < NT) { WAITB(3, 2); } else if ((tt) + 2 < NT) { WAITB(1, 1); } else { WAITB(0, 0); } } while (0)
  for (; t + 1 < NT; t += 2) {
    STEP(pB0, pB1, pA0, pA1, t, true, (t + 3 < NT), (t + 1 < NT), (t + 1 < NT));         ENDW(t);     RESC(); ROT();
    STEP(pA0, pA1, pB0, pB1, t + 1, true, (t + 4 < NT), (t + 2 < NT), (t + 2 < NT));     ENDW(t + 1); RESC(); ROT();
  }
  STEP(pB0, pB1, pA0, pA1, NT - 1, true, false, false, false); RESC();
  { float sacc = pB0[0] + pB0[1];
#pragma unroll
    for (int r = 2; r < 16; ++r) sacc += pB0[r];
#pragma unroll
    for (int r = 0; r < 16; ++r) sacc += pB1[r];
    l_reg += sacc;
    pw0 = (u32x4){PKW(pB0, 0), PKW(pB0, 2), PKW(pB0, 4), PKW(pB0, 6)}; pw1 = (u32x4){PKW(pB0, 8), PKW(pB0, 10), PKW(pB0, 12), PKW(pB0, 14)};
    pw2 = (u32x4){PKW(pB1, 0), PKW(pB1, 2), PKW(pB1, 4), PKW(pB1, 6)}; pw3 = (u32x4){PKW(pB1, 8), PKW(pB1, 10), PKW(pB1, 12), PKW(pB1, 14)};
    const lds_cptr vp_ = vp0 + s_cur * VT_BYTES;
#pragma unroll
    for (int i = 0; i < 8; ++i) VRD(i);
    o[0] = MFMAH(PAF(0), VFR(0), o[0]); o[1] = MFMAH(PAF(0), VFR(4), o[1]); o[0] = MFMAH(PAF(1), VFR(1), o[0]); o[1] = MFMAH(PAF(1), VFR(5), o[1]);
    o[0] = MFMAH(PAF(2), VFR(2), o[0]); o[1] = MFMAH(PAF(2), VFR(6), o[1]); o[0] = MFMAH(PAF(3), VFR(3), o[0]); o[1] = MFMAH(PAF(3), VFR(7), o[1]); }
  { auto rr = __builtin_amdgcn_permlane32_swap(__float_as_uint(l_reg), __float_as_uint(l_reg), false, false); l_reg = __uint_as_float(rr[0]) + __uint_as_float(rr[1]); }
  if (hi == 0) li_l[r32] = l_reg; asm volatile("s_waitcnt lgkmcnt(0)" ::: "memory");
  float rli[16];
#pragma unroll
  for (int r = 0; r < 16; ++r) rli[r] = __builtin_amdgcn_rcpf(li_l[crow(r, hi)]);
  if (z_cnt && wid == 0) { unsigned sp = 0;
    while (__hip_atomic_load(z_cnt, __ATOMIC_RELAXED, __HIP_MEMORY_SCOPE_AGENT) < 2u) { __builtin_amdgcn_s_sleep(2); if (++sp > (1u << 22)) { if (lane == 0) __hip_atomic_store(tmo, 1u, __ATOMIC_RELAXED, __HIP_MEMORY_SCOPE_AGENT); break; } }
    __builtin_amdgcn_fence(__ATOMIC_ACQUIRE, "agent"); asm volatile("s_waitcnt vmcnt(0)" ::: "memory"); }
  asm volatile("s_waitcnt lgkmcnt(0)\n\ts_barrier" ::: "memory");
  const long orow0 = rowbase + q0 + wid * QBLK;
  { unsigned short* stg = (unsigned short*)(lds + LDS_OST) + wid * 2048;
#pragma unroll
    for (int r = 0; r < 16; ++r) { const int orow = crow(r, hi);
#pragma unroll
      for (int d0 = 0; d0 < 2; ++d0) stg[orow * 64 + d0 * 32 + r32] = __builtin_bit_cast(unsigned short, (_Float16)(o[d0][r] * rli[r])); }
    asm volatile("s_waitcnt lgkmcnt(0)" ::: "memory");
#pragma unroll
    for (int i = 0; i < 4; ++i) { const int row = i * 8 + (lane >> 3), ch = lane & 7; const long grow = orow0 + row;
      const u32x4 ov = *(const u32x4*)(stg + row * 64 + ch * 8); const u32x4 zv = __builtin_nontemporal_load((const u32x4*)(PROJ + grow * ldp + zcol0 + h * 64 + ch * 8));
      u32x4 w;
      w.x = gate2(ov.x, zv.x); w.y = gate2(ov.y, zv.y); w.z = gate2(ov.z, zv.z); w.w = gate2(ov.w, zv.w);
      store16_wt(YCAT + grow * 1024 + 512 + h * 64 + ch * 8, w); } }
  asm volatile("s_waitcnt vmcnt(0)\n\ts_barrier" ::: "memory");
  if (tid == 0) __hip_atomic_fetch_add(done_cnt, 1u, __ATOMIC_RELAXED, __HIP_MEMORY_SCOPE_AGENT);
#undef GLDS
#undef DMA_K
#undef DMA_V
#undef WAITB
#undef ROT
#undef RESC
#undef PKW
#undef PAF
#undef VFR
#undef VRD
#undef KRD
#undef GAPA
#undef GAPA3
#undef GAPB
#undef STEP
#undef ENDW
}
#undef PIN
#undef MFMAH
#undef MX3
#undef SBAR
}

#define GAS __attribute__((address_space(1)))
#define LAS __attribute__((address_space(3)))
typedef unsigned v4u __attribute__((ext_vector_type(4)));
typedef float f32x4 __attribute__((ext_vector_type(4)));
typedef short bf16x8 __attribute__((ext_vector_type(8)));
typedef GAS unsigned gu32;
typedef GAS unsigned long long gu64;
#define RLX_AGENT __ATOMIC_RELAXED, __HIP_MEMORY_SCOPE_AGENT
#define LDS_WAIT() asm volatile("s_waitcnt lgkmcnt(0)" ::: "memory")
#define VM_WAIT() asm volatile("s_waitcnt vmcnt(0)" ::: "memory")
__device__ __forceinline__ unsigned long long rt() { return __builtin_amdgcn_s_memrealtime(); }

#define XB_TMO      128
#define XB_XCNT(j)  (256  + 64 * (j))
#define XB_XSUB(j)  (1280 + 64 * (j))
#define XB_XGEN(j)  (2304 + 64 * (j))
#define XB_TOP      3328
#define XB_TOPGEN   3392
#define XCD_BAR_WORDS 3456
#define XB_SPIN_CAP (1u << 18)

__device__ __forceinline__ unsigned xb_ld(unsigned* p)              { return __hip_atomic_load(p, __ATOMIC_RELAXED, __HIP_MEMORY_SCOPE_AGENT); }
__device__ __forceinline__ unsigned xb_add(unsigned* p, unsigned v) { return __hip_atomic_fetch_add(p, v, __ATOMIC_RELAXED, __HIP_MEMORY_SCOPE_AGENT); }
__device__ __forceinline__ unsigned xb_xcc_id() { return (unsigned)__builtin_amdgcn_s_getreg((3 << 11) | 20) & 0xFu; }
#define XB_SPIN(cond, bar) do { unsigned _sp = 0; while (cond) { __builtin_amdgcn_s_sleep(1); \
    if ((++_sp & 255u) == 0u) { if (xb_ld(&(bar)[XB_TMO])) break; if (_sp > XB_SPIN_CAP) { atomicAdd(&(bar)[XB_TMO], 1u); break; } } } } while (0)

struct XcdBarrier {
    unsigned* bar; unsigned x;
    volatile LAS unsigned* st;
};

__device__ __forceinline__ XcdBarrier xcd_barrier_post(unsigned* bar, volatile LAS unsigned* st) {
    XcdBarrier b; b.bar = bar; b.x = xb_xcc_id(); b.st = st;
    if (threadIdx.x == 0) (void)xb_add(&bar[XB_XCNT(b.x)], 1u);
    return b;
}
__device__ __forceinline__ void xcd_barrier_complete(unsigned* bar, unsigned x, unsigned& nloc, unsigned& nx) {
    const unsigned G = gridDim.x * gridDim.y * gridDim.z;
    unsigned sum, cnt, mine, sp = 0u;
    for (;;) {
        sum = 0u; cnt = 0u; mine = 0u;
#pragma unroll
        for (unsigned j = 0; j < 16; ++j) { const unsigned c = xb_ld(&bar[XB_XCNT(j)]); sum += c; cnt += (c > 0u) ? 1u : 0u; mine = (j == x) ? c : mine; }
        if (sum == G) break;
        __builtin_amdgcn_s_sleep(1);
        if ((++sp & 255u) == 0u) { if (xb_ld(&bar[XB_TMO])) break; if (sp > XB_SPIN_CAP) { atomicAdd(&bar[XB_TMO], 1u); break; } }
    }
    nloc = mine > 0u ? mine : 1u; nx = cnt > 0u ? cnt : 1u;
}

__device__ __forceinline__ void xcd_barrier(const XcdBarrier& b) {
    asm volatile("s_waitcnt vmcnt(0)" ::: "memory");
    __syncthreads();
    if (threadIdx.x == 0) {
        unsigned* bar = b.bar;
        __builtin_amdgcn_s_waitcnt(0);
        unsigned nloc = b.st[0], nx = b.st[1];
        if (nloc == 0u) { xcd_barrier_complete(bar, b.x, nloc, nx); b.st[0] = nloc; b.st[1] = nx; }
        const unsigned old = xb_add(&bar[XB_XSUB(b.x)], 1u);
        const unsigned gen = old / nloc;
        if (old + 1u == (gen + 1u) * nloc) {
            __builtin_amdgcn_fence(__ATOMIC_RELEASE, "agent");
            asm volatile("s_waitcnt vmcnt(0)" ::: "memory");
            const unsigned og = xb_add(&bar[XB_TOP], 1u);
            const unsigned tg = og / nx;
            if (og + 1u == (tg + 1u) * nx) xb_add(&bar[XB_TOPGEN], 1u);
            else XB_SPIN(xb_ld(&bar[XB_TOPGEN]) == tg, bar);
            __builtin_amdgcn_fence(__ATOMIC_ACQUIRE, "agent");
            xb_add(&bar[XB_XGEN(b.x)], 1u);
            asm volatile("s_waitcnt vmcnt(0)" ::: "memory");
        } else {
            XB_SPIN(xb_ld(&bar[XB_XGEN(b.x)]) == gen, bar);
            __builtin_amdgcn_fence(__ATOMIC_ACQUIRE, "agent");
            asm volatile("s_waitcnt vmcnt(0)" ::: "memory");
        }
    }
    __syncthreads();
}

constexpr int NWAVES = 8;
constexpr int NPHASE = 4;
constexpr int CW_RDV = 98304;
constexpr int CW_TMO = 0, CW_CODE = 1, CW_MODC = 64, CW_OUTQ = 2048, CW_CHAIN = 81920, CW_ATTQ = 1024, CW_PANEL = 65536, CW_OUTP = 73728, CW_BAR = 4096;
constexpr int RING_OFF = 0, RING_BYTES = 131072;
constexpr int LDSCTL_OFF = RING_BYTES, MISC_OFF = LDSCTL_OFF + 320;
constexpr int SACT_OFF = LDSCTL_OFF + 1024;
constexpr int LDS_BYTES = 147456;
static_assert(MISC_OFF + 128 <= SACT_OFF && SACT_OFF + 8192 + 1024 <= LDS_BYTES, "LDS map");
static_assert(att::LDS_ATT2 <= RING_BYTES && pg8::STAGE_BYTES <= RING_BYTES, "phase scratch fits the ring");

struct Frame {
    LAS unsigned char* lds;
    volatile LAS unsigned* MISC;
    gu32* ctl;
    int tid, lane, wave, vcu, G;
};
__device__ __forceinline__ float wave_sum(float v) {
#pragma unroll
    for (int o = 1; o < 64; o <<= 1) v += __shfl_xor(v, o);
    return v;
}
__device__ __forceinline__ unsigned pk2h(float lo, float hi) { return pg8::cvt_pk_h(lo, hi); }

__device__ __forceinline__ void p0_transpose_item(const float* W, int ldw, int K, int src_n0, bf16* WT, int dst_row0, int k0, LAS float* scr, int lane, const float* gk = nullptr) {
    float t_[32];
#pragma unroll
    for (int i = 0; i < 32; ++i) t_[i] = __builtin_nontemporal_load(W + (size_t)(k0 + 2 * i + (lane >> 5)) * ldw + src_n0 + (lane & 31));
#pragma unroll
    for (int i = 0; i < 32; ++i) scr[(2 * i + (lane >> 5)) * 33 + (lane & 31)] = t_[i];
    LDS_WAIT(); asm volatile("" ::: "memory");
    const int c = lane & 7;
#pragma unroll
    for (int j = 0; j < 4; ++j) { const int n = (lane >> 3) + 8 * j; const LAS float* s = scr + (8 * c) * 33 + n;
        f32x4 g0 = {1.f, 1.f, 1.f, 1.f}, g1 = g0; if (gk) { g0 = *(const f32x4*)(gk + k0 + 8 * c); g1 = *(const f32x4*)(gk + k0 + 8 * c + 4); }
        v4u o; o.x = pk2h(s[0 * 33] * g0.x, s[1 * 33] * g0.y); o.y = pk2h(s[2 * 33] * g0.z, s[3 * 33] * g0.w); o.z = pk2h(s[4 * 33] * g1.x, s[5 * 33] * g1.y); o.w = pk2h(s[6 * 33] * g1.z, s[7 * 33] * g1.w);
        *(GAS v4u*)(WT + (size_t)(dst_row0 + n) * K + k0 + 8 * c) = o; }
    LDS_WAIT(); asm volatile("" ::: "memory");
}

struct Args {
    const float* in[24]; float* out; unsigned char* ws; int ph_lo, ph_hi, li, pad;
};

__device__ __forceinline__ void p0_mod_block(const LAS float* sact, LAS float* part, const float* w_ada, const float* b_ada, float* mod, gu32* cnt, int j, int wave, int lane) {
    const int kk = lane >> 2, c4 = lane & 3, col = 16 * j + 4 * c4;
    f32x4 w[8];
#pragma unroll
    for (int s = 0; s < 8; ++s) w[s] = __builtin_nontemporal_load((const GAS f32x4*)(w_ada + (size_t)(128 * wave + kk + 16 * s) * 3072 + col));
    f32x4 a0 = {0.f, 0.f, 0.f, 0.f}, a1 = {0.f, 0.f, 0.f, 0.f};
#pragma unroll
    for (int s = 0; s < 8; ++s) { const int k = 128 * wave + kk + 16 * s; a0 += w[s] * sact[k]; a1 += w[s] * sact[1024 + k]; }
#pragma unroll
    for (int o = 4; o < 64; o <<= 1) {
#pragma unroll
        for (int e = 0; e < 4; ++e) { a0[e] += __shfl_xor(a0[e], o); a1[e] += __shfl_xor(a1[e], o); } }
    if (lane < 4) {
#pragma unroll
        for (int e = 0; e < 4; ++e) { part[wave * 32 + 4 * c4 + e] = a0[e]; part[wave * 32 + 16 + 4 * c4 + e] = a1[e]; } }
    __syncthreads();
    if (wave == 0) {
        if (lane < 32) { float t = b_ada[16 * j + (lane & 15)];
#pragma unroll
            for (int ww = 0; ww < 8; ++ww) t += part[ww * 32 + lane];
            __hip_atomic_store((GAS float*)(mod + (lane >> 4) * 3072 + 16 * j + (lane & 15)), t, RLX_AGENT); }
        asm volatile("s_waitcnt vmcnt(0)" ::: "memory");
        if (lane == 0) __hip_atomic_fetch_add(cnt, 1u, RLX_AGENT);
    }
    __syncthreads();
}
__device__ __forceinline__ void cis_reduced(double ang, float& c, float& s) {
    const double TWO_PI = 6.283185307179586476925286766559;
    const float r = (float)(ang - TWO_PI * rint(ang / TWO_PI)); c = cosf(r); s = sinf(r);
}
__device__ __forceinline__ void ssm_pow(float lr, float li, float dtf, int n, float& pr, float& pi) {
    float c, s_; cis_reduced((double)n * (double)li * (double)dtf, c, s_); const float e = expf((float)n * lr * dtf); pr = e * c; pi = e * s_;
}
__device__ __forceinline__ void p0_ssm_item(const float* log_dt, const float* lam_re, const float* lam_im, float* AC, int g, int lane) {
    const float dtf = expf(log_dt[g]); const float lr = lam_re[g * 64 + lane], li = lam_im[g * 64 + lane];
    float a0, a1, a2, a3; ssm_pow(lr, li, dtf, 1, a0, a1); ssm_pow(lr, li, dtf, 16, a2, a3); const f32x4 v = {a0, a1, a2, a3};
    *(f32x4*)(AC + ((size_t)g * 64 + lane) * 4) = v;
}
__device__ __forceinline__ void ssm_coef_pow(const float* log_dt, const float* lam_re, const float* lam_im, int g, int lane, int n, float& cr, float& ci) {
    const float dtf = expf(log_dt[g]); const float lr = lam_re[g * 64 + lane], li = lam_im[g * 64 + lane];
    float ar, ai, pr, pi; ssm_pow(lr, li, dtf, 1, ar, ai); ssm_pow(lr, li, dtf, n, pr, pi);
    const float nr = ar - 1.f, ni = ai, den = lr * lr + li * li;
    const float kr = (nr * lr + ni * li) / den, ki = (ni * lr - nr * li) / den;
    cr = kr * pr - ki * pi; ci = kr * pi + ki * pr;
}
__device__ __forceinline__ void p0_ssm_K_item(const float* log_dt, const float* lam_re, const float* lam_im, const float* b_re, const float* b_im, const float* c_re, const float* c_im,
                                              bf16* TQ, int g, int d, LAS float* scr, int lane) {
    float cr, ci; ssm_coef_pow(log_dt, lam_re, lam_im, g, lane, d, cr, ci);
#pragma unroll
    for (int j = 0; j < 16; ++j) { const float br = b_re[(g * 64 + lane) * 16 + j], bi = b_im[(g * 64 + lane) * 16 + j];
        scr[(lane * 16 + j) * 2] = cr * br - ci * bi; scr[(lane * 16 + j) * 2 + 1] = cr * bi + ci * br; }
    LAS float* cl = scr + 2048;
#pragma unroll
    for (int q = 0; q < 16; ++q) { cl[(q * 64 + lane) * 2] = c_re[(g * 16 + q) * 64 + lane]; cl[(q * 64 + lane) * 2 + 1] = c_im[(g * 16 + q) * 64 + lane]; }
    LDS_WAIT(); asm volatile("" ::: "memory");
    const int i = lane & 15, jq = lane >> 4; float acc[4] = {0.f, 0.f, 0.f, 0.f};
#pragma unroll 8
    for (int p = 0; p < 64; ++p) { const float xr = cl[(i * 64 + p) * 2], xi = cl[(i * 64 + p) * 2 + 1];
#pragma unroll
        for (int e = 0; e < 4; ++e) acc[e] += xr * scr[(p * 16 + 4 * jq + e) * 2] - xi * scr[(p * 16 + 4 * jq + e) * 2 + 1]; }
    const unsigned long long kv = (unsigned long long)pk2h(acc[0], acc[1]) | ((unsigned long long)pk2h(acc[2], acc[3]) << 32);
    bf16* base = TQ + (size_t)g * 256 * 384;
    for (int t = d; t < 16; ++t) *(GAS unsigned long long*)(base + (size_t)(t * 16 + i) * 384 + (t - d) * 16 + 4 * jq) = kv;
    if (d > 0) for (int t = 0; t + d < 16; ++t) *(GAS unsigned long long*)(base + (size_t)(t * 16 + i) * 384 + (t + d) * 16 + 4 * jq) = 0ull;
    LDS_WAIT(); asm volatile("" ::: "memory");
}
__device__ __forceinline__ void p0_ssm_Q_item(const float* log_dt, const float* lam_re, const float* lam_im, const float* c_re, const float* c_im, bf16* TQ, int g, int t, int lane) {
    const float dtf = expf(log_dt[g]); float pr, pi; ssm_pow(lam_re[g * 64 + lane], lam_im[g * 64 + lane], dtf, t + 1, pr, pi);
#pragma unroll
    for (int i = 0; i < 16; ++i) { const float xr = c_re[(g * 16 + i) * 64 + lane], xi = c_im[(g * 16 + i) * 64 + lane];
        *(GAS unsigned*)(TQ + ((size_t)g * 256 + t * 16 + i) * 384 + 256 + 2 * lane) = pk2h(xr * pr - xi * pi, -(xr * pi + xi * pr)); }
}
__device__ __forceinline__ void p0_ssm_P_item(const float* log_dt, const float* lam_re, const float* lam_im, const float* b_re, const float* b_im, bf16* PP, int g, int s_, int lane) {
    float cr, ci; ssm_coef_pow(log_dt, lam_re, lam_im, g, lane, 15 - s_, cr, ci);
    float wr[16], wi[16];
#pragma unroll
    for (int j = 0; j < 16; ++j) { const float br = b_re[(g * 64 + lane) * 16 + j], bi = b_im[(g * 64 + lane) * 16 + j]; wr[j] = cr * br - ci * bi; wi[j] = cr * bi + ci * br; }
    bf16* r0 = PP + ((size_t)g * 256 + 2 * lane) * 256 + s_ * 16;
    v4u o; o.x = pk2h(wr[0], wr[1]); o.y = pk2h(wr[2], wr[3]); o.z = pk2h(wr[4], wr[5]); o.w = pk2h(wr[6], wr[7]); *(GAS v4u*)r0 = o;
    o.x = pk2h(wr[8], wr[9]); o.y = pk2h(wr[10], wr[11]); o.z = pk2h(wr[12], wr[13]); o.w = pk2h(wr[14], wr[15]); *(GAS v4u*)(r0 + 8) = o;
    o.x = pk2h(wi[0], wi[1]); o.y = pk2h(wi[2], wi[3]); o.z = pk2h(wi[4], wi[5]); o.w = pk2h(wi[6], wi[7]); *(GAS v4u*)(r0 + 256) = o;
    o.x = pk2h(wi[8], wi[9]); o.y = pk2h(wi[10], wi[11]); o.z = pk2h(wi[12], wi[13]); o.w = pk2h(wi[14], wi[15]); *(GAS v4u*)(r0 + 256 + 8) = o;
}

__global__ void __launch_bounds__(NWAVES * 64, 2) mega_fwd(Args args) {
    extern __shared__ __attribute__((aligned(16))) unsigned char lds[];
    Frame F;
    F.lds = (LAS unsigned char*)lds;
    F.MISC = (volatile LAS unsigned*)(F.lds + MISC_OFF);
    F.tid = threadIdx.x; F.lane = F.tid & 63; F.wave = __builtin_amdgcn_readfirstlane(F.tid >> 6);
    F.G = gridDim.x; { const int bx = blockIdx.x; F.vcu = (F.G % 8 == 0) ? (bx % 8) * (F.G / 8) + bx / 8 : bx; }
    unsigned char* ws = args.ws;
    F.ctl = (gu32*)(ws + WS_CTL);
    const float* x = args.in[0]; const float* cvec = args.in[1]; const int* positions = (const int*)args.in[2];
    const float* w_ada = args.in[3]; const float* b_ada = args.in[4]; const float* norm_g = args.in[5]; const float* w_in = args.in[6];
    const float* log_dt = args.in[7]; const float* lam_re = args.in[8]; const float* lam_im = args.in[9]; const float* b_re = args.in[10]; const float* b_im = args.in[11];
    const float* c_re = args.in[12]; const float* c_im = args.in[13]; const float* d_skip = args.in[14]; const float* w_glu = args.in[15]; const float* b_glu = args.in[16];
    const float* q_a_g = args.in[17]; const float* w_q_b = args.in[18]; const float* kv_a_g = args.in[19]; const float* w_kv_b = args.in[20];
    const float* q_norm_g = args.in[21]; const float* k_norm_g = args.in[22]; const float* w_out = args.in[23];
    float* MOD = (float*)(ws + WS_MOD); float* AC = (float*)(ws + WS_AC); bf16* BB = (bf16*)(ws + WS_BB); bf16* CB = (bf16*)(ws + WS_CB); float* EST = (float*)(ws + WS_E);
    bf16* WIN_T = (bf16*)(ws + WS_WIN); bf16* WQ_T = (bf16*)(ws + WS_WQ); bf16* WKV_T = (bf16*)(ws + WS_WKV); bf16* WGLU_T = (bf16*)(ws + WS_WGLU); bf16* WOUT_T = (bf16*)(ws + WS_WOUT);
    bf16* PROJ = (bf16*)(ws + WS_PROJ); bf16* HB = (bf16*)(ws + WS_HB); bf16* QRAW = (bf16*)(ws + WS_HB); bf16* YCAT = (bf16*)(ws + WS_YCAT); bf16* ZM = (bf16*)(ws + WS_ZM);
    bf16* KVRAW = (bf16*)(ws + WS_KVRAW); bf16* Qb = (bf16*)(ws + WS_Q); bf16* Kb = (bf16*)(ws + WS_K); bf16* Vb = (bf16*)(ws + WS_V);
    bf16* CQN = (bf16*)(ws + WS_CQN); bf16* CKVN = (bf16*)(ws + WS_CKVN); bf16* YPRE = (bf16*)(ws + WS_YPRE);
    float* RS = (float*)(ws + WS_RS); float* ROPE = (float*)(ws + WS_ROPE); bf16* USG = (bf16*)(ws + WS_USG); bf16* TQ = (bf16*)(ws + WS_TQ); bf16* PPM = (bf16*)(ws + WS_PP); float* HAND = (float*)(ws + WS_HAND); (void)BB; (void)CB; (void)EST; (void)CQN; (void)CKVN; (void)QRAW; (void)KVRAW;

    for (int u = F.tid; u < (LDS_BYTES - LDSCTL_OFF) / 4; u += NWAVES * 64) ((LAS unsigned*)(F.lds + LDSCTL_OFF))[u] = 0u;
    __syncthreads();
    const int lo = args.ph_lo, hi = args.ph_hi;
    const bool multi = (hi - lo) > 1;
    XcdBarrier bar; bar.bar = (unsigned*)(F.ctl + CW_BAR) + args.li * XCD_BAR_WORDS; bar.x = 0; bar.st = nullptr;
    if (multi) bar = xcd_barrier_post((unsigned*)(F.ctl + CW_BAR) + args.li * XCD_BAR_WORDS, F.MISC + 8);
#define IN(k) (lo <= (k) && (k) < hi)
#define SEAM(k) do { if (IN(k) && IN((k) + 1)) xcd_barrier(bar); } while (0)
    const int gw = F.vcu * NWAVES + F.wave, NGW = F.G * NWAVES;

    if (IN(0)) {
        LAS float* scr = (LAS float*)(F.lds + RING_OFF + F.wave * 16384);
        constexpr int I_MOD = 192, I_SSM = 32;
        constexpr int T_U = 256, T_ZS = 256, T_ZM = 256, T_CKV = 128, T_CQ = 192, T_KR = 16, T_WQ = 144, T_WKV = 128, T_WGLU = 128, T_WOUT = 512;
        constexpr int I_TR = T_U + T_ZS + T_ZM + T_CKV + T_CQ + T_KR + T_WQ + T_WKV + T_WGLU + T_WOUT;
        constexpr int I_Z1 = 96, I_Z2 = 256;
        constexpr int NITEMS = I_MOD + I_SSM + I_TR + I_Z1 + I_Z2;
        { LAS float* sact = (LAS float*)(F.lds + SACT_OFF); LAS float* part = (LAS float*)(F.lds + SACT_OFF + 8192);
          for (int e = F.tid; e < 2048; e += NWAVES * 64) { const float cv = cvec[e]; sact[e] = cv / (1.f + __expf(-cv)); }
          __syncthreads();
          for (int r = (int)blockIdx.x; r < I_MOD; r += F.G) p0_mod_block(sact, part, w_ada, b_ada, MOD, F.ctl + CW_MODC, r, F.wave, F.lane); }
        for (int it = I_MOD + gw; it < NITEMS; it += NGW) {
            int r = it - I_MOD;
            if (r < I_SSM) { p0_ssm_item(log_dt, lam_re, lam_im, AC, r, F.lane); continue; } r -= I_SSM;
            if (r < I_TR) {
                if (r < T_U)   { p0_transpose_item(w_in, D_IN, 1024, SC_U + 32 * (r % 16), WIN_T, 0 + 32 * (r % 16), 64 * (r / 16), scr, F.lane); continue; } r -= T_U;
                if (r < T_ZS)  { p0_transpose_item(w_in, D_IN, 1024, SC_ZS + 32 * (r % 16), WIN_T, 512 + 32 * (r % 16), 64 * (r / 16), scr, F.lane); continue; } r -= T_ZS;
                if (r < T_ZM)  { p0_transpose_item(w_in, D_IN, 1024, SC_ZM + 32 * (r % 16), WIN_T, WR_ZM + 32 * (r % 16), 64 * (r / 16), scr, F.lane); continue; } r -= T_ZM;
                if (r < T_CKV) { p0_transpose_item(w_in, D_IN, 1024, SC_CKV + 32 * (r % 8), WIN_T, 1024 + 32 * (r % 8), 64 * (r / 8), scr, F.lane); continue; } r -= T_CKV;
                if (r < T_CQ)  { p0_transpose_item(w_in, D_IN, 1024, SC_CQ + 32 * (r % 12), WIN_T, 1280 + 32 * (r % 12), 64 * (r / 12), scr, F.lane); continue; } r -= T_CQ;
                if (r < T_KR)  { p0_transpose_item(w_in, D_IN, 1024, SC_KR, WIN_T, GC_KR, 64 * r, scr, F.lane); continue; } r -= T_KR;
                if (r < T_WQ)  { const int nb = r % 24, kb = r / 24, n0 = 32 * nb;
                                 p0_transpose_item(w_q_b, 768, 384, n0, WQ_T, (n0 / 96) * 128 + (n0 % 96), 64 * kb, scr, F.lane, q_a_g); continue; } r -= T_WQ;
                if (r < T_WKV) { p0_transpose_item(w_kv_b, 1024, 256, 32 * (r % 32), WKV_T, 32 * (r % 32), 64 * (r / 32), scr, F.lane, kv_a_g); continue; } r -= T_WKV;
                if (r < T_WGLU){ p0_transpose_item(w_glu, 512, 512, 32 * (r % 16), WGLU_T, 32 * (r % 16), 64 * (r / 16), scr, F.lane); continue; } r -= T_WGLU;
                p0_transpose_item(w_out, 1024, 1024, 32 * (r % 32), WOUT_T, 32 * (r % 32), 64 * (r / 32), scr, F.lane); continue;
            }
            r -= I_TR;
            const v4u z = {0u, 0u, 0u, 0u};
            if (r < I_Z1) { GAS v4u* p = (GAS v4u*)(WIN_T + (size_t)(GC_KR + 32 + r) * 1024); p[F.lane] = z; p[64 + F.lane] = z; continue; } r -= I_Z1;
            { const int hh = r / 32, rr = r % 32; GAS v4u* p = (GAS v4u*)(WQ_T + (size_t)(hh * 128 + 96 + rr) * 384); if (F.lane < 48) p[F.lane] = z; }
        }
        f32x4 v0[4], v1[4], v2[4];
#define LDROW(dst, mm) do { const GAS f32x4* xr_ = (const GAS f32x4*)(x + (size_t)(mm) * DM) + F.lane; _Pragma("unroll") for (int j = 0; j < 4; ++j) dst[j] = __builtin_nontemporal_load(xr_ + 64 * j); } while (0)
        if (gw < M) LDROW(v0, gw);
        if (gw + NGW < M) LDROW(v1, gw + NGW);
        __syncthreads();
        if (F.wave == 0) { unsigned sp = 0;
            while (__hip_atomic_load(F.ctl + CW_MODC, RLX_AGENT) < 192u) { __builtin_amdgcn_s_sleep(2); if (++sp > (1u << 22)) { if (F.lane == 0) __hip_atomic_store(F.ctl + CW_TMO, 1u, RLX_AGENT); break; } }
            __builtin_amdgcn_fence(__ATOMIC_ACQUIRE, "agent"); asm volatile("s_waitcnt vmcnt(0)" ::: "memory"); }
        __syncthreads();
        { f32x4 PA[4], PB[4]; int curb = -1;
          const float ifq = (float)exp(-(double)(F.lane & 15) / 16.0 * 9.210340371976184);
          for (int m = gw; m < M; m += NGW) {
            if (m + 2 * NGW < M) LDROW(v2, m + 2 * NGW);
            const int b = m / SEQ;
            if (b != curb) { curb = b;
#pragma unroll
                for (int j = 0; j < 4; ++j) { const int e = 4 * F.lane + 256 * j;
                    const f32x4 g4 = *(const f32x4*)(norm_g + e), sc = *(const f32x4*)(MOD + b * 3072 + 1024 + e); PB[j] = *(const f32x4*)(MOD + b * 3072 + e); PA[j] = g4 * (sc + 1.f); } }
            if (F.lane < 16) { const double TWO_PI = 6.283185307179586476925286766559;
                const float ang = (float)positions[m] * ifq; const float kq = rintf(ang * 0.15915494309189535f);
                const float rr = fmaf(-kq, 0.0019353071795864769f, fmaf(-kq, 6.28125f, ang)); (void)TWO_PI;
                typedef float f32x2_ __attribute__((ext_vector_type(2))); *(f32x2_*)(ROPE + ((size_t)m * 16 + F.lane) * 2) = (f32x2_){__cosf(rr), __sinf(rr)}; }
            float s = 0.f;
#pragma unroll
            for (int j = 0; j < 4; ++j) s += (v0[j].x * v0[j].x + v0[j].y * v0[j].y) + (v0[j].z * v0[j].z + v0[j].w * v0[j].w);
            const float rstd = 1.f / sqrtf(wave_sum(s) * (1.f / DM) + EPS);
            GAS unsigned long long* o8 = (GAS unsigned long long*)(HB + (size_t)m * DM) + F.lane;
#pragma unroll
            for (int j = 0; j < 4; ++j) { const f32x4 hv = v0[j] * rstd * PA[j] + PB[j];
                o8[64 * j] = (unsigned long long)pk2h(hv.x, hv.y) | ((unsigned long long)pk2h(hv.z, hv.w) << 32); }
#pragma unroll
            for (int j = 0; j < 4; ++j) { v0[j] = v1[j]; v1[j] = v2[j]; }
          }
#undef LDROW
        }
    }
    SEAM(0);

    if (IN(1)) {
        pg8::Gemm g{HB, WIN_T, M, NPROJ, 1024, 1024}; pg8::StaticOrder S; S.init(M, NPROJ, F.G, (int)blockIdx.x);
        pg8::EpiProj E{PROJ, LDP, RS, 4, USG, SEQ};
        pg8::gemm_phase<pg8::EpiProj, pg8::StaticOrder, true, true>(F.lds + RING_OFF, g, S, E);
        if (F.G == 256 ? blockIdx.x >= 192 : true) { __syncthreads();
            LAS float* scr = (LAS float*)(F.lds + RING_OFF + F.wave * 16384);
            const int nw = (F.G == 256) ? 512 : NGW, w0 = (F.G == 256) ? ((int)blockIdx.x - 192) * NWAVES + F.wave : gw;
            for (int it = w0; it < 512 * 3 + 256; it += nw) { int r = it;
                if (r < 512) { p0_ssm_K_item(log_dt, lam_re, lam_im, b_re, b_im, c_re, c_im, TQ, r >> 4, r & 15, scr, F.lane); continue; } r -= 512;
                if (r < 512) { p0_ssm_Q_item(log_dt, lam_re, lam_im, c_re, c_im, TQ, r >> 4, r & 15, F.lane); continue; } r -= 512;
                if (r < 512) { p0_ssm_P_item(log_dt, lam_re, lam_im, b_re, b_im, PPM, r >> 4, r & 15, F.lane); continue; } r -= 512;
                { const v4u z0 = {0u, 0u, 0u, 0u}; GAS v4u* pz = (GAS v4u*)(PPM + ((size_t)(r >> 3) * 256 + 128 + (r & 7) * 16) * 256);
#pragma unroll
                  for (int q = 0; q < 8; ++q) pz[F.lane + 64 * q] = z0; } } }
    }
    SEAM(1);

    if (IN(2)) {
        { const pg8::MlaAux AUX{RS, ROPE, PROJ, LDP, PC_KR};
          if (F.G == 256) {
            { pg8::Gemm g{PROJ + PC_CQ, WQ_T, M, 1024, Q_LORA, LDP}; pg8::StaticOrder S; S.init(M, 1024, F.G, (int)blockIdx.x);
              pg8::EpiQ E{AUX, q_norm_g, Qb, 0.10206207261596575f * 1.4426950408889634f, EPS, SEQ};
              pg8::gemm_phase<pg8::EpiQ, pg8::StaticOrder, false, true>(F.lds + RING_OFF, g, S, E); }
            __syncthreads();
            { pg8::Gemm g{PROJ + PC_CKV, WKV_T, M, 1024, KV_LORA, LDP}; pg8::StaticOrder S; S.init(M, 1024, F.G, (int)blockIdx.x);
              pg8::EpiKV E{AUX, k_norm_g, Kb, Vb, EPS, SEQ};
              pg8::gemm_phase<pg8::EpiKV, pg8::StaticOrder, false, true>(F.lds + RING_OFF, g, S, E); }
          } else if (F.tid == 0) __hip_atomic_store(F.ctl + CW_TMO, 1u, RLX_AGENT);
        }
        __syncthreads();
        { pg8::Gemm g{USG, PPM, 32768, 8192, 256, 384}; pg8::DiagOrder S{128, 4, F.G, (int)blockIdx.x, nullptr, 0u, nullptr};
          pg8::EpiELds E{};
          if (F.G >= 128) { pg8::gemm_phase<pg8::EpiELds, pg8::DiagOrder, false, true>(F.lds + RING_OFF, g, S, E);
              pg8::Unit u; const bool has = S.next(0, u);
              __syncthreads();
              if (has && F.wave == 0) pg8::ssm_chain_unit(u, F.lds + RING_OFF, USG, AC, HAND, (unsigned*)(F.ctl + CW_CHAIN), (unsigned*)(F.ctl + CW_TMO), F.lane);
              __syncthreads(); }
          else if (F.tid == 0) __hip_atomic_store(F.ctl + CW_TMO, 1u, RLX_AGENT); }
        { pg8::Gemm g{HB, WIN_T + (size_t)WR_ZM * 1024, M, 512, 1024, 1024}; pg8::StaticOrder S; S.init(M, 512, F.G, (int)((blockIdx.x + 128u) % (unsigned)F.G));
          pg8::EpiH16 E{ZM, 512};
          pg8::gemm_phase<pg8::EpiH16, pg8::StaticOrder, true, true>(F.lds + RING_OFF, g, S, E); }
    }
    SEAM(2);

    if (IN(3)) {
        { pg8::Gemm g{USG, TQ, 32768, 8192, 384, 384}; pg8::DiagOrder S{128, 4, F.G, (int)blockIdx.x, nullptr, 0u, nullptr};
          pg8::EpiY E{USG, d_skip, YPRE, SEQ};
          pg8::gemm_phase<pg8::EpiY, pg8::DiagOrder, true, true>(F.lds + RING_OFF, g, S, E);
          if (F.tid == 0) { pg8::Unit u; for (int i = 0; S.next(i, u); ++i) { const int k4 = u.pm & 3;
              for (int q = 0; q < 16; ++q) __hip_atomic_fetch_add(F.ctl + CW_PANEL + 64 * ((k4 >> 1) * 32 + (k4 & 1) * 16 + q), 1u, RLX_AGENT); } } }
        __syncthreads();
        __syncthreads();
#define RUN_GLU_UNITS() do { \
        { pg8::Gemm g{YPRE, WGLU_T, M, 512, 512, 512}; pg8::PanelOrder S; S.init(M, 512, F.G, (int)((blockIdx.x + 128u) % (unsigned)F.G)); S.cnt = (unsigned*)(F.ctl + CW_PANEL); S.want = 32u; S.tmo = (unsigned*)(F.ctl + CW_TMO); \
          pg8::EpiGlu E{YPRE, PROJ, LDP, PC_ZS, b_glu, YCAT}; \
          pg8::gemm_phase<pg8::EpiGlu, pg8::PanelOrder, true, true>(F.lds + RING_OFF, g, S, E); \
          if (F.tid == 0) { pg8::Unit u; for (int i = 0; S.next(i, u); ++i) __hip_atomic_fetch_add(F.ctl + CW_OUTP + 64 * u.pm, 1u, RLX_AGENT); } } \
        __syncthreads(); } while (0)
#define OUT_UNIT_OF(k, uu) do { const int pk_ = (k) >> 2; (uu).pm = (pk_ & 1) * 32 + (24 - 8 * (pk_ >> 1)) + j; (uu).pn = (k) & 3; } while (0)
#define RUN_OUT_UNIT(uu) do { if (F.tid < 64) { __builtin_amdgcn_fence(__ATOMIC_ACQUIRE, "agent"); asm volatile("s_waitcnt vmcnt(0)" ::: "memory"); } __syncthreads(); \
            pg8::Gemm g_{YCAT, WOUT_T, M, 1024, 1024, 1024}; pg8::OneUnit S_; S_.u = (uu); pg8::EpiOutRows E_{x, MOD + 2048, 3072, SEQ, args.out}; \
            pg8::gemm_phase<pg8::EpiOutRows, pg8::OneUnit, false, true>(F.lds + RING_OFF, g_, S_, E_); __syncthreads(); } while (0)
        const int j = (int)(blockIdx.x & 7); bool glu_done = false;
        for (;;) {
            if (F.tid == 0) F.MISC[16] = __hip_atomic_fetch_add(F.ctl + CW_ATTQ + 64 * j, 1u, RLX_AGENT);
            __syncthreads();
            const unsigned ua = F.MISC[16];
            __syncthreads();
            if (ua >= 64u) break;
            const int bh = 2 * j + (int)(ua & 1u), qb = 31 - (int)(ua >> 1);
            att::attn_unit(bh >> 3, bh & 7, qb, Qb, Kb, Vb, ZM, 512, 0, YCAT, (char*)lds + RING_OFF, F.lds + RING_OFF, (unsigned*)(F.ctl + CW_OUTP + 64 * ((bh >> 3) * 32 + qb)), nullptr, (unsigned*)(F.ctl + CW_TMO));
            if (!glu_done) { glu_done = true; RUN_GLU_UNITS(); }
            if (F.tid == 0) { unsigned k = __hip_atomic_load(F.ctl + CW_OUTQ + 64 * j, RLX_AGENT), got = 0xffffffffu;
                if (MK_CLAIM_BETWEEN && k < 32u) { pg8::Unit t; OUT_UNIT_OF((int)k, t);
                    if (__hip_atomic_load(F.ctl + CW_OUTP + 64 * t.pm, RLX_AGENT) >= 10u) { unsigned e = k;
                        if (__hip_atomic_compare_exchange_strong(F.ctl + CW_OUTQ + 64 * j, &e, k + 1u, __ATOMIC_RELAXED, __ATOMIC_RELAXED, __HIP_MEMORY_SCOPE_AGENT)) got = k; } }
                F.MISC[17] = got; }
            __syncthreads();
            const unsigned ko = F.MISC[17];
            __syncthreads();
            if (ko != 0xffffffffu) { pg8::Unit uo; OUT_UNIT_OF((int)ko, uo); RUN_OUT_UNIT(uo); }
        }
        if (!glu_done) { glu_done = true; RUN_GLU_UNITS(); }
        for (;;) {
            if (F.tid == 0) F.MISC[17] = __hip_atomic_fetch_add(F.ctl + CW_OUTQ + 64 * j, 1u, RLX_AGENT);
            __syncthreads();
            const unsigned ko = F.MISC[17];
            __syncthreads();
            if (ko >= 32u) break;
            pg8::Unit uo; OUT_UNIT_OF((int)ko, uo);
            if (F.tid < 64) { unsigned sp = 0;
                while (__hip_atomic_load(F.ctl + CW_OUTP + 64 * uo.pm, RLX_AGENT) < 10u) { __builtin_amdgcn_s_sleep(4);
                    if (++sp > (1u << 22)) { if (F.tid == 0) __hip_atomic_store(F.ctl + CW_TMO, 1u, RLX_AGENT); break; } }
                if (F.tid == 0) __hip_atomic_fetch_add(F.ctl + CW_RDV + 64 * uo.pm, 1u, RLX_AGENT);
                sp = 0; while (__hip_atomic_load(F.ctl + CW_RDV + 64 * uo.pm, RLX_AGENT) < 4u && ++sp < 20000u) __builtin_amdgcn_s_sleep(2); }
            RUN_OUT_UNIT(uo);
        }
#undef OUT_UNIT_OF
#undef RUN_GLU_UNITS
#undef RUN_OUT_UNIT
    }
#undef IN
#undef SEAM
}

#ifndef MK_MODE
#define MK_MODE 2
#endif
#ifndef MK_FAST_MASK
#define MK_FAST_MASK 0x7
#endif
extern "C" void kernel_launch(void* const* d_in, const int* in_sizes, int n_in, void* d_out, int out_size, void* d_ws, size_t ws_size, hipStream_t stream) {
    static int grid = 0;
    if (grid == 0) {
        if (n_in != 24 || in_sizes[0] != M * DM || out_size != M * DM || ws_size < WS_END) { fprintf(stderr, "kernel_launch: unexpected shapes (n_in %d, in0 %d, out %d, ws %zu)\n", n_in, n_in > 0 ? in_sizes[0] : -1, out_size, ws_size); grid = -1; return; }
        int dev = 0, cus = 0, per_cu = 0;
        if (hipGetDevice(&dev) != hipSuccess || hipDeviceGetAttribute(&cus, hipDeviceAttributeMultiprocessorCount, dev) != hipSuccess) { fprintf(stderr, "kernel_launch: device query failed\n"); grid = -1; return; }
        if (hipFuncSetAttribute((const void*)mega_fwd, hipFuncAttributeMaxDynamicSharedMemorySize, LDS_BYTES) != hipSuccess) { fprintf(stderr, "kernel_launch: hipFuncSetAttribute failed\n"); grid = -1; return; }
        if (hipOccupancyMaxActiveBlocksPerMultiprocessor(&per_cu, (const void*)mega_fwd, NWAVES * 64, LDS_BYTES) != hipSuccess || per_cu < 1)
            fprintf(stderr, "kernel_launch: note: occupancy query reports %d workgroups per CU\n", per_cu);
        (void)hipGetLastError();
        grid = cus;
    }
    if (grid < 0) return;
    const float* x = (const float*)d_in[0]; const float* c = (const float*)d_in[1]; const int* positions = (const int*)d_in[2];
    const float* w_ada = (const float*)d_in[3]; const float* b_ada = (const float*)d_in[4]; const float* norm_g = (const float*)d_in[5];
    const float* w_in = (const float*)d_in[6]; const float* log_dt = (const float*)d_in[7]; const float* lam_re = (const float*)d_in[8];
    const float* lam_im = (const float*)d_in[9]; const float* b_re = (const float*)d_in[10]; const float* b_im = (const float*)d_in[11];
    const float* c_re = (const float*)d_in[12]; const float* c_im = (const float*)d_in[13]; const float* d_skip = (const float*)d_in[14];
    const float* w_glu = (const float*)d_in[15]; const float* b_glu = (const float*)d_in[16]; const float* q_a_g = (const float*)d_in[17];
    const float* w_q_b = (const float*)d_in[18]; const float* kv_a_g = (const float*)d_in[19]; const float* w_kv_b = (const float*)d_in[20];
    const float* q_norm_g = (const float*)d_in[21]; const float* k_norm_g = (const float*)d_in[22]; const float* w_out = (const float*)d_in[23];
    unsigned char* ws = (unsigned char*)d_ws; float* out = (float*)d_out;
    float* MOD = (float*)(ws + WS_MOD); bf16* PROJ = (bf16*)(ws + WS_PROJ); bf16* HB = (bf16*)(ws + WS_HB); bf16* QRAW = (bf16*)(ws + WS_HB); bf16* YCAT = (bf16*)(ws + WS_YCAT); bf16* ZM = (bf16*)(ws + WS_ZM);
    bf16* KVRAW = (bf16*)(ws + WS_KVRAW); bf16* Qb = (bf16*)(ws + WS_Q); bf16* Kb = (bf16*)(ws + WS_K); bf16* Vb = (bf16*)(ws + WS_V);
    bf16* CQN = (bf16*)(ws + WS_CQN); bf16* CKVN = (bf16*)(ws + WS_CKVN); bf16* YPRE = (bf16*)(ws + WS_YPRE);
    (void)x; (void)c; (void)positions; (void)w_ada; (void)b_ada; (void)norm_g; (void)w_in; (void)log_dt; (void)lam_re; (void)lam_im; (void)b_re; (void)b_im; (void)c_re; (void)c_im; (void)d_skip;
    (void)w_glu; (void)b_glu; (void)q_a_g; (void)w_q_b; (void)kv_a_g; (void)w_kv_b; (void)q_norm_g; (void)k_norm_g; (void)w_out; (void)MOD; (void)PROJ; (void)HB; (void)QRAW; (void)YCAT;
    (void)KVRAW; (void)Qb; (void)Kb; (void)Vb; (void)CQN; (void)CKVN; (void)YPRE; (void)out;

    Args a{}; int n_mega = 0;
    for (int i = 0; i < 24; ++i) a.in[i] = (const float*)d_in[i];
    a.out = out; a.ws = ws;
#define MEGA(lo_, hi_) do { a.ph_lo = (lo_); a.ph_hi = (hi_); a.li = n_mega++; hipLaunchKernelGGL(mega_fwd, dim3(grid), dim3(NWAVES * 64), LDS_BYTES, stream, a); } while (0)
#if MK_MODE == 2
    if (hipMemsetAsync(ws + WS_CTL, 0, CTL_ZERO_BYTES, stream) != hipSuccess) { fprintf(stderr, "kernel_launch: memset failed\n"); return; }
#if MK_DOUBLE >= 0
    MEGA(0, MK_DOUBLE + 1); MEGA(MK_DOUBLE, NPHASE);
#else
    MEGA(0, NPHASE);
#endif
#else
    const unsigned fast = (MK_MODE == 0) ? 0u : (unsigned)MK_FAST_MASK;
    (void)hipMemsetAsync(ws + WS_CTL, 0, CTL_ZERO_BYTES, stream);
    if (MK_MODE != 0) MEGA(0, 1);
    if (!(fast & 1u)) { hipLaunchKernelGGL(v0_mod, dim3(24), dim3(256), 0, stream, c, w_ada, b_ada, MOD); hipLaunchKernelGGL(v0_h, dim3(M), dim3(256), 0, stream, x, norm_g, MOD, HB); }
    if (fast & 2u) MEGA(1, 2); else {
        const int seg[5][3] = {{PC_U, SC_U, 512}, {PC_ZS, SC_ZS, 512}, {PC_CKV, SC_CKV, 256}, {PC_CQ, SC_CQ, 384}, {PC_KR, SC_KR, 32}};
        for (int s = 1; s < 5; ++s) hipLaunchKernelGGL(v0_gemm, dim3(M), dim3(256), 1024 * 4, stream, HB, 1024, 1024, w_in, D_IN, seg[s][1], PROJ, LDP, seg[s][0], seg[s][2]);
        hipLaunchKernelGGL(v0_usg, dim3(M), dim3(256), 1024 * 4, stream, HB, w_in, D_IN, (bf16*)(ws + WS_USG));
        hipLaunchKernelGGL(v0_gemm, dim3(M), dim3(256), 1024 * 4, stream, HB, 1024, 1024, w_in, D_IN, SC_ZM, ZM, 512, 0, 512); }
    if (fast & 4u) { MEGA(2, 3); MEGA(3, 4); }
    else { hipLaunchKernelGGL(v0_cqn, dim3(M), dim3(256), 0, stream, PROJ, q_a_g, kv_a_g, CQN, CKVN);
        for (int h = 0; h < NH; ++h) hipLaunchKernelGGL(v0_gemm, dim3(M), dim3(128), 384 * 4, stream, CQN, 384, 384, w_q_b, 768, h * 96, QRAW, 1024, h * 128, 96);
        hipLaunchKernelGGL(v0_gemm, dim3(M), dim3(256), 256 * 4, stream, CKVN, 256, 256, w_kv_b, 1024, 0, KVRAW, 1024, 0, 1024);
        hipLaunchKernelGGL(v0_qkv, dim3(M * NH * 2 / 256), dim3(256), 0, stream, QRAW, KVRAW, PROJ, positions, q_norm_g, k_norm_g, Qb, Kb, Vb);
        hipLaunchKernelGGL(v0_ssm, dim3(BATCH * SSM_G), dim3(64), 0, stream, (bf16*)(ws + WS_USG), log_dt, lam_re, lam_im, b_re, b_im, c_re, c_im, d_skip, YPRE);
        hipLaunchKernelGGL(v0_attn, dim3(BATCH * NH * (SEQ / 256)), dim3(256), 0, stream, Qb, Kb, Vb, ZM, YCAT);
        hipLaunchKernelGGL(v0_glu, dim3(M), dim3(256), 0, stream, YPRE, w_glu, b_glu, PROJ, YCAT);
        hipLaunchKernelGGL(v0_out, dim3(M), dim3(256), 0, stream, YCAT, w_out, x, MOD, out); }
#endif
    const hipError_t le = hipPeekAtLastError();
    if (le != hipSuccess) fprintf(stderr, "kernel_launch: launch failed: %s\n", hipGetErrorName(le));
}
```

```cpp
#include <hip/hip_runtime.h>
#include <cstdio>
#include <cstdint>
#ifndef MK_CLAIM_BETWEEN
#define MK_CLAIM_BETWEEN 0
#endif
#ifndef MK_DOUBLE
#define MK_DOUBLE (-1)
#endif

constexpr int BATCH = 2, SEQ = 8192, DM = 1024, M = BATCH * SEQ;
constexpr int SSM_W = 512, SSM_G = 32, SSM_GC = 16, SSM_P = 64;
constexpr int NH = 8, QK_NOPE = 64, QK_ROPE = 32, QK_HEAD = 96, V_HEAD = 64, MLA_W = 512, Q_LORA = 384, KV_LORA = 256;
constexpr int D_IN = 2208;
constexpr float EPS = 1e-6f;
constexpr int NPROJ = 1792;
constexpr int LDP = 1280;
constexpr int PC_U = 0, PC_ZS = 0, PC_CKV = 512, PC_CQ = 768, PC_KR = 1152;
constexpr int GC_KR = 1664;
constexpr int WR_ZM = 1792;
constexpr int SC_U = 0, SC_ZS = 512, SC_CQ = 1024, SC_CKV = 1408, SC_KR = 1664, SC_ZM = 1696;

constexpr size_t MiB = 1u << 20;
constexpr size_t WS_CTL = 0, CTL_ZERO_BYTES = 1 * MiB;
constexpr size_t WS_MOD = 1 * MiB;
constexpr size_t WS_AC = 1 * MiB + 64 * 1024;
constexpr size_t WS_BB = 1 * MiB + 128 * 1024;
constexpr size_t WS_CB = 1 * MiB + 256 * 1024;
constexpr size_t WS_E = 2 * MiB;
constexpr size_t WS_WIN = 4 * MiB;
constexpr size_t WS_WQ = 9 * MiB;
constexpr size_t WS_WKV = 10 * MiB;
constexpr size_t WS_WGLU = 11 * MiB;
constexpr size_t WS_WOUT = 12 * MiB;
constexpr size_t WS_PROJ = 16 * MiB;
constexpr size_t WS_USG = 56 * MiB;
constexpr size_t WS_ZM = 80 * MiB;
constexpr size_t WS_HB = 96 * MiB;
constexpr size_t WS_YCAT = 128 * MiB;
constexpr size_t WS_KVRAW = 128 * MiB;
constexpr size_t WS_Q = 160 * MiB;
constexpr size_t WS_CQN = 160 * MiB;
constexpr size_t WS_CKVN = 172 * MiB;
constexpr size_t WS_K = 184 * MiB;
constexpr size_t WS_V = 208 * MiB;
constexpr size_t WS_YPRE = 224 * MiB;
constexpr size_t WS_TQ = 240 * MiB;
constexpr size_t WS_PP = 246 * MiB;
constexpr size_t WS_ROPE = 250 * MiB;
constexpr size_t WS_HAND = 252 * MiB;
constexpr size_t WS_RS = 14 * MiB;
constexpr size_t WS_END = 253 * MiB;

typedef unsigned short bf16;
__device__ __forceinline__ unsigned f2bf(float f) { return (unsigned)__builtin_bit_cast(unsigned short, (_Float16)f); }
__device__ __forceinline__ float bf2f(bf16 b) { return (float)__builtin_bit_cast(_Float16, b); }
__device__ __forceinline__ float silu_f(float v) { return v / (1.f + __expf(-v)); }
__device__ __forceinline__ float sigmoid_f(float v) { return 1.f / (1.f + __expf(-v)); }
__device__ __forceinline__ float gelu_tanh(float v) { const float z = 0.7978845608028654f * (v + 0.044715f * v * v * v); return v / (1.f + __expf(-2.f * z)); }

__device__ __forceinline__ float block_sum_256(float v, float* red) {
    for (int o = 32; o > 0; o >>= 1) v += __shfl_xor(v, o);
    const int w = threadIdx.x >> 6;
    __syncthreads();
    if ((threadIdx.x & 63) == 0) red[w] = v;
    __syncthreads();
    float s = 0.f; for (int i = 0; i < (int)(blockDim.x >> 6); ++i) s += red[i];
    return s;
}

__global__ void v0_mod(const float* c, const float* w_ada, const float* b_ada, float* mod) {
    const int idx = blockIdx.x * blockDim.x + threadIdx.x; if (idx >= BATCH * 3 * DM) return;
    const int b = idx / (3 * DM), n = idx % (3 * DM);
    float acc = b_ada[n];
    for (int k = 0; k < DM; ++k) acc += silu_f(c[b * DM + k]) * w_ada[(size_t)k * 3 * DM + n];
    mod[idx] = acc;
}
__global__ void v0_h(const float* x, const float* norm_g, const float* mod, bf16* hb) {
    __shared__ float red[8];
    const int m = blockIdx.x, b = m / SEQ, t = threadIdx.x;
    float v[4], ss = 0.f;
    for (int j = 0; j < 4; ++j) { v[j] = x[(size_t)m * DM + t + 256 * j]; ss += v[j] * v[j]; }
    ss = block_sum_256(ss, red);
    const float rstd = 1.f / sqrtf(ss / DM + EPS);
    for (int j = 0; j < 4; ++j) { const int e = t + 256 * j;
        const float hv = v[j] * rstd * norm_g[e] * (1.f + mod[b * 3 * DM + DM + e]) + mod[b * 3 * DM + e];
        hb[(size_t)m * DM + e] = (bf16)f2bf(hv); }
}
__global__ void v0_gemm(const bf16* A, int lda, int K, const float* W, int ldw, int src0, bf16* C, int ldc, int dst0, int width) {
    extern __shared__ float arow[];
    const int m = blockIdx.x;
    for (int k = threadIdx.x; k < K; k += blockDim.x) arow[k] = bf2f(A[(size_t)m * lda + k]);
    __syncthreads();
    for (int j = threadIdx.x; j < width; j += blockDim.x) {
        float acc = 0.f;
        for (int k = 0; k < K; ++k) acc += arow[k] * W[(size_t)k * ldw + src0 + j];
        C[(size_t)m * ldc + dst0 + j] = (bf16)f2bf(acc);
    }
}
__global__ void v0_usg(const bf16* A, const float* W, int ldw, bf16* USG) {
    extern __shared__ float arow[];
    const int m = blockIdx.x, b = m / SEQ, t = m % SEQ;
    for (int k = threadIdx.x; k < 1024; k += blockDim.x) arow[k] = bf2f(A[(size_t)m * 1024 + k]);
    __syncthreads();
    for (int c = threadIdx.x; c < 512; c += blockDim.x) { float acc = 0.f;
        for (int k = 0; k < 1024; ++k) acc += arow[k] * W[(size_t)k * ldw + c];
        USG[((size_t)(c >> 4) * 1024 + b * 512 + (t >> 4)) * 384 + (t & 15) * 16 + (c & 15)] = (bf16)f2bf(acc); }
}
__global__ void v0_cqn(const bf16* proj, const float* q_a_g, const float* kv_a_g, bf16* cqn, bf16* ckvn) {
    __shared__ float red[8];
    const int m = blockIdx.x, t = threadIdx.x;
    float a = 0.f, b2 = 0.f, ss = 0.f;
    if (t < 192) { a = bf2f(proj[(size_t)m * LDP + PC_CQ + t]); b2 = bf2f(proj[(size_t)m * LDP + PC_CQ + 192 + t]); ss = a * a + b2 * b2; }
    ss = block_sum_256(ss, red);
    float rstd = 1.f / sqrtf(ss / Q_LORA + EPS);
    if (t < 192) { cqn[(size_t)m * Q_LORA + t] = (bf16)f2bf(a * rstd * q_a_g[t]); cqn[(size_t)m * Q_LORA + 192 + t] = (bf16)f2bf(b2 * rstd * q_a_g[192 + t]); }
    const float cv = bf2f(proj[(size_t)m * LDP + PC_CKV + t]);
    ss = block_sum_256(cv * cv, red);
    rstd = 1.f / sqrtf(ss / KV_LORA + EPS);
    ckvn[(size_t)m * KV_LORA + t] = (bf16)f2bf(cv * rstd * kv_a_g[t]);
}
__device__ __forceinline__ int v0_vst(int k, int c) { const int kk = (k & ~0xC) | ((k & 4) << 1) | ((k & 8) >> 1); return ((kk >> 3) * 2 + (c >> 5)) * 512 + ((kk & 7) * 32 + (c & 31)) * 2; }
__global__ void __launch_bounds__(256) v0_qkv(const bf16* qraw, const bf16* kvraw, const bf16* proj, const int* positions, const float* q_norm_g, const float* k_norm_g, bf16* Q, bf16* K, bf16* V) {
    const int idx = blockIdx.x * blockDim.x + threadIdx.x; if (idx >= M * NH * 2) return;
    const int which = idx & 1, m = (idx >> 1) / NH, h = (idx >> 1) % NH;
    const float pos = (float)positions[m];
    const float* gn = which ? k_norm_g : q_norm_g;
    float q[96];
    float sq = 0.f;
    if (which == 0) {
#pragma unroll
        for (int d = 0; d < 96; ++d) q[d] = bf2f(qraw[(size_t)m * 1024 + h * 128 + d]);
    } else {
#pragma unroll
        for (int d = 0; d < 64; ++d) q[d] = bf2f(kvraw[(size_t)m * 1024 + h * 128 + d]);
#pragma unroll
        for (int d = 0; d < 32; ++d) q[64 + d] = bf2f(proj[(size_t)m * LDP + PC_KR + d]);
    }
#pragma unroll
    for (int d = 0; d < 96; ++d) sq += q[d] * q[d];
    const float rq = 1.f / sqrtf(sq / 96.f + EPS);
#pragma unroll
    for (int d = 0; d < 96; ++d) q[d] = q[d] * rq * gn[d];
#pragma unroll
    for (int i = 0; i < 16; ++i) {
        const float inv_freq = (float)pow(10000.0, -(double)i / 16.0);
        const float ang = pos * inv_freq;
        const double TWO_PI = 6.283185307179586476925286766559;
        const double r = (double)ang - TWO_PI * rint((double)ang / TWO_PI);
        const float rf = (float)r; const float cs = __cosf(rf), sn = __sinf(rf);
        const float q1 = q[64 + i], q2 = q[80 + i]; q[64 + i] = q1 * cs - q2 * sn; q[80 + i] = q2 * cs + q1 * sn;
    }
    if (which == 0) {
#pragma unroll
        for (int d = 0; d < 96; ++d) Q[(size_t)m * 768 + h * 96 + d] = (bf16)f2bf(q[d] * (0.10206207261596575f * 1.4426950408889634f));
    } else {
        const int bb = m / SEQ, tt = m % SEQ; const size_t tix = (size_t)(bb * 8 + h) * 128 + (tt >> 6); const int row = tt & 63;
#pragma unroll
        for (int d = 0; d < 96; ++d) K[tix * 6144 + (d >> 3) * 512 + row * 8 + (d & 7)] = (bf16)f2bf(q[d]);
        for (int d = 0; d < 64; ++d) V[tix * 4096 + v0_vst(row, d) / 2] = kvraw[(size_t)m * 1024 + h * 128 + 64 + d];
    }
}
__global__ void __launch_bounds__(64) v0_ssm(const bf16* proj, const float* log_dt, const float* lam_re, const float* lam_im, const float* b_re, const float* b_im,
                       const float* c_re, const float* c_im, const float* d_skip, bf16* ypre) {
    __shared__ float sre[64], sim[64], us[16];
    const int b = blockIdx.x / SSM_G, g = blockIdx.x % SSM_G, p = threadIdx.x;
    const double dt = exp((double)log_dt[g]);
    const double lr = lam_re[g * 64 + p], li = lam_im[g * 64 + p];
    const double er = exp(lr * dt), ar = er * cos(li * dt), ai = er * sin(li * dt);
    const double nr = ar - 1.0, ni = ai, den = lr * lr + li * li;
    const double cr = (nr * lr + ni * li) / den, ci = (ni * lr - nr * li) / den;
    float Br[16], Bi[16];
#pragma unroll
    for (int j = 0; j < 16; ++j) { const double br = b_re[(g * 64 + p) * 16 + j], bi = b_im[(g * 64 + p) * 16 + j];
        Br[j] = (float)(cr * br - ci * bi); Bi[j] = (float)(cr * bi + ci * br); }
    const float far = (float)ar, fai = (float)ai;
    float s_r = 0.f, s_i = 0.f;
    const float dsk = p < 16 ? d_skip[g * 16 + p] : 0.f;
    for (int t = 0; t < SEQ; ++t) {
        const size_t row = (size_t)(b * SEQ + t);
        if (p < 16) us[p] = bf2f(proj[((size_t)g * 1024 + b * 512 + (t >> 4)) * 384 + (t & 15) * 16 + p]);
        __syncthreads();
        float bur = 0.f, bui = 0.f;
#pragma unroll
        for (int j = 0; j < 16; ++j) { bur += Br[j] * us[j]; bui += Bi[j] * us[j]; }
        const float nr2 = far * s_r - fai * s_i + bur, ni2 = far * s_i + fai * s_r + bui;
        s_r = nr2; s_i = ni2; sre[p] = s_r; sim[p] = s_i;
        __syncthreads();
        if (p < 16) {
            float y = 0.f;
            for (int q = 0; q < 64; ++q) y += c_re[(g * 16 + p) * 64 + q] * sre[q] - c_im[(g * 16 + p) * 64 + q] * sim[q];
            y += dsk * us[p];
            ypre[row * SSM_W + g * 16 + p] = (bf16)f2bf(gelu_tanh(y));
        }
        __syncthreads();
    }
}
__global__ void __launch_bounds__(256) v0_attn(const bf16* Q, const bf16* K, const bf16* V, const bf16* zm, bf16* ycat) {
    const int qb = blockIdx.x % (SEQ / 256), bh = blockIdx.x / (SEQ / 256), b = bh / NH, h = bh % NH;
    const int qi = qb * 256 + threadIdx.x;
    const size_t qrow = (size_t)b * SEQ + qi;
    float q[96], o[64];
    const float sc = 0.10206207261596575f;
#pragma unroll
    for (int d = 0; d < 96; ++d) q[d] = bf2f(Q[qrow * 768 + h * 96 + d]) * sc;
#pragma unroll
    for (int d = 0; d < 64; ++d) o[d] = 0.f;
    float mx = -1e30f, l = 0.f;
    const int jmax = qb * 256 + 255;
    for (int j = 0; j <= jmax; ++j) {
        const size_t tix = (size_t)(b * 8 + h) * 128 + (j >> 6); const int jr = j & 63;
        const bf16* kp = K + tix * 6144 + jr * 8; const bf16* vp = V + tix * 4096;
        float s = 0.f;
#pragma unroll
        for (int d = 0; d < 96; ++d) s += q[d] * bf2f(kp[(d >> 3) * 512 + (d & 7)]);
        if (j <= qi) {
            const float mn = fmaxf(mx, s); const float al = exp2f(mx - mn), pp = exp2f(s - mn);
            l = l * al + pp;
#pragma unroll
            for (int d = 0; d < 64; ++d) o[d] = o[d] * al + pp * bf2f(vp[v0_vst(jr, d) / 2]);
            mx = mn;
        }
    }
    const float rl = 1.f / l;
#pragma unroll
    for (int d = 0; d < 64; ++d) {
        const float z = bf2f(zm[qrow * 512 + h * 64 + d]);
        ycat[qrow * 1024 + 512 + h * 64 + d] = (bf16)f2bf(o[d] * rl * silu_f(z));
    }
}
__global__ void v0_glu(const bf16* ypre, const float* w_glu, const float* b_glu, const bf16* proj, bf16* ycat) {
    __shared__ float arow[512];
    const int m = blockIdx.x;
    for (int k = threadIdx.x; k < 512; k += blockDim.x) arow[k] = bf2f(ypre[(size_t)m * 512 + k]);
    __syncthreads();
    for (int j = threadIdx.x; j < 512; j += blockDim.x) {
        float acc = b_glu[j];
        for (int k = 0; k < 512; ++k) acc += arow[k] * w_glu[(size_t)k * 512 + j];
        const float z = bf2f(proj[(size_t)m * LDP + PC_ZS + j]);
        ycat[(size_t)m * 1024 + j] = (bf16)f2bf(arow[j] * sigmoid_f(acc) * silu_f(z));
    }
}
__global__ void v0_out(const bf16* ycat, const float* w_out, const float* x, const float* mod, float* out) {
    __shared__ float arow[1024];
    const int m = blockIdx.x, b = m / SEQ;
    for (int k = threadIdx.x; k < 1024; k += blockDim.x) arow[k] = bf2f(ycat[(size_t)m * 1024 + k]);
    __syncthreads();
    for (int j = threadIdx.x; j < 1024; j += blockDim.x) {
        float acc = 0.f;
        for (int k = 0; k < 1024; ++k) acc += arow[k] * w_out[(size_t)k * 1024 + j];
        out[(size_t)m * DM + j] = x[(size_t)m * DM + j] + mod[b * 3 * DM + 2 * DM + j] * acc;
    }
}


typedef unsigned wt_u32x4 __attribute__((ext_vector_type(4)));
__device__ __forceinline__ void store16_wt(void* p, wt_u32x4 v) { asm volatile("global_store_dwordx4 %0, %1, off sc1\n\ts_nop 1" :: "v"(p), "v"(v) : "memory"); }

namespace pg8 {
#define PG8_LAS __attribute__((address_space(3)))
typedef unsigned short bf16_t;
typedef _Float16 bf16x8 __attribute__((ext_vector_type(8)));
typedef float f32x4 __attribute__((ext_vector_type(4)));
typedef unsigned u32x4 __attribute__((ext_vector_type(4)));
constexpr int BM = 256, BK = 64, HALF = 128, HTB = HALF * BK * 2  , STAGE_BYTES = 8 * HTB, NXCD = 8, WGM = 8;

__host__ __device__ __forceinline__ int lds_byte(int r, int c) { const int st = (r >> 4) * 2 + (c >> 5), rr = r & 15, cc = c & 31, ob = rr * 64 + cc * 2; return st * 1024 + (ob ^ (((ob >> 9) & 1) << 5)); }
__host__ __device__ __forceinline__ void stage_rc(int b, int& R, int& C) { const int st = b / 1024, sb = b % 1024, swz = sb ^ (((sb >> 9) & 1) << 5); R = (st >> 1) * 16 + swz / 64; C = (st & 1) * 32 + (swz % 64) / 2; }
__host__ __device__ __forceinline__ int perm32(int rho) { const int n = rho >> 4, i = rho & 15; return 8 * (i >> 2) + 4 * n + (i & 3); }

struct Unit { int pm, pn; };
struct Gemm { const bf16_t* A; const bf16_t* Bt; int M, N, K, lda; };

struct StaticOrder {
    int nM, nN, nwg, G, c;
    __host__ __device__ void init(int M, int N, int G_, int c_) { nM = M / BM; nN = N / BM; nwg = nM * nN; G = G_; c = c_; }
    __host__ __device__ bool next(int i, Unit& u) const {
        const long L = (long)i * G + c; if (L >= nwg) return false;
        int wgid = (int)L; { const int q = nwg / NXCD, r = nwg % NXCD, xcd = wgid % NXCD, off = wgid / NXCD; wgid = (xcd < r ? xcd * (q + 1) : r * (q + 1) + (xcd - r) * q) + off; }
        const int nig = WGM * nN, gid = wgid / nig, fm = gid * WGM, gsz = (nM - fm) < WGM ? (nM - fm) : WGM;
        u.pm = fm + ((wgid % nig) % gsz); u.pn = (wgid % nig) / gsz; return true;
    }
    __device__ __forceinline__ void a_ready(const Unit&) const {}
    __device__ __forceinline__ void done(const Unit&) const {}
};


struct DiagOrder {
    int nunits, per, G, c; unsigned* cnt; unsigned want; unsigned* tmo;
    __device__ __forceinline__ bool next(int i, Unit& u) const { const int L = i * G + c; if (L >= nunits) return false; u.pm = L; u.pn = L / per; return true; }
    __device__ __forceinline__ void a_ready(const Unit& u) const {
        if (!cnt) return;
        if (threadIdx.x < 64) { unsigned sp = 0;
            while (__hip_atomic_load(cnt + 64 * u.pm, __ATOMIC_RELAXED, __HIP_MEMORY_SCOPE_AGENT) < want) { __builtin_amdgcn_s_sleep(2);
                if (++sp > (1u << 22)) { if (threadIdx.x == 0) __hip_atomic_store(tmo, 1u, __ATOMIC_RELAXED, __HIP_MEMORY_SCOPE_AGENT); break; } }
            __builtin_amdgcn_fence(__ATOMIC_ACQUIRE, "agent"); asm volatile("s_waitcnt vmcnt(0)" ::: "memory"); }
        __syncthreads();
    }
    __device__ __forceinline__ void done(const Unit&) const {}
};
struct OneUnit { Unit u;
    __device__ __forceinline__ bool next(int i, Unit& x) const { if (i) return false; x = u; return true; }
    __device__ __forceinline__ void a_ready(const Unit&) const {}
    __device__ __forceinline__ void done(const Unit&) const {} };
struct PanelOrder : StaticOrder {
    unsigned* cnt; unsigned want; unsigned* tmo;
    __device__ __forceinline__ void a_ready(const Unit& u) const {
        if (threadIdx.x < 64) { unsigned sp = 0;
            while (__hip_atomic_load(cnt + 64 * u.pm, __ATOMIC_RELAXED, __HIP_MEMORY_SCOPE_AGENT) < want) { __builtin_amdgcn_s_sleep(2);
                if (++sp > (1u << 22)) { if (threadIdx.x == 0) __hip_atomic_store(tmo, 1u, __ATOMIC_RELAXED, __HIP_MEMORY_SCOPE_AGENT); break; } }
            __builtin_amdgcn_fence(__ATOMIC_ACQUIRE, "agent"); asm volatile("s_waitcnt vmcnt(0)" ::: "memory"); }
        __syncthreads();
    }
};

typedef float f32x2 __attribute__((ext_vector_type(2)));
typedef _Float16 f16x2 __attribute__((ext_vector_type(2)));
__device__ __forceinline__ unsigned cvt_pk_h(float lo, float hi) { const f16x2 v = __builtin_convertvector((f32x2){lo, hi}, f16x2); return __builtin_bit_cast(unsigned, v); }
__device__ __forceinline__ float h_lo(unsigned w) { return (float)__builtin_bit_cast(f16x2, w)[0]; }
__device__ __forceinline__ float h_hi(unsigned w) { return (float)__builtin_bit_cast(f16x2, w)[1]; }
__device__ __forceinline__ float fsilu(float v) { return v * __builtin_amdgcn_rcpf(1.f + __builtin_amdgcn_exp2f(-1.4426950408889634f * v)); }
__device__ __forceinline__ float fsigm(float v) { return __builtin_amdgcn_rcpf(1.f + __builtin_amdgcn_exp2f(-1.4426950408889634f * v)); }

struct EpiH16 {
    static constexpr bool PERM = true, AFTER_DRAIN = false;
    bf16_t* O; int ldc;
    __device__ __forceinline__ void operator()(const f32x4 (&acc)[2][2][4][2], const Unit& u, int wr, int wc, int fr, int fq) const {
        const int row0 = u.pm * BM + wr * 64 + fr, col0 = u.pn * BM + wc * 32 + 8 * fq;
#pragma unroll
        for (int ai = 0; ai < 2; ++ai)
#pragma unroll
            for (int m = 0; m < 4; ++m) { bf16_t* rowp = O + (size_t)(row0 + ai * HALF + m * 16) * ldc + col0;
#pragma unroll
                for (int bj = 0; bj < 2; ++bj) { const f32x4 v0 = acc[ai][bj][m][0], v1 = acc[ai][bj][m][1];
                    u32x4 w; w.x = cvt_pk_h(v0[0], v0[1]); w.y = cvt_pk_h(v0[2], v0[3]); w.z = cvt_pk_h(v1[0], v1[1]); w.w = cvt_pk_h(v1[2], v1[3]);
                    store16_wt(rowp + bj * HALF, w); } }
    }
};
struct EpiProj {
    static constexpr bool PERM = true, AFTER_DRAIN = false;
    bf16_t* O; int ldc; float* RS; int rs_pn0; bf16_t* USG; int seq;
    __device__ __forceinline__ void operator()(const f32x4 (&acc)[2][2][4][2], const Unit& u, int wr, int wc, int fr, int fq) const {
        const int row0 = u.pm * BM + wr * 64 + fr, col0 = u.pn * BM + wc * 32 + 8 * fq;
#pragma unroll
        for (int ai = 0; ai < 2; ++ai)
#pragma unroll
            for (int m = 0; m < 4; ++m) { const int grow = row0 + ai * HALF + m * 16; bf16_t* rowp = O + (size_t)grow * ldc + col0 - 512;
                const int bb = grow / seq, tt = grow % seq;
#pragma unroll
                for (int bj = 0; bj < 2; ++bj) { const f32x4 v0 = acc[ai][bj][m][0], v1 = acc[ai][bj][m][1];
                    u32x4 w; w.x = cvt_pk_h(v0[0], v0[1]); w.y = cvt_pk_h(v0[2], v0[3]); w.z = cvt_pk_h(v1[0], v1[1]); w.w = cvt_pk_h(v1[2], v1[3]);
                    if (u.pn < 2) { const int c = col0 + bj * HALF;
                        *(u32x4*)(USG + ((size_t)(c >> 4) * 1024 + bb * 512 + (tt >> 4)) * 384 + (tt & 15) * 16 + (c & 15)) = w;
                    }
                    else *(u32x4*)(rowp + bj * HALF) = w; } }
        if (u.pn >= rs_pn0) {
#pragma unroll
            for (int ai = 0; ai < 2; ++ai)
#pragma unroll
                for (int m = 0; m < 4; ++m)
#pragma unroll
                    for (int bj = 0; bj < 2; ++bj) { const f32x4 v0 = acc[ai][bj][m][0], v1 = acc[ai][bj][m][1];
                        float q = (v0[0] * v0[0] + v0[1] * v0[1]) + (v0[2] * v0[2] + v0[3] * v0[3]) + (v1[0] * v1[0] + v1[1] * v1[1]) + (v1[2] * v1[2] + v1[3] * v1[3]);
                        q += __shfl_xor(q, 16); q += __shfl_xor(q, 32);
                        if (fq == 0) RS[((size_t)(row0 + ai * HALF + m * 16) * 3 + (u.pn - rs_pn0)) * 8 + bj * 4 + wc] = q; }
        }
    }
};
struct MlaAux { const float* RS; const float* rope; const bf16_t* proj; int ldp, krcol0; };
constexpr int MLA_TBL = 8192, MLA_ROPE = 12288, MLA_KR = 45056;
__device__ __forceinline__ void mla_stage_rows(const MlaAux& A, const Unit& u, PG8_LAS unsigned char* lds, int tid, bool want_kr, float eps) {
    const size_t row0 = (size_t)u.pm * BM;
    u32x4 rp[4];
#pragma unroll
    for (int j = 0; j < 4; ++j) rp[j] = *(const u32x4*)((const char*)(A.rope + row0 * 32) + (size_t)(tid + 512 * j) * 16);
    u32x4 kr[2] = {{0u, 0u, 0u, 0u}, {0u, 0u, 0u, 0u}};
    if (want_kr) {
#pragma unroll
        for (int j = 0; j < 2; ++j) { const int c = tid + 512 * j; kr[j] = *(const u32x4*)(A.proj + (row0 + (c >> 2)) * A.ldp + A.krcol0 + 8 * (c & 3)); } }
    if (tid < 256) { const float* rs = A.RS + (row0 + tid) * 24;
        const f32x4 s6a = *(const f32x4*)rs, s6b = *(const f32x4*)(rs + 4), s7a = *(const f32x4*)(rs + 8), s7b = *(const f32x4*)(rs + 12), s8a = *(const f32x4*)(rs + 16); const float skr = rs[20];
        const float sq = ((s7a[0] + s7a[1]) + (s7a[2] + s7a[3])) + ((s7b[0] + s7b[1]) + (s7b[2] + s7b[3])) + ((s8a[0] + s8a[1]) + (s8a[2] + s8a[3]));
        const float skv = ((s6a[0] + s6a[1]) + (s6a[2] + s6a[3])) + ((s6b[0] + s6b[1]) + (s6b[2] + s6b[3]));
        *(PG8_LAS f32x4*)(lds + MLA_TBL + tid * 16) = (f32x4){1.f / sqrtf(sq * (1.f / 384.f) + eps), 1.f / sqrtf(skv * (1.f / 256.f) + eps), skr, 0.f}; }
#pragma unroll
    for (int j = 0; j < 4; ++j) *(PG8_LAS u32x4*)(lds + MLA_ROPE + (tid + 512 * j) * 16) = rp[j];
    if (want_kr) {
#pragma unroll
        for (int j = 0; j < 2; ++j) *(PG8_LAS u32x4*)(lds + MLA_KR + (tid + 512 * j) * 16) = kr[j]; }
}
struct EpiQ {
    static constexpr bool PERM = true, AFTER_DRAIN = true;
    MlaAux A; const float* gq; bf16_t* Q; float qscale, eps; int seq;
    __device__ __forceinline__ void fused(f32x4 (&acc)[2][2][4][2], const Unit& u, int wr, int wc, int fr, int fq, PG8_LAS unsigned char* lds, int wid, int lane) const {
        PG8_LAS float* P = (PG8_LAS float*)lds;
#pragma unroll
        for (int ai = 0; ai < 2; ++ai)
#pragma unroll
            for (int m = 0; m < 4; ++m)
#pragma unroll
                for (int bj = 0; bj < 2; ++bj) { const f32x4 v0 = acc[ai][bj][m][0], v1 = acc[ai][bj][m][1];
                    float q = (v0[0] * v0[0] + v0[1] * v0[1]) + (v0[2] * v0[2] + v0[3] * v0[3]) + (v1[0] * v1[0] + v1[1] * v1[1]) + (v1[2] * v1[2] + v1[3] * v1[3]);
                    q += __shfl_xor(q, 16); q += __shfl_xor(q, 32);
                    if (fq == 0) P[((ai * HALF + wr * 64 + m * 16 + fr) * 2 + bj) * 4 + wc] = q; }
        mla_stage_rows(A, u, lds, wid * 64 + lane, false, eps);
        asm volatile("s_waitcnt lgkmcnt(0)" ::: "memory"); __builtin_amdgcn_s_barrier(); asm volatile("" ::: "memory");
        if (wc == 3) return;
        const int d0 = 32 * wc + 8 * fq;
        const f32x4 g0 = *(const f32x4*)(gq + (wc == 2 ? 64 + 8 * fq : d0)), g1 = *(const f32x4*)(gq + (wc == 2 ? 64 + 8 * fq : d0) + 4);
#pragma unroll
        for (int ai = 0; ai < 2; ++ai)
#pragma unroll
            for (int m = 0; m < 4; ++m) { const int r = ai * HALF + wr * 64 + m * 16 + fr; const size_t grow = (size_t)u.pm * BM + r;
                const float rstd = (*(const PG8_LAS f32x4*)(lds + MLA_TBL + r * 16))[0];
                f32x4 cs0 = {0.f, 0.f, 0.f, 0.f}, cs1 = cs0, cs2 = cs0, cs3 = cs0;
                if (wc == 2) { const PG8_LAS float* rp = (const PG8_LAS float*)(lds + MLA_ROPE) + (r * 16 + 8 * (fq & 1)) * 2; cs0 = *(const PG8_LAS f32x4*)rp; cs1 = *(const PG8_LAS f32x4*)(rp + 4); cs2 = *(const PG8_LAS f32x4*)(rp + 8); cs3 = *(const PG8_LAS f32x4*)(rp + 12); }
#pragma unroll
                for (int bj = 0; bj < 2; ++bj) { const f32x4 pp = *(const PG8_LAS f32x4*)(P + (r * 2 + bj) * 4);
                    const float tot = (pp[0] + pp[1]) + pp[2];
                    const float rs = qscale * rstd * __builtin_amdgcn_rsqf(rstd * rstd * tot * (1.f / 96.f) + eps);
                    f32x4 v0 = acc[ai][bj][m][0] * rs * g0, v1 = acc[ai][bj][m][1] * rs * g1;
                    if (wc == 2) {
                        f32x4 o0, o1;
#pragma unroll
                        for (int e = 0; e < 4; ++e) { o0[e] = __shfl_xor(v0[e], 32); o1[e] = __shfl_xor(v1[e], 32); }
                        const float sg = (fq < 2) ? -1.f : 1.f;
                        v0[0] = v0[0] * cs0[0] + sg * o0[0] * cs0[1]; v0[1] = v0[1] * cs0[2] + sg * o0[1] * cs0[3]; v0[2] = v0[2] * cs1[0] + sg * o0[2] * cs1[1]; v0[3] = v0[3] * cs1[2] + sg * o0[3] * cs1[3];
                        v1[0] = v1[0] * cs2[0] + sg * o1[0] * cs2[1]; v1[1] = v1[1] * cs2[2] + sg * o1[1] * cs2[3]; v1[2] = v1[2] * cs3[0] + sg * o1[2] * cs3[1]; v1[3] = v1[3] * cs3[2] + sg * o1[3] * cs3[3]; }
                    u32x4 w; w.x = cvt_pk_h(v0[0], v0[1]); w.y = cvt_pk_h(v0[2], v0[3]); w.z = cvt_pk_h(v1[0], v1[1]); w.w = cvt_pk_h(v1[2], v1[3]);
                    *(u32x4*)(Q + grow * 768 + (2 * u.pn + bj) * 96 + d0) = w; } }
    }
};
struct EpiKV {
    static constexpr bool PERM = true, AFTER_DRAIN = true;
    MlaAux A; const float* gk; bf16_t* KIMG; bf16_t* VIMG; float eps; int seq;
    __device__ __forceinline__ static int vst(int k, int c) { return (c >> 5) * 4096 + k * 64 + (c & 31) * 2; }
    __device__ __forceinline__ void fused(f32x4 (&acc)[2][2][4][2], const Unit& u, int wr, int wc, int fr, int fq, PG8_LAS unsigned char* lds, int wid, int lane) const {
        PG8_LAS float* P = (PG8_LAS float*)lds;
        if (wc < 2) {
#pragma unroll
            for (int ai = 0; ai < 2; ++ai)
#pragma unroll
                for (int m = 0; m < 4; ++m)
#pragma unroll
                    for (int bj = 0; bj < 2; ++bj) { const f32x4 v0 = acc[ai][bj][m][0], v1 = acc[ai][bj][m][1];
                        float q = (v0[0] * v0[0] + v0[1] * v0[1]) + (v0[2] * v0[2] + v0[3] * v0[3]) + (v1[0] * v1[0] + v1[1] * v1[1]) + (v1[2] * v1[2] + v1[3] * v1[3]);
                        q += __shfl_xor(q, 16); q += __shfl_xor(q, 32);
                        if (fq == 0) P[((ai * HALF + wr * 64 + m * 16 + fr) * 2 + bj) * 2 + wc] = q; }
        }
        mla_stage_rows(A, u, lds, wid * 64 + lane, true, eps);
        asm volatile("s_waitcnt lgkmcnt(0)" ::: "memory"); __builtin_amdgcn_s_barrier(); asm volatile("" ::: "memory");
        const int q8 = 4 * (wc & 1) + fq;
        f32x4 g0 = {0.f, 0.f, 0.f, 0.f}, g1 = g0; float ga = 0.f, gb = 0.f, gc = 0.f, gd = 0.f;
        if (wc < 2) { g0 = *(const f32x4*)(gk + 32 * wc + 8 * fq); g1 = *(const f32x4*)(gk + 32 * wc + 8 * fq + 4); }
        else { ga = gk[64 + 2 * q8]; gb = gk[65 + 2 * q8]; gc = gk[80 + 2 * q8]; gd = gk[81 + 2 * q8]; }
#pragma unroll
        for (int ai = 0; ai < 2; ++ai)
#pragma unroll
            for (int m = 0; m < 4; ++m) { const int r = ai * HALF + wr * 64 + m * 16 + fr; const size_t grow = (size_t)u.pm * BM + r;
                const f32x4 tb = *(const PG8_LAS f32x4*)(lds + MLA_TBL + r * 16); const float rstd = tb[1], skr = tb[2];
                const int bb = (int)(grow / (size_t)seq), tt = (int)(grow % (size_t)seq), trow = tt & 63;
                float cA = 0.f, sA = 0.f, cB = 0.f, sB = 0.f, x1a = 0.f, x1b = 0.f, x2a = 0.f, x2b = 0.f;
                if (wc >= 2) { const f32x4 cs = *(const PG8_LAS f32x4*)((const PG8_LAS float*)(lds + MLA_ROPE) + (r * 16 + 2 * q8) * 2); cA = cs[0]; sA = cs[1]; cB = cs[2]; sB = cs[3];
                    const PG8_LAS bf16_t* krow = (const PG8_LAS bf16_t*)(lds + MLA_KR) + r * 32;
                    const unsigned ra = *(const PG8_LAS unsigned*)(krow + 2 * q8), rb = *(const PG8_LAS unsigned*)(krow + 16 + 2 * q8);
                    x1a = h_lo(ra); x1b = h_hi(ra); x2a = h_lo(rb); x2b = h_hi(rb); }
#pragma unroll
                for (int bj = 0; bj < 2; ++bj) { const f32x2 pp = *(const PG8_LAS f32x2*)(P + (r * 2 + bj) * 2);
                    const float rs = __builtin_amdgcn_rsqf((rstd * rstd * (pp[0] + pp[1]) + skr) * (1.f / 96.f) + eps);
                    const size_t tix = (size_t)(bb * 8 + 2 * u.pn + bj) * 128 + (tt >> 6);
                    if (wc < 2) { const float f = rstd * rs; const f32x4 v0 = acc[ai][bj][m][0] * f * g0, v1 = acc[ai][bj][m][1] * f * g1;
                        u32x4 w; w.x = cvt_pk_h(v0[0], v0[1]); w.y = cvt_pk_h(v0[2], v0[3]); w.z = cvt_pk_h(v1[0], v1[1]); w.w = cvt_pk_h(v1[2], v1[3]);
                        *(u32x4*)(KIMG + tix * 6144 + (4 * wc + fq) * 512 + trow * 8) = w; }
                    else { const f32x4 v0 = acc[ai][bj][m][0] * rstd, v1 = acc[ai][bj][m][1] * rstd;
                        u32x4 w; w.x = cvt_pk_h(v0[0], v0[1]); w.y = cvt_pk_h(v0[2], v0[3]); w.z = cvt_pk_h(v1[0], v1[1]); w.w = cvt_pk_h(v1[2], v1[3]);
                        *(u32x4*)(VIMG + tix * 4096 + vst(trow, 32 * (wc - 2) + 8 * fq) / 2) = w;
                        const float y1a = x1a * rs * ga, y1b = x1b * rs * gb, y2a = x2a * rs * gc, y2b = x2b * rs * gd;
                        bf16_t* kd = KIMG + tix * 6144 + trow * 8;
                        *(unsigned*)(kd + (8 + (q8 >> 2)) * 512 + ((2 * q8) & 7)) = cvt_pk_h(y1a * cA - y2a * sA, y1b * cB - y2b * sB);
                        *(unsigned*)(kd + (10 + (q8 >> 2)) * 512 + ((2 * q8) & 7)) = cvt_pk_h(y2a * cA + y1a * sA, y2b * cB + y1b * sB); } } }
    }
};
struct EpiELds {
    static constexpr bool PERM = true, AFTER_DRAIN = true;
    __device__ __forceinline__ void fused(f32x4 (&acc)[2][2][4][2], const Unit& u, int wr, int wc, int fr, int fq, PG8_LAS unsigned char* lds, int wid, int lane) const {
        PG8_LAS float* El = (PG8_LAS float*)lds;
#pragma unroll
        for (int ai = 0; ai < 2; ++ai)
#pragma unroll
            for (int m = 0; m < 4; ++m) { const int r = ai * HALF + wr * 64 + m * 16 + fr; PG8_LAS float* rp = El + r * 128 + wc * 32 + 8 * fq;
                *(PG8_LAS f32x4*)rp = acc[ai][0][m][0]; *(PG8_LAS f32x4*)(rp + 4) = acc[ai][0][m][1]; }
    }
};
__device__ __forceinline__ void ssm_chain_unit(const Unit& u, const PG8_LAS unsigned char* lds, bf16_t* USG, const float* AC, float* hand, unsigned* cnt, unsigned* tmo, int lane) {
        const PG8_LAS float* El = (const PG8_LAS float*)lds;
        const int g = u.pn, k4 = u.pm & 3, seqi = g * 2 + (k4 >> 1), p = lane;
        const f32x4 ac = *(const f32x4*)(AC + ((size_t)g * 64 + p) * 4);
        float sr = 0.f, si = 0.f;
        if (k4 & 1) { unsigned sp = 0;
            while (__hip_atomic_load(cnt + 64 * seqi, __ATOMIC_RELAXED, __HIP_MEMORY_SCOPE_AGENT) < 1u) { __builtin_amdgcn_s_sleep(2);
                if (++sp > (1u << 22)) { if (lane == 0) __hip_atomic_store(tmo, 1u, __ATOMIC_RELAXED, __HIP_MEMORY_SCOPE_AGENT); break; } }
            const unsigned long long hv = __hip_atomic_load((const unsigned long long*)(hand + ((size_t)seqi * 64 + p) * 2), __ATOMIC_RELAXED, __HIP_MEMORY_SCOPE_AGENT);
            sr = __uint_as_float((unsigned)hv); si = __uint_as_float((unsigned)(hv >> 32)); }
        bf16_t* srow = USG + (size_t)u.pm * BM * 384 + 256 + 2 * p;
#pragma unroll 8
        for (int t = 0; t < 256; ++t) { const f32x2 e = *(const PG8_LAS f32x2*)(El + t * 128 + 2 * p);
            *(unsigned*)(srow + (size_t)t * 384) = cvt_pk_h(sr, si);
            const float nr = ac[2] * sr - ac[3] * si + e[0], ni = ac[2] * si + ac[3] * sr + e[1]; sr = nr; si = ni; }
        if (!(k4 & 1)) { __hip_atomic_store((unsigned long long*)(hand + ((size_t)seqi * 64 + p) * 2), (unsigned long long)__float_as_uint(sr) | ((unsigned long long)__float_as_uint(si) << 32), __ATOMIC_RELAXED, __HIP_MEMORY_SCOPE_AGENT);
            asm volatile("s_waitcnt vmcnt(0)" ::: "memory");
            if (lane == 0) __hip_atomic_fetch_add(cnt + 64 * seqi, 1u, __ATOMIC_RELAXED, __HIP_MEMORY_SCOPE_AGENT); }
}
struct EpiY {
    static constexpr bool PERM = true, AFTER_DRAIN = false;
    const bf16_t* USG; const float* dskip; bf16_t* YPRE; int seq;
    __device__ __forceinline__ static float gelu_t(float v) { const float z = 0.7978845608028654f * (v + 0.044715f * v * v * v); return v * __builtin_amdgcn_rcpf(1.f + __builtin_amdgcn_exp2f(-2.885390081777927f * z)); }
    __device__ __forceinline__ void operator()(const f32x4 (&acc)[2][2][4][2], const Unit& u, int wr, int wc, int fr, int fq) const {
        const int g = u.pn, k4 = u.pm & 3, bb = k4 >> 1;
        const int i0 = (8 * fq) & 15;
        const f32x4 d0 = *(const f32x4*)(dskip + g * 16 + i0), d1 = *(const f32x4*)(dskip + g * 16 + i0 + 4);
#pragma unroll
        for (int ai = 0; ai < 2; ++ai)
#pragma unroll
            for (int m = 0; m < 4; ++m) { const int r = ai * HALF + wr * 64 + m * 16 + fr; const size_t arow = (size_t)u.pm * BM + r; const int tile = (k4 & 1) * 256 + r;
#pragma unroll
                for (int bj = 0; bj < 2; ++bj) { const int col = bj * HALF + wc * 32 + 8 * fq, t = col >> 4;
                    const u32x4 uv = *(const u32x4*)(USG + arow * 384 + col);
                    const f32x4 v0 = acc[ai][bj][m][0], v1 = acc[ai][bj][m][1];
                    u32x4 w;
                    w.x = cvt_pk_h(gelu_t(v0[0] + d0[0] * h_lo(uv.x)), gelu_t(v0[1] + d0[1] * h_hi(uv.x))); w.y = cvt_pk_h(gelu_t(v0[2] + d0[2] * h_lo(uv.y)), gelu_t(v0[3] + d0[3] * h_hi(uv.y)));
                    w.z = cvt_pk_h(gelu_t(v1[0] + d1[0] * h_lo(uv.z)), gelu_t(v1[1] + d1[1] * h_hi(uv.z))); w.w = cvt_pk_h(gelu_t(v1[2] + d1[2] * h_lo(uv.w)), gelu_t(v1[3] + d1[3] * h_hi(uv.w)));
                    store16_wt(YPRE + ((size_t)bb * seq + (size_t)tile * 16 + t) * 512 + g * 16 + i0, w); } }
    }
};
struct EpiGlu {
    static constexpr bool PERM = true, AFTER_DRAIN = false;
    const bf16_t* ypre; const bf16_t* proj; int ldp, zcol0; const float* bglu; bf16_t* ycat;
    __device__ __forceinline__ void operator()(const f32x4 (&acc)[2][2][4][2], const Unit& u, int wr, int wc, int fr, int fq) const {
        const int row0 = u.pm * BM + wr * 64 + fr, col0 = u.pn * BM + wc * 32 + 8 * fq;
        f32x4 bv[2][2];
#pragma unroll
        for (int bj = 0; bj < 2; ++bj)
#pragma unroll
            for (int n = 0; n < 2; ++n) bv[bj][n] = *(const f32x4*)(bglu + col0 + bj * HALF + 4 * n);
#pragma unroll
        for (int ai = 0; ai < 2; ++ai)
#pragma unroll
            for (int m = 0; m < 4; ++m) { const size_t row = (size_t)(row0 + ai * HALF + m * 16);
#pragma unroll
                for (int bj = 0; bj < 2; ++bj) { const int col = col0 + bj * HALF;
                    const u32x4 yv = __builtin_nontemporal_load((const u32x4*)(ypre + row * 512 + col)); const u32x4 zv = __builtin_nontemporal_load((const u32x4*)(proj + row * ldp + zcol0 + col));
                    const f32x4 t0 = acc[ai][bj][m][0] + bv[bj][0], t1 = acc[ai][bj][m][1] + bv[bj][1];
                    u32x4 w;
                    w.x = cvt_pk_h(h_lo(yv.x) * fsigm(t0[0]) * fsilu(h_lo(zv.x)), h_hi(yv.x) * fsigm(t0[1]) * fsilu(h_hi(zv.x)));
                    w.y = cvt_pk_h(h_lo(yv.y) * fsigm(t0[2]) * fsilu(h_lo(zv.y)), h_hi(yv.y) * fsigm(t0[3]) * fsilu(h_hi(zv.y)));
                    w.z = cvt_pk_h(h_lo(yv.z) * fsigm(t1[0]) * fsilu(h_lo(zv.z)), h_hi(yv.z) * fsigm(t1[1]) * fsilu(h_hi(zv.z)));
                    w.w = cvt_pk_h(h_lo(yv.w) * fsigm(t1[2]) * fsilu(h_lo(zv.w)), h_hi(yv.w) * fsigm(t1[3]) * fsilu(h_hi(zv.w)));
                    store16_wt(ycat + row * 1024 + col, w); } }
    }
};
struct EpiOutRows {
    static constexpr bool PERM = false, AFTER_DRAIN = true;
    const float* x; const float* gate; int gate_stride, rows_per_batch; float* out;
    __device__ __forceinline__ static int slot(int r, int s16) { return r * 1024 + ((s16 ^ (r & 15)) << 4); }
    __device__ __forceinline__ void fused(f32x4 (&acc)[2][2][4][2], const Unit& u, int wr, int wc, int fr, int fq, PG8_LAS unsigned char* lds, int wid, int lane) const {
        const int b = (u.pm * BM) / rows_per_batch;
        const f32x4 gv = *(const f32x4*)(gate + (size_t)b * gate_stride + u.pn * BM + 4 * lane);
#pragma unroll
        for (int ai = 0; ai < 2; ++ai) {
#pragma unroll
            for (int m = 0; m < 4; ++m) { const int rl = wr * 64 + m * 16 + fr;
#pragma unroll
                for (int bj = 0; bj < 2; ++bj)
#pragma unroll
                    for (int n = 0; n < 2; ++n) *(PG8_LAS f32x4*)(lds + slot(rl, 32 * bj + 8 * wc + 4 * n + fq)) = acc[ai][bj][m][n]; }
            asm volatile("s_waitcnt lgkmcnt(0)" ::: "memory"); __builtin_amdgcn_s_barrier(); asm volatile("" ::: "memory");
            const size_t g0 = ((size_t)u.pm * BM + ai * HALF + wid * 16) * 1024 + u.pn * BM + 4 * lane;
#pragma unroll
            for (int i0 = 0; i0 < 16; i0 += 8) { f32x4 xs[8];
#pragma unroll
                for (int i = 0; i < 8; ++i) xs[i] = __builtin_nontemporal_load((const f32x4*)(x + g0 + (size_t)(i0 + i) * 1024));
#pragma unroll
                for (int i = 0; i < 8; ++i) { const f32x4 v = *(const PG8_LAS f32x4*)(lds + slot(wid * 16 + i0 + i, lane)); __builtin_nontemporal_store(xs[i] + gv * v, (f32x4*)(out + g0 + (size_t)(i0 + i) * 1024)); } }
            if (ai == 0) { asm volatile("s_waitcnt lgkmcnt(0)" ::: "memory"); __builtin_amdgcn_s_barrier(); asm volatile("" ::: "memory"); }
        }
    }
};
template <class Epi, class Sched, bool ALIGN_EPI = false, bool SP2 = false>
__device__ __forceinline__ void gemm_phase(PG8_LAS unsigned char* lds, const Gemm g, const Sched& S, const Epi& E) {
    int tid_ = threadIdx.x; asm volatile("" : "+v"(tid_));
    const int tid = tid_, wid = __builtin_amdgcn_readfirstlane(tid >> 6), lane = tid & 63, wr = wid >> 2, wc = wid & 3, fr = lane & 15, fq = lane >> 4;
    const int K = g.K, nt = K / BK;
    unsigned voffA[2], voffB[2];
#pragma unroll
    for (int i = 0; i < 2; ++i) { int R, C; stage_rc(tid * 16 + i * 8192, R, C); const int Rb = Epi::PERM ? ((R & ~31) + perm32(R & 31)) : R;
        voffA[i] = (unsigned)(R * g.lda + C) * 2u; voffB[i] = (unsigned)(Rb * K + C) * 2u; }
    const size_t kstep = (size_t)(BK * 2);
    const size_t hstepA = (size_t)HALF * g.lda * 2, hstepB = (size_t)HALF * K * 2;
    const size_t tstepA = 2 * hstepA, tstepB = 2 * hstepB;
    const unsigned ldsw = (unsigned)wid * 1024u;
    const int aoff = lds_byte(wr * 64 + fr, fq * 8), boff = lds_byte(wc * 32 + fr, fq * 8);
#define PG8_SA(b, h) (((b) * 2 + (h)) * HTB)
#define PG8_SB(b, h) ((4 + (b) * 2 + (h)) * HTB)
#define PG8_STAGE(bufoff, gbase, voff) do { _Pragma("unroll") for (int _i = 0; _i < 2; ++_i) \
        __builtin_amdgcn_global_load_lds((const unsigned*)((const char*)(gbase) + (voff)[_i]), (PG8_LAS unsigned*)(lds + (bufoff) + ldsw + _i * 8192), 16, 0, 0); } while (0)
#define PG8_LDA(dst, b, h) do { _Pragma("unroll") for (int m = 0; m < 4; ++m) _Pragma("unroll") for (int k = 0; k < 2; ++k) dst[m][k] = *(const PG8_LAS bf16x8*)(lds + PG8_SA(b, h) + aoff + m * 2048 + k * 1024); } while (0)
#define PG8_LDB(dst, b, h) do { _Pragma("unroll") for (int n = 0; n < 2; ++n) _Pragma("unroll") for (int k = 0; k < 2; ++k) dst[n][k] = *(const PG8_LAS bf16x8*)(lds + PG8_SB(b, h) + boff + n * 2048 + k * 1024); } while (0)
#define PG8_MMA(ai, bj, At, Bt) do { __builtin_amdgcn_s_setprio(1); _Pragma("unroll") for (int m = 0; m < 4; ++m) _Pragma("unroll") for (int n = 0; n < 2; ++n) _Pragma("unroll") for (int k = 0; k < 2; ++k) \
        acc[ai][bj][m][n] = __builtin_amdgcn_mfma_f32_16x16x32_f16(Bt[n][k], At[m][k], acc[ai][bj][m][n], 0, 0, 0); __builtin_amdgcn_s_setprio(0); } while (0)
#define PG8_WAIT_V(n) asm volatile("s_waitcnt vmcnt(" #n ")" ::: "memory")
#define PG8_WAIT_L(n) asm volatile("s_waitcnt lgkmcnt(" #n ")" ::: "memory")
#define PG8_BAR __builtin_amdgcn_s_barrier()
#define PG8_SCHED __builtin_amdgcn_sched_barrier(0)
    Unit cur, nxt; int ui = 0;
    if (!S.next(0, cur)) return;
    f32x4 acc[2][2][4][2];
#pragma unroll
    for (int a = 0; a < 2; ++a)
#pragma unroll
        for (int b = 0; b < 2; ++b)
#pragma unroll
            for (int m = 0; m < 4; ++m)
#pragma unroll
                for (int n = 0; n < 2; ++n) acc[a][b][m][n] = (f32x4){0.f, 0.f, 0.f, 0.f};
    bf16x8 At[4][2], B0[2][2], B1[2][2];
    const char* cA = (const char*)g.A + (size_t)cur.pm * tstepA; const char* cB = (const char*)g.Bt + (size_t)cur.pn * tstepB;
    S.a_ready(cur);
    if constexpr (SP2) {
        PG8_STAGE(PG8_SB(0, 0), cB, voffB); PG8_STAGE(PG8_SB(0, 1), cB + hstepB, voffB); PG8_STAGE(PG8_SA(0, 0), cA, voffA); PG8_STAGE(PG8_SA(0, 1), cA + hstepA, voffA);
        if (wr == 1) PG8_BAR;
        PG8_WAIT_V(2); PG8_BAR;
        PG8_STAGE(PG8_SB(1, 0), cB + kstep, voffB); PG8_STAGE(PG8_SA(1, 0), cA + kstep, voffA); PG8_STAGE(PG8_SB(1, 1), cB + hstepB + kstep, voffB);
        PG8_WAIT_V(6); PG8_BAR;
    } else {
        PG8_STAGE(PG8_SB(0, 0), cB, voffB); PG8_STAGE(PG8_SA(0, 0), cA, voffA); PG8_STAGE(PG8_SB(0, 1), cB + hstepB, voffB); PG8_STAGE(PG8_SA(0, 1), cA + hstepA, voffA);
        if (wr == 1) PG8_BAR;
        PG8_WAIT_V(4); PG8_BAR;
        PG8_STAGE(PG8_SB(1, 0), cB + kstep, voffB); PG8_STAGE(PG8_SA(1, 0), cA + kstep, voffA); PG8_STAGE(PG8_SB(1, 1), cB + hstepB + kstep, voffB);
        PG8_WAIT_V(6); PG8_BAR;
    }
    for (;;) {
        const bool has_next = S.next(ui + 1, nxt);
        const char* nA = has_next ? (const char*)g.A + (size_t)nxt.pm * tstepA : cA; const char* nB = has_next ? (const char*)g.Bt + (size_t)nxt.pn * tstepB : cB;
        for (int t = 0; t < nt; t += 2) {
            const bool last = (t == nt - 2);
            const char* a1 = cA + (size_t)(t + 1) * kstep;
            const char* a2 = last ? nA : cA + (size_t)(t + 2) * kstep; const char* b2 = last ? nB : cB + (size_t)(t + 2) * kstep;
            const char* a3 = a2 + kstep; const char* b3 = b2 + kstep;
            if (last && has_next) S.a_ready(nxt);
            if constexpr (SP2) {
            PG8_LDB(B0, 0, 0); PG8_LDB(B1, 0, 1); PG8_SCHED; PG8_LDA(At, 0, 0); PG8_STAGE(PG8_SA(1, 1), a1 + hstepA, voffA);
            PG8_WAIT_V(8); PG8_WAIT_L(0); PG8_BAR; PG8_MMA(0, 0, At, B0); PG8_MMA(0, 1, At, B1); PG8_BAR; PG8_SCHED;
            PG8_LDA(At, 0, 1); PG8_STAGE(PG8_SB(0, 0), b2, voffB); PG8_STAGE(PG8_SB(0, 1), b2 + hstepB, voffB); PG8_STAGE(PG8_SA(0, 0), a2, voffA);
            PG8_WAIT_V(8); PG8_WAIT_L(0); PG8_BAR; PG8_MMA(1, 0, At, B0); PG8_MMA(1, 1, At, B1); PG8_BAR; PG8_SCHED;
            PG8_LDB(B0, 1, 0); PG8_LDB(B1, 1, 1); PG8_SCHED; PG8_LDA(At, 1, 0); PG8_STAGE(PG8_SA(0, 1), a2 + hstepA, voffA);
            PG8_WAIT_V(8); PG8_WAIT_L(0); PG8_BAR; PG8_MMA(0, 0, At, B0); PG8_MMA(0, 1, At, B1); PG8_BAR; PG8_SCHED;
            PG8_LDA(At, 1, 1); PG8_STAGE(PG8_SB(1, 0), b3, voffB); PG8_STAGE(PG8_SB(1, 1), b3 + hstepB, voffB); PG8_STAGE(PG8_SA(1, 0), a3, voffA);
            PG8_WAIT_V(8); PG8_WAIT_L(0); PG8_BAR; PG8_MMA(1, 0, At, B0); PG8_MMA(1, 1, At, B1); PG8_BAR; PG8_SCHED;
            } else {
            PG8_LDB(B0, 0, 0); PG8_SCHED; PG8_LDA(At, 0, 0); PG8_STAGE(PG8_SA(1, 1), a1 + hstepA, voffA);
            PG8_WAIT_L(8); PG8_BAR; PG8_WAIT_L(0); PG8_MMA(0, 0, At, B0); PG8_BAR; PG8_SCHED;
            PG8_LDB(B1, 0, 1); PG8_STAGE(PG8_SB(0, 0), b2, voffB);
            PG8_BAR; PG8_WAIT_L(0); PG8_MMA(0, 1, At, B1); PG8_BAR;
            PG8_LDA(At, 0, 1); PG8_STAGE(PG8_SA(0, 0), a2, voffA);
            PG8_BAR; PG8_WAIT_L(0); PG8_MMA(1, 0, At, B0); PG8_BAR; PG8_SCHED;
            PG8_STAGE(PG8_SB(0, 1), b2 + hstepB, voffB);
            PG8_WAIT_V(6); PG8_BAR; PG8_MMA(1, 1, At, B1); PG8_BAR;
            PG8_LDB(B0, 1, 0); PG8_SCHED; PG8_LDA(At, 1, 0); PG8_STAGE(PG8_SA(0, 1), a2 + hstepA, voffA);
            PG8_WAIT_L(8); PG8_BAR; PG8_WAIT_L(0); PG8_MMA(0, 0, At, B0); PG8_BAR; PG8_SCHED;
            PG8_LDB(B1, 1, 1); PG8_STAGE(PG8_SB(1, 0), b3, voffB);
            PG8_BAR; PG8_WAIT_L(0); PG8_MMA(0, 1, At, B1); PG8_BAR;
            PG8_LDA(At, 1, 1); PG8_STAGE(PG8_SA(1, 0), a3, voffA);
            PG8_BAR; PG8_WAIT_L(0); PG8_MMA(1, 0, At, B0); PG8_BAR; PG8_SCHED;
            PG8_STAGE(PG8_SB(1, 1), b3 + hstepB, voffB);
            PG8_WAIT_V(6); PG8_BAR; PG8_MMA(1, 1, At, B1); PG8_BAR;
            }
        }
        if constexpr (ALIGN_EPI) { if (wr == 0) PG8_BAR; }
        if constexpr (!Epi::AFTER_DRAIN) { E(acc, cur, wr, wc, fr, fq); S.done(cur); }
        if (!has_next) break;
#pragma unroll
        for (int a = 0; a < 2; ++a)
#pragma unroll
            for (int b = 0; b < 2; ++b)
#pragma unroll
                for (int m = 0; m < 4; ++m)
#pragma unroll
                    for (int n = 0; n < 2; ++n) acc[a][b][m][n] = (f32x4){0.f, 0.f, 0.f, 0.f};
        cur = nxt; cA = nA; cB = nB; ++ui;
        if constexpr (ALIGN_EPI) { if (wr == 1) PG8_BAR; }
    }
    PG8_WAIT_V(0);
    if constexpr (!ALIGN_EPI) { if (wr == 0) PG8_BAR; }
    PG8_BAR;
    if constexpr (Epi::AFTER_DRAIN) { E.fused(acc, cur, wr, wc, fr, fq, lds, wid, lane); S.done(cur); }
#undef PG8_SA
#undef PG8_SB
#undef PG8_STAGE
#undef PG8_LDA
#undef PG8_LDB
#undef PG8_MMA
#undef PG8_WAIT_V
#undef PG8_WAIT_L
#undef PG8_BAR
#undef PG8_SCHED
}
}

namespace att {
using h16x8 = __attribute__((ext_vector_type(8))) _Float16;
using s16x4 = __attribute__((ext_vector_type(4))) short;
using f32x16 = __attribute__((ext_vector_type(16))) float;
using u32x4 = __attribute__((ext_vector_type(4))) unsigned;
typedef float f32x2_t __attribute__((ext_vector_type(2))); typedef _Float16 f16x2_t __attribute__((ext_vector_type(2)));
constexpr int NW = 8, QBLK = 32, KVBLK = 64, QB = 256, ASEQ = 8192;
constexpr int LDQ = 768, LDK = 1024, LDV = 512;
constexpr float SCALE = 0.10206207261596575f;
constexpr float THR = 8.f;
#define SBAR() __builtin_amdgcn_sched_barrier(0)
__device__ __forceinline__ int crow(int r, int hi) { return (r & 3) + 8 * (r >> 2) + 4 * hi; }
__device__ __forceinline__ unsigned cvtpk(float lo, float hi) { const f16x2_t v = __builtin_convertvector((f32x2_t){lo, hi}, f16x2_t); return __builtin_bit_cast(unsigned, v); }

__device__ __forceinline__ void cmask(f32x16& p0, f32x16& p1, int jb, int qrel, int hi) {
  const float NEG = -INFINITY; const int kb = 64 * jb + 4 * hi;
#pragma unroll
  for (int r = 0; r < 16; ++r) { const int kv = kb + (r & 3) + 8 * (r >> 2); if (kv > qrel) p0[r] = NEG; if (kv + 32 > qrel) p1[r] = NEG; }
}
constexpr int KT_BYTES = 12288, VT_BYTES = 8192, NKS = 3, NVS = 4;
constexpr int LDS_V0 = NKS * KT_BYTES, LDS_WSC = LDS_V0 + NVS * VT_BYTES;
constexpr int LDS_OST = LDS_WSC + NW * 64 * 4;
constexpr int LDS_ATT2 = LDS_OST + NW * 4096;
typedef __attribute__((address_space(3))) unsigned char* lds3_t;
__device__ __forceinline__ unsigned gate2(unsigned ow, unsigned zw) {
  const f16x2_t o2 = __builtin_bit_cast(f16x2_t, ow), z2 = __builtin_bit_cast(f16x2_t, zw); const float z0 = (float)z2[0], z1 = (float)z2[1];
  return cvtpk((float)o2[0] * (z0 * __builtin_amdgcn_rcpf(1.f + __builtin_amdgcn_exp2f(-1.4426950408889634f * z0))), (float)o2[1] * (z1 * __builtin_amdgcn_rcpf(1.f + __builtin_amdgcn_exp2f(-1.4426950408889634f * z1))));
}
#define PIN(x) asm volatile("" : "+v"(x))
#define MFMAH(a, b, c) __builtin_amdgcn_mfma_f32_32x32x16_f16(a, b, c, 0, 0, 0)
typedef __attribute__((address_space(3))) const char* lds_cptr;
typedef short v4i16_t __attribute__((ext_vector_type(4)));
__device__ __forceinline__ void kload2(h16x8* kf, lds_cptr kp, int d0) { kf[2 * d0] = *(const __attribute__((address_space(3))) h16x8*)(kp + d0 * 2048); kf[2 * d0 + 1] = *(const __attribute__((address_space(3))) h16x8*)(kp + d0 * 2048 + 512); }
__device__ __forceinline__ s16x4 vtr(lds_cptr p) { return __builtin_bit_cast(s16x4, __builtin_amdgcn_ds_read_tr16_b64_v4i16((__attribute__((address_space(3))) v4i16_t*)p)); }
#define MX3(a, b, c) __builtin_fmaxf(__builtin_fmaxf((a), (b)), (c))
__device__ __forceinline__ float rowmax(const f32x16& p0, const f32x16& p1) {
  float a = MX3(p0[0], p0[1], p1[0]), b = MX3(p0[2], p0[3], p1[1]); a = MX3(a, p1[2], p1[3]);
#pragma unroll
  for (int r = 4; r < 16; r += 4) { a = MX3(a, p0[r], p0[r + 1]); b = MX3(b, p0[r + 2], p0[r + 3]); a = MX3(a, p1[r], p1[r + 1]); b = MX3(b, p1[r + 2], p1[r + 3]); }
  float m = __builtin_fmaxf(a, b); auto rr = __builtin_amdgcn_permlane32_swap(__float_as_uint(m), __float_as_uint(m), false, false);
  return __builtin_fmaxf(__uint_as_float(rr[0]), __uint_as_float(rr[1])); }
__device__ __forceinline__ void attn_unit(int b, int h, int qb, const unsigned short* __restrict__ Q, const unsigned short* __restrict__ KIMG, const unsigned short* __restrict__ VIMG,
                                          const unsigned short* __restrict__ PROJ, int ldp, int zcol0, unsigned short* __restrict__ YCAT, char* lds, lds3_t lds3, unsigned* done_cnt, unsigned* z_cnt, unsigned* tmo,
                                          int next_qword, int next_slot_off) {
  int tid_ = threadIdx.x; asm volatile("" : "+v"(tid_));
  const int tid = tid_, lane = tid & 63, r32 = lane & 31, hi = lane >> 5; const int wid = __builtin_amdgcn_readfirstlane(tid >> 6);
  float* ws = (float*)(lds + LDS_WSC) + wid * 64; float* li_l = ws; float* al_l = ws + 32;
  const long rowbase = (long)b * ASEQ; const int q0 = qb * QB;
  const int NT = (q0 + QB) / KVBLK;
  const char* Kg = (const char*)KIMG + (size_t)(b * 8 + h) * 128 * KT_BYTES;
  const char* Vg = (const char*)VIMG + (size_t)(b * 8 + h) * 128 * VT_BYTES;
  const unsigned lo16 = (unsigned)lane * 16u;
  const lds_cptr kp0 = (lds_cptr)lds3 + hi * 1024 + r32 * 16;
  const lds_cptr vp0 = (lds_cptr)lds3 + LDS_V0 + ((lane >> 4) & 1) * 32 + (lane & 3) * 8 + (4 * hi + ((lane & 15) >> 2)) * 64;
  constexpr float THRL = THR * 1.4426950408889634f;
#define GLDS(gp, loff) do { const char* gu_ = (gp); asm volatile("" : "+s"(gu_)); __builtin_amdgcn_global_load_lds((const unsigned*)(gu_ + lo16), (__attribute__((address_space(3))) unsigned*)(lds3 + (loff)), 16, 0, 0); } while (0)
#define DMA_K(t, slot) do { const char* kg_ = Kg + (size_t)(t) * KT_BYTES; const int ko_ = (slot) * KT_BYTES; GLDS(kg_ + wid * 1024, ko_ + wid * 1024); if (wid < 4) GLDS(kg_ + (8 + wid) * 1024, ko_ + (8 + wid) * 1024); } while (0)
#define DMA_V(t, slot) do { GLDS(Vg + (size_t)(t) * VT_BYTES + wid * 1024, LDS_V0 + (slot) * VT_BYTES + wid * 1024); } while (0)
#define WAITB(A, B) do { if (wid < 4) asm volatile("s_waitcnt vmcnt(" #A ") lgkmcnt(0)\n\ts_barrier" ::: "memory"); else asm volatile("s_waitcnt vmcnt(" #B ") lgkmcnt(0)\n\ts_barrier" ::: "memory"); } while (0)
  float mhat = 0.f, l_reg = 0.f; f32x16 o[2]; o[0] = f32x16{}; o[1] = f32x16{}; h16x8 qr[6]; f32x16 negm = {}; PIN(negm);
  const int qrel = wid * QBLK + r32; bool resc = false;
  f32x16 pA0, pA1, pB0, pB1; h16x8 kf[12]; s16x4 vlo[8], vhi[8]; u32x4 pw0, pw1, pw2, pw3;
  int s_prev = 0, s_cur = 0, s_next = 1;
#define ROT() do { s_prev = s_cur; s_cur = s_next; s_next = (s_next == 2) ? 0 : s_next + 1; } while (0)
#define RESC() do { if (resc) { _Pragma("unroll") for (int d_ = 0; d_ < 2; ++d_) _Pragma("unroll") for (int r = 0; r < 16; ++r) o[d_][r] *= al_l[crow(r, hi)]; } } while (0)
  DMA_K(0, 0); DMA_V(0, 0); DMA_K(1, 1);
  { const unsigned short* Qw = Q + (rowbase + q0 + wid * QBLK + r32) * LDQ + h * 96 + hi * 8;
#pragma unroll
    for (int d0 = 0; d0 < 6; ++d0) qr[d0] = __builtin_nontemporal_load(reinterpret_cast<const h16x8*>(Qw + d0 * 16)); }
  DMA_K(2, 2);
  WAITB(2, 1);
#pragma unroll
  for (int d0 = 0; d0 < 6; ++d0) kload2(kf, kp0, d0);
  pA0 = MFMAH(kf[0], qr[0], negm); pA1 = MFMAH(kf[1], qr[0], negm);
#pragma unroll
  for (int d0 = 1; d0 < 6; ++d0) { pA0 = MFMAH(kf[2 * d0], qr[d0], pA0); pA1 = MFMAH(kf[2 * d0 + 1], qr[d0], pA1); }
  if (NT == 4) cmask(pA0, pA1, 0, qrel, hi);
  { const float rm = rowmax(pA0, pA1); mhat = rm;
#pragma unroll
    for (int r = 0; r < 16; ++r) negm[r] = -rm;
    PIN(negm);
#pragma unroll
    for (int r = 0; r < 16; ++r) { pA0[r] = __builtin_amdgcn_exp2f(pA0[r] - rm); pA1[r] = __builtin_amdgcn_exp2f(pA1[r] - rm); } }
  WAITB(0, 0);
  DMA_K(3, 0); DMA_V(1, 1); ROT();
#pragma unroll
  for (int d0 = 0; d0 < 6; ++d0) kload2(kf, kp0 + s_cur * KT_BYTES, d0);
  WAITB(3, 2);
#define PKW(P, i) cvtpk(P[i], P[i + 1])
#define PAF(k) __builtin_bit_cast(h16x8, pw##k)
#define VFR(i) __builtin_bit_cast(h16x8, (__attribute__((ext_vector_type(8))) short){vlo[i][0], vlo[i][1], vlo[i][2], vlo[i][3], vhi[i][0], vhi[i][1], vhi[i][2], vhi[i][3]})
#define VRD(i) do { vlo[i] = vtr(vp_ + (((i) >> 2) * 4096 + ((i) & 3) * 1024)); vhi[i] = vtr(vp_ + (((i) >> 2) * 4096 + ((i) & 3) * 1024 + 512)); } while (0)
#define KRD(G, d0) do { if (G) { kload2(kf, kp0 + s_next * KT_BYTES, d0); SBAR(); } } while (0)
#define GAPA(MF, a0, a1, a2, W0, W1, PW) do { MF; sacc += a0; sacc += a1; sacc += a2; W0; W1; PIN(PW); PIN(sacc); SBAR(); } while (0)
#define GAPA3(MF, a0, a1, a2) do { MF; sacc += a0; sacc += a1; sacc += a2; PIN(sacc); SBAR(); } while (0)
#define GAPB(MF, X, i) do { MF; X[i] = __builtin_amdgcn_exp2f(X[i]); X[i + 1] = __builtin_amdgcn_exp2f(X[i + 1]); X[i + 2] = __builtin_amdgcn_exp2f(X[i + 2]); X[i + 3] = __builtin_amdgcn_exp2f(X[i + 3]); PIN(X); SBAR(); } while (0)
#define STEP(C0, C1, P0, P1, t, MASK, GK, GV, GL) do { SBAR(); \
    const lds_cptr vp_ = vp0 + s_prev * VT_BYTES; \
    VRD(0); SBAR(); float sacc = P0[0] + P0[1]; \
                    GAPA(C0 = MFMAH(kf[0], qr[0], negm), P0[2], P0[3], P0[4],     pw0[0] = PKW(P0, 0),  pw0[1] = PKW(P0, 2),  pw0); \
    VRD(4); SBAR(); GAPA(C1 = MFMAH(kf[1], qr[0], negm), P0[5], P0[6], P0[7],     pw0[2] = PKW(P0, 4),  pw0[3] = PKW(P0, 6),  pw0); \
    VRD(1); SBAR(); GAPA(C0 = MFMAH(kf[2], qr[1], C0),   P0[8], P0[9], P0[10],    pw1[0] = PKW(P0, 8),  pw1[1] = PKW(P0, 10), pw1); \
    VRD(5); SBAR(); GAPA(C1 = MFMAH(kf[3], qr[1], C1),   P0[11], P0[12], P0[13],  pw1[2] = PKW(P0, 12), pw1[3] = PKW(P0, 14), pw1); \
    VRD(2); SBAR(); GAPA(C0 = MFMAH(kf[4], qr[2], C0),   P0[14], P0[15], P1[0],   pw2[0] = PKW(P1, 0),  pw2[1] = PKW(P1, 2),  pw2); \
    VRD(6); SBAR(); GAPA(C1 = MFMAH(kf[5], qr[2], C1),   P1[1], P1[2], P1[3],     pw2[2] = PKW(P1, 4),  pw2[3] = PKW(P1, 6),  pw2); \
                    GAPA(C0 = MFMAH(kf[6], qr[3], C0),   P1[4], P1[5], P1[6],     pw3[0] = PKW(P1, 8),  pw3[1] = PKW(P1, 10), pw3); \
                    GAPA(C1 = MFMAH(kf[7], qr[3], C1),   P1[7], P1[8], P1[9],     pw3[2] = PKW(P1, 12), pw3[3] = PKW(P1, 14), pw3); \
    GAPA3(C0 = MFMAH(kf[8], qr[4], C0), P1[10], P1[11], P1[12]); \
    GAPA3(C1 = MFMAH(kf[9], qr[4], C1), P1[13], P1[14], P1[15]); \
    C0 = MFMAH(kf[10], qr[5], C0); C1 = MFMAH(kf[11], qr[5], C1); \
    l_reg += sacc; \
    if (GK) DMA_K((t) + 3, s_cur); if (GV) DMA_V((t) + 1, s_next);                                                         \
    if (MASK) cmask(C0, C1, (t) - (NT - 4), qrel, hi); \
    { const float rm = rowmax(C0, C1); resc = false;                                                                       \
      if (__builtin_expect(__any(rm > THRL), 0)) { const float dl = __builtin_fmaxf(rm, 0.f); mhat += dl;                  \
          const float f = __builtin_amdgcn_exp2f(-dl); l_reg *= f; if (hi == 0) al_l[r32] = f; resc = true; \
          _Pragma("unroll") for (int r = 0; r < 16; ++r) { C0[r] -= dl; C1[r] -= dl; } \
          _Pragma("unroll") for (int r = 0; r < 16; ++r) negm[r] = -mhat; \
          PIN(negm); } } \
    SBAR(); \
    VRD(3); SBAR(); GAPB(o[0] = MFMAH(PAF(0), VFR(0), o[0]), C0, 0);  VRD(7); SBAR(); GAPB(o[1] = MFMAH(PAF(0), VFR(4), o[1]), C0, 4);     \
    KRD(GL, 0); GAPB(o[0] = MFMAH(PAF(1), VFR(1), o[0]), C0, 8);  KRD(GL, 1); GAPB(o[1] = MFMAH(PAF(1), VFR(5), o[1]), C0, 12); \
    KRD(GL, 2); GAPB(o[0] = MFMAH(PAF(2), VFR(2), o[0]), C1, 0);  KRD(GL, 3); GAPB(o[1] = MFMAH(PAF(2), VFR(6), o[1]), C1, 4); \
    KRD(GL, 4); GAPB(o[0] = MFMAH(PAF(3), VFR(3), o[0]), C1, 8);  KRD(GL, 5); GAPB(o[1] = MFMAH(PAF(3), VFR(7), o[1]), C1, 12); \
    } while (0)
  int t = 1;
  for (; t + 5 < NT; t += 2) {
    STEP(pB0, pB1, pA0, pA1, t, false, true, true, true);     WAITB(3, 2); RESC(); ROT();
    STEP(pA0, pA1, pB0, pB1, t + 1, false, true, true, true); WAITB(3, 2); RESC(); ROT();
  }
#define ENDW(tt) do { if ((tt) + 3 < NT) { WAITB(3, 2); } else if ((tt) + 2 < NT) { WAITB(1, 1); } else { WAITB(0, 0); } } while (0)
  for (; t + 1 < NT; t += 2) {
    STEP(pB0, pB1, pA0, pA1, t, true, (t + 3 < NT), (t + 1 < NT), (t + 1 < NT));         ENDW(t);     RESC(); ROT();
    STEP(pA0, pA1, pB0, pB1, t + 1, true, (t + 4 < NT), (t + 2 < NT), (t + 2 < NT));     ENDW(t + 1); RESC(); ROT();
  }
  STEP(pB0, pB1, pA0, pA1, NT - 1, true, false, false, false); RESC();
  { float sacc = pB0[0] + pB0[1];
#pragma unroll
    for (int r = 2; r < 16; ++r) sacc += pB0[r];
#pragma unroll
    for (int r = 0; r < 16; ++r) sacc += pB1[r];
    l_reg += sacc;
    pw0 = (u32x4){PKW(pB0, 0), PKW(pB0, 2), PKW(pB0, 4), PKW(pB0, 6)}; pw1 = (u32x4){PKW(pB0, 8), PKW(pB0, 10), PKW(pB0, 12), PKW(pB0, 14)};
    pw2 = (u32x4){PKW(pB1, 0), PKW(pB1, 2), PKW(pB1, 4), PKW(pB1, 6)}; pw3 = (u32x4){PKW(pB1, 8), PKW(pB1, 10), PKW(pB1, 12), PKW(pB1, 14)};
    const lds_cptr vp_ = vp0 + s_cur * VT_BYTES;
#pragma unroll
    for (int i = 0; i < 8; ++i) VRD(i);
    o[0] = MFMAH(PAF(0), VFR(0), o[0]); o[1] = MFMAH(PAF(0), VFR(4), o[1]); o[0] = MFMAH(PAF(1), VFR(1), o[0]); o[1] = MFMAH(PAF(1), VFR(5), o[1]);
    o[0] = MFMAH(PAF(2), VFR(2), o[0]); o[1] = MFMAH(PAF(2), VFR(6), o[1]); o[0] = MFMAH(PAF(3), VFR(3), o[0]); o[1] = MFMAH(PAF(3), VFR(7), o[1]); }
  { auto rr = __builtin_amdgcn_permlane32_swap(__float_as_uint(l_reg), __float_as_uint(l_reg), false, false); l_reg = __uint_as_float(rr[0]) + __uint_as_float(rr[1]); }
  if (hi == 0) li_l[r32] = l_reg; asm volatile("s_waitcnt lgkmcnt(0)" ::: "memory");
  float rli[16];
#pragma unroll
  for (int r = 0; r < 16; ++r) rli[r] = __builtin_amdgcn_rcpf(li_l[crow(r, hi)]);
  if (z_cnt && wid == 0) { unsigned sp = 0;
    while (__hip_atomic_load(z_cnt, __ATOMIC_RELAXED, __HIP_MEMORY_SCOPE_AGENT) < 2u) { __builtin_amdgcn_s_sleep(2); if (++sp > (1u << 22)) { if (lane == 0) __hip_atomic_store(tmo, 1u, __ATOMIC_RELAXED, __HIP_MEMORY_SCOPE_AGENT); break; } }
    __builtin_amdgcn_fence(__ATOMIC_ACQUIRE, "agent"); asm volatile("s_waitcnt vmcnt(0)" ::: "memory"); }
  unsigned nxt_ = 0u; if (next_qword >= 0 && tid == 0) nxt_ = __hip_atomic_fetch_add(tmo + next_qword + 64 * (blockIdx.x & 7u), 1u, __ATOMIC_RELAXED, __HIP_MEMORY_SCOPE_AGENT);
  asm volatile("s_waitcnt lgkmcnt(0)\n\ts_barrier" ::: "memory");
  const long orow0 = rowbase + q0 + wid * QBLK;
  { unsigned short* stg = (unsigned short*)(lds + LDS_OST) + wid * 2048;
#pragma unroll
    for (int r = 0; r < 16; ++r) { const int orow = crow(r, hi);
#pragma unroll
      for (int d0 = 0; d0 < 2; ++d0) stg[orow * 64 + d0 * 32 + r32] = __builtin_bit_cast(unsigned short, (_Float16)(o[d0][r] * rli[r])); }
    asm volatile("s_waitcnt lgkmcnt(0)" ::: "memory");
#pragma unroll
    for (int i = 0; i < 4; ++i) { const int row = i * 8 + (lane >> 3), ch = lane & 7; const long grow = orow0 + row;
      const u32x4 ov = *(const u32x4*)(stg + row * 64 + ch * 8); const u32x4 zv = __builtin_nontemporal_load((const u32x4*)(PROJ + grow * ldp + zcol0 + h * 64 + ch * 8));
      u32x4 w;
      w.x = gate2(ov.x, zv.x); w.y = gate2(ov.y, zv.y); w.z = gate2(ov.z, zv.z); w.w = gate2(ov.w, zv.w);
      store16_wt(YCAT + grow * 1024 + 512 + h * 64 + ch * 8, w); } }
  if (next_qword >= 0 && tid == 0) *(volatile __attribute__((address_space(3))) unsigned*)(lds3 + next_slot_off) = nxt_;
  asm volatile("s_waitcnt vmcnt(0) lgkmcnt(0)\n\ts_barrier" ::: "memory");
  if (tid == 0) __hip_atomic_fetch_add(done_cnt, 1u, __ATOMIC_RELAXED, __HIP_MEMORY_SCOPE_AGENT);
#undef GLDS
#undef DMA_K
#undef DMA_V
#undef WAITB
#undef ROT
#undef RESC
#undef PKW
#undef PAF
#undef VFR
#undef VRD
#undef KRD
#undef GAPA
#undef GAPA3
#undef GAPB
#undef STEP
#undef ENDW
}
#undef PIN
#undef MFMAH
#undef MX3
#undef SBAR
}

#define GAS __attribute__((address_space(1)))
#define LAS __attribute__((address_space(3)))
typedef unsigned v4u __attribute__((ext_vector_type(4)));
typedef float f32x4 __attribute__((ext_vector_type(4)));
typedef short bf16x8 __attribute__((ext_vector_type(8)));
typedef GAS unsigned gu32;
typedef GAS unsigned long long gu64;
#define RLX_AGENT __ATOMIC_RELAXED, __HIP_MEMORY_SCOPE_AGENT
#define LDS_WAIT() asm volatile("s_waitcnt lgkmcnt(0)" ::: "memory")
#define VM_WAIT() asm volatile("s_waitcnt vmcnt(0)" ::: "memory")
__device__ __forceinline__ unsigned long long rt() { return __builtin_amdgcn_s_memrealtime(); }

#define XB_TMO      128
#define XB_XCNT(j)  (256  + 64 * (j))
#define XB_XSUB(j)  (1280 + 64 * (j))
#define XB_XGEN(j)  (2304 + 64 * (j))
#define XB_TOP      3328
#define XB_TOPGEN   3392
#define XCD_BAR_WORDS 3456
#define XB_SPIN_CAP (1u << 18)

__device__ __forceinline__ unsigned xb_ld(unsigned* p)              { return __hip_atomic_load(p, __ATOMIC_RELAXED, __HIP_MEMORY_SCOPE_AGENT); }
__device__ __forceinline__ unsigned xb_add(unsigned* p, unsigned v) { return __hip_atomic_fetch_add(p, v, __ATOMIC_RELAXED, __HIP_MEMORY_SCOPE_AGENT); }
__device__ __forceinline__ unsigned xb_xcc_id() { return (unsigned)__builtin_amdgcn_s_getreg((3 << 11) | 20) & 0xFu; }
#define XB_SPIN(cond, bar) do { unsigned _sp = 0; while (cond) { __builtin_amdgcn_s_sleep(1); \
    if ((++_sp & 255u) == 0u) { if (xb_ld(&(bar)[XB_TMO])) break; if (_sp > XB_SPIN_CAP) { atomicAdd(&(bar)[XB_TMO], 1u); break; } } } } while (0)

struct XcdBarrier {
    unsigned* bar; unsigned x;
    volatile LAS unsigned* st;
};

__device__ __forceinline__ XcdBarrier xcd_barrier_post(unsigned* bar, volatile LAS unsigned* st) {
    XcdBarrier b; b.bar = bar; b.x = xb_xcc_id(); b.st = st;
    if (threadIdx.x == 0) (void)xb_add(&bar[XB_XCNT(b.x)], 1u);
    return b;
}
__device__ __forceinline__ void xcd_barrier_complete(unsigned* bar, unsigned x, unsigned& nloc, unsigned& nx) {
    const unsigned G = gridDim.x * gridDim.y * gridDim.z;
    unsigned sum, cnt, mine, sp = 0u;
    for (;;) {
        sum = 0u; cnt = 0u; mine = 0u;
#pragma unroll
        for (unsigned j = 0; j < 16; ++j) { const unsigned c = xb_ld(&bar[XB_XCNT(j)]); sum += c; cnt += (c > 0u) ? 1u : 0u; mine = (j == x) ? c : mine; }
        if (sum == G) break;
        __builtin_amdgcn_s_sleep(1);
        if ((++sp & 255u) == 0u) { if (xb_ld(&bar[XB_TMO])) break; if (sp > XB_SPIN_CAP) { atomicAdd(&bar[XB_TMO], 1u); break; } }
    }
    nloc = mine > 0u ? mine : 1u; nx = cnt > 0u ? cnt : 1u;
}

__device__ __forceinline__ void xcd_barrier(const XcdBarrier& b) {
    asm volatile("s_waitcnt vmcnt(0)" ::: "memory");
    __syncthreads();
    if (threadIdx.x == 0) {
        unsigned* bar = b.bar;
        __builtin_amdgcn_s_waitcnt(0);
        unsigned nloc = b.st[0], nx = b.st[1];
        if (nloc == 0u) { xcd_barrier_complete(bar, b.x, nloc, nx); b.st[0] = nloc; b.st[1] = nx; }
        const unsigned old = xb_add(&bar[XB_XSUB(b.x)], 1u);
        const unsigned gen = old / nloc;
        if (old + 1u == (gen + 1u) * nloc) {
            __builtin_amdgcn_fence(__ATOMIC_RELEASE, "agent");
            asm volatile("s_waitcnt vmcnt(0)" ::: "memory");
            const unsigned og = xb_add(&bar[XB_TOP], 1u);
            const unsigned tg = og / nx;
            if (og + 1u == (tg + 1u) * nx) xb_add(&bar[XB_TOPGEN], 1u);
            else XB_SPIN(xb_ld(&bar[XB_TOPGEN]) == tg, bar);
            __builtin_amdgcn_fence(__ATOMIC_ACQUIRE, "agent");
            xb_add(&bar[XB_XGEN(b.x)], 1u);
            asm volatile("s_waitcnt vmcnt(0)" ::: "memory");
        } else {
            XB_SPIN(xb_ld(&bar[XB_XGEN(b.x)]) == gen, bar);
            __builtin_amdgcn_fence(__ATOMIC_ACQUIRE, "agent");
            asm volatile("s_waitcnt vmcnt(0)" ::: "memory");
        }
    }
    __syncthreads();
}

constexpr int NWAVES = 8;
constexpr int NPHASE = 4;
constexpr int CW_RDV = 98304;
constexpr int CW_TMO = 0, CW_CODE = 1, CW_MODC = 64, CW_OUTQ = 2048, CW_CHAIN = 81920, CW_ATTQ = 1024, CW_PANEL = 65536, CW_OUTP = 73728, CW_BAR = 4096;
constexpr int RING_OFF = 0, RING_BYTES = 131072;
constexpr int LDSCTL_OFF = RING_BYTES, MISC_OFF = LDSCTL_OFF + 320;
constexpr int SACT_OFF = LDSCTL_OFF + 1024;
constexpr int LDS_BYTES = 147456;
static_assert(MISC_OFF + 128 <= SACT_OFF && SACT_OFF + 8192 + 1024 <= LDS_BYTES, "LDS map");
static_assert(att::LDS_ATT2 <= RING_BYTES && pg8::STAGE_BYTES <= RING_BYTES, "phase scratch fits the ring");

struct Frame {
    LAS unsigned char* lds;
    volatile LAS unsigned* MISC;
    gu32* ctl;
    int tid, lane, wave, vcu, G;
};
__device__ __forceinline__ float wave_sum(float v) {
#pragma unroll
    for (int o = 1; o < 64; o <<= 1) v += __shfl_xor(v, o);
    return v;
}
__device__ __forceinline__ unsigned pk2h(float lo, float hi) { return pg8::cvt_pk_h(lo, hi); }

__device__ __forceinline__ void p0_transpose_item(const float* W, int ldw, int K, int src_n0, bf16* WT, int dst_row0, int k0, LAS float* scr, int lane, const float* gk = nullptr) {
    float t_[32];
#pragma unroll
    for (int i = 0; i < 32; ++i) t_[i] = __builtin_nontemporal_load(W + (size_t)(k0 + 2 * i + (lane >> 5)) * ldw + src_n0 + (lane & 31));
#pragma unroll
    for (int i = 0; i < 32; ++i) scr[(2 * i + (lane >> 5)) * 33 + (lane & 31)] = t_[i];
    LDS_WAIT(); asm volatile("" ::: "memory");
    const int c = lane & 7;
#pragma unroll
    for (int j = 0; j < 4; ++j) { const int n = (lane >> 3) + 8 * j; const LAS float* s = scr + (8 * c) * 33 + n;
        f32x4 g0 = {1.f, 1.f, 1.f, 1.f}, g1 = g0; if (gk) { g0 = *(const f32x4*)(gk + k0 + 8 * c); g1 = *(const f32x4*)(gk + k0 + 8 * c + 4); }
        v4u o; o.x = pk2h(s[0 * 33] * g0.x, s[1 * 33] * g0.y); o.y = pk2h(s[2 * 33] * g0.z, s[3 * 33] * g0.w); o.z = pk2h(s[4 * 33] * g1.x, s[5 * 33] * g1.y); o.w = pk2h(s[6 * 33] * g1.z, s[7 * 33] * g1.w);
        *(GAS v4u*)(WT + (size_t)(dst_row0 + n) * K + k0 + 8 * c) = o; }
    LDS_WAIT(); asm volatile("" ::: "memory");
}

struct Args {
    const float* in[24]; float* out; unsigned char* ws; int ph_lo, ph_hi, li, pad;
};

__device__ __forceinline__ void p0_mod_block(const LAS float* sact, LAS float* part, const float* w_ada, const float* b_ada, float* mod, gu32* cnt, int j, int wave, int lane) {
    const int kk = lane >> 2, c4 = lane & 3, col = 16 * j + 4 * c4;
    f32x4 w[8];
#pragma unroll
    for (int s = 0; s < 8; ++s) w[s] = __builtin_nontemporal_load((const GAS f32x4*)(w_ada + (size_t)(128 * wave + kk + 16 * s) * 3072 + col));
    f32x4 a0 = {0.f, 0.f, 0.f, 0.f}, a1 = {0.f, 0.f, 0.f, 0.f};
#pragma unroll
    for (int s = 0; s < 8; ++s) { const int k = 128 * wave + kk + 16 * s; a0 += w[s] * sact[k]; a1 += w[s] * sact[1024 + k]; }
#pragma unroll
    for (int o = 4; o < 64; o <<= 1) {
#pragma unroll
        for (int e = 0; e < 4; ++e) { a0[e] += __shfl_xor(a0[e], o); a1[e] += __shfl_xor(a1[e], o); } }
    if (lane < 4) {
#pragma unroll
        for (int e = 0; e < 4; ++e) { part[wave * 32 + 4 * c4 + e] = a0[e]; part[wave * 32 + 16 + 4 * c4 + e] = a1[e]; } }
    __syncthreads();
    if (wave == 0) {
        if (lane < 32) { float t = b_ada[16 * j + (lane & 15)];
#pragma unroll
            for (int ww = 0; ww < 8; ++ww) t += part[ww * 32 + lane];
            __hip_atomic_store((GAS float*)(mod + (lane >> 4) * 3072 + 16 * j + (lane & 15)), t, RLX_AGENT); }
        asm volatile("s_waitcnt vmcnt(0)" ::: "memory");
        if (lane == 0) __hip_atomic_fetch_add(cnt, 1u, RLX_AGENT);
    }
    __syncthreads();
}
__device__ __forceinline__ void cis_reduced(double ang, float& c, float& s) {
    const double TWO_PI = 6.283185307179586476925286766559;
    const float r = (float)(ang - TWO_PI * rint(ang / TWO_PI)); c = cosf(r); s = sinf(r);
}
__device__ __forceinline__ void ssm_pow(float lr, float li, float dtf, int n, float& pr, float& pi) {
    float c, s_; cis_reduced((double)n * (double)li * (double)dtf, c, s_); const float e = expf((float)n * lr * dtf); pr = e * c; pi = e * s_;
}
__device__ __forceinline__ void p0_ssm_item(const float* log_dt, const float* lam_re, const float* lam_im, float* AC, int g, int lane) {
    const float dtf = expf(log_dt[g]); const float lr = lam_re[g * 64 + lane], li = lam_im[g * 64 + lane];
    float a0, a1, a2, a3; ssm_pow(lr, li, dtf, 1, a0, a1); ssm_pow(lr, li, dtf, 16, a2, a3); const f32x4 v = {a0, a1, a2, a3};
    *(f32x4*)(AC + ((size_t)g * 64 + lane) * 4) = v;
}
__device__ __forceinline__ void ssm_coef_pow(const float* log_dt, const float* lam_re, const float* lam_im, int g, int lane, int n, float& cr, float& ci) {
    const float dtf = expf(log_dt[g]); const float lr = lam_re[g * 64 + lane], li = lam_im[g * 64 + lane];
    float ar, ai, pr, pi; ssm_pow(lr, li, dtf, 1, ar, ai); ssm_pow(lr, li, dtf, n, pr, pi);
    const float nr = ar - 1.f, ni = ai, den = lr * lr + li * li;
    const float kr = (nr * lr + ni * li) / den, ki = (ni * lr - nr * li) / den;
    cr = kr * pr - ki * pi; ci = kr * pi + ki * pr;
}
__device__ __forceinline__ void p0_ssm_K_item(const float* log_dt, const float* lam_re, const float* lam_im, const float* b_re, const float* b_im, const float* c_re, const float* c_im,
                                              bf16* TQ, int g, int d, LAS float* scr, int lane) {
    float cr, ci; ssm_coef_pow(log_dt, lam_re, lam_im, g, lane, d, cr, ci);
#pragma unroll
    for (int j = 0; j < 16; ++j) { const float br = b_re[(g * 64 + lane) * 16 + j], bi = b_im[(g * 64 + lane) * 16 + j];
        scr[(lane * 16 + j) * 2] = cr * br - ci * bi; scr[(lane * 16 + j) * 2 + 1] = cr * bi + ci * br; }
    LAS float* cl = scr + 2048;
#pragma unroll
    for (int q = 0; q < 16; ++q) { cl[(q * 64 + lane) * 2] = c_re[(g * 16 + q) * 64 + lane]; cl[(q * 64 + lane) * 2 + 1] = c_im[(g * 16 + q) * 64 + lane]; }
    LDS_WAIT(); asm volatile("" ::: "memory");
    const int i = lane & 15, jq = lane >> 4; float acc[4] = {0.f, 0.f, 0.f, 0.f};
#pragma unroll 8
    for (int p = 0; p < 64; ++p) { const float xr = cl[(i * 64 + p) * 2], xi = cl[(i * 64 + p) * 2 + 1];
#pragma unroll
        for (int e = 0; e < 4; ++e) acc[e] += xr * scr[(p * 16 + 4 * jq + e) * 2] - xi * scr[(p * 16 + 4 * jq + e) * 2 + 1]; }
    const unsigned long long kv = (unsigned long long)pk2h(acc[0], acc[1]) | ((unsigned long long)pk2h(acc[2], acc[3]) << 32);
    bf16* base = TQ + (size_t)g * 256 * 384;
    for (int t = d; t < 16; ++t) *(GAS unsigned long long*)(base + (size_t)(t * 16 + i) * 384 + (t - d) * 16 + 4 * jq) = kv;
    if (d > 0) for (int t = 0; t + d < 16; ++t) *(GAS unsigned long long*)(base + (size_t)(t * 16 + i) * 384 + (t + d) * 16 + 4 * jq) = 0ull;
    LDS_WAIT(); asm volatile("" ::: "memory");
}
__device__ __forceinline__ void p0_ssm_Q_item(const float* log_dt, const float* lam_re, const float* lam_im, const float* c_re, const float* c_im, bf16* TQ, int g, int t, int lane) {
    const float dtf = expf(log_dt[g]); float pr, pi; ssm_pow(lam_re[g * 64 + lane], lam_im[g * 64 + lane], dtf, t + 1, pr, pi);
#pragma unroll
    for (int i = 0; i < 16; ++i) { const float xr = c_re[(g * 16 + i) * 64 + lane], xi = c_im[(g * 16 + i) * 64 + lane];
        *(GAS unsigned*)(TQ + ((size_t)g * 256 + t * 16 + i) * 384 + 256 + 2 * lane) = pk2h(xr * pr - xi * pi, -(xr * pi + xi * pr)); }
}
__device__ __forceinline__ void p0_ssm_P_item(const float* log_dt, const float* lam_re, const float* lam_im, const float* b_re, const float* b_im, bf16* PP, int g, int s_, int lane) {
    float cr, ci; ssm_coef_pow(log_dt, lam_re, lam_im, g, lane, 15 - s_, cr, ci);
    float wr[16], wi[16];
#pragma unroll
    for (int j = 0; j < 16; ++j) { const float br = b_re[(g * 64 + lane) * 16 + j], bi = b_im[(g * 64 + lane) * 16 + j]; wr[j] = cr * br - ci * bi; wi[j] = cr * bi + ci * br; }
    bf16* r0 = PP + ((size_t)g * 256 + 2 * lane) * 256 + s_ * 16;
    v4u o; o.x = pk2h(wr[0], wr[1]); o.y = pk2h(wr[2], wr[3]); o.z = pk2h(wr[4], wr[5]); o.w = pk2h(wr[6], wr[7]); *(GAS v4u*)r0 = o;
    o.x = pk2h(wr[8], wr[9]); o.y = pk2h(wr[10], wr[11]); o.z = pk2h(wr[12], wr[13]); o.w = pk2h(wr[14], wr[15]); *(GAS v4u*)(r0 + 8) = o;
    o.x = pk2h(wi[0], wi[1]); o.y = pk2h(wi[2], wi[3]); o.z = pk2h(wi[4], wi[5]); o.w = pk2h(wi[6], wi[7]); *(GAS v4u*)(r0 + 256) = o;
    o.x = pk2h(wi[8], wi[9]); o.y = pk2h(wi[10], wi[11]); o.z = pk2h(wi[12], wi[13]); o.w = pk2h(wi[14], wi[15]); *(GAS v4u*)(r0 + 256 + 8) = o;
}

__global__ void __launch_bounds__(NWAVES * 64, 2) mega_fwd(Args args) {
    extern __shared__ __attribute__((aligned(16))) unsigned char lds[];
    Frame F;
    F.lds = (LAS unsigned char*)lds;
    F.MISC = (volatile LAS unsigned*)(F.lds + MISC_OFF);
    F.tid = threadIdx.x; F.lane = F.tid & 63; F.wave = __builtin_amdgcn_readfirstlane(F.tid >> 6);
    F.G = gridDim.x; { const int bx = blockIdx.x; F.vcu = (F.G % 8 == 0) ? (bx % 8) * (F.G / 8) + bx / 8 : bx; }
    unsigned char* ws = args.ws;
    F.ctl = (gu32*)(ws + WS_CTL);
    const float* x = args.in[0]; const float* cvec = args.in[1]; const int* positions = (const int*)args.in[2];
    const float* w_ada = args.in[3]; const float* b_ada = args.in[4]; const float* norm_g = args.in[5]; const float* w_in = args.in[6];
    const float* log_dt = args.in[7]; const float* lam_re = args.in[8]; const float* lam_im = args.in[9]; const float* b_re = args.in[10]; const float* b_im = args.in[11];
    const float* c_re = args.in[12]; const float* c_im = args.in[13]; const float* d_skip = args.in[14]; const float* w_glu = args.in[15]; const float* b_glu = args.in[16];
    const float* q_a_g = args.in[17]; const float* w_q_b = args.in[18]; const float* kv_a_g = args.in[19]; const float* w_kv_b = args.in[20];
    const float* q_norm_g = args.in[21]; const float* k_norm_g = args.in[22]; const float* w_out = args.in[23];
    float* MOD = (float*)(ws + WS_MOD); float* AC = (float*)(ws + WS_AC); bf16* BB = (bf16*)(ws + WS_BB); bf16* CB = (bf16*)(ws + WS_CB); float* EST = (float*)(ws + WS_E);
    bf16* WIN_T = (bf16*)(ws + WS_WIN); bf16* WQ_T = (bf16*)(ws + WS_WQ); bf16* WKV_T = (bf16*)(ws + WS_WKV); bf16* WGLU_T = (bf16*)(ws + WS_WGLU); bf16* WOUT_T = (bf16*)(ws + WS_WOUT);
    bf16* PROJ = (bf16*)(ws + WS_PROJ); bf16* HB = (bf16*)(ws + WS_HB); bf16* QRAW = (bf16*)(ws + WS_HB); bf16* YCAT = (bf16*)(ws + WS_YCAT); bf16* ZM = (bf16*)(ws + WS_ZM);
    bf16* KVRAW = (bf16*)(ws + WS_KVRAW); bf16* Qb = (bf16*)(ws + WS_Q); bf16* Kb = (bf16*)(ws + WS_K); bf16* Vb = (bf16*)(ws + WS_V);
    bf16* CQN = (bf16*)(ws + WS_CQN); bf16* CKVN = (bf16*)(ws + WS_CKVN); bf16* YPRE = (bf16*)(ws + WS_YPRE);
    float* RS = (float*)(ws + WS_RS); float* ROPE = (float*)(ws + WS_ROPE); bf16* USG = (bf16*)(ws + WS_USG); bf16* TQ = (bf16*)(ws + WS_TQ); bf16* PPM = (bf16*)(ws + WS_PP); float* HAND = (float*)(ws + WS_HAND); (void)BB; (void)CB; (void)EST; (void)CQN; (void)CKVN; (void)QRAW; (void)KVRAW;

    for (int u = F.tid; u < (LDS_BYTES - LDSCTL_OFF) / 4; u += NWAVES * 64) ((LAS unsigned*)(F.lds + LDSCTL_OFF))[u] = 0u;
    __syncthreads();
    const int lo = args.ph_lo, hi = args.ph_hi;
    const bool multi = (hi - lo) > 1;
    XcdBarrier bar; bar.bar = (unsigned*)(F.ctl + CW_BAR) + args.li * XCD_BAR_WORDS; bar.x = 0; bar.st = nullptr;
    if (multi) bar = xcd_barrier_post((unsigned*)(F.ctl + CW_BAR) + args.li * XCD_BAR_WORDS, F.MISC + 8);
#define IN(k) (lo <= (k) && (k) < hi)
#define SEAM(k) do { if (IN(k) && IN((k) + 1)) xcd_barrier(bar); } while (0)
    const int gw = F.vcu * NWAVES + F.wave, NGW = F.G * NWAVES;

    if (IN(0)) {
        LAS float* scr = (LAS float*)(F.lds + RING_OFF + F.wave * 16384);
        constexpr int I_MOD = 192, I_SSM = 32;
        constexpr int T_U = 256, T_ZS = 256, T_ZM = 256, T_CKV = 128, T_CQ = 192, T_KR = 16, T_WQ = 144, T_WKV = 128, T_WGLU = 128, T_WOUT = 512;
        constexpr int I_TR = T_U + T_ZS + T_ZM + T_CKV + T_CQ + T_KR + T_WQ + T_WKV + T_WGLU + T_WOUT;
        constexpr int I_Z1 = 96, I_Z2 = 256;
        constexpr int NITEMS = I_MOD + I_SSM + I_TR + I_Z1 + I_Z2;
        { LAS float* sact = (LAS float*)(F.lds + SACT_OFF); LAS float* part = (LAS float*)(F.lds + SACT_OFF + 8192);
          for (int e = F.tid; e < 2048; e += NWAVES * 64) { const float cv = cvec[e]; sact[e] = cv / (1.f + __expf(-cv)); }
          __syncthreads();
          for (int r = (int)blockIdx.x; r < I_MOD; r += F.G) p0_mod_block(sact, part, w_ada, b_ada, MOD, F.ctl + CW_MODC, r, F.wave, F.lane); }
        for (int it = I_MOD + gw; it < NITEMS; it += NGW) {
            int r = it - I_MOD;
            if (r < I_SSM) { p0_ssm_item(log_dt, lam_re, lam_im, AC, r, F.lane); continue; } r -= I_SSM;
            if (r < I_TR) {
                if (r < T_U)   { p0_transpose_item(w_in, D_IN, 1024, SC_U + 32 * (r % 16), WIN_T, 0 + 32 * (r % 16), 64 * (r / 16), scr, F.lane); continue; } r -= T_U;
                if (r < T_ZS)  { p0_transpose_item(w_in, D_IN, 1024, SC_ZS + 32 * (r % 16), WIN_T, 512 + 32 * (r % 16), 64 * (r / 16), scr, F.lane); continue; } r -= T_ZS;
                if (r < T_ZM)  { p0_transpose_item(w_in, D_IN, 1024, SC_ZM + 32 * (r % 16), WIN_T, WR_ZM + 32 * (r % 16), 64 * (r / 16), scr, F.lane); continue; } r -= T_ZM;
                if (r < T_CKV) { p0_transpose_item(w_in, D_IN, 1024, SC_CKV + 32 * (r % 8), WIN_T, 1024 + 32 * (r % 8), 64 * (r / 8), scr, F.lane); continue; } r -= T_CKV;
                if (r < T_CQ)  { p0_transpose_item(w_in, D_IN, 1024, SC_CQ + 32 * (r % 12), WIN_T, 1280 + 32 * (r % 12), 64 * (r / 12), scr, F.lane); continue; } r -= T_CQ;
                if (r < T_KR)  { p0_transpose_item(w_in, D_IN, 1024, SC_KR, WIN_T, GC_KR, 64 * r, scr, F.lane); continue; } r -= T_KR;
                if (r < T_WQ)  { const int nb = r % 24, kb = r / 24, n0 = 32 * nb;
                                 p0_transpose_item(w_q_b, 768, 384, n0, WQ_T, (n0 / 96) * 128 + (n0 % 96), 64 * kb, scr, F.lane, q_a_g); continue; } r -= T_WQ;
                if (r < T_WKV) { p0_transpose_item(w_kv_b, 1024, 256, 32 * (r % 32), WKV_T, 32 * (r % 32), 64 * (r / 32), scr, F.lane, kv_a_g); continue; } r -= T_WKV;
                if (r < T_WGLU){ p0_transpose_item(w_glu, 512, 512, 32 * (r % 16), WGLU_T, 32 * (r % 16), 64 * (r / 16), scr, F.lane); continue; } r -= T_WGLU;
                p0_transpose_item(w_out, 1024, 1024, 32 * (r % 32), WOUT_T, 32 * (r % 32), 64 * (r / 32), scr, F.lane); continue;
            }
            r -= I_TR;
            const v4u z = {0u, 0u, 0u, 0u};
            if (r < I_Z1) { GAS v4u* p = (GAS v4u*)(WIN_T + (size_t)(GC_KR + 32 + r) * 1024); p[F.lane] = z; p[64 + F.lane] = z; continue; } r -= I_Z1;
            { const int hh = r / 32, rr = r % 32; GAS v4u* p = (GAS v4u*)(WQ_T + (size_t)(hh * 128 + 96 + rr) * 384); if (F.lane < 48) p[F.lane] = z; }
        }
        f32x4 v0[4], v1[4], v2[4];
#define LDROW(dst, mm) do { const GAS f32x4* xr_ = (const GAS f32x4*)(x + (size_t)(mm) * DM) + F.lane; _Pragma("unroll") for (int j = 0; j < 4; ++j) dst[j] = __builtin_nontemporal_load(xr_ + 64 * j); } while (0)
        if (gw < M) LDROW(v0, gw);
        if (gw + NGW < M) LDROW(v1, gw + NGW);
        __syncthreads();
        if (F.wave == 0) { unsigned sp = 0;
            while (__hip_atomic_load(F.ctl + CW_MODC, RLX_AGENT) < 192u) { __builtin_amdgcn_s_sleep(2); if (++sp > (1u << 22)) { if (F.lane == 0) __hip_atomic_store(F.ctl + CW_TMO, 1u, RLX_AGENT); break; } }
            __builtin_amdgcn_fence(__ATOMIC_ACQUIRE, "agent"); asm volatile("s_waitcnt vmcnt(0)" ::: "memory"); }
        __syncthreads();
        { f32x4 PA[4], PB[4]; int curb = -1;
          const float ifq = (float)exp(-(double)(F.lane & 15) / 16.0 * 9.210340371976184);
          for (int m = gw; m < M; m += NGW) {
            if (m + 2 * NGW < M) LDROW(v2, m + 2 * NGW);
            const int b = m / SEQ;
            if (b != curb) { curb = b;
#pragma unroll
                for (int j = 0; j < 4; ++j) { const int e = 4 * F.lane + 256 * j;
                    const f32x4 g4 = *(const f32x4*)(norm_g + e), sc = *(const f32x4*)(MOD + b * 3072 + 1024 + e); PB[j] = *(const f32x4*)(MOD + b * 3072 + e); PA[j] = g4 * (sc + 1.f); } }
            if (F.lane < 16) { const double TWO_PI = 6.283185307179586476925286766559;
                const float ang = (float)positions[m] * ifq; const float kq = rintf(ang * 0.15915494309189535f);
                const float rr = fmaf(-kq, 0.0019353071795864769f, fmaf(-kq, 6.28125f, ang)); (void)TWO_PI;
                typedef float f32x2_ __attribute__((ext_vector_type(2))); *(f32x2_*)(ROPE + ((size_t)m * 16 + F.lane) * 2) = (f32x2_){__cosf(rr), __sinf(rr)}; }
            float s = 0.f;
#pragma unroll
            for (int j = 0; j < 4; ++j) s += (v0[j].x * v0[j].x + v0[j].y * v0[j].y) + (v0[j].z * v0[j].z + v0[j].w * v0[j].w);
            const float rstd = 1.f / sqrtf(wave_sum(s) * (1.f / DM) + EPS);
            GAS unsigned long long* o8 = (GAS unsigned long long*)(HB + (size_t)m * DM) + F.lane;
#pragma unroll
            for (int j = 0; j < 4; ++j) { const f32x4 hv = v0[j] * rstd * PA[j] + PB[j];
                o8[64 * j] = (unsigned long long)pk2h(hv.x, hv.y) | ((unsigned long long)pk2h(hv.z, hv.w) << 32); }
#pragma unroll
            for (int j = 0; j < 4; ++j) { v0[j] = v1[j]; v1[j] = v2[j]; }
          }
#undef LDROW
        }
    }
    SEAM(0);

    if (IN(1)) {
        pg8::Gemm g{HB, WIN_T, M, NPROJ, 1024, 1024}; pg8::StaticOrder S; S.init(M, NPROJ, F.G, (int)blockIdx.x);
        pg8::EpiProj E{PROJ, LDP, RS, 4, USG, SEQ};
        pg8::gemm_phase<pg8::EpiProj, pg8::StaticOrder, true, true>(F.lds + RING_OFF, g, S, E);
        if (F.G == 256 ? blockIdx.x >= 192 : true) { __syncthreads();
            LAS float* scr = (LAS float*)(F.lds + RING_OFF + F.wave * 16384);
            const int nw = (F.G == 256) ? 512 : NGW, w0 = (F.G == 256) ? ((int)blockIdx.x - 192) * NWAVES + F.wave : gw;
            for (int it = w0; it < 512 * 3 + 256; it += nw) { int r = it;
                if (r < 512) { p0_ssm_K_item(log_dt, lam_re, lam_im, b_re, b_im, c_re, c_im, TQ, r >> 4, r & 15, scr, F.lane); continue; } r -= 512;
                if (r < 512) { p0_ssm_Q_item(log_dt, lam_re, lam_im, c_re, c_im, TQ, r >> 4, r & 15, F.lane); continue; } r -= 512;
                if (r < 512) { p0_ssm_P_item(log_dt, lam_re, lam_im, b_re, b_im, PPM, r >> 4, r & 15, F.lane); continue; } r -= 512;
                { const v4u z0 = {0u, 0u, 0u, 0u}; GAS v4u* pz = (GAS v4u*)(PPM + ((size_t)(r >> 3) * 256 + 128 + (r & 7) * 16) * 256);
#pragma unroll
                  for (int q = 0; q < 8; ++q) pz[F.lane + 64 * q] = z0; } } }
    }
    SEAM(1);

    if (IN(2)) {
        { const pg8::MlaAux AUX{RS, ROPE, PROJ, LDP, PC_KR};
          if (F.G == 256) {
            { pg8::Gemm g{PROJ + PC_CQ, WQ_T, M, 1024, Q_LORA, LDP}; pg8::StaticOrder S; S.init(M, 1024, F.G, (int)blockIdx.x);
              pg8::EpiQ E{AUX, q_norm_g, Qb, 0.10206207261596575f * 1.4426950408889634f, EPS, SEQ};
              pg8::gemm_phase<pg8::EpiQ, pg8::StaticOrder, false, true>(F.lds + RING_OFF, g, S, E); }
            __syncthreads();
            { pg8::Gemm g{PROJ + PC_CKV, WKV_T, M, 1024, KV_LORA, LDP}; pg8::StaticOrder S; S.init(M, 1024, F.G, (int)blockIdx.x);
              pg8::EpiKV E{AUX, k_norm_g, Kb, Vb, EPS, SEQ};
              pg8::gemm_phase<pg8::EpiKV, pg8::StaticOrder, false, true>(F.lds + RING_OFF, g, S, E); }
          } else if (F.tid == 0) __hip_atomic_store(F.ctl + CW_TMO, 1u, RLX_AGENT);
        }
        __syncthreads();
        { pg8::Gemm g{USG, PPM, 32768, 8192, 256, 384}; pg8::DiagOrder S{128, 4, F.G, (int)blockIdx.x, nullptr, 0u, nullptr};
          pg8::EpiELds E{};
          if (F.G >= 128) { pg8::gemm_phase<pg8::EpiELds, pg8::DiagOrder, false, true>(F.lds + RING_OFF, g, S, E);
              pg8::Unit u; const bool has = S.next(0, u);
              __syncthreads();
              if (has && F.wave == 0) pg8::ssm_chain_unit(u, F.lds + RING_OFF, USG, AC, HAND, (unsigned*)(F.ctl + CW_CHAIN), (unsigned*)(F.ctl + CW_TMO), F.lane);
              __syncthreads(); }
          else if (F.tid == 0) __hip_atomic_store(F.ctl + CW_TMO, 1u, RLX_AGENT); }
        { pg8::Gemm g{HB, WIN_T + (size_t)WR_ZM * 1024, M, 512, 1024, 1024}; pg8::StaticOrder S; S.init(M, 512, F.G, (int)((blockIdx.x + 128u) % (unsigned)F.G));
          pg8::EpiH16 E{ZM, 512};
          pg8::gemm_phase<pg8::EpiH16, pg8::StaticOrder, true, true>(F.lds + RING_OFF, g, S, E); }
    }
    SEAM(2);

    if (IN(3)) {
        { pg8::Gemm g{USG, TQ, 32768, 8192, 384, 384}; pg8::DiagOrder S{128, 4, F.G, (int)blockIdx.x, nullptr, 0u, nullptr};
          pg8::EpiY E{USG, d_skip, YPRE, SEQ};
          pg8::gemm_phase<pg8::EpiY, pg8::DiagOrder, true, true>(F.lds + RING_OFF, g, S, E);
          if (F.tid == 0) { pg8::Unit u; for (int i = 0; S.next(i, u); ++i) { const int k4 = u.pm & 3;
              for (int q = 0; q < 16; ++q) __hip_atomic_fetch_add(F.ctl + CW_PANEL + 64 * ((k4 >> 1) * 32 + (k4 & 1) * 16 + q), 1u, RLX_AGENT); } } }
        __syncthreads();
        __syncthreads();
#define RUN_GLU_UNITS() do { \
        { pg8::Gemm g{YPRE, WGLU_T, M, 512, 512, 512}; pg8::PanelOrder S; S.init(M, 512, F.G, (int)((blockIdx.x + 128u) % (unsigned)F.G)); S.cnt = (unsigned*)(F.ctl + CW_PANEL); S.want = 32u; S.tmo = (unsigned*)(F.ctl + CW_TMO); \
          pg8::EpiGlu E{YPRE, PROJ, LDP, PC_ZS, b_glu, YCAT}; \
          pg8::gemm_phase<pg8::EpiGlu, pg8::PanelOrder, true, true>(F.lds + RING_OFF, g, S, E); \
          if (F.tid == 0) { pg8::Unit u; for (int i = 0; S.next(i, u); ++i) __hip_atomic_fetch_add(F.ctl + CW_OUTP + 64 * u.pm, 1u, RLX_AGENT); } } \
        __syncthreads(); } while (0)
#define OUT_UNIT_OF(k, uu) do { const int pk_ = (k) >> 2; (uu).pm = (pk_ & 1) * 32 + (24 - 8 * (pk_ >> 1)) + j; (uu).pn = (k) & 3; } while (0)
#define RUN_OUT_UNIT(uu) do { if (F.tid < 64) { __builtin_amdgcn_fence(__ATOMIC_ACQUIRE, "agent"); asm volatile("s_waitcnt vmcnt(0)" ::: "memory"); } __syncthreads(); \
            pg8::Gemm g_{YCAT, WOUT_T, M, 1024, 1024, 1024}; pg8::OneUnit S_; S_.u = (uu); pg8::EpiOutRows E_{x, MOD + 2048, 3072, SEQ, args.out}; \
            pg8::gemm_phase<pg8::EpiOutRows, pg8::OneUnit, false, true>(F.lds + RING_OFF, g_, S_, E_); __syncthreads(); } while (0)
        const int j = (int)(blockIdx.x & 7); bool glu_done = false;
        bool popped = false;
        for (;;) {
            if (!popped && F.tid == 0) F.MISC[16] = __hip_atomic_fetch_add(F.ctl + CW_ATTQ + 64 * j, 1u, RLX_AGENT);
            __syncthreads();
            const unsigned ua = (unsigned)__builtin_amdgcn_readfirstlane((int)F.MISC[16]);
            __syncthreads();
            if (ua >= 64u) break;
            const int bh = 2 * j + (int)(ua & 1u), qb = 31 - (int)(ua >> 1);
            const bool early = glu_done || ((blockIdx.x + 128u) % (unsigned)F.G) >= 128u;
            att::attn_unit(bh >> 3, bh & 7, qb, Qb, Kb, Vb, ZM, 512, 0, YCAT, (char*)lds + RING_OFF, F.lds + RING_OFF, (unsigned*)(F.ctl + CW_OUTP + 64 * ((bh >> 3) * 32 + qb)), nullptr, (unsigned*)(F.ctl + CW_TMO), early ? CW_ATTQ - CW_TMO : -1, MISC_OFF - RING_OFF + 16 * 4);
            popped = early;
            if (!glu_done) { glu_done = true; RUN_GLU_UNITS(); }
            if (F.tid == 0) { unsigned k = __hip_atomic_load(F.ctl + CW_OUTQ + 64 * j, RLX_AGENT), got = 0xffffffffu;
                if (MK_CLAIM_BETWEEN && k < 32u) { pg8::Unit t; OUT_UNIT_OF((int)k, t);
                    if (__hip_atomic_load(F.ctl + CW_OUTP + 64 * t.pm, RLX_AGENT) >= 10u) { unsigned e = k;
                        if (__hip_atomic_compare_exchange_strong(F.ctl + CW_OUTQ + 64 * j, &e, k + 1u, __ATOMIC_RELAXED, __ATOMIC_RELAXED, __HIP_MEMORY_SCOPE_AGENT)) got = k; } }
                F.MISC[17] = got; }
            __syncthreads();
            const unsigned ko = (unsigned)__builtin_amdgcn_readfirstlane((int)F.MISC[17]);
            __syncthreads();
            if (ko != 0xffffffffu) { pg8::Unit uo; OUT_UNIT_OF((int)ko, uo); RUN_OUT_UNIT(uo); }
        }
        if (!glu_done) { glu_done = true; RUN_GLU_UNITS(); }
        for (;;) {
            if (F.tid == 0) F.MISC[17] = __hip_atomic_fetch_add(F.ctl + CW_OUTQ + 64 * j, 1u, RLX_AGENT);
            __syncthreads();
            const unsigned ko = (unsigned)__builtin_amdgcn_readfirstlane((int)F.MISC[17]);
            __syncthreads();
            if (ko >= 32u) break;
            pg8::Unit uo; OUT_UNIT_OF((int)ko, uo);
            if (F.tid < 64) { unsigned sp = 0;
                while (__hip_atomic_load(F.ctl + CW_OUTP + 64 * uo.pm, RLX_AGENT) < 10u) { __builtin_amdgcn_s_sleep(4);
                    if (++sp > (1u << 22)) { if (F.tid == 0) __hip_atomic_store(F.ctl + CW_TMO, 1u, RLX_AGENT); break; } }
                if (F.tid == 0) __hip_atomic_fetch_add(F.ctl + CW_RDV + 64 * uo.pm, 1u, RLX_AGENT);
                sp = 0; while (__hip_atomic_load(F.ctl + CW_RDV + 64 * uo.pm, RLX_AGENT) < 4u && ++sp < 20000u) __builtin_amdgcn_s_sleep(2); }
            RUN_OUT_UNIT(uo);
        }
#undef OUT_UNIT_OF
#undef RUN_GLU_UNITS
#undef RUN_OUT_UNIT
    }
#undef IN
#undef SEAM
}

#ifndef MK_MODE
#define MK_MODE 2
#endif
#ifndef MK_FAST_MASK
#define MK_FAST_MASK 0x7
#endif
extern "C" void kernel_launch(void* const* d_in, const int* in_sizes, int n_in, void* d_out, int out_size, void* d_ws, size_t ws_size, hipStream_t stream) {
    static int grid = 0;
    if (grid == 0) {
        if (n_in != 24 || in_sizes[0] != M * DM || out_size != M * DM || ws_size < WS_END) { fprintf(stderr, "kernel_launch: unexpected shapes (n_in %d, in0 %d, out %d, ws %zu)\n", n_in, n_in > 0 ? in_sizes[0] : -1, out_size, ws_size); grid = -1; return; }
        int dev = 0, cus = 0, per_cu = 0;
        if (hipGetDevice(&dev) != hipSuccess || hipDeviceGetAttribute(&cus, hipDeviceAttributeMultiprocessorCount, dev) != hipSuccess) { fprintf(stderr, "kernel_launch: device query failed\n"); grid = -1; return; }
        if (hipFuncSetAttribute((const void*)mega_fwd, hipFuncAttributeMaxDynamicSharedMemorySize, LDS_BYTES) != hipSuccess) { fprintf(stderr, "kernel_launch: hipFuncSetAttribute failed\n"); grid = -1; return; }
        if (hipOccupancyMaxActiveBlocksPerMultiprocessor(&per_cu, (const void*)mega_fwd, NWAVES * 64, LDS_BYTES) != hipSuccess || per_cu < 1)
            fprintf(stderr, "kernel_launch: note: occupancy query reports %d workgroups per CU\n", per_cu);
        (void)hipGetLastError();
        grid = cus;
    }
    if (grid < 0) return;
    const float* x = (const float*)d_in[0]; const float* c = (const float*)d_in[1]; const int* positions = (const int*)d_in[2];
    const float* w_ada = (const float*)d_in[3]; const float* b_ada = (const float*)d_in[4]; const float* norm_g = (const float*)d_in[5];
    const float* w_in = (const float*)d_in[6]; const float* log_dt = (const float*)d_in[7]; const float* lam_re = (const float*)d_in[8];
    const float* lam_im = (const float*)d_in[9]; const float* b_re = (const float*)d_in[10]; const float* b_im = (const float*)d_in[11];
    const float* c_re = (const float*)d_in[12]; const float* c_im = (const float*)d_in[13]; const float* d_skip = (const float*)d_in[14];
    const float* w_glu = (const float*)d_in[15]; const float* b_glu = (const float*)d_in[16]; const float* q_a_g = (const float*)d_in[17];
    const float* w_q_b = (const float*)d_in[18]; const float* kv_a_g = (const float*)d_in[19]; const float* w_kv_b = (const float*)d_in[20];
    const float* q_norm_g = (const float*)d_in[21]; const float* k_norm_g = (const float*)d_in[22]; const float* w_out = (const float*)d_in[23];
    unsigned char* ws = (unsigned char*)d_ws; float* out = (float*)d_out;
    float* MOD = (float*)(ws + WS_MOD); bf16* PROJ = (bf16*)(ws + WS_PROJ); bf16* HB = (bf16*)(ws + WS_HB); bf16* QRAW = (bf16*)(ws + WS_HB); bf16* YCAT = (bf16*)(ws + WS_YCAT); bf16* ZM = (bf16*)(ws + WS_ZM);
    bf16* KVRAW = (bf16*)(ws + WS_KVRAW); bf16* Qb = (bf16*)(ws + WS_Q); bf16* Kb = (bf16*)(ws + WS_K); bf16* Vb = (bf16*)(ws + WS_V);
    bf16* CQN = (bf16*)(ws + WS_CQN); bf16* CKVN = (bf16*)(ws + WS_CKVN); bf16* YPRE = (bf16*)(ws + WS_YPRE);
    (void)x; (void)c; (void)positions; (void)w_ada; (void)b_ada; (void)norm_g; (void)w_in; (void)log_dt; (void)lam_re; (void)lam_im; (void)b_re; (void)b_im; (void)c_re; (void)c_im; (void)d_skip;
    (void)w_glu; (void)b_glu; (void)q_a_g; (void)w_q_b; (void)kv_a_g; (void)w_kv_b; (void)q_norm_g; (void)k_norm_g; (void)w_out; (void)MOD; (void)PROJ; (void)HB; (void)QRAW; (void)YCAT;
    (void)KVRAW; (void)Qb; (void)Kb; (void)Vb; (void)CQN; (void)CKVN; (void)YPRE; (void)out;

    Args a{}; int n_mega = 0;
    for (int i = 0; i < 24; ++i) a.in[i] = (const float*)d_in[i];
    a.out = out; a.ws = ws;
#define MEGA(lo_, hi_) do { a.ph_lo = (lo_); a.ph_hi = (hi_); a.li = n_mega++; hipLaunchKernelGGL(mega_fwd, dim3(grid), dim3(NWAVES * 64), LDS_BYTES, stream, a); } while (0)
#if MK_MODE == 2
    if (hipMemsetAsync(ws + WS_CTL, 0, CTL_ZERO_BYTES, stream) != hipSuccess) { fprintf(stderr, "kernel_launch: memset failed\n"); return; }
#if MK_DOUBLE >= 0
    MEGA(0, MK_DOUBLE + 1); MEGA(MK_DOUBLE, NPHASE);
#else
    MEGA(0, NPHASE);
#endif
#else
    const unsigned fast = (MK_MODE == 0) ? 0u : (unsigned)MK_FAST_MASK;
    (void)hipMemsetAsync(ws + WS_CTL, 0, CTL_ZERO_BYTES, stream);
    if (MK_MODE != 0) MEGA(0, 1);
    if (!(fast & 1u)) { hipLaunchKernelGGL(v0_mod, dim3(24), dim3(256), 0, stream, c, w_ada, b_ada, MOD); hipLaunchKernelGGL(v0_h, dim3(M), dim3(256), 0, stream, x, norm_g, MOD, HB); }
    if (fast & 2u) MEGA(1, 2); else {
        const int seg[5][3] = {{PC_U, SC_U, 512}, {PC_ZS, SC_ZS, 512}, {PC_CKV, SC_CKV, 256}, {PC_CQ, SC_CQ, 384}, {PC_KR, SC_KR, 32}};
        for (int s = 1; s < 5; ++s) hipLaunchKernelGGL(v0_gemm, dim3(M), dim3(256), 1024 * 4, stream, HB, 1024, 1024, w_in, D_IN, seg[s][1], PROJ, LDP, seg[s][0], seg[s][2]);
        hipLaunchKernelGGL(v0_usg, dim3(M), dim3(256), 1024 * 4, stream, HB, w_in, D_IN, (bf16*)(ws + WS_USG));
        hipLaunchKernelGGL(v0_gemm, dim3(M), dim3(256), 1024 * 4, stream, HB, 1024, 1024, w_in, D_IN, SC_ZM, ZM, 512, 0, 512); }
    if (fast & 4u) { MEGA(2, 3); MEGA(3, 4); }
    else { hipLaunchKernelGGL(v0_cqn, dim3(M), dim3(256), 0, stream, PROJ, q_a_g, kv_a_g, CQN, CKVN);
        for (int h = 0; h < NH; ++h) hipLaunchKernelGGL(v0_gemm, dim3(M), dim3(128), 384 * 4, stream, CQN, 384, 384, w_q_b, 768, h * 96, QRAW, 1024, h * 128, 96);
        hipLaunchKernelGGL(v0_gemm, dim3(M), dim3(256), 256 * 4, stream, CKVN, 256, 256, w_kv_b, 1024, 0, KVRAW, 1024, 0, 1024);
        hipLaunchKernelGGL(v0_qkv, dim3(M * NH * 2 / 256), dim3(256), 0, stream, QRAW, KVRAW, PROJ, positions, q_norm_g, k_norm_g, Qb, Kb, Vb);
        hipLaunchKernelGGL(v0_ssm, dim3(BATCH * SSM_G), dim3(64), 0, stream, (bf16*)(ws + WS_USG), log_dt, lam_re, lam_im, b_re, b_im, c_re, c_im, d_skip, YPRE);
        hipLaunchKernelGGL(v0_attn, dim3(BATCH * NH * (SEQ / 256)), dim3(256), 0, stream, Qb, Kb, Vb, ZM, YCAT);
        hipLaunchKernelGGL(v0_glu, dim3(M), dim3(256), 0, stream, YPRE, w_glu, b_glu, PROJ, YCAT);
        hipLaunchKernelGGL(v0_out, dim3(M), dim3(256), 0, stream, YCAT, w_out, x, MOD, out); }
#endif
    const hipError_t le = hipPeekAtLastError();
    if (le != hipSuccess) fprintf(stderr, "kernel_launch: launch failed: %s\n", hipGetErrorName(le));
}
```

```cpp
#include <hip/hip_runtime.h>
#include <cstdio>
#include <cstdint>
#ifndef MK_CLAIM_BETWEEN
#define MK_CLAIM_BETWEEN 0
#endif
#ifndef MK_DOUBLE
#define MK_DOUBLE (-1)
#endif

constexpr int BATCH = 2, SEQ = 8192, DM = 1024, M = BATCH * SEQ;
constexpr int SSM_W = 512, SSM_G = 32, SSM_GC = 16, SSM_P = 64;
constexpr int NH = 8, QK_NOPE = 64, QK_ROPE = 32, QK_HEAD = 96, V_HEAD = 64, MLA_W = 512, Q_LORA = 384, KV_LORA = 256;
constexpr int D_IN = 2208;
constexpr float EPS = 1e-6f;
constexpr int NPROJ = 1792;
constexpr int LDP = 1280;
constexpr int PC_U = 0, PC_ZS = 0, PC_CKV = 512, PC_CQ = 768, PC_KR = 1152;
constexpr int GC_KR = 1664;
constexpr int WR_ZM = 1792;
constexpr int SC_U = 0, SC_ZS = 512, SC_CQ = 1024, SC_CKV = 1408, SC_KR = 1664, SC_ZM = 1696;

constexpr size_t MiB = 1u << 20;
constexpr size_t WS_CTL = 0, CTL_ZERO_BYTES = 1 * MiB;
constexpr size_t WS_MOD = 1 * MiB;
constexpr size_t WS_AC = 1 * MiB + 64 * 1024;
constexpr size_t WS_BB = 1 * MiB + 128 * 1024;
constexpr size_t WS_CB = 1 * MiB + 256 * 1024;
constexpr size_t WS_E = 2 * MiB;
constexpr size_t WS_WIN = 4 * MiB;
constexpr size_t WS_WQ = 9 * MiB;
constexpr size_t WS_WKV = 10 * MiB;
constexpr size_t WS_WGLU = 11 * MiB;
constexpr size_t WS_WOUT = 12 * MiB;
constexpr size_t WS_PROJ = 16 * MiB;
constexpr size_t WS_USG = 56 * MiB;
constexpr size_t WS_ZM = 80 * MiB;
constexpr size_t WS_HB = 96 * MiB;
constexpr size_t WS_YCAT = 128 * MiB;
constexpr size_t WS_KVRAW = 128 * MiB;
constexpr size_t WS_Q = 160 * MiB;
constexpr size_t WS_CQN = 160 * MiB;
constexpr size_t WS_CKVN = 172 * MiB;
constexpr size_t WS_K = 184 * MiB;
constexpr size_t WS_V = 208 * MiB;
constexpr size_t WS_YPRE = 224 * MiB;
constexpr size_t WS_TQ = 240 * MiB;
constexpr size_t WS_PP = 246 * MiB;
constexpr size_t WS_ROPE = 250 * MiB;
constexpr size_t WS_HAND = 252 * MiB;
constexpr size_t WS_RS = 14 * MiB;
constexpr size_t WS_END = 253 * MiB;

typedef unsigned short bf16;
__device__ __forceinline__ unsigned f2bf(float f) { return (unsigned)__builtin_bit_cast(unsigned short, (_Float16)f); }
__device__ __forceinline__ float bf2f(bf16 b) { return (float)__builtin_bit_cast(_Float16, b); }
__device__ __forceinline__ float silu_f(float v) { return v / (1.f + __expf(-v)); }
__device__ __forceinline__ float sigmoid_f(float v) { return 1.f / (1.f + __expf(-v)); }
__device__ __forceinline__ float gelu_tanh(float v) { const float z = 0.7978845608028654f * (v + 0.044715f * v * v * v); return v / (1.f + __expf(-2.f * z)); }

__device__ __forceinline__ float block_sum_256(float v, float* red) {
    for (int o = 32; o > 0; o >>= 1) v += __shfl_xor(v, o);
    const int w = threadIdx.x >> 6;
    __syncthreads();
    if ((threadIdx.x & 63) == 0) red[w] = v;
    __syncthreads();
    float s = 0.f; for (int i = 0; i < (int)(blockDim.x >> 6); ++i) s += red[i];
    return s;
}

__global__ void v0_mod(const float* c, const float* w_ada, const float* b_ada, float* mod) {
    const int idx = blockIdx.x * blockDim.x + threadIdx.x; if (idx >= BATCH * 3 * DM) return;
    const int b = idx / (3 * DM), n = idx % (3 * DM);
    float acc = b_ada[n];
    for (int k = 0; k < DM; ++k) acc += silu_f(c[b * DM + k]) * w_ada[(size_t)k * 3 * DM + n];
    mod[idx] = acc;
}
__global__ void v0_h(const float* x, const float* norm_g, const float* mod, bf16* hb) {
    __shared__ float red[8];
    const int m = blockIdx.x, b = m / SEQ, t = threadIdx.x;
    float v[4], ss = 0.f;
    for (int j = 0; j < 4; ++j) { v[j] = x[(size_t)m * DM + t + 256 * j]; ss += v[j] * v[j]; }
    ss = block_sum_256(ss, red);
    const float rstd = 1.f / sqrtf(ss / DM + EPS);
    for (int j = 0; j < 4; ++j) { const int e = t + 256 * j;
        const float hv = v[j] * rstd * norm_g[e] * (1.f + mod[b * 3 * DM + DM + e]) + mod[b * 3 * DM + e];
        hb[(size_t)m * DM + e] = (bf16)f2bf(hv); }
}
__global__ void v0_gemm(const bf16* A, int lda, int K, const float* W, int ldw, int src0, bf16* C, int ldc, int dst0, int width) {
    extern __shared__ float arow[];
    const int m = blockIdx.x;
    for (int k = threadIdx.x; k < K; k += blockDim.x) arow[k] = bf2f(A[(size_t)m * lda + k]);
    __syncthreads();
    for (int j = threadIdx.x; j < width; j += blockDim.x) {
        float acc = 0.f;
        for (int k = 0; k < K; ++k) acc += arow[k] * W[(size_t)k * ldw + src0 + j];
        C[(size_t)m * ldc + dst0 + j] = (bf16)f2bf(acc);
    }
}
__global__ void v0_usg(const bf16* A, const float* W, int ldw, bf16* USG) {
    extern __shared__ float arow[];
    const int m = blockIdx.x, b = m / SEQ, t = m % SEQ;
    for (int k = threadIdx.x; k < 1024; k += blockDim.x) arow[k] = bf2f(A[(size_t)m * 1024 + k]);
    __syncthreads();
    for (int c = threadIdx.x; c < 512; c += blockDim.x) { float acc = 0.f;
        for (int k = 0; k < 1024; ++k) acc += arow[k] * W[(size_t)k * ldw + c];
        USG[((size_t)(c >> 4) * 1024 + b * 512 + (t >> 4)) * 384 + (t & 15) * 16 + (c & 15)] = (bf16)f2bf(acc); }
}
__global__ void v0_cqn(const bf16* proj, const float* q_a_g, const float* kv_a_g, bf16* cqn, bf16* ckvn) {
    __shared__ float red[8];
    const int m = blockIdx.x, t = threadIdx.x;
    float a = 0.f, b2 = 0.f, ss = 0.f;
    if (t < 192) { a = bf2f(proj[(size_t)m * LDP + PC_CQ + t]); b2 = bf2f(proj[(size_t)m * LDP + PC_CQ + 192 + t]); ss = a * a + b2 * b2; }
    ss = block_sum_256(ss, red);
    float rstd = 1.f / sqrtf(ss / Q_LORA + EPS);
    if (t < 192) { cqn[(size_t)m * Q_LORA + t] = (bf16)f2bf(a * rstd * q_a_g[t]); cqn[(size_t)m * Q_LORA + 192 + t] = (bf16)f2bf(b2 * rstd * q_a_g[192 + t]); }
    const float cv = bf2f(proj[(size_t)m * LDP + PC_CKV + t]);
    ss = block_sum_256(cv * cv, red);
    rstd = 1.f / sqrtf(ss / KV_LORA + EPS);
    ckvn[(size_t)m * KV_LORA + t] = (bf16)f2bf(cv * rstd * kv_a_g[t]);
}
__device__ __forceinline__ int v0_vst(int k, int c) { const int kk = (k & ~0xC) | ((k & 4) << 1) | ((k & 8) >> 1); return ((kk >> 3) * 2 + (c >> 5)) * 512 + ((kk & 7) * 32 + (c & 31)) * 2; }
__global__ void __launch_bounds__(256) v0_qkv(const bf16* qraw, const bf16* kvraw, const bf16* proj, const int* positions, const float* q_norm_g, const float* k_norm_g, bf16* Q, bf16* K, bf16* V) {
    const int idx = blockIdx.x * blockDim.x + threadIdx.x; if (idx >= M * NH * 2) return;
    const int which = idx & 1, m = (idx >> 1) / NH, h = (idx >> 1) % NH;
    const float pos = (float)positions[m];
    const float* gn = which ? k_norm_g : q_norm_g;
    float q[96];
    float sq = 0.f;
    if (which == 0) {
#pragma unroll
        for (int d = 0; d < 96; ++d) q[d] = bf2f(qraw[(size_t)m * 1024 + h * 128 + d]);
    } else {
#pragma unroll
        for (int d = 0; d < 64; ++d) q[d] = bf2f(kvraw[(size_t)m * 1024 + h * 128 + d]);
#pragma unroll
        for (int d = 0; d < 32; ++d) q[64 + d] = bf2f(proj[(size_t)m * LDP + PC_KR + d]);
    }
#pragma unroll
    for (int d = 0; d < 96; ++d) sq += q[d] * q[d];
    const float rq = 1.f / sqrtf(sq / 96.f + EPS);
#pragma unroll
    for (int d = 0; d < 96; ++d) q[d] = q[d] * rq * gn[d];
#pragma unroll
    for (int i = 0; i < 16; ++i) {
        const float inv_freq = (float)pow(10000.0, -(double)i / 16.0);
        const float ang = pos * inv_freq;
        const double TWO_PI = 6.283185307179586476925286766559;
        const double r = (double)ang - TWO_PI * rint((double)ang / TWO_PI);
        const float rf = (float)r; const float cs = __cosf(rf), sn = __sinf(rf);
        const float q1 = q[64 + i], q2 = q[80 + i]; q[64 + i] = q1 * cs - q2 * sn; q[80 + i] = q2 * cs + q1 * sn;
    }
    if (which == 0) {
#pragma unroll
        for (int d = 0; d < 96; ++d) Q[(size_t)m * 768 + h * 96 + d] = (bf16)f2bf(q[d] * (0.10206207261596575f * 1.4426950408889634f));
    } else {
        const int bb = m / SEQ, tt = m % SEQ; const size_t tix = (size_t)(bb * 8 + h) * 128 + (tt >> 6); const int row = tt & 63;
#pragma unroll
        for (int d = 0; d < 96; ++d) K[tix * 6144 + (d >> 3) * 512 + row * 8 + (d & 7)] = (bf16)f2bf(q[d]);
        for (int d = 0; d < 64; ++d) V[tix * 4096 + v0_vst(row, d) / 2] = kvraw[(size_t)m * 1024 + h * 128 + 64 + d];
    }
}
__global__ void __launch_bounds__(64) v0_ssm(const bf16* proj, const float* log_dt, const float* lam_re, const float* lam_im, const float* b_re, const float* b_im,
                       const float* c_re, const float* c_im, const float* d_skip, bf16* ypre) {
    __shared__ float sre[64], sim[64], us[16];
    const int b = blockIdx.x / SSM_G, g = blockIdx.x % SSM_G, p = threadIdx.x;
    const double dt = exp((double)log_dt[g]);
    const double lr = lam_re[g * 64 + p], li = lam_im[g * 64 + p];
    const double er = exp(lr * dt), ar = er * cos(li * dt), ai = er * sin(li * dt);
    const double nr = ar - 1.0, ni = ai, den = lr * lr + li * li;
    const double cr = (nr * lr + ni * li) / den, ci = (ni * lr - nr * li) / den;
    float Br[16], Bi[16];
#pragma unroll
    for (int j = 0; j < 16; ++j) { const double br = b_re[(g * 64 + p) * 16 + j], bi = b_im[(g * 64 + p) * 16 + j];
        Br[j] = (float)(cr * br - ci * bi); Bi[j] = (float)(cr * bi + ci * br); }
    const float far = (float)ar, fai = (float)ai;
    float s_r = 0.f, s_i = 0.f;
    const float dsk = p < 16 ? d_skip[g * 16 + p] : 0.f;
    for (int t = 0; t < SEQ; ++t) {
        const size_t row = (size_t)(b * SEQ + t);
        if (p < 16) us[p] = bf2f(proj[((size_t)g * 1024 + b * 512 + (t >> 4)) * 384 + (t & 15) * 16 + p]);
        __syncthreads();
        float bur = 0.f, bui = 0.f;
#pragma unroll
        for (int j = 0; j < 16; ++j) { bur += Br[j] * us[j]; bui += Bi[j] * us[j]; }
        const float nr2 = far * s_r - fai * s_i + bur, ni2 = far * s_i + fai * s_r + bui;
        s_r = nr2; s_i = ni2; sre[p] = s_r; sim[p] = s_i;
        __syncthreads();
        if (p < 16) {
            float y = 0.f;
            for (int q = 0; q < 64; ++q) y += c_re[(g * 16 + p) * 64 + q] * sre[q] - c_im[(g * 16 + p) * 64 + q] * sim[q];
            y += dsk * us[p];
            ypre[row * SSM_W + g * 16 + p] = (bf16)f2bf(gelu_tanh(y));
        }
        __syncthreads();
    }
}
__global__ void __launch_bounds__(256) v0_attn(const bf16* Q, const bf16* K, const bf16* V, const bf16* zm, bf16* ycat) {
    const int qb = blockIdx.x % (SEQ / 256), bh = blockIdx.x / (SEQ / 256), b = bh / NH, h = bh % NH;
    const int qi = qb * 256 + threadIdx.x;
    const size_t qrow = (size_t)b * SEQ + qi;
    float q[96], o[64];
    const float sc = 0.10206207261596575f;
#pragma unroll
    for (int d = 0; d < 96; ++d) q[d] = bf2f(Q[qrow * 768 + h * 96 + d]) * sc;
#pragma unroll
    for (int d = 0; d < 64; ++d) o[d] = 0.f;
    float mx = -1e30f, l = 0.f;
    const int jmax = qb * 256 + 255;
    for (int j = 0; j <= jmax; ++j) {
        const size_t tix = (size_t)(b * 8 + h) * 128 + (j >> 6); const int jr = j & 63;
        const bf16* kp = K + tix * 6144 + jr * 8; const bf16* vp = V + tix * 4096;
        float s = 0.f;
#pragma unroll
        for (int d = 0; d < 96; ++d) s += q[d] * bf2f(kp[(d >> 3) * 512 + (d & 7)]);
        if (j <= qi) {
            const float mn = fmaxf(mx, s); const float al = exp2f(mx - mn), pp = exp2f(s - mn);
            l = l * al + pp;
#pragma unroll
            for (int d = 0; d < 64; ++d) o[d] = o[d] * al + pp * bf2f(vp[v0_vst(jr, d) / 2]);
            mx = mn;
        }
    }
    const float rl = 1.f / l;
#pragma unroll
    for (int d = 0; d < 64; ++d) {
        const float z = bf2f(zm[qrow * 512 + h * 64 + d]);
        ycat[qrow * 1024 + 512 + h * 64 + d] = (bf16)f2bf(o[d] * rl * silu_f(z));
    }
}
__global__ void v0_glu(const bf16* ypre, const float* w_glu, const float* b_glu, const bf16* proj, bf16* ycat) {
    __shared__ float arow[512];
    const int m = blockIdx.x;
    for (int k = threadIdx.x; k < 512; k += blockDim.x) arow[k] = bf2f(ypre[(size_t)m * 512 + k]);
    __syncthreads();
    for (int j = threadIdx.x; j < 512; j += blockDim.x) {
        float acc = b_glu[j];
        for (int k = 0; k < 512; ++k) acc += arow[k] * w_glu[(size_t)k * 512 + j];
        const float z = bf2f(proj[(size_t)m * LDP + PC_ZS + j]);
        ycat[(size_t)m * 1024 + j] = (bf16)f2bf(arow[j] * sigmoid_f(acc) * silu_f(z));
    }
}
__global__ void v0_out(const bf16* ycat, const float* w_out, const float* x, const float* mod, float* out) {
    __shared__ float arow[1024];
    const int m = blockIdx.x, b = m / SEQ;
    for (int k = threadIdx.x; k < 1024; k += blockDim.x) arow[k] = bf2f(ycat[(size_t)m * 1024 + k]);
    __syncthreads();
    for (int j = threadIdx.x; j < 1024; j += blockDim.x) {
        float acc = 0.f;
        for (int k = 0; k < 1024; ++k) acc += arow[k] * w_out[(size_t)k * 1024 + j];
        out[(size_t)m * DM + j] = x[(size_t)m * DM + j] + mod[b * 3 * DM + 2 * DM + j] * acc;
    }
}


typedef unsigned wt_u32x4 __attribute__((ext_vector_type(4)));
__device__ __forceinline__ void store16_wt(void* p, wt_u32x4 v) { asm volatile("global_store_dwordx4 %0, %1, off sc1\n\ts_nop 1" :: "v"(p), "v"(v) : "memory"); }

namespace pg8 {
#define PG8_LAS __attribute__((address_space(3)))
typedef unsigned short bf16_t;
typedef _Float16 bf16x8 __attribute__((ext_vector_type(8)));
typedef float f32x4 __attribute__((ext_vector_type(4)));
typedef unsigned u32x4 __attribute__((ext_vector_type(4)));
constexpr int BM = 256, BK = 64, HALF = 128, HTB = HALF * BK * 2  , STAGE_BYTES = 8 * HTB, NXCD = 8, WGM = 8;

__host__ __device__ __forceinline__ int lds_byte(int r, int c) { const int st = (r >> 4) * 2 + (c >> 5), rr = r & 15, cc = c & 31, ob = rr * 64 + cc * 2; return st * 1024 + (ob ^ (((ob >> 9) & 1) << 5)); }
__host__ __device__ __forceinline__ void stage_rc(int b, int& R, int& C) { const int st = b / 1024, sb = b % 1024, swz = sb ^ (((sb >> 9) & 1) << 5); R = (st >> 1) * 16 + swz / 64; C = (st & 1) * 32 + (swz % 64) / 2; }
__host__ __device__ __forceinline__ int perm32(int rho) { const int n = rho >> 4, i = rho & 15; return 8 * (i >> 2) + 4 * n + (i & 3); }

struct Unit { int pm, pn; };
struct Gemm { const bf16_t* A; const bf16_t* Bt; int M, N, K, lda; };

struct StaticOrder {
    int nM, nN, nwg, G, c;
    __host__ __device__ void init(int M, int N, int G_, int c_) { nM = M / BM; nN = N / BM; nwg = nM * nN; G = G_; c = c_; }
    __host__ __device__ bool next(int i, Unit& u) const {
        const long L = (long)i * G + c; if (L >= nwg) return false;
        int wgid = (int)L; { const int q = nwg / NXCD, r = nwg % NXCD, xcd = wgid % NXCD, off = wgid / NXCD; wgid = (xcd < r ? xcd * (q + 1) : r * (q + 1) + (xcd - r) * q) + off; }
        const int nig = WGM * nN, gid = wgid / nig, fm = gid * WGM, gsz = (nM - fm) < WGM ? (nM - fm) : WGM;
        u.pm = fm + ((wgid % nig) % gsz); u.pn = (wgid % nig) / gsz; return true;
    }
    __device__ __forceinline__ void a_ready(const Unit&) const {}
    __device__ __forceinline__ void done(const Unit&) const {}
};


struct DiagOrder {
    int nunits, per, G, c; unsigned* cnt; unsigned want; unsigned* tmo;
    __device__ __forceinline__ bool next(int i, Unit& u) const { const int L = i * G + c; if (L >= nunits) return false; u.pm = L; u.pn = L / per; return true; }
    __device__ __forceinline__ void a_ready(const Unit& u) const {
        if (!cnt) return;
        if (threadIdx.x < 64) { unsigned sp = 0;
            while (__hip_atomic_load(cnt + 64 * u.pm, __ATOMIC_RELAXED, __HIP_MEMORY_SCOPE_AGENT) < want) { __builtin_amdgcn_s_sleep(2);
                if (++sp > (1u << 22)) { if (threadIdx.x == 0) __hip_atomic_store(tmo, 1u, __ATOMIC_RELAXED, __HIP_MEMORY_SCOPE_AGENT); break; } }
            __builtin_amdgcn_fence(__ATOMIC_ACQUIRE, "agent"); asm volatile("s_waitcnt vmcnt(0)" ::: "memory"); }
        __syncthreads();
    }
    __device__ __forceinline__ void done(const Unit&) const {}
};
struct OneUnit { Unit u;
    __device__ __forceinline__ bool next(int i, Unit& x) const { if (i) return false; x = u; return true; }
    __device__ __forceinline__ void a_ready(const Unit&) const {}
    __device__ __forceinline__ void done(const Unit&) const {} };
struct PanelOrder : StaticOrder {
    unsigned* cnt; unsigned want; unsigned* tmo;
    __device__ __forceinline__ void a_ready(const Unit& u) const {
        if (threadIdx.x < 64) { unsigned sp = 0;
            while (__hip_atomic_load(cnt + 64 * u.pm, __ATOMIC_RELAXED, __HIP_MEMORY_SCOPE_AGENT) < want) { __builtin_amdgcn_s_sleep(2);
                if (++sp > (1u << 22)) { if (threadIdx.x == 0) __hip_atomic_store(tmo, 1u, __ATOMIC_RELAXED, __HIP_MEMORY_SCOPE_AGENT); break; } }
            __builtin_amdgcn_fence(__ATOMIC_ACQUIRE, "agent"); asm volatile("s_waitcnt vmcnt(0)" ::: "memory"); }
        __syncthreads();
    }
};

typedef float f32x2 __attribute__((ext_vector_type(2)));
typedef _Float16 f16x2 __attribute__((ext_vector_type(2)));
__device__ __forceinline__ unsigned cvt_pk_h(float lo, float hi) { const f16x2 v = __builtin_convertvector((f32x2){lo, hi}, f16x2); return __builtin_bit_cast(unsigned, v); }
__device__ __forceinline__ float h_lo(unsigned w) { return (float)__builtin_bit_cast(f16x2, w)[0]; }
__device__ __forceinline__ float h_hi(unsigned w) { return (float)__builtin_bit_cast(f16x2, w)[1]; }
__device__ __forceinline__ float fsilu(float v) { return v * __builtin_amdgcn_rcpf(1.f + __builtin_amdgcn_exp2f(-1.4426950408889634f * v)); }
__device__ __forceinline__ float fsigm(float v) { return __builtin_amdgcn_rcpf(1.f + __builtin_amdgcn_exp2f(-1.4426950408889634f * v)); }

struct EpiH16 {
    static constexpr bool PERM = true, AFTER_DRAIN = false;
    bf16_t* O; int ldc;
    __device__ __forceinline__ void operator()(const f32x4 (&acc)[2][2][4][2], const Unit& u, int wr, int wc, int fr, int fq) const {
        const int row0 = u.pm * BM + wr * 64 + fr, col0 = u.pn * BM + wc * 32 + 8 * fq;
#pragma unroll
        for (int ai = 0; ai < 2; ++ai)
#pragma unroll
            for (int m = 0; m < 4; ++m) { bf16_t* rowp = O + (size_t)(row0 + ai * HALF + m * 16) * ldc + col0;
#pragma unroll
                for (int bj = 0; bj < 2; ++bj) { const f32x4 v0 = acc[ai][bj][m][0], v1 = acc[ai][bj][m][1];
                    u32x4 w; w.x = cvt_pk_h(v0[0], v0[1]); w.y = cvt_pk_h(v0[2], v0[3]); w.z = cvt_pk_h(v1[0], v1[1]); w.w = cvt_pk_h(v1[2], v1[3]);
                    store16_wt(rowp + bj * HALF, w); } }
    }
};
struct EpiProj {
    static constexpr bool PERM = true, AFTER_DRAIN = false;
    bf16_t* O; int ldc; float* RS; int rs_pn0; bf16_t* USG; int seq;
    __device__ __forceinline__ void operator()(const f32x4 (&acc)[2][2][4][2], const Unit& u, int wr, int wc, int fr, int fq) const {
        const int row0 = u.pm * BM + wr * 64 + fr, col0 = u.pn * BM + wc * 32 + 8 * fq;
#pragma unroll
        for (int ai = 0; ai < 2; ++ai)
#pragma unroll
            for (int m = 0; m < 4; ++m) { const int grow = row0 + ai * HALF + m * 16; bf16_t* rowp = O + (size_t)grow * ldc + col0 - 512;
                const int bb = grow / seq, tt = grow % seq;
#pragma unroll
                for (int bj = 0; bj < 2; ++bj) { const f32x4 v0 = acc[ai][bj][m][0], v1 = acc[ai][bj][m][1];
                    u32x4 w; w.x = cvt_pk_h(v0[0], v0[1]); w.y = cvt_pk_h(v0[2], v0[3]); w.z = cvt_pk_h(v1[0], v1[1]); w.w = cvt_pk_h(v1[2], v1[3]);
                    if (u.pn < 2) { const int c = col0 + bj * HALF;
                        *(u32x4*)(USG + ((size_t)(c >> 4) * 1024 + bb * 512 + (tt >> 4)) * 384 + (tt & 15) * 16 + (c & 15)) = w;
                    }
                    else *(u32x4*)(rowp + bj * HALF) = w; } }
        if (u.pn >= rs_pn0) {
#pragma unroll
            for (int ai = 0; ai < 2; ++ai)
#pragma unroll
                for (int m = 0; m < 4; ++m)
#pragma unroll
                    for (int bj = 0; bj < 2; ++bj) { const f32x4 v0 = acc[ai][bj][m][0], v1 = acc[ai][bj][m][1];
                        float q = (v0[0] * v0[0] + v0[1] * v0[1]) + (v0[2] * v0[2] + v0[3] * v0[3]) + (v1[0] * v1[0] + v1[1] * v1[1]) + (v1[2] * v1[2] + v1[3] * v1[3]);
                        q += __shfl_xor(q, 16); q += __shfl_xor(q, 32);
                        if (fq == 0) RS[((size_t)(row0 + ai * HALF + m * 16) * 3 + (u.pn - rs_pn0)) * 8 + bj * 4 + wc] = q; }
        }
    }
};
struct MlaAux { const float* RS; const float* rope; const bf16_t* proj; int ldp, krcol0; };
constexpr int MLA_TBL = 8192, MLA_ROPE = 12288, MLA_KR = 45056;
__device__ __forceinline__ void mla_stage_rows(const MlaAux& A, const Unit& u, PG8_LAS unsigned char* lds, int tid, bool want_kr, float eps) {
    const size_t row0 = (size_t)u.pm * BM;
    u32x4 rp[4];
#pragma unroll
    for (int j = 0; j < 4; ++j) rp[j] = *(const u32x4*)((const char*)(A.rope + row0 * 32) + (size_t)(tid + 512 * j) * 16);
    u32x4 kr[2] = {{0u, 0u, 0u, 0u}, {0u, 0u, 0u, 0u}};
    if (want_kr) {
#pragma unroll
        for (int j = 0; j < 2; ++j) { const int c = tid + 512 * j; kr[j] = *(const u32x4*)(A.proj + (row0 + (c >> 2)) * A.ldp + A.krcol0 + 8 * (c & 3)); } }
    if (tid < 256) { const float* rs = A.RS + (row0 + tid) * 24;
        const f32x4 s6a = *(const f32x4*)rs, s6b = *(const f32x4*)(rs + 4), s7a = *(const f32x4*)(rs + 8), s7b = *(const f32x4*)(rs + 12), s8a = *(const f32x4*)(rs + 16); const float skr = rs[20];
        const float sq = ((s7a[0] + s7a[1]) + (s7a[2] + s7a[3])) + ((s7b[0] + s7b[1]) + (s7b[2] + s7b[3])) + ((s8a[0] + s8a[1]) + (s8a[2] + s8a[3]));
        const float skv = ((s6a[0] + s6a[1]) + (s6a[2] + s6a[3])) + ((s6b[0] + s6b[1]) + (s6b[2] + s6b[3]));
        *(PG8_LAS f32x4*)(lds + MLA_TBL + tid * 16) = (f32x4){1.f / sqrtf(sq * (1.f / 384.f) + eps), 1.f / sqrtf(skv * (1.f / 256.f) + eps), skr, 0.f}; }
#pragma unroll
    for (int j = 0; j < 4; ++j) *(PG8_LAS u32x4*)(lds + MLA_ROPE + (tid + 512 * j) * 16) = rp[j];
    if (want_kr) {
#pragma unroll
        for (int j = 0; j < 2; ++j) *(PG8_LAS u32x4*)(lds + MLA_KR + (tid + 512 * j) * 16) = kr[j]; }
}
struct EpiQ {
    static constexpr bool PERM = true, AFTER_DRAIN = true;
    MlaAux A; const float* gq; bf16_t* Q; float qscale, eps; int seq;
    __device__ __forceinline__ void fused(f32x4 (&acc)[2][2][4][2], const Unit& u, int wr, int wc, int fr, int fq, PG8_LAS unsigned char* lds, int wid, int lane) const {
        PG8_LAS float* P = (PG8_LAS float*)lds;
#pragma unroll
        for (int ai = 0; ai < 2; ++ai)
#pragma unroll
            for (int m = 0; m < 4; ++m)
#pragma unroll
                for (int bj = 0; bj < 2; ++bj) { const f32x4 v0 = acc[ai][bj][m][0], v1 = acc[ai][bj][m][1];
                    float q = (v0[0] * v0[0] + v0[1] * v0[1]) + (v0[2] * v0[2] + v0[3] * v0[3]) + (v1[0] * v1[0] + v1[1] * v1[1]) + (v1[2] * v1[2] + v1[3] * v1[3]);
                    q += __shfl_xor(q, 16); q += __shfl_xor(q, 32);
                    if (fq == 0) P[((ai * HALF + wr * 64 + m * 16 + fr) * 2 + bj) * 4 + wc] = q; }
        mla_stage_rows(A, u, lds, wid * 64 + lane, false, eps);
        asm volatile("s_waitcnt lgkmcnt(0)" ::: "memory"); __builtin_amdgcn_s_barrier(); asm volatile("" ::: "memory");
        if (wc == 3) return;
        const int d0 = 32 * wc + 8 * fq;
        const f32x4 g0 = *(const f32x4*)(gq + (wc == 2 ? 64 + 8 * fq : d0)), g1 = *(const f32x4*)(gq + (wc == 2 ? 64 + 8 * fq : d0) + 4);
#pragma unroll
        for (int ai = 0; ai < 2; ++ai)
#pragma unroll
            for (int m = 0; m < 4; ++m) { const int r = ai * HALF + wr * 64 + m * 16 + fr; const size_t grow = (size_t)u.pm * BM + r;
                const float rstd = (*(const PG8_LAS f32x4*)(lds + MLA_TBL + r * 16))[0];
                f32x4 cs0 = {0.f, 0.f, 0.f, 0.f}, cs1 = cs0, cs2 = cs0, cs3 = cs0;
                if (wc == 2) { const PG8_LAS float* rp = (const PG8_LAS float*)(lds + MLA_ROPE) + (r * 16 + 8 * (fq & 1)) * 2; cs0 = *(const PG8_LAS f32x4*)rp; cs1 = *(const PG8_LAS f32x4*)(rp + 4); cs2 = *(const PG8_LAS f32x4*)(rp + 8); cs3 = *(const PG8_LAS f32x4*)(rp + 12); }
#pragma unroll
                for (int bj = 0; bj < 2; ++bj) { const f32x4 pp = *(const PG8_LAS f32x4*)(P + (r * 2 + bj) * 4);
                    const float tot = (pp[0] + pp[1]) + pp[2];
                    const float rs = qscale * rstd * __builtin_amdgcn_rsqf(rstd * rstd * tot * (1.f / 96.f) + eps);
                    f32x4 v0 = acc[ai][bj][m][0] * rs * g0, v1 = acc[ai][bj][m][1] * rs * g1;
                    if (wc == 2) {
                        f32x4 o0, o1;
#pragma unroll
                        for (int e = 0; e < 4; ++e) { o0[e] = __shfl_xor(v0[e], 32); o1[e] = __shfl_xor(v1[e], 32); }
                        const float sg = (fq < 2) ? -1.f : 1.f;
                        v0[0] = v0[0] * cs0[0] + sg * o0[0] * cs0[1]; v0[1] = v0[1] * cs0[2] + sg * o0[1] * cs0[3]; v0[2] = v0[2] * cs1[0] + sg * o0[2] * cs1[1]; v0[3] = v0[3] * cs1[2] + sg * o0[3] * cs1[3];
                        v1[0] = v1[0] * cs2[0] + sg * o1[0] * cs2[1]; v1[1] = v1[1] * cs2[2] + sg * o1[1] * cs2[3]; v1[2] = v1[2] * cs3[0] + sg * o1[2] * cs3[1]; v1[3] = v1[3] * cs3[2] + sg * o1[3] * cs3[3]; }
                    u32x4 w; w.x = cvt_pk_h(v0[0], v0[1]); w.y = cvt_pk_h(v0[2], v0[3]); w.z = cvt_pk_h(v1[0], v1[1]); w.w = cvt_pk_h(v1[2], v1[3]);
                    *(u32x4*)(Q + grow * 768 + (2 * u.pn + bj) * 96 + d0) = w; } }
    }
};
struct EpiKV {
    static constexpr bool PERM = true, AFTER_DRAIN = true;
    MlaAux A; const float* gk; bf16_t* KIMG; bf16_t* VIMG; float eps; int seq;
    __device__ __forceinline__ static int vst(int k, int c) { return (c >> 5) * 4096 + k * 64 + (c & 31) * 2; }
    __device__ __forceinline__ void fused(f32x4 (&acc)[2][2][4][2], const Unit& u, int wr, int wc, int fr, int fq, PG8_LAS unsigned char* lds, int wid, int lane) const {
        PG8_LAS float* P = (PG8_LAS float*)lds;
        if (wc < 2) {
#pragma unroll
            for (int ai = 0; ai < 2; ++ai)
#pragma unroll
                for (int m = 0; m < 4; ++m)
#pragma unroll
                    for (int bj = 0; bj < 2; ++bj) { const f32x4 v0 = acc[ai][bj][m][0], v1 = acc[ai][bj][m][1];
                        float q = (v0[0] * v0[0] + v0[1] * v0[1]) + (v0[2] * v0[2] + v0[3] * v0[3]) + (v1[0] * v1[0] + v1[1] * v1[1]) + (v1[2] * v1[2] + v1[3] * v1[3]);
                        q += __shfl_xor(q, 16); q += __shfl_xor(q, 32);
                        if (fq == 0) P[((ai * HALF + wr * 64 + m * 16 + fr) * 2 + bj) * 2 + wc] = q; }
        }
        mla_stage_rows(A, u, lds, wid * 64 + lane, true, eps);
        asm volatile("s_waitcnt lgkmcnt(0)" ::: "memory"); __builtin_amdgcn_s_barrier(); asm volatile("" ::: "memory");
        const int q8 = 4 * (wc & 1) + fq;
        f32x4 g0 = {0.f, 0.f, 0.f, 0.f}, g1 = g0; float ga = 0.f, gb = 0.f, gc = 0.f, gd = 0.f;
        if (wc < 2) { g0 = *(const f32x4*)(gk + 32 * wc + 8 * fq); g1 = *(const f32x4*)(gk + 32 * wc + 8 * fq + 4); }
        else { ga = gk[64 + 2 * q8]; gb = gk[65 + 2 * q8]; gc = gk[80 + 2 * q8]; gd = gk[81 + 2 * q8]; }
#pragma unroll
        for (int ai = 0; ai < 2; ++ai)
#pragma unroll
            for (int m = 0; m < 4; ++m) { const int r = ai * HALF + wr * 64 + m * 16 + fr; const size_t grow = (size_t)u.pm * BM + r;
                const f32x4 tb = *(const PG8_LAS f32x4*)(lds + MLA_TBL + r * 16); const float rstd = tb[1], skr = tb[2];
                const int bb = (int)(grow / (size_t)seq), tt = (int)(grow % (size_t)seq), trow = tt & 63;
                float cA = 0.f, sA = 0.f, cB = 0.f, sB = 0.f, x1a = 0.f, x1b = 0.f, x2a = 0.f, x2b = 0.f;
                if (wc >= 2) { const f32x4 cs = *(const PG8_LAS f32x4*)((const PG8_LAS float*)(lds + MLA_ROPE) + (r * 16 + 2 * q8) * 2); cA = cs[0]; sA = cs[1]; cB = cs[2]; sB = cs[3];
                    const PG8_LAS bf16_t* krow = (const PG8_LAS bf16_t*)(lds + MLA_KR) + r * 32;
                    const unsigned ra = *(const PG8_LAS unsigned*)(krow + 2 * q8), rb = *(const PG8_LAS unsigned*)(krow + 16 + 2 * q8);
                    x1a = h_lo(ra); x1b = h_hi(ra); x2a = h_lo(rb); x2b = h_hi(rb); }
#pragma unroll
                for (int bj = 0; bj < 2; ++bj) { const f32x2 pp = *(const PG8_LAS f32x2*)(P + (r * 2 + bj) * 2);
                    const float rs = __builtin_amdgcn_rsqf((rstd * rstd * (pp[0] + pp[1]) + skr) * (1.f / 96.f) + eps);
                    const size_t tix = (size_t)(bb * 8 + 2 * u.pn + bj) * 128 + (tt >> 6);
                    if (wc < 2) { const float f = rstd * rs; const f32x4 v0 = acc[ai][bj][m][0] * f * g0, v1 = acc[ai][bj][m][1] * f * g1;
                        u32x4 w; w.x = cvt_pk_h(v0[0], v0[1]); w.y = cvt_pk_h(v0[2], v0[3]); w.z = cvt_pk_h(v1[0], v1[1]); w.w = cvt_pk_h(v1[2], v1[3]);
                        *(u32x4*)(KIMG + tix * 6144 + (4 * wc + fq) * 512 + trow * 8) = w; }
                    else { const f32x4 v0 = acc[ai][bj][m][0] * rstd, v1 = acc[ai][bj][m][1] * rstd;
                        u32x4 w; w.x = cvt_pk_h(v0[0], v0[1]); w.y = cvt_pk_h(v0[2], v0[3]); w.z = cvt_pk_h(v1[0], v1[1]); w.w = cvt_pk_h(v1[2], v1[3]);
                        *(u32x4*)(VIMG + tix * 4096 + vst(trow, 32 * (wc - 2) + 8 * fq) / 2) = w;
                        const float y1a = x1a * rs * ga, y1b = x1b * rs * gb, y2a = x2a * rs * gc, y2b = x2b * rs * gd;
                        bf16_t* kd = KIMG + tix * 6144 + trow * 8;
                        *(unsigned*)(kd + (8 + (q8 >> 2)) * 512 + ((2 * q8) & 7)) = cvt_pk_h(y1a * cA - y2a * sA, y1b * cB - y2b * sB);
                        *(unsigned*)(kd + (10 + (q8 >> 2)) * 512 + ((2 * q8) & 7)) = cvt_pk_h(y2a * cA + y1a * sA, y2b * cB + y1b * sB); } } }
    }
};
struct EpiELds {
    static constexpr bool PERM = true, AFTER_DRAIN = true;
    __device__ __forceinline__ void fused(f32x4 (&acc)[2][2][4][2], const Unit& u, int wr, int wc, int fr, int fq, PG8_LAS unsigned char* lds, int wid, int lane) const {
        PG8_LAS float* El = (PG8_LAS float*)lds;
#pragma unroll
        for (int ai = 0; ai < 2; ++ai)
#pragma unroll
            for (int m = 0; m < 4; ++m) { const int r = ai * HALF + wr * 64 + m * 16 + fr; PG8_LAS float* rp = El + r * 128 + wc * 32 + 8 * fq;
                *(PG8_LAS f32x4*)rp = acc[ai][0][m][0]; *(PG8_LAS f32x4*)(rp + 4) = acc[ai][0][m][1]; }
    }
};
__device__ __forceinline__ void ssm_chain_unit(const Unit& u, const PG8_LAS unsigned char* lds, bf16_t* USG, const float* AC, float* hand, unsigned* cnt, unsigned* tmo, int lane) {
        const PG8_LAS float* El = (const PG8_LAS float*)lds;
        const int g = u.pn, k4 = u.pm & 3, seqi = g * 2 + (k4 >> 1), p = lane;
        const f32x4 ac = *(const f32x4*)(AC + ((size_t)g * 64 + p) * 4);
        float sr = 0.f, si = 0.f;
        if (k4 & 1) { unsigned sp = 0;
            while (__hip_atomic_load(cnt + 64 * seqi, __ATOMIC_RELAXED, __HIP_MEMORY_SCOPE_AGENT) < 1u) { __builtin_amdgcn_s_sleep(2);
                if (++sp > (1u << 22)) { if (lane == 0) __hip_atomic_store(tmo, 1u, __ATOMIC_RELAXED, __HIP_MEMORY_SCOPE_AGENT); break; } }
            const unsigned long long hv = __hip_atomic_load((const unsigned long long*)(hand + ((size_t)seqi * 64 + p) * 2), __ATOMIC_RELAXED, __HIP_MEMORY_SCOPE_AGENT);
            sr = __uint_as_float((unsigned)hv); si = __uint_as_float((unsigned)(hv >> 32)); }
        bf16_t* srow = USG + (size_t)u.pm * BM * 384 + 256 + 2 * p;
#pragma unroll 8
        for (int t = 0; t < 256; ++t) { const f32x2 e = *(const PG8_LAS f32x2*)(El + t * 128 + 2 * p);
            *(unsigned*)(srow + (size_t)t * 384) = cvt_pk_h(sr, si);
            const float nr = ac[2] * sr - ac[3] * si + e[0], ni = ac[2] * si + ac[3] * sr + e[1]; sr = nr; si = ni; }
        if (!(k4 & 1)) { __hip_atomic_store((unsigned long long*)(hand + ((size_t)seqi * 64 + p) * 2), (unsigned long long)__float_as_uint(sr) | ((unsigned long long)__float_as_uint(si) << 32), __ATOMIC_RELAXED, __HIP_MEMORY_SCOPE_AGENT);
            asm volatile("s_waitcnt vmcnt(0)" ::: "memory");
            if (lane == 0) __hip_atomic_fetch_add(cnt + 64 * seqi, 1u, __ATOMIC_RELAXED, __HIP_MEMORY_SCOPE_AGENT); }
}
struct EpiY {
    static constexpr bool PERM = true, AFTER_DRAIN = false;
    const bf16_t* USG; const float* dskip; bf16_t* YPRE; int seq;
    __device__ __forceinline__ static float gelu_t(float v) { const float z = 0.7978845608028654f * (v + 0.044715f * v * v * v); return v * __builtin_amdgcn_rcpf(1.f + __builtin_amdgcn_exp2f(-2.885390081777927f * z)); }
    __device__ __forceinline__ void operator()(const f32x4 (&acc)[2][2][4][2], const Unit& u, int wr, int wc, int fr, int fq) const {
        const int g = u.pn, k4 = u.pm & 3, bb = k4 >> 1;
        const int i0 = (8 * fq) & 15;
        const f32x4 d0 = *(const f32x4*)(dskip + g * 16 + i0), d1 = *(const f32x4*)(dskip + g * 16 + i0 + 4);
#pragma unroll
        for (int ai = 0; ai < 2; ++ai)
#pragma unroll
            for (int m = 0; m < 4; ++m) { const int r = ai * HALF + wr * 64 + m * 16 + fr; const size_t arow = (size_t)u.pm * BM + r; const int tile = (k4 & 1) * 256 + r;
#pragma unroll
                for (int bj = 0; bj < 2; ++bj) { const int col = bj * HALF + wc * 32 + 8 * fq, t = col >> 4;
                    const u32x4 uv = *(const u32x4*)(USG + arow * 384 + col);
                    const f32x4 v0 = acc[ai][bj][m][0], v1 = acc[ai][bj][m][1];
                    u32x4 w;
                    w.x = cvt_pk_h(gelu_t(v0[0] + d0[0] * h_lo(uv.x)), gelu_t(v0[1] + d0[1] * h_hi(uv.x))); w.y = cvt_pk_h(gelu_t(v0[2] + d0[2] * h_lo(uv.y)), gelu_t(v0[3] + d0[3] * h_hi(uv.y)));
                    w.z = cvt_pk_h(gelu_t(v1[0] + d1[0] * h_lo(uv.z)), gelu_t(v1[1] + d1[1] * h_hi(uv.z))); w.w = cvt_pk_h(gelu_t(v1[2] + d1[2] * h_lo(uv.w)), gelu_t(v1[3] + d1[3] * h_hi(uv.w)));
                    store16_wt(YPRE + ((size_t)bb * seq + (size_t)tile * 16 + t) * 512 + g * 16 + i0, w); } }
    }
};
struct EpiGlu {
    static constexpr bool PERM = true, AFTER_DRAIN = false;
    const bf16_t* ypre; const bf16_t* proj; int ldp, zcol0; const float* bglu; bf16_t* ycat;
    __device__ __forceinline__ void operator()(const f32x4 (&acc)[2][2][4][2], const Unit& u, int wr, int wc, int fr, int fq) const {
        const int row0 = u.pm * BM + wr * 64 + fr, col0 = u.pn * BM + wc * 32 + 8 * fq;
        f32x4 bv[2][2];
#pragma unroll
        for (int bj = 0; bj < 2; ++bj)
#pragma unroll
            for (int n = 0; n < 2; ++n) bv[bj][n] = *(const f32x4*)(bglu + col0 + bj * HALF + 4 * n);
#pragma unroll
        for (int ai = 0; ai < 2; ++ai)
#pragma unroll
            for (int m = 0; m < 4; ++m) { const size_t row = (size_t)(row0 + ai * HALF + m * 16);
#pragma unroll
                for (int bj = 0; bj < 2; ++bj) { const int col = col0 + bj * HALF;
                    const u32x4 yv = __builtin_nontemporal_load((const u32x4*)(ypre + row * 512 + col)); const u32x4 zv = __builtin_nontemporal_load((const u32x4*)(proj + row * ldp + zcol0 + col));
                    const f32x4 t0 = acc[ai][bj][m][0] + bv[bj][0], t1 = acc[ai][bj][m][1] + bv[bj][1];
                    u32x4 w;
                    w.x = cvt_pk_h(h_lo(yv.x) * fsigm(t0[0]) * fsilu(h_lo(zv.x)), h_hi(yv.x) * fsigm(t0[1]) * fsilu(h_hi(zv.x)));
                    w.y = cvt_pk_h(h_lo(yv.y) * fsigm(t0[2]) * fsilu(h_lo(zv.y)), h_hi(yv.y) * fsigm(t0[3]) * fsilu(h_hi(zv.y)));
                    w.z = cvt_pk_h(h_lo(yv.z) * fsigm(t1[0]) * fsilu(h_lo(zv.z)), h_hi(yv.z) * fsigm(t1[1]) * fsilu(h_hi(zv.z)));
                    w.w = cvt_pk_h(h_lo(yv.w) * fsigm(t1[2]) * fsilu(h_lo(zv.w)), h_hi(yv.w) * fsigm(t1[3]) * fsilu(h_hi(zv.w)));
                    store16_wt(ycat + row * 1024 + col, w); } }
    }
};
struct EpiOutRows {
    static constexpr bool PERM = false, AFTER_DRAIN = true;
    const float* x; const float* gate; int gate_stride, rows_per_batch; float* out;
    __device__ __forceinline__ static int slot(int r, int s16) { return r * 1024 + ((s16 ^ (r & 15)) << 4); }
    __device__ __forceinline__ void fused(f32x4 (&acc)[2][2][4][2], const Unit& u, int wr, int wc, int fr, int fq, PG8_LAS unsigned char* lds, int wid, int lane) const {
        const int b = (u.pm * BM) / rows_per_batch;
        const f32x4 gv = *(const f32x4*)(gate + (size_t)b * gate_stride + u.pn * BM + 4 * lane);
#pragma unroll
        for (int ai = 0; ai < 2; ++ai) {
#pragma unroll
            for (int m = 0; m < 4; ++m) { const int rl = wr * 64 + m * 16 + fr;
#pragma unroll
                for (int bj = 0; bj < 2; ++bj)
#pragma unroll
                    for (int n = 0; n < 2; ++n) *(PG8_LAS f32x4*)(lds + slot(rl, 32 * bj + 8 * wc + 4 * n + fq)) = acc[ai][bj][m][n]; }
            asm volatile("s_waitcnt lgkmcnt(0)" ::: "memory"); __builtin_amdgcn_s_barrier(); asm volatile("" ::: "memory");
            const size_t g0 = ((size_t)u.pm * BM + ai * HALF + wid * 16) * 1024 + u.pn * BM + 4 * lane;
#pragma unroll
            for (int i0 = 0; i0 < 16; i0 += 8) { f32x4 xs[8];
#pragma unroll
                for (int i = 0; i < 8; ++i) xs[i] = __builtin_nontemporal_load((const f32x4*)(x + g0 + (size_t)(i0 + i) * 1024));
#pragma unroll
                for (int i = 0; i < 8; ++i) { const f32x4 v = *(const PG8_LAS f32x4*)(lds + slot(wid * 16 + i0 + i, lane)); __builtin_nontemporal_store(xs[i] + gv * v, (f32x4*)(out + g0 + (size_t)(i0 + i) * 1024)); } }
            if (ai == 0) { asm volatile("s_waitcnt lgkmcnt(0)" ::: "memory"); __builtin_amdgcn_s_barrier(); asm volatile("" ::: "memory"); }
        }
    }
};
template <class Epi, class Sched, bool ALIGN_EPI = false, bool SP2 = false>
__device__ __forceinline__ void gemm_phase(PG8_LAS unsigned char* lds, const Gemm g, const Sched& S, const Epi& E) {
    int tid_ = threadIdx.x; asm volatile("" : "+v"(tid_));
    const int tid = tid_, wid = __builtin_amdgcn_readfirstlane(tid >> 6), lane = tid & 63, wr = wid >> 2, wc = wid & 3, fr = lane & 15, fq = lane >> 4;
    const int K = g.K, nt = K / BK;
    unsigned voffA[2], voffB[2];
#pragma unroll
    for (int i = 0; i < 2; ++i) { int R, C; stage_rc(tid * 16 + i * 8192, R, C); const int Rb = Epi::PERM ? ((R & ~31) + perm32(R & 31)) : R;
        voffA[i] = (unsigned)(R * g.lda + C) * 2u; voffB[i] = (unsigned)(Rb * K + C) * 2u; }
    const size_t kstep = (size_t)(BK * 2);
    const size_t hstepA = (size_t)HALF * g.lda * 2, hstepB = (size_t)HALF * K * 2;
    const size_t tstepA = 2 * hstepA, tstepB = 2 * hstepB;
    const unsigned ldsw = (unsigned)wid * 1024u;
    const int aoff = lds_byte(wr * 64 + fr, fq * 8), boff = lds_byte(wc * 32 + fr, fq * 8);
#define PG8_SA(b, h) (((b) * 2 + (h)) * HTB)
#define PG8_SB(b, h) ((4 + (b) * 2 + (h)) * HTB)
#define PG8_STAGE(bufoff, gbase, voff) do { _Pragma("unroll") for (int _i = 0; _i < 2; ++_i) \
        __builtin_amdgcn_global_load_lds((const unsigned*)((const char*)(gbase) + (voff)[_i]), (PG8_LAS unsigned*)(lds + (bufoff) + ldsw + _i * 8192), 16, 0, 0); } while (0)
#define PG8_LDA(dst, b, h) do { _Pragma("unroll") for (int m = 0; m < 4; ++m) _Pragma("unroll") for (int k = 0; k < 2; ++k) dst[m][k] = *(const PG8_LAS bf16x8*)(lds + PG8_SA(b, h) + aoff + m * 2048 + k * 1024); } while (0)
#define PG8_LDB(dst, b, h) do { _Pragma("unroll") for (int n = 0; n < 2; ++n) _Pragma("unroll") for (int k = 0; k < 2; ++k) dst[n][k] = *(const PG8_LAS bf16x8*)(lds + PG8_SB(b, h) + boff + n * 2048 + k * 1024); } while (0)
#define PG8_MMA(ai, bj, At, Bt) do { __builtin_amdgcn_s_setprio(1); _Pragma("unroll") for (int m = 0; m < 4; ++m) _Pragma("unroll") for (int n = 0; n < 2; ++n) _Pragma("unroll") for (int k = 0; k < 2; ++k) \
        acc[ai][bj][m][n] = __builtin_amdgcn_mfma_f32_16x16x32_f16(Bt[n][k], At[m][k], acc[ai][bj][m][n], 0, 0, 0); __builtin_amdgcn_s_setprio(0); } while (0)
#define PG8_WAIT_V(n) asm volatile("s_waitcnt vmcnt(" #n ")" ::: "memory")
#define PG8_WAIT_L(n) asm volatile("s_waitcnt lgkmcnt(" #n ")" ::: "memory")
#define PG8_BAR __builtin_amdgcn_s_barrier()
#define PG8_SCHED __builtin_amdgcn_sched_barrier(0)
    Unit cur, nxt; int ui = 0;
    if (!S.next(0, cur)) return;
    f32x4 acc[2][2][4][2];
#pragma unroll
    for (int a = 0; a < 2; ++a)
#pragma unroll
        for (int b = 0; b < 2; ++b)
#pragma unroll
            for (int m = 0; m < 4; ++m)
#pragma unroll
                for (int n = 0; n < 2; ++n) acc[a][b][m][n] = (f32x4){0.f, 0.f, 0.f, 0.f};
    bf16x8 At[4][2], B0[2][2], B1[2][2];
    const char* cA = (const char*)g.A + (size_t)cur.pm * tstepA; const char* cB = (const char*)g.Bt + (size_t)cur.pn * tstepB;
    S.a_ready(cur);
    if constexpr (SP2) {
        PG8_STAGE(PG8_SB(0, 0), cB, voffB); PG8_STAGE(PG8_SB(0, 1), cB + hstepB, voffB); PG8_STAGE(PG8_SA(0, 0), cA, voffA); PG8_STAGE(PG8_SA(0, 1), cA + hstepA, voffA);
        if (wr == 1) PG8_BAR;
        PG8_WAIT_V(2); PG8_BAR;
        PG8_STAGE(PG8_SB(1, 0), cB + kstep, voffB); PG8_STAGE(PG8_SA(1, 0), cA + kstep, voffA); PG8_STAGE(PG8_SB(1, 1), cB + hstepB + kstep, voffB);
        PG8_WAIT_V(6); PG8_BAR;
    } else {
        PG8_STAGE(PG8_SB(0, 0), cB, voffB); PG8_STAGE(PG8_SA(0, 0), cA, voffA); PG8_STAGE(PG8_SB(0, 1), cB + hstepB, voffB); PG8_STAGE(PG8_SA(0, 1), cA + hstepA, voffA);
        if (wr == 1) PG8_BAR;
        PG8_WAIT_V(4); PG8_BAR;
        PG8_STAGE(PG8_SB(1, 0), cB + kstep, voffB); PG8_STAGE(PG8_SA(1, 0), cA + kstep, voffA); PG8_STAGE(PG8_SB(1, 1), cB + hstepB + kstep, voffB);
        PG8_WAIT_V(6); PG8_BAR;
    }
    for (;;) {
        const bool has_next = S.next(ui + 1, nxt);
        const char* nA = has_next ? (const char*)g.A + (size_t)nxt.pm * tstepA : cA; const char* nB = has_next ? (const char*)g.Bt + (size_t)nxt.pn * tstepB : cB;
        for (int t = 0; t < nt; t += 2) {
            const bool last = (t == nt - 2);
            const char* a1 = cA + (size_t)(t + 1) * kstep;
            const char* a2 = last ? nA : cA + (size_t)(t + 2) * kstep; const char* b2 = last ? nB : cB + (size_t)(t + 2) * kstep;
            const char* a3 = a2 + kstep; const char* b3 = b2 + kstep;
            if (last && has_next) S.a_ready(nxt);
            if constexpr (SP2) {
            PG8_LDB(B0, 0, 0); PG8_LDB(B1, 0, 1); PG8_SCHED; PG8_LDA(At, 0, 0); PG8_STAGE(PG8_SA(1, 1), a1 + hstepA, voffA);
            PG8_WAIT_V(8); PG8_WAIT_L(0); PG8_BAR; PG8_MMA(0, 0, At, B0); PG8_MMA(0, 1, At, B1); PG8_BAR; PG8_SCHED;
            PG8_LDA(At, 0, 1); PG8_STAGE(PG8_SB(0, 0), b2, voffB); PG8_STAGE(PG8_SB(0, 1), b2 + hstepB, voffB); PG8_STAGE(PG8_SA(0, 0), a2, voffA);
            PG8_WAIT_V(8); PG8_WAIT_L(0); PG8_BAR; PG8_MMA(1, 0, At, B0); PG8_MMA(1, 1, At, B1); PG8_BAR; PG8_SCHED;
            PG8_LDB(B0, 1, 0); PG8_LDB(B1, 1, 1); PG8_SCHED; PG8_LDA(At, 1, 0); PG8_STAGE(PG8_SA(0, 1), a2 + hstepA, voffA);
            PG8_WAIT_V(8); PG8_WAIT_L(0); PG8_BAR; PG8_MMA(0, 0, At, B0); PG8_MMA(0, 1, At, B1); PG8_BAR; PG8_SCHED;
            PG8_LDA(At, 1, 1); PG8_STAGE(PG8_SB(1, 0), b3, voffB); PG8_STAGE(PG8_SB(1, 1), b3 + hstepB, voffB); PG8_STAGE(PG8_SA(1, 0), a3, voffA);
            PG8_WAIT_V(8); PG8_WAIT_L(0); PG8_BAR; PG8_MMA(1, 0, At, B0); PG8_MMA(1, 1, At, B1); PG8_BAR; PG8_SCHED;
            } else {
            PG8_LDB(B0, 0, 0); PG8_SCHED; PG8_LDA(At, 0, 0); PG8_STAGE(PG8_SA(1, 1), a1 + hstepA, voffA);
            PG8_WAIT_L(8); PG8_BAR; PG8_WAIT_L(0); PG8_MMA(0, 0, At, B0); PG8_BAR; PG8_SCHED;
            PG8_LDB(B1, 0, 1); PG8_STAGE(PG8_SB(0, 0), b2, voffB);
            PG8_BAR; PG8_WAIT_L(0); PG8_MMA(0, 1, At, B1); PG8_BAR;
            PG8_LDA(At, 0, 1); PG8_STAGE(PG8_SA(0, 0), a2, voffA);
            PG8_BAR; PG8_WAIT_L(0); PG8_MMA(1, 0, At, B0); PG8_BAR; PG8_SCHED;
            PG8_STAGE(PG8_SB(0, 1), b2 + hstepB, voffB);
            PG8_WAIT_V(6); PG8_BAR; PG8_MMA(1, 1, At, B1); PG8_BAR;
            PG8_LDB(B0, 1, 0); PG8_SCHED; PG8_LDA(At, 1, 0); PG8_STAGE(PG8_SA(0, 1), a2 + hstepA, voffA);
            PG8_WAIT_L(8); PG8_BAR; PG8_WAIT_L(0); PG8_MMA(0, 0, At, B0); PG8_BAR; PG8_SCHED;
            PG8_LDB(B1, 1, 1); PG8_STAGE(PG8_SB(1, 0), b3, voffB);
            PG8_BAR; PG8_WAIT_L(0); PG8_MMA(0, 1, At, B1); PG8_BAR;
            PG8_LDA(At, 1, 1); PG8_STAGE(PG8_SA(1, 0), a3, voffA);
            PG8_BAR; PG8_WAIT_L(0); PG8_MMA(1, 0, At, B0); PG8_BAR; PG8_SCHED;
            PG8_STAGE(PG8_SB(1, 1), b3 + hstepB, voffB);
            PG8_WAIT_V(6); PG8_BAR; PG8_MMA(1, 1, At, B1); PG8_BAR;
            }
        }
        if constexpr (ALIGN_EPI) { if (wr == 0) PG8_BAR; }
        if constexpr (!Epi::AFTER_DRAIN) { E(acc, cur, wr, wc, fr, fq); S.done(cur); }
        if (!has_next) break;
#pragma unroll
        for (int a = 0; a < 2; ++a)
#pragma unroll
            for (int b = 0; b < 2; ++b)
#pragma unroll
                for (int m = 0; m < 4; ++m)
#pragma unroll
                    for (int n = 0; n < 2; ++n) acc[a][b][m][n] = (f32x4){0.f, 0.f, 0.f, 0.f};
        cur = nxt; cA = nA; cB = nB; ++ui;
        if constexpr (ALIGN_EPI) { if (wr == 1) PG8_BAR; }
    }
    PG8_WAIT_V(0);
    if constexpr (!ALIGN_EPI) { if (wr == 0) PG8_BAR; }
    PG8_BAR;
    if constexpr (Epi::AFTER_DRAIN) { E.fused(acc, cur, wr, wc, fr, fq, lds, wid, lane); S.done(cur); }
#undef PG8_SA
#undef PG8_SB
#undef PG8_STAGE
#undef PG8_LDA
#undef PG8_LDB
#undef PG8_MMA
#undef PG8_WAIT_V
#undef PG8_WAIT_L
#undef PG8_BAR
#undef PG8_SCHED
}
}

namespace att {
using h16x8 = __attribute__((ext_vector_type(8))) _Float16;
using s16x4 = __attribute__((ext_vector_type(4))) short;
using f32x16 = __attribute__((ext_vector_type(16))) float;
using u32x4 = __attribute__((ext_vector_type(4))) unsigned;
typedef float f32x2_t __attribute__((ext_vector_type(2))); typedef _Float16 f16x2_t __attribute__((ext_vector_type(2)));
constexpr int NW = 8, QBLK = 32, KVBLK = 64, QB = 256, ASEQ = 8192;
constexpr int LDQ = 768, LDK = 1024, LDV = 512;
constexpr float SCALE = 0.10206207261596575f;
constexpr float THR = 8.f;
#define SBAR() __builtin_amdgcn_sched_barrier(0)
__device__ __forceinline__ int crow(int r, int hi) { return (r & 3) + 8 * (r >> 2) + 4 * hi; }
__device__ __forceinline__ unsigned cvtpk(float lo, float hi) { const f16x2_t v = __builtin_convertvector((f32x2_t){lo, hi}, f16x2_t); return __builtin_bit_cast(unsigned, v); }

__device__ __forceinline__ void cmask(f32x16& p0, f32x16& p1, int jb, int qrel, int hi) {
  const float NEG = -INFINITY; const int kb = 64 * jb + 4 * hi;
#pragma unroll
  for (int r = 0; r < 16; ++r) { const int kv = kb + (r & 3) + 8 * (r >> 2); if (kv > qrel) p0[r] = NEG; if (kv + 32 > qrel) p1[r] = NEG; }
}
constexpr int KT_BYTES = 12288, VT_BYTES = 8192, NKS = 3, NVS = 4;
constexpr int LDS_V0 = NKS * KT_BYTES, LDS_WSC = LDS_V0 + NVS * VT_BYTES;
constexpr int LDS_OST = LDS_WSC + NW * 64 * 4;
constexpr int LDS_ATT2 = LDS_OST + NW * 4096;
typedef __attribute__((address_space(3))) unsigned char* lds3_t;
__device__ __forceinline__ unsigned gate2(unsigned ow, unsigned zw) {
  const f16x2_t o2 = __builtin_bit_cast(f16x2_t, ow), z2 = __builtin_bit_cast(f16x2_t, zw); const float z0 = (float)z2[0], z1 = (float)z2[1];
  return cvtpk((float)o2[0] * (z0 * __builtin_amdgcn_rcpf(1.f + __builtin_amdgcn_exp2f(-1.4426950408889634f * z0))), (float)o2[1] * (z1 * __builtin_amdgcn_rcpf(1.f + __builtin_amdgcn_exp2f(-1.4426950408889634f * z1))));
}
#define PIN(x) asm volatile("" : "+v"(x))
#define MFMAH(a, b, c) __builtin_amdgcn_mfma_f32_32x32x16_f16(a, b, c, 0, 0, 0)
typedef __attribute__((address_space(3))) const char* lds_cptr;
typedef short v4i16_t __attribute__((ext_vector_type(4)));
__device__ __forceinline__ void kload2(h16x8* kf, lds_cptr kp, int d0) { kf[2 * d0] = *(const __attribute__((address_space(3))) h16x8*)(kp + d0 * 2048); kf[2 * d0 + 1] = *(const __attribute__((address_space(3))) h16x8*)(kp + d0 * 2048 + 512); }
__device__ __forceinline__ s16x4 vtr(lds_cptr p) { return __builtin_bit_cast(s16x4, __builtin_amdgcn_ds_read_tr16_b64_v4i16((__attribute__((address_space(3))) v4i16_t*)p)); }
#define MX3(a, b, c) __builtin_fmaxf(__builtin_fmaxf((a), (b)), (c))
__device__ __forceinline__ float rowmax(const f32x16& p0, const f32x16& p1) {
  float a = MX3(p0[0], p0[1], p1[0]), b = MX3(p0[2], p0[3], p1[1]); a = MX3(a, p1[2], p1[3]);
#pragma unroll
  for (int r = 4; r < 16; r += 4) { a = MX3(a, p0[r], p0[r + 1]); b = MX3(b, p0[r + 2], p0[r + 3]); a = MX3(a, p1[r], p1[r + 1]); b = MX3(b, p1[r + 2], p1[r + 3]); }
  float m = __builtin_fmaxf(a, b); auto rr = __builtin_amdgcn_permlane32_swap(__float_as_uint(m), __float_as_uint(m), false, false);
  return __builtin_fmaxf(__uint_as_float(rr[0]), __uint_as_float(rr[1])); }
__device__ __forceinline__ void attn_unit(int b, int h, int qb, const unsigned short* __restrict__ Q, const unsigned short* __restrict__ KIMG, const unsigned short* __restrict__ VIMG,
                                          const unsigned short* __restrict__ PROJ, int ldp, int zcol0, unsigned short* __restrict__ YCAT, char* lds, lds3_t lds3, unsigned* done_cnt, unsigned* z_cnt, unsigned* tmo,
                                          int next_qword, int next_slot_off) {
  int tid_ = threadIdx.x; asm volatile("" : "+v"(tid_));
  const int tid = tid_, lane = tid & 63, r32 = lane & 31, hi = lane >> 5; const int wid = __builtin_amdgcn_readfirstlane(tid >> 6);
  float* ws = (float*)(lds + LDS_WSC) + wid * 64; float* li_l = ws; float* al_l = ws + 32;
  const long rowbase = (long)b * ASEQ; const int q0 = qb * QB;
  const int NT = (q0 + QB) / KVBLK;
  const char* Kg = (const char*)KIMG + (size_t)(b * 8 + h) * 128 * KT_BYTES;
  const char* Vg = (const char*)VIMG + (size_t)(b * 8 + h) * 128 * VT_BYTES;
  const unsigned lo16 = (unsigned)lane * 16u;
  const lds_cptr kp0 = (lds_cptr)lds3 + hi * 1024 + r32 * 16;
  const lds_cptr vp0 = (lds_cptr)lds3 + LDS_V0 + ((lane >> 4) & 1) * 32 + (lane & 3) * 8 + (4 * hi + ((lane & 15) >> 2)) * 64;
  constexpr float THRL = THR * 1.4426950408889634f;
#define GLDS(gp, loff) do { const char* gu_ = (gp); asm volatile("" : "+s"(gu_)); __builtin_amdgcn_global_load_lds((const unsigned*)(gu_ + lo16), (__attribute__((address_space(3))) unsigned*)(lds3 + (loff)), 16, 0, 0); } while (0)
#define DMA_K(t, slot) do { const char* kg_ = Kg + (size_t)(t) * KT_BYTES; const int ko_ = (slot) * KT_BYTES; GLDS(kg_ + wid * 1024, ko_ + wid * 1024); if (wid < 4) GLDS(kg_ + (8 + wid) * 1024, ko_ + (8 + wid) * 1024); } while (0)
#define DMA_V(t, slot) do { GLDS(Vg + (size_t)(t) * VT_BYTES + wid * 1024, LDS_V0 + (slot) * VT_BYTES + wid * 1024); } while (0)
#define WAITB(A, B) do { if (wid < 4) asm volatile("s_waitcnt vmcnt(" #A ") lgkmcnt(0)\n\ts_barrier" ::: "memory"); else asm volatile("s_waitcnt vmcnt(" #B ") lgkmcnt(0)\n\ts_barrier" ::: "memory"); } while (0)
  float mhat = 0.f, l_reg = 0.f; f32x16 o[2]; o[0] = f32x16{}; o[1] = f32x16{}; h16x8 qr[6]; f32x16 negm = {}; PIN(negm);
  const int qrel = wid * QBLK + r32; bool resc = false;
  f32x16 pA0, pA1, pB0, pB1; h16x8 kf[12]; s16x4 vlo[8], vhi[8]; u32x4 pw0, pw1, pw2, pw3;
  int s_prev = 0, s_cur = 0, s_next = 1;
#define ROT() do { s_prev = s_cur; s_cur = s_next; s_next = (s_next == 2) ? 0 : s_next + 1; } while (0)
#define RESC() do { if (resc) { _Pragma("unroll") for (int d_ = 0; d_ < 2; ++d_) _Pragma("unroll") for (int r = 0; r < 16; ++r) o[d_][r] *= al_l[crow(r, hi)]; } } while (0)
  DMA_K(0, 0); DMA_V(0, 0); DMA_K(1, 1);
  { const unsigned short* Qw = Q + (rowbase + q0 + wid * QBLK + r32) * LDQ + h * 96 + hi * 8;
#pragma unroll
    for (int d0 = 0; d0 < 6; ++d0) qr[d0] = __builtin_nontemporal_load(reinterpret_cast<const h16x8*>(Qw + d0 * 16)); }
  DMA_K(2, 2);
  WAITB(2, 1);
#pragma unroll
  for (int d0 = 0; d0 < 6; ++d0) kload2(kf, kp0, d0);
  pA0 = MFMAH(kf[0], qr[0], negm); pA1 = MFMAH(kf[1], qr[0], negm);
#pragma unroll
  for (int d0 = 1; d0 < 6; ++d0) { pA0 = MFMAH(kf[2 * d0], qr[d0], pA0); pA1 = MFMAH(kf[2 * d0 + 1], qr[d0], pA1); }
  if (NT == 4) cmask(pA0, pA1, 0, qrel, hi);
  { const float rm = rowmax(pA0, pA1); mhat = rm;
#pragma unroll
    for (int r = 0; r < 16; ++r) negm[r] = -rm;
    PIN(negm);
#pragma unroll
    for (int r = 0; r < 16; ++r) { pA0[r] = __builtin_amdgcn_exp2f(pA0[r] - rm); pA1[r] = __builtin_amdgcn_exp2f(pA1[r] - rm); } }
  WAITB(0, 0);
  DMA_K(3, 0); DMA_V(1, 1); ROT();
#pragma unroll
  for (int d0 = 0; d0 < 6; ++d0) kload2(kf, kp0 + s_cur * KT_BYTES, d0);
  WAITB(3, 2);
#define PKW(P, i) cvtpk(P[i], P[i + 1])
#define PAF(k) __builtin_bit_cast(h16x8, pw##k)
#define VFR(i) __builtin_bit_cast(h16x8, (__attribute__((ext_vector_type(8))) short){vlo[i][0], vlo[i][1], vlo[i][2], vlo[i][3], vhi[i][0], vhi[i][1], vhi[i][2], vhi[i][3]})
#define VRD(i) do { vlo[i] = vtr(vp_ + (((i) >> 2) * 4096 + ((i) & 3) * 1024)); vhi[i] = vtr(vp_ + (((i) >> 2) * 4096 + ((i) & 3) * 1024 + 512)); } while (0)
#define KRD(G, d0) do { if (G) { kload2(kf, kp0 + s_next * KT_BYTES, d0); SBAR(); } } while (0)
#define GAPA(MF, a0, a1, a2, W0, W1, PW) do { MF; sacc += a0; sacc += a1; sacc += a2; W0; W1; PIN(PW); PIN(sacc); SBAR(); } while (0)
#define GAPA3(MF, a0, a1, a2) do { MF; sacc += a0; sacc += a1; sacc += a2; PIN(sacc); SBAR(); } while (0)
#define GAPB(MF, X, i) do { MF; X[i] = __builtin_amdgcn_exp2f(X[i]); X[i + 1] = __builtin_amdgcn_exp2f(X[i + 1]); X[i + 2] = __builtin_amdgcn_exp2f(X[i + 2]); X[i + 3] = __builtin_amdgcn_exp2f(X[i + 3]); PIN(X); SBAR(); } while (0)
#define STEP(C0, C1, P0, P1, t, MASK, GK, GV, GL) do { SBAR(); \
    const lds_cptr vp_ = vp0 + s_prev * VT_BYTES; \
    VRD(0); SBAR(); float sacc = P0[0] + P0[1]; \
                    GAPA(C0 = MFMAH(kf[0], qr[0], negm), P0[2], P0[3], P0[4],     pw0[0] = PKW(P0, 0),  pw0[1] = PKW(P0, 2),  pw0); \
    VRD(4); SBAR(); GAPA(C1 = MFMAH(kf[1], qr[0], negm), P0[5], P0[6], P0[7],     pw0[2] = PKW(P0, 4),  pw0[3] = PKW(P0, 6),  pw0); \
    VRD(1); SBAR(); GAPA(C0 = MFMAH(kf[2], qr[1], C0),   P0[8], P0[9], P0[10],    pw1[0] = PKW(P0, 8),  pw1[1] = PKW(P0, 10), pw1); \
    VRD(5); SBAR(); GAPA(C1 = MFMAH(kf[3], qr[1], C1),   P0[11], P0[12], P0[13],  pw1[2] = PKW(P0, 12), pw1[3] = PKW(P0, 14), pw1); \
    VRD(2); SBAR(); GAPA(C0 = MFMAH(kf[4], qr[2], C0),   P0[14], P0[15], P1[0],   pw2[0] = PKW(P1, 0),  pw2[1] = PKW(P1, 2),  pw2); \
    VRD(6); SBAR(); GAPA(C1 = MFMAH(kf[5], qr[2], C1),   P1[1], P1[2], P1[3],     pw2[2] = PKW(P1, 4),  pw2[3] = PKW(P1, 6),  pw2); \
                    GAPA(C0 = MFMAH(kf[6], qr[3], C0),   P1[4], P1[5], P1[6],     pw3[0] = PKW(P1, 8),  pw3[1] = PKW(P1, 10), pw3); \
                    GAPA(C1 = MFMAH(kf[7], qr[3], C1),   P1[7], P1[8], P1[9],     pw3[2] = PKW(P1, 12), pw3[3] = PKW(P1, 14), pw3); \
    GAPA3(C0 = MFMAH(kf[8], qr[4], C0), P1[10], P1[11], P1[12]); \
    GAPA3(C1 = MFMAH(kf[9], qr[4], C1), P1[13], P1[14], P1[15]); \
    C0 = MFMAH(kf[10], qr[5], C0); C1 = MFMAH(kf[11], qr[5], C1); \
    l_reg += sacc; \
    if (GK) DMA_K((t) + 3, s_cur); if (GV) DMA_V((t) + 1, s_next);                                                         \
    if (MASK) cmask(C0, C1, (t) - (NT - 4), qrel, hi); \
    { const float rm = rowmax(C0, C1); resc = false;                                                                       \
      if (__builtin_expect(__any(rm > THRL), 0)) { const float dl = __builtin_fmaxf(rm, 0.f); mhat += dl;                  \
          const float f = __builtin_amdgcn_exp2f(-dl); l_reg *= f; if (hi == 0) al_l[r32] = f; resc = true; \
          _Pragma("unroll") for (int r = 0; r < 16; ++r) { C0[r] -= dl; C1[r] -= dl; } \
          _Pragma("unroll") for (int r = 0; r < 16; ++r) negm[r] = -mhat; \
          PIN(negm); } } \
    SBAR(); \
    VRD(3); SBAR(); KRD(GL, 0); GAPB(o[0] = MFMAH(PAF(0), VFR(0), o[0]), C0, 0);  VRD(7); SBAR(); KRD(GL, 1); GAPB(o[1] = MFMAH(PAF(0), VFR(4), o[1]), C0, 4);     \
    KRD(GL, 2); GAPB(o[0] = MFMAH(PAF(1), VFR(1), o[0]), C0, 8);  KRD(GL, 3); GAPB(o[1] = MFMAH(PAF(1), VFR(5), o[1]), C0, 12); \
    KRD(GL, 4); GAPB(o[0] = MFMAH(PAF(2), VFR(2), o[0]), C1, 0);  KRD(GL, 5); GAPB(o[1] = MFMAH(PAF(2), VFR(6), o[1]), C1, 4); \
    GAPB(o[0] = MFMAH(PAF(3), VFR(3), o[0]), C1, 8);              GAPB(o[1] = MFMAH(PAF(3), VFR(7), o[1]), C1, 12); \
    } while (0)
  int t = 1;
  for (; t + 5 < NT; t += 2) {
    STEP(pB0, pB1, pA0, pA1, t, false, true, true, true);     WAITB(3, 2); RESC(); ROT();
    STEP(pA0, pA1, pB0, pB1, t + 1, false, true, true, true); WAITB(3, 2); RESC(); ROT();
  }
#define ENDW(tt) do { if ((tt) + 3 < NT) { WAITB(3, 2); } else if ((tt) + 2 < NT) { WAITB(1, 1); } else { WAITB(0, 0); } } while (0)
  for (; t + 1 < NT; t += 2) {
    STEP(pB0, pB1, pA0, pA1, t, true, (t + 3 < NT), (t + 1 < NT), (t + 1 < NT));         ENDW(t);     RESC(); ROT();
    STEP(pA0, pA1, pB0, pB1, t + 1, true, (t + 4 < NT), (t + 2 < NT), (t + 2 < NT));     ENDW(t + 1); RESC(); ROT();
  }
  STEP(pB0, pB1, pA0, pA1, NT - 1, true, false, false, false); RESC();
  { float sacc = pB0[0] + pB0[1];
#pragma unroll
    for (int r = 2; r < 16; ++r) sacc += pB0[r];
#pragma unroll
    for (int r = 0; r < 16; ++r) sacc += pB1[r];
    l_reg += sacc;
    pw0 = (u32x4){PKW(pB0, 0), PKW(pB0, 2), PKW(pB0, 4), PKW(pB0, 6)}; pw1 = (u32x4){PKW(pB0, 8), PKW(pB0, 10), PKW(pB0, 12), PKW(pB0, 14)};
    pw2 = (u32x4){PKW(pB1, 0), PKW(pB1, 2), PKW(pB1, 4), PKW(pB1, 6)}; pw3 = (u32x4){PKW(pB1, 8), PKW(pB1, 10), PKW(pB1, 12), PKW(pB1, 14)};
    const lds_cptr vp_ = vp0 + s_cur * VT_BYTES;
#pragma unroll
    for (int i = 0; i < 8; ++i) VRD(i);
    o[0] = MFMAH(PAF(0), VFR(0), o[0]); o[1] = MFMAH(PAF(0), VFR(4), o[1]); o[0] = MFMAH(PAF(1), VFR(1), o[0]); o[1] = MFMAH(PAF(1), VFR(5), o[1]);
    o[0] = MFMAH(PAF(2), VFR(2), o[0]); o[1] = MFMAH(PAF(2), VFR(6), o[1]); o[0] = MFMAH(PAF(3), VFR(3), o[0]); o[1] = MFMAH(PAF(3), VFR(7), o[1]); }
  { auto rr = __builtin_amdgcn_permlane32_swap(__float_as_uint(l_reg), __float_as_uint(l_reg), false, false); l_reg = __uint_as_float(rr[0]) + __uint_as_float(rr[1]); }
  if (hi == 0) li_l[r32] = l_reg; asm volatile("s_waitcnt lgkmcnt(0)" ::: "memory");
  float rli[16];
#pragma unroll
  for (int r = 0; r < 16; ++r) rli[r] = __builtin_amdgcn_rcpf(li_l[crow(r, hi)]);
  if (z_cnt && wid == 0) { unsigned sp = 0;
    while (__hip_atomic_load(z_cnt, __ATOMIC_RELAXED, __HIP_MEMORY_SCOPE_AGENT) < 2u) { __builtin_amdgcn_s_sleep(2); if (++sp > (1u << 22)) { if (lane == 0) __hip_atomic_store(tmo, 1u, __ATOMIC_RELAXED, __HIP_MEMORY_SCOPE_AGENT); break; } }
    __builtin_amdgcn_fence(__ATOMIC_ACQUIRE, "agent"); asm volatile("s_waitcnt vmcnt(0)" ::: "memory"); }
  unsigned nxt_ = 0u; if (next_qword >= 0 && tid == 0) nxt_ = __hip_atomic_fetch_add(tmo + next_qword + 64 * (blockIdx.x & 7u), 1u, __ATOMIC_RELAXED, __HIP_MEMORY_SCOPE_AGENT);
  asm volatile("s_waitcnt lgkmcnt(0)\n\ts_barrier" ::: "memory");
  const long orow0 = rowbase + q0 + wid * QBLK;
  { unsigned short* stg = (unsigned short*)(lds + LDS_OST) + wid * 2048;
#pragma unroll
    for (int r = 0; r < 16; ++r) { const int orow = crow(r, hi);
#pragma unroll
      for (int d0 = 0; d0 < 2; ++d0) stg[orow * 64 + d0 * 32 + r32] = __builtin_bit_cast(unsigned short, (_Float16)(o[d0][r] * rli[r])); }
    asm volatile("s_waitcnt lgkmcnt(0)" ::: "memory");
#pragma unroll
    for (int i = 0; i < 4; ++i) { const int row = i * 8 + (lane >> 3), ch = lane & 7; const long grow = orow0 + row;
      const u32x4 ov = *(const u32x4*)(stg + row * 64 + ch * 8); const u32x4 zv = __builtin_nontemporal_load((const u32x4*)(PROJ + grow * ldp + zcol0 + h * 64 + ch * 8));
      u32x4 w;
      w.x = gate2(ov.x, zv.x); w.y = gate2(ov.y, zv.y); w.z = gate2(ov.z, zv.z); w.w = gate2(ov.w, zv.w);
      store16_wt(YCAT + grow * 1024 + 512 + h * 64 + ch * 8, w); } }
  if (next_qword >= 0 && tid == 0) *(volatile __attribute__((address_space(3))) unsigned*)(lds3 + next_slot_off) = nxt_;
  asm volatile("s_waitcnt vmcnt(0) lgkmcnt(0)\n\ts_barrier" ::: "memory");
  if (tid == 0) __hip_atomic_fetch_add(done_cnt, 1u, __ATOMIC_RELAXED, __HIP_MEMORY_SCOPE_AGENT);
#undef GLDS
#undef DMA_K
#undef DMA_V
#undef WAITB
#undef ROT
#undef RESC
#undef PKW
#undef PAF
#undef VFR
#undef VRD
#undef KRD
#undef GAPA
#undef GAPA3
#undef GAPB
#undef STEP
#undef ENDW
}
#undef PIN
#undef MFMAH
#undef MX3
#undef SBAR
}

#define GAS __attribute__((address_space(1)))
#define LAS __attribute__((address_space(3)))
typedef unsigned v4u __attribute__((ext_vector_type(4)));
typedef float f32x4 __attribute__((ext_vector_type(4)));
typedef short bf16x8 __attribute__((ext_vector_type(8)));
typedef GAS unsigned gu32;
typedef GAS unsigned long long gu64;
#define RLX_AGENT __ATOMIC_RELAXED, __HIP_MEMORY_SCOPE_AGENT
#define LDS_WAIT() asm volatile("s_waitcnt lgkmcnt(0)" ::: "memory")
#define VM_WAIT() asm volatile("s_waitcnt vmcnt(0)" ::: "memory")
__device__ __forceinline__ unsigned long long rt() { return __builtin_amdgcn_s_memrealtime(); }

#define XB_TMO      128
#define XB_XCNT(j)  (256  + 64 * (j))
#define XB_XSUB(j)  (1280 + 64 * (j))
#define XB_XGEN(j)  (2304 + 64 * (j))
#define XB_TOP      3328
#define XB_TOPGEN   3392
#define XCD_BAR_WORDS 3456
#define XB_SPIN_CAP (1u << 18)

__device__ __forceinline__ unsigned xb_ld(unsigned* p)              { return __hip_atomic_load(p, __ATOMIC_RELAXED, __HIP_MEMORY_SCOPE_AGENT); }
__device__ __forceinline__ unsigned xb_add(unsigned* p, unsigned v) { return __hip_atomic_fetch_add(p, v, __ATOMIC_RELAXED, __HIP_MEMORY_SCOPE_AGENT); }
__device__ __forceinline__ unsigned xb_xcc_id() { return (unsigned)__builtin_amdgcn_s_getreg((3 << 11) | 20) & 0xFu; }
#define XB_SPIN(cond, bar) do { unsigned _sp = 0; while (cond) { __builtin_amdgcn_s_sleep(1); \
    if ((++_sp & 255u) == 0u) { if (xb_ld(&(bar)[XB_TMO])) break; if (_sp > XB_SPIN_CAP) { atomicAdd(&(bar)[XB_TMO], 1u); break; } } } } while (0)

struct XcdBarrier {
    unsigned* bar; unsigned x;
    volatile LAS unsigned* st;
};

__device__ __forceinline__ XcdBarrier xcd_barrier_post(unsigned* bar, volatile LAS unsigned* st) {
    XcdBarrier b; b.bar = bar; b.x = xb_xcc_id(); b.st = st;
    if (threadIdx.x == 0) (void)xb_add(&bar[XB_XCNT(b.x)], 1u);
    return b;
}
__device__ __forceinline__ void xcd_barrier_complete(unsigned* bar, unsigned x, unsigned& nloc, unsigned& nx) {
    const unsigned G = gridDim.x * gridDim.y * gridDim.z;
    unsigned sum, cnt, mine, sp = 0u;
    for (;;) {
        sum = 0u; cnt = 0u; mine = 0u;
#pragma unroll
        for (unsigned j = 0; j < 16; ++j) { const unsigned c = xb_ld(&bar[XB_XCNT(j)]); sum += c; cnt += (c > 0u) ? 1u : 0u; mine = (j == x) ? c : mine; }
        if (sum == G) break;
        __builtin_amdgcn_s_sleep(1);
        if ((++sp & 255u) == 0u) { if (xb_ld(&bar[XB_TMO])) break; if (sp > XB_SPIN_CAP) { atomicAdd(&bar[XB_TMO], 1u); break; } }
    }
    nloc = mine > 0u ? mine : 1u; nx = cnt > 0u ? cnt : 1u;
}

__device__ __forceinline__ void xcd_barrier(const XcdBarrier& b) {
    asm volatile("s_waitcnt vmcnt(0)" ::: "memory");
    __syncthreads();
    if (threadIdx.x == 0) {
        unsigned* bar = b.bar;
        __builtin_amdgcn_s_waitcnt(0);
        unsigned nloc = b.st[0], nx = b.st[1];
        if (nloc == 0u) { xcd_barrier_complete(bar, b.x, nloc, nx); b.st[0] = nloc; b.st[1] = nx; }
        const unsigned old = xb_add(&bar[XB_XSUB(b.x)], 1u);
        const unsigned gen = old / nloc;
        if (old + 1u == (gen + 1u) * nloc) {
            __builtin_amdgcn_fence(__ATOMIC_RELEASE, "agent");
            asm volatile("s_waitcnt vmcnt(0)" ::: "memory");
            const unsigned og = xb_add(&bar[XB_TOP], 1u);
            const unsigned tg = og / nx;
            if (og + 1u == (tg + 1u) * nx) xb_add(&bar[XB_TOPGEN], 1u);
            else XB_SPIN(xb_ld(&bar[XB_TOPGEN]) == tg, bar);
            __builtin_amdgcn_fence(__ATOMIC_ACQUIRE, "agent");
            xb_add(&bar[XB_XGEN(b.x)], 1u);
            asm volatile("s_waitcnt vmcnt(0)" ::: "memory");
        } else {
            XB_SPIN(xb_ld(&bar[XB_XGEN(b.x)]) == gen, bar);
            __builtin_amdgcn_fence(__ATOMIC_ACQUIRE, "agent");
            asm volatile("s_waitcnt vmcnt(0)" ::: "memory");
        }
    }
    __syncthreads();
}

constexpr int NWAVES = 8;
constexpr int NPHASE = 4;
constexpr int CW_RDV = 98304;
constexpr int CW_TMO = 0, CW_CODE = 1, CW_MODC = 64, CW_OUTQ = 2048, CW_CHAIN = 81920, CW_ATTQ = 1024, CW_PANEL = 65536, CW_OUTP = 73728, CW_BAR = 4096;
constexpr int RING_OFF = 0, RING_BYTES = 131072;
constexpr int LDSCTL_OFF = RING_BYTES, MISC_OFF = LDSCTL_OFF + 320;
constexpr int SACT_OFF = LDSCTL_OFF + 1024;
constexpr int LDS_BYTES = 147456;
static_assert(MISC_OFF + 128 <= SACT_OFF && SACT_OFF + 8192 + 1024 <= LDS_BYTES, "LDS map");
static_assert(att::LDS_ATT2 <= RING_BYTES && pg8::STAGE_BYTES <= RING_BYTES, "phase scratch fits the ring");

struct Frame {
    LAS unsigned char* lds;
    volatile LAS unsigned* MISC;
    gu32* ctl;
    int tid, lane, wave, vcu, G;
};
__device__ __forceinline__ float wave_sum(float v) {
#pragma unroll
    for (int o = 1; o < 64; o <<= 1) v += __shfl_xor(v, o);
    return v;
}
__device__ __forceinline__ unsigned pk2h(float lo, float hi) { return pg8::cvt_pk_h(lo, hi); }

__device__ __forceinline__ void p0_transpose_item(const float* W, int ldw, int K, int src_n0, bf16* WT, int dst_row0, int k0, LAS float* scr, int lane, const float* gk = nullptr) {
    float t_[32];
#pragma unroll
    for (int i = 0; i < 32; ++i) t_[i] = __builtin_nontemporal_load(W + (size_t)(k0 + 2 * i + (lane >> 5)) * ldw + src_n0 + (lane & 31));
#pragma unroll
    for (int i = 0; i < 32; ++i) scr[(2 * i + (lane >> 5)) * 33 + (lane & 31)] = t_[i];
    LDS_WAIT(); asm volatile("" ::: "memory");
    const int c = lane & 7;
#pragma unroll
    for (int j = 0; j < 4; ++j) { const int n = (lane >> 3) + 8 * j; const LAS float* s = scr + (8 * c) * 33 + n;
        f32x4 g0 = {1.f, 1.f, 1.f, 1.f}, g1 = g0; if (gk) { g0 = *(const f32x4*)(gk + k0 + 8 * c); g1 = *(const f32x4*)(gk + k0 + 8 * c + 4); }
        v4u o; o.x = pk2h(s[0 * 33] * g0.x, s[1 * 33] * g0.y); o.y = pk2h(s[2 * 33] * g0.z, s[3 * 33] * g0.w); o.z = pk2h(s[4 * 33] * g1.x, s[5 * 33] * g1.y); o.w = pk2h(s[6 * 33] * g1.z, s[7 * 33] * g1.w);
        *(GAS v4u*)(WT + (size_t)(dst_row0 + n) * K + k0 + 8 * c) = o; }
    LDS_WAIT(); asm volatile("" ::: "memory");
}

struct Args {
    const float* in[24]; float* out; unsigned char* ws; int ph_lo, ph_hi, li, pad;
};

__device__ __forceinline__ void p0_mod_block(const LAS float* sact, LAS float* part, const float* w_ada, const float* b_ada, float* mod, gu32* cnt, int j, int wave, int lane) {
    const int kk = lane >> 2, c4 = lane & 3, col = 16 * j + 4 * c4;
    f32x4 w[8];
#pragma unroll
    for (int s = 0; s < 8; ++s) w[s] = __builtin_nontemporal_load((const GAS f32x4*)(w_ada + (size_t)(128 * wave + kk + 16 * s) * 3072 + col));
    f32x4 a0 = {0.f, 0.f, 0.f, 0.f}, a1 = {0.f, 0.f, 0.f, 0.f};
#pragma unroll
    for (int s = 0; s < 8; ++s) { const int k = 128 * wave + kk + 16 * s; a0 += w[s] * sact[k]; a1 += w[s] * sact[1024 + k]; }
#pragma unroll
    for (int o = 4; o < 64; o <<= 1) {
#pragma unroll
        for (int e = 0; e < 4; ++e) { a0[e] += __shfl_xor(a0[e], o); a1[e] += __shfl_xor(a1[e], o); } }
    if (lane < 4) {
#pragma unroll
        for (int e = 0; e < 4; ++e) { part[wave * 32 + 4 * c4 + e] = a0[e]; part[wave * 32 + 16 + 4 * c4 + e] = a1[e]; } }
    __syncthreads();
    if (wave == 0) {
        if (lane < 32) { float t = b_ada[16 * j + (lane & 15)];
#pragma unroll
            for (int ww = 0; ww < 8; ++ww) t += part[ww * 32 + lane];
            __hip_atomic_store((GAS float*)(mod + (lane >> 4) * 3072 + 16 * j + (lane & 15)), t, RLX_AGENT); }
        asm volatile("s_waitcnt vmcnt(0)" ::: "memory");
        if (lane == 0) __hip_atomic_fetch_add(cnt, 1u, RLX_AGENT);
    }
    __syncthreads();
}
__device__ __forceinline__ void cis_reduced(double ang, float& c, float& s) {
    const double TWO_PI = 6.283185307179586476925286766559;
    const float r = (float)(ang - TWO_PI * rint(ang / TWO_PI)); c = cosf(r); s = sinf(r);
}
__device__ __forceinline__ void ssm_pow(float lr, float li, float dtf, int n, float& pr, float& pi) {
    float c, s_; cis_reduced((double)n * (double)li * (double)dtf, c, s_); const float e = expf((float)n * lr * dtf); pr = e * c; pi = e * s_;
}
__device__ __forceinline__ void p0_ssm_item(const float* log_dt, const float* lam_re, const float* lam_im, float* AC, int g, int lane) {
    const float dtf = expf(log_dt[g]); const float lr = lam_re[g * 64 + lane], li = lam_im[g * 64 + lane];
    float a0, a1, a2, a3; ssm_pow(lr, li, dtf, 1, a0, a1); ssm_pow(lr, li, dtf, 16, a2, a3); const f32x4 v = {a0, a1, a2, a3};
    *(f32x4*)(AC + ((size_t)g * 64 + lane) * 4) = v;
}
__device__ __forceinline__ void ssm_coef_pow(const float* log_dt, const float* lam_re, const float* lam_im, int g, int lane, int n, float& cr, float& ci) {
    const float dtf = expf(log_dt[g]); const float lr = lam_re[g * 64 + lane], li = lam_im[g * 64 + lane];
    float ar, ai, pr, pi; ssm_pow(lr, li, dtf, 1, ar, ai); ssm_pow(lr, li, dtf, n, pr, pi);
    const float nr = ar - 1.f, ni = ai, den = lr * lr + li * li;
    const float kr = (nr * lr + ni * li) / den, ki = (ni * lr - nr * li) / den;
    cr = kr * pr - ki * pi; ci = kr * pi + ki * pr;
}
__device__ __forceinline__ void p0_ssm_K_item(const float* log_dt, const float* lam_re, const float* lam_im, const float* b_re, const float* b_im, const float* c_re, const float* c_im,
                                              bf16* TQ, int g, int d, LAS float* scr, int lane) {
    float cr, ci; ssm_coef_pow(log_dt, lam_re, lam_im, g, lane, d, cr, ci);
#pragma unroll
    for (int j = 0; j < 16; ++j) { const float br = b_re[(g * 64 + lane) * 16 + j], bi = b_im[(g * 64 + lane) * 16 + j];
        scr[(lane * 16 + j) * 2] = cr * br - ci * bi; scr[(lane * 16 + j) * 2 + 1] = cr * bi + ci * br; }
    LAS float* cl = scr + 2048;
#pragma unroll
    for (int q = 0; q < 16; ++q) { cl[(q * 64 + lane) * 2] = c_re[(g * 16 + q) * 64 + lane]; cl[(q * 64 + lane) * 2 + 1] = c_im[(g * 16 + q) * 64 + lane]; }
    LDS_WAIT(); asm volatile("" ::: "memory");
    const int i = lane & 15, jq = lane >> 4; float acc[4] = {0.f, 0.f, 0.f, 0.f};
#pragma unroll 8
    for (int p = 0; p < 64; ++p) { const float xr = cl[(i * 64 + p) * 2], xi = cl[(i * 64 + p) * 2 + 1];
#pragma unroll
        for (int e = 0; e < 4; ++e) acc[e] += xr * scr[(p * 16 + 4 * jq + e) * 2] - xi * scr[(p * 16 + 4 * jq + e) * 2 + 1]; }
    const unsigned long long kv = (unsigned long long)pk2h(acc[0], acc[1]) | ((unsigned long long)pk2h(acc[2], acc[3]) << 32);
    bf16* base = TQ + (size_t)g * 256 * 384;
    for (int t = d; t < 16; ++t) *(GAS unsigned long long*)(base + (size_t)(t * 16 + i) * 384 + (t - d) * 16 + 4 * jq) = kv;
    if (d > 0) for (int t = 0; t + d < 16; ++t) *(GAS unsigned long long*)(base + (size_t)(t * 16 + i) * 384 + (t + d) * 16 + 4 * jq) = 0ull;
    LDS_WAIT(); asm volatile("" ::: "memory");
}
__device__ __forceinline__ void p0_ssm_Q_item(const float* log_dt, const float* lam_re, const float* lam_im, const float* c_re, const float* c_im, bf16* TQ, int g, int t, int lane) {
    const float dtf = expf(log_dt[g]); float pr, pi; ssm_pow(lam_re[g * 64 + lane], lam_im[g * 64 + lane], dtf, t + 1, pr, pi);
#pragma unroll
    for (int i = 0; i < 16; ++i) { const float xr = c_re[(g * 16 + i) * 64 + lane], xi = c_im[(g * 16 + i) * 64 + lane];
        *(GAS unsigned*)(TQ + ((size_t)g * 256 + t * 16 + i) * 384 + 256 + 2 * lane) = pk2h(xr * pr - xi * pi, -(xr * pi + xi * pr)); }
}
__device__ __forceinline__ void p0_ssm_P_item(const float* log_dt, const float* lam_re, const float* lam_im, const float* b_re, const float* b_im, bf16* PP, int g, int s_, int lane) {
    float cr, ci; ssm_coef_pow(log_dt, lam_re, lam_im, g, lane, 15 - s_, cr, ci);
    float wr[16], wi[16];
#pragma unroll
    for (int j = 0; j < 16; ++j) { const float br = b_re[(g * 64 + lane) * 16 + j], bi = b_im[(g * 64 + lane) * 16 + j]; wr[j] = cr * br - ci * bi; wi[j] = cr * bi + ci * br; }
    bf16* r0 = PP + ((size_t)g * 256 + 2 * lane) * 256 + s_ * 16;
    v4u o; o.x = pk2h(wr[0], wr[1]); o.y = pk2h(wr[2], wr[3]); o.z = pk2h(wr[4], wr[5]); o.w = pk2h(wr[6], wr[7]); *(GAS v4u*)r0 = o;
    o.x = pk2h(wr[8], wr[9]); o.y = pk2h(wr[10], wr[11]); o.z = pk2h(wr[12], wr[13]); o.w = pk2h(wr[14], wr[15]); *(GAS v4u*)(r0 + 8) = o;
    o.x = pk2h(wi[0], wi[1]); o.y = pk2h(wi[2], wi[3]); o.z = pk2h(wi[4], wi[5]); o.w = pk2h(wi[6], wi[7]); *(GAS v4u*)(r0 + 256) = o;
    o.x = pk2h(wi[8], wi[9]); o.y = pk2h(wi[10], wi[11]); o.z = pk2h(wi[12], wi[13]); o.w = pk2h(wi[14], wi[15]); *(GAS v4u*)(r0 + 256 + 8) = o;
}

__global__ void __launch_bounds__(NWAVES * 64, 2) mega_fwd(Args args) {
    extern __shared__ __attribute__((aligned(16))) unsigned char lds[];
    Frame F;
    F.lds = (LAS unsigned char*)lds;
    F.MISC = (volatile LAS unsigned*)(F.lds + MISC_OFF);
    F.tid = threadIdx.x; F.lane = F.tid & 63; F.wave = __builtin_amdgcn_readfirstlane(F.tid >> 6);
    F.G = gridDim.x; { const int bx = blockIdx.x; F.vcu = (F.G % 8 == 0) ? (bx % 8) * (F.G / 8) + bx / 8 : bx; }
    unsigned char* ws = args.ws;
    F.ctl = (gu32*)(ws + WS_CTL);
    const float* x = args.in[0]; const float* cvec = args.in[1]; const int* positions = (const int*)args.in[2];
    const float* w_ada = args.in[3]; const float* b_ada = args.in[4]; const float* norm_g = args.in[5]; const float* w_in = args.in[6];
    const float* log_dt = args.in[7]; const float* lam_re = args.in[8]; const float* lam_im = args.in[9]; const float* b_re = args.in[10]; const float* b_im = args.in[11];
    const float* c_re = args.in[12]; const float* c_im = args.in[13]; const float* d_skip = args.in[14]; const float* w_glu = args.in[15]; const float* b_glu = args.in[16];
    const float* q_a_g = args.in[17]; const float* w_q_b = args.in[18]; const float* kv_a_g = args.in[19]; const float* w_kv_b = args.in[20];
    const float* q_norm_g = args.in[21]; const float* k_norm_g = args.in[22]; const float* w_out = args.in[23];
    float* MOD = (float*)(ws + WS_MOD); float* AC = (float*)(ws + WS_AC); bf16* BB = (bf16*)(ws + WS_BB); bf16* CB = (bf16*)(ws + WS_CB); float* EST = (float*)(ws + WS_E);
    bf16* WIN_T = (bf16*)(ws + WS_WIN); bf16* WQ_T = (bf16*)(ws + WS_WQ); bf16* WKV_T = (bf16*)(ws + WS_WKV); bf16* WGLU_T = (bf16*)(ws + WS_WGLU); bf16* WOUT_T = (bf16*)(ws + WS_WOUT);
    bf16* PROJ = (bf16*)(ws + WS_PROJ); bf16* HB = (bf16*)(ws + WS_HB); bf16* QRAW = (bf16*)(ws + WS_HB); bf16* YCAT = (bf16*)(ws + WS_YCAT); bf16* ZM = (bf16*)(ws + WS_ZM);
    bf16* KVRAW = (bf16*)(ws + WS_KVRAW); bf16* Qb = (bf16*)(ws + WS_Q); bf16* Kb = (bf16*)(ws + WS_K); bf16* Vb = (bf16*)(ws + WS_V);
    bf16* CQN = (bf16*)(ws + WS_CQN); bf16* CKVN = (bf16*)(ws + WS_CKVN); bf16* YPRE = (bf16*)(ws + WS_YPRE);
    float* RS = (float*)(ws + WS_RS); float* ROPE = (float*)(ws + WS_ROPE); bf16* USG = (bf16*)(ws + WS_USG); bf16* TQ = (bf16*)(ws + WS_TQ); bf16* PPM = (bf16*)(ws + WS_PP); float* HAND = (float*)(ws + WS_HAND); (void)BB; (void)CB; (void)EST; (void)CQN; (void)CKVN; (void)QRAW; (void)KVRAW;

    for (int u = F.tid; u < (LDS_BYTES - LDSCTL_OFF) / 4; u += NWAVES * 64) ((LAS unsigned*)(F.lds + LDSCTL_OFF))[u] = 0u;
    __syncthreads();
    const int lo = args.ph_lo, hi = args.ph_hi;
    const bool multi = (hi - lo) > 1;
    XcdBarrier bar; bar.bar = (unsigned*)(F.ctl + CW_BAR) + args.li * XCD_BAR_WORDS; bar.x = 0; bar.st = nullptr;
    if (multi) bar = xcd_barrier_post((unsigned*)(F.ctl + CW_BAR) + args.li * XCD_BAR_WORDS, F.MISC + 8);
#define IN(k) (lo <= (k) && (k) < hi)
#define SEAM(k) do { if (IN(k) && IN((k) + 1)) xcd_barrier(bar); } while (0)
    const int gw = F.vcu * NWAVES + F.wave, NGW = F.G * NWAVES;

    if (IN(0)) {
        LAS float* scr = (LAS float*)(F.lds + RING_OFF + F.wave * 16384);
        constexpr int I_MOD = 192, I_SSM = 32;
        constexpr int T_U = 256, T_ZS = 256, T_ZM = 256, T_CKV = 128, T_CQ = 192, T_KR = 16, T_WQ = 144, T_WKV = 128, T_WGLU = 128, T_WOUT = 512;
        constexpr int I_TR = T_U + T_ZS + T_ZM + T_CKV + T_CQ + T_KR + T_WQ + T_WKV + T_WGLU + T_WOUT;
        constexpr int I_Z1 = 96, I_Z2 = 256;
        constexpr int NITEMS = I_MOD + I_SSM + I_TR + I_Z1 + I_Z2;
        { LAS float* sact = (LAS float*)(F.lds + SACT_OFF); LAS float* part = (LAS float*)(F.lds + SACT_OFF + 8192);
          for (int e = F.tid; e < 2048; e += NWAVES * 64) { const float cv = cvec[e]; sact[e] = cv / (1.f + __expf(-cv)); }
          __syncthreads();
          for (int r = (int)blockIdx.x; r < I_MOD; r += F.G) p0_mod_block(sact, part, w_ada, b_ada, MOD, F.ctl + CW_MODC, r, F.wave, F.lane); }
        for (int it = I_MOD + gw; it < NITEMS; it += NGW) {
            int r = it - I_MOD;
            if (r < I_SSM) { p0_ssm_item(log_dt, lam_re, lam_im, AC, r, F.lane); continue; } r -= I_SSM;
            if (r < I_TR) {
                if (r < T_U)   { p0_transpose_item(w_in, D_IN, 1024, SC_U + 32 * (r % 16), WIN_T, 0 + 32 * (r % 16), 64 * (r / 16), scr, F.lane); continue; } r -= T_U;
                if (r < T_ZS)  { p0_transpose_item(w_in, D_IN, 1024, SC_ZS + 32 * (r % 16), WIN_T, 512 + 32 * (r % 16), 64 * (r / 16), scr, F.lane); continue; } r -= T_ZS;
                if (r < T_ZM)  { p0_transpose_item(w_in, D_IN, 1024, SC_ZM + 32 * (r % 16), WIN_T, WR_ZM + 32 * (r % 16), 64 * (r / 16), scr, F.lane); continue; } r -= T_ZM;
                if (r < T_CKV) { p0_transpose_item(w_in, D_IN, 1024, SC_CKV + 32 * (r % 8), WIN_T, 1024 + 32 * (r % 8), 64 * (r / 8), scr, F.lane); continue; } r -= T_CKV;
                if (r < T_CQ)  { p0_transpose_item(w_in, D_IN, 1024, SC_CQ + 32 * (r % 12), WIN_T, 1280 + 32 * (r % 12), 64 * (r / 12), scr, F.lane); continue; } r -= T_CQ;
                if (r < T_KR)  { p0_transpose_item(w_in, D_IN, 1024, SC_KR, WIN_T, GC_KR, 64 * r, scr, F.lane); continue; } r -= T_KR;
                if (r < T_WQ)  { const int nb = r % 24, kb = r / 24, n0 = 32 * nb;
                                 p0_transpose_item(w_q_b, 768, 384, n0, WQ_T, (n0 / 96) * 128 + (n0 % 96), 64 * kb, scr, F.lane, q_a_g); continue; } r -= T_WQ;
                if (r < T_WKV) { p0_transpose_item(w_kv_b, 1024, 256, 32 * (r % 32), WKV_T, 32 * (r % 32), 64 * (r / 32), scr, F.lane, kv_a_g); continue; } r -= T_WKV;
                if (r < T_WGLU){ p0_transpose_item(w_glu, 512, 512, 32 * (r % 16), WGLU_T, 32 * (r % 16), 64 * (r / 16), scr, F.lane); continue; } r -= T_WGLU;
                p0_transpose_item(w_out, 1024, 1024, 32 * (r % 32), WOUT_T, 32 * (r % 32), 64 * (r / 32), scr, F.lane); continue;
            }
            r -= I_TR;
            const v4u z = {0u, 0u, 0u, 0u};
            if (r < I_Z1) { GAS v4u* p = (GAS v4u*)(WIN_T + (size_t)(GC_KR + 32 + r) * 1024); p[F.lane] = z; p[64 + F.lane] = z; continue; } r -= I_Z1;
            { const int hh = r / 32, rr = r % 32; GAS v4u* p = (GAS v4u*)(WQ_T + (size_t)(hh * 128 + 96 + rr) * 384); if (F.lane < 48) p[F.lane] = z; }
        }
        f32x4 v0[4], v1[4], v2[4];
#define LDROW(dst, mm) do { const GAS f32x4* xr_ = (const GAS f32x4*)(x + (size_t)(mm) * DM) + F.lane; _Pragma("unroll") for (int j = 0; j < 4; ++j) dst[j] = __builtin_nontemporal_load(xr_ + 64 * j); } while (0)
        if (gw < M) LDROW(v0, gw);
        if (gw + NGW < M) LDROW(v1, gw + NGW);
        __syncthreads();
        if (F.wave == 0) { unsigned sp = 0;
            while (__hip_atomic_load(F.ctl + CW_MODC, RLX_AGENT) < 192u) { __builtin_amdgcn_s_sleep(2); if (++sp > (1u << 22)) { if (F.lane == 0) __hip_atomic_store(F.ctl + CW_TMO, 1u, RLX_AGENT); break; } }
            __builtin_amdgcn_fence(__ATOMIC_ACQUIRE, "agent"); asm volatile("s_waitcnt vmcnt(0)" ::: "memory"); }
        __syncthreads();
        { f32x4 PA[4], PB[4]; int curb = -1;
          const float ifq = (float)exp(-(double)(F.lane & 15) / 16.0 * 9.210340371976184);
          for (int m = gw; m < M; m += NGW) {
            if (m + 2 * NGW < M) LDROW(v2, m + 2 * NGW);
            const int b = m / SEQ;
            if (b != curb) { curb = b;
#pragma unroll
                for (int j = 0; j < 4; ++j) { const int e = 4 * F.lane + 256 * j;
                    const f32x4 g4 = *(const f32x4*)(norm_g + e), sc = *(const f32x4*)(MOD + b * 3072 + 1024 + e); PB[j] = *(const f32x4*)(MOD + b * 3072 + e); PA[j] = g4 * (sc + 1.f); } }
            if (F.lane < 16) { const double TWO_PI = 6.283185307179586476925286766559;
                const float ang = (float)positions[m] * ifq; const float kq = rintf(ang * 0.15915494309189535f);
                const float rr = fmaf(-kq, 0.0019353071795864769f, fmaf(-kq, 6.28125f, ang)); (void)TWO_PI;
                typedef float f32x2_ __attribute__((ext_vector_type(2))); *(f32x2_*)(ROPE + ((size_t)m * 16 + F.lane) * 2) = (f32x2_){__cosf(rr), __sinf(rr)}; }
            float s = 0.f;
#pragma unroll
            for (int j = 0; j < 4; ++j) s += (v0[j].x * v0[j].x + v0[j].y * v0[j].y) + (v0[j].z * v0[j].z + v0[j].w * v0[j].w);
            const float rstd = 1.f / sqrtf(wave_sum(s) * (1.f / DM) + EPS);
            GAS unsigned long long* o8 = (GAS unsigned long long*)(HB + (size_t)m * DM) + F.lane;
#pragma unroll
            for (int j = 0; j < 4; ++j) { const f32x4 hv = v0[j] * rstd * PA[j] + PB[j];
                o8[64 * j] = (unsigned long long)pk2h(hv.x, hv.y) | ((unsigned long long)pk2h(hv.z, hv.w) << 32); }
#pragma unroll
            for (int j = 0; j < 4; ++j) { v0[j] = v1[j]; v1[j] = v2[j]; }
          }
#undef LDROW
        }
    }
    SEAM(0);

    if (IN(1)) {
        pg8::Gemm g{HB, WIN_T, M, NPROJ, 1024, 1024}; pg8::StaticOrder S; S.init(M, NPROJ, F.G, (int)blockIdx.x);
        pg8::EpiProj E{PROJ, LDP, RS, 4, USG, SEQ};
        pg8::gemm_phase<pg8::EpiProj, pg8::StaticOrder, true, true>(F.lds + RING_OFF, g, S, E);
        if (F.G == 256 ? blockIdx.x >= 192 : true) { __syncthreads();
            LAS float* scr = (LAS float*)(F.lds + RING_OFF + F.wave * 16384);
            const int nw = (F.G == 256) ? 512 : NGW, w0 = (F.G == 256) ? ((int)blockIdx.x - 192) * NWAVES + F.wave : gw;
            for (int it = w0; it < 512 * 3 + 256; it += nw) { int r = it;
                if (r < 512) { p0_ssm_K_item(log_dt, lam_re, lam_im, b_re, b_im, c_re, c_im, TQ, r >> 4, r & 15, scr, F.lane); continue; } r -= 512;
                if (r < 512) { p0_ssm_Q_item(log_dt, lam_re, lam_im, c_re, c_im, TQ, r >> 4, r & 15, F.lane); continue; } r -= 512;
                if (r < 512) { p0_ssm_P_item(log_dt, lam_re, lam_im, b_re, b_im, PPM, r >> 4, r & 15, F.lane); continue; } r -= 512;
                { const v4u z0 = {0u, 0u, 0u, 0u}; GAS v4u* pz = (GAS v4u*)(PPM + ((size_t)(r >> 3) * 256 + 128 + (r & 7) * 16) * 256);
#pragma unroll
                  for (int q = 0; q < 8; ++q) pz[F.lane + 64 * q] = z0; } } }
    }
    SEAM(1);

    if (IN(2)) {
        { const pg8::MlaAux AUX{RS, ROPE, PROJ, LDP, PC_KR};
          if (F.G == 256) {
            { pg8::Gemm g{PROJ + PC_CQ, WQ_T, M, 1024, Q_LORA, LDP}; pg8::StaticOrder S; S.init(M, 1024, F.G, (int)blockIdx.x);
              pg8::EpiQ E{AUX, q_norm_g, Qb, 0.10206207261596575f * 1.4426950408889634f, EPS, SEQ};
              pg8::gemm_phase<pg8::EpiQ, pg8::StaticOrder, false, true>(F.lds + RING_OFF, g, S, E); }
            __syncthreads();
            { pg8::Gemm g{PROJ + PC_CKV, WKV_T, M, 1024, KV_LORA, LDP}; pg8::StaticOrder S; S.init(M, 1024, F.G, (int)blockIdx.x);
              pg8::EpiKV E{AUX, k_norm_g, Kb, Vb, EPS, SEQ};
              pg8::gemm_phase<pg8::EpiKV, pg8::StaticOrder, false, true>(F.lds + RING_OFF, g, S, E); }
          } else if (F.tid == 0) __hip_atomic_store(F.ctl + CW_TMO, 1u, RLX_AGENT);
        }
        __syncthreads();
        { pg8::Gemm g{USG, PPM, 32768, 8192, 256, 384}; pg8::DiagOrder S{128, 4, F.G, (int)blockIdx.x, nullptr, 0u, nullptr};
          pg8::EpiELds E{};
          if (F.G >= 128) { pg8::gemm_phase<pg8::EpiELds, pg8::DiagOrder, false, true>(F.lds + RING_OFF, g, S, E);
              pg8::Unit u; const bool has = S.next(0, u);
              __syncthreads();
              if (has && F.wave == 0) pg8::ssm_chain_unit(u, F.lds + RING_OFF, USG, AC, HAND, (unsigned*)(F.ctl + CW_CHAIN), (unsigned*)(F.ctl + CW_TMO), F.lane);
              __syncthreads(); }
          else if (F.tid == 0) __hip_atomic_store(F.ctl + CW_TMO, 1u, RLX_AGENT); }
        { pg8::Gemm g{HB, WIN_T + (size_t)WR_ZM * 1024, M, 512, 1024, 1024}; pg8::StaticOrder S; S.init(M, 512, F.G, (int)((blockIdx.x + 128u) % (unsigned)F.G));
          pg8::EpiH16 E{ZM, 512};
          pg8::gemm_phase<pg8::EpiH16, pg8::StaticOrder, true, true>(F.lds + RING_OFF, g, S, E); }
    }
    SEAM(2);

    if (IN(3)) {
        { pg8::Gemm g{USG, TQ, 32768, 8192, 384, 384}; pg8::DiagOrder S{128, 4, F.G, (int)blockIdx.x, nullptr, 0u, nullptr};
          pg8::EpiY E{USG, d_skip, YPRE, SEQ};
          pg8::gemm_phase<pg8::EpiY, pg8::DiagOrder, true, true>(F.lds + RING_OFF, g, S, E);
          if (F.tid == 0) { pg8::Unit u; for (int i = 0; S.next(i, u); ++i) { const int k4 = u.pm & 3;
              for (int q = 0; q < 16; ++q) __hip_atomic_fetch_add(F.ctl + CW_PANEL + 64 * ((k4 >> 1) * 32 + (k4 & 1) * 16 + q), 1u, RLX_AGENT); } } }
        __syncthreads();
        __syncthreads();
#define RUN_GLU_UNITS() do { \
        { pg8::Gemm g{YPRE, WGLU_T, M, 512, 512, 512}; pg8::PanelOrder S; S.init(M, 512, F.G, (int)((blockIdx.x + 128u) % (unsigned)F.G)); S.cnt = (unsigned*)(F.ctl + CW_PANEL); S.want = 32u; S.tmo = (unsigned*)(F.ctl + CW_TMO); \
          pg8::EpiGlu E{YPRE, PROJ, LDP, PC_ZS, b_glu, YCAT}; \
          pg8::gemm_phase<pg8::EpiGlu, pg8::PanelOrder, true, true>(F.lds + RING_OFF, g, S, E); \
          if (F.tid == 0) { pg8::Unit u; for (int i = 0; S.next(i, u); ++i) __hip_atomic_fetch_add(F.ctl + CW_OUTP + 64 * u.pm, 1u, RLX_AGENT); } } \
        __syncthreads(); } while (0)
#define OUT_UNIT_OF(k, uu) do { const int pk_ = (k) >> 2; (uu).pm = (pk_ & 1) * 32 + (24 - 8 * (pk_ >> 1)) + j; (uu).pn = (k) & 3; } while (0)
#define RUN_OUT_UNIT(uu) do { if (F.tid < 64) { __builtin_amdgcn_fence(__ATOMIC_ACQUIRE, "agent"); asm volatile("s_waitcnt vmcnt(0)" ::: "memory"); } __syncthreads(); \
            pg8::Gemm g_{YCAT, WOUT_T, M, 1024, 1024, 1024}; pg8::OneUnit S_; S_.u = (uu); pg8::EpiOutRows E_{x, MOD + 2048, 3072, SEQ, args.out}; \
            pg8::gemm_phase<pg8::EpiOutRows, pg8::OneUnit, false, true>(F.lds + RING_OFF, g_, S_, E_); __syncthreads(); } while (0)
        const int j = (int)(blockIdx.x & 7); bool glu_done = false;
        bool popped = false;
        for (;;) {
            if (!popped && F.tid == 0) F.MISC[16] = __hip_atomic_fetch_add(F.ctl + CW_ATTQ + 64 * j, 1u, RLX_AGENT);
            __syncthreads();
            const unsigned ua = (unsigned)__builtin_amdgcn_readfirstlane((int)F.MISC[16]);
            __syncthreads();
            if (ua >= 64u) break;
            const int bh = 2 * j + (int)(ua & 1u), qb = 31 - (int)(ua >> 1);
            const bool early = glu_done || ((blockIdx.x + 128u) % (unsigned)F.G) >= 128u;
            att::attn_unit(bh >> 3, bh & 7, qb, Qb, Kb, Vb, ZM, 512, 0, YCAT, (char*)lds + RING_OFF, F.lds + RING_OFF, (unsigned*)(F.ctl + CW_OUTP + 64 * ((bh >> 3) * 32 + qb)), nullptr, (unsigned*)(F.ctl + CW_TMO), early ? CW_ATTQ - CW_TMO : -1, MISC_OFF - RING_OFF + 16 * 4);
            popped = early;
            if (!glu_done) { glu_done = true; RUN_GLU_UNITS(); }
            if (F.tid == 0) { unsigned k = __hip_atomic_load(F.ctl + CW_OUTQ + 64 * j, RLX_AGENT), got = 0xffffffffu;
                if (MK_CLAIM_BETWEEN && k < 32u) { pg8::Unit t; OUT_UNIT_OF((int)k, t);
                    if (__hip_atomic_load(F.ctl + CW_OUTP + 64 * t.pm, RLX_AGENT) >= 10u) { unsigned e = k;
                        if (__hip_atomic_compare_exchange_strong(F.ctl + CW_OUTQ + 64 * j, &e, k + 1u, __ATOMIC_RELAXED, __ATOMIC_RELAXED, __HIP_MEMORY_SCOPE_AGENT)) got = k; } }
                F.MISC[17] = got; }
            __syncthreads();
            const unsigned ko = (unsigned)__builtin_amdgcn_readfirstlane((int)F.MISC[17]);
            __syncthreads();
            if (ko != 0xffffffffu) { pg8::Unit uo; OUT_UNIT_OF((int)ko, uo); RUN_OUT_UNIT(uo); }
        }
        if (!glu_done) { glu_done = true; RUN_GLU_UNITS(); }
        for (;;) {
            if (F.tid == 0) F.MISC[17] = __hip_atomic_fetch_add(F.ctl + CW_OUTQ + 64 * j, 1u, RLX_AGENT);
            __syncthreads();
            const unsigned ko = (unsigned)__builtin_amdgcn_readfirstlane((int)F.MISC[17]);
            __syncthreads();
            if (ko >= 32u) break;
            pg8::Unit uo; OUT_UNIT_OF((int)ko, uo);
            if (F.tid < 64) { unsigned sp = 0;
                while (__hip_atomic_load(F.ctl + CW_OUTP + 64 * uo.pm, RLX_AGENT) < 10u) { __builtin_amdgcn_s_sleep(4);
                    if (++sp > (1u << 22)) { if (F.tid == 0) __hip_atomic_store(F.ctl + CW_TMO, 1u, RLX_AGENT); break; } }
                if (F.tid == 0) __hip_atomic_fetch_add(F.ctl + CW_RDV + 64 * uo.pm, 1u, RLX_AGENT);
                sp = 0; while (__hip_atomic_load(F.ctl + CW_RDV + 64 * uo.pm, RLX_AGENT) < 4u && ++sp < 20000u) __builtin_amdgcn_s_sleep(2); }
            RUN_OUT_UNIT(uo);
        }
#undef OUT_UNIT_OF
#undef RUN_GLU_UNITS
#undef RUN_OUT_UNIT
    }
#undef IN
#undef SEAM
}

#ifndef MK_MODE
#define MK_MODE 2
#endif
#ifndef MK_FAST_MASK
#define MK_FAST_MASK 0x7
#endif
extern "C" void kernel_launch(void* const* d_in, const int* in_sizes, int n_in, void* d_out, int out_size, void* d_ws, size_t ws_size, hipStream_t stream) {
    static int grid = 0;
    if (grid == 0) {
        if (n_in != 24 || in_sizes[0] != M * DM || out_size != M * DM || ws_size < WS_END) { fprintf(stderr, "kernel_launch: unexpected shapes (n_in %d, in0 %d, out %d, ws %zu)\n", n_in, n_in > 0 ? in_sizes[0] : -1, out_size, ws_size); grid = -1; return; }
        int dev = 0, cus = 0, per_cu = 0;
        if (hipGetDevice(&dev) != hipSuccess || hipDeviceGetAttribute(&cus, hipDeviceAttributeMultiprocessorCount, dev) != hipSuccess) { fprintf(stderr, "kernel_launch: device query failed\n"); grid = -1; return; }
        if (hipFuncSetAttribute((const void*)mega_fwd, hipFuncAttributeMaxDynamicSharedMemorySize, LDS_BYTES) != hipSuccess) { fprintf(stderr, "kernel_launch: hipFuncSetAttribute failed\n"); grid = -1; return; }
        if (hipOccupancyMaxActiveBlocksPerMultiprocessor(&per_cu, (const void*)mega_fwd, NWAVES * 64, LDS_BYTES) != hipSuccess || per_cu < 1)
            fprintf(stderr, "kernel_launch: note: occupancy query reports %d workgroups per CU\n", per_cu);
        (void)hipGetLastError();
        grid = cus;
    }
    if (grid < 0) return;
    const float* x = (const float*)d_in[0]; const float* c = (const float*)d_in[1]; const int* positions = (const int*)d_in[2];
    const float* w_ada = (const float*)d_in[3]; const float* b_ada = (const float*)d_in[4]; const float* norm_g = (const float*)d_in[5];
    const float* w_in = (const float*)d_in[6]; const float* log_dt = (const float*)d_in[7]; const float* lam_re = (const float*)d_in[8];
    const float* lam_im = (const float*)d_in[9]; const float* b_re = (const float*)d_in[10]; const float* b_im = (const float*)d_in[11];
    const float* c_re = (const float*)d_in[12]; const float* c_im = (const float*)d_in[13]; const float* d_skip = (const float*)d_in[14];
    const float* w_glu = (const float*)d_in[15]; const float* b_glu = (const float*)d_in[16]; const float* q_a_g = (const float*)d_in[17];
    const float* w_q_b = (const float*)d_in[18]; const float* kv_a_g = (const float*)d_in[19]; const float* w_kv_b = (const float*)d_in[20];
    const float* q_norm_g = (const float*)d_in[21]; const float* k_norm_g = (const float*)d_in[22]; const float* w_out = (const float*)d_in[23];
    unsigned char* ws = (unsigned char*)d_ws; float* out = (float*)d_out;
    float* MOD = (float*)(ws + WS_MOD); bf16* PROJ = (bf16*)(ws + WS_PROJ); bf16* HB = (bf16*)(ws + WS_HB); bf16* QRAW = (bf16*)(ws + WS_HB); bf16* YCAT = (bf16*)(ws + WS_YCAT); bf16* ZM = (bf16*)(ws + WS_ZM);
    bf16* KVRAW = (bf16*)(ws + WS_KVRAW); bf16* Qb = (bf16*)(ws + WS_Q); bf16* Kb = (bf16*)(ws + WS_K); bf16* Vb = (bf16*)(ws + WS_V);
    bf16* CQN = (bf16*)(ws + WS_CQN); bf16* CKVN = (bf16*)(ws + WS_CKVN); bf16* YPRE = (bf16*)(ws + WS_YPRE);
    (void)x; (void)c; (void)positions; (void)w_ada; (void)b_ada; (void)norm_g; (void)w_in; (void)log_dt; (void)lam_re; (void)lam_im; (void)b_re; (void)b_im; (void)c_re; (void)c_im; (void)d_skip;
    (void)w_glu; (void)b_glu; (void)q_a_g; (void)w_q_b; (void)kv_a_g; (void)w_kv_b; (void)q_norm_g; (void)k_norm_g; (void)w_out; (void)MOD; (void)PROJ; (void)HB; (void)QRAW; (void)YCAT;
    (void)KVRAW; (void)Qb; (void)Kb; (void)Vb; (void)CQN; (void)CKVN; (void)YPRE; (void)out;

    Args a{}; int n_mega = 0;
    for (int i = 0; i < 24; ++i) a.in[i] = (const float*)d_in[i];
    a.out = out; a.ws = ws;
#define MEGA(lo_, hi_) do { a.ph_lo = (lo_); a.ph_hi = (hi_); a.li = n_mega++; hipLaunchKernelGGL(mega_fwd, dim3(grid), dim3(NWAVES * 64), LDS_BYTES, stream, a); } while (0)
#if MK_MODE == 2
    if (hipMemsetAsync(ws + WS_CTL, 0, CTL_ZERO_BYTES, stream) != hipSuccess) { fprintf(stderr, "kernel_launch: memset failed\n"); return; }
#if MK_DOUBLE >= 0
    MEGA(0, MK_DOUBLE + 1); MEGA(MK_DOUBLE, NPHASE);
#else
    MEGA(0, NPHASE);
#endif
#else
    const unsigned fast = (MK_MODE == 0) ? 0u : (unsigned)MK_FAST_MASK;
    (void)hipMemsetAsync(ws + WS_CTL, 0, CTL_ZERO_BYTES, stream);
    if (MK_MODE != 0) MEGA(0, 1);
    if (!(fast & 1u)) { hipLaunchKernelGGL(v0_mod, dim3(24), dim3(256), 0, stream, c, w_ada, b_ada, MOD); hipLaunchKernelGGL(v0_h, dim3(M), dim3(256), 0, stream, x, norm_g, MOD, HB); }
    if (fast & 2u) MEGA(1, 2); else {
        const int seg[5][3] = {{PC_U, SC_U, 512}, {PC_ZS, SC_ZS, 512}, {PC_CKV, SC_CKV, 256}, {PC_CQ, SC_CQ, 384}, {PC_KR, SC_KR, 32}};
        for (int s = 1; s < 5; ++s) hipLaunchKernelGGL(v0_gemm, dim3(M), dim3(256), 1024 * 4, stream, HB, 1024, 1024, w_in, D_IN, seg[s][1], PROJ, LDP, seg[s][0], seg[s][2]);
        hipLaunchKernelGGL(v0_usg, dim3(M), dim3(256), 1024 * 4, stream, HB, w_in, D_IN, (bf16*)(ws + WS_USG));
        hipLaunchKernelGGL(v0_gemm, dim3(M), dim3(256), 1024 * 4, stream, HB, 1024, 1024, w_in, D_IN, SC_ZM, ZM, 512, 0, 512); }
    if (fast & 4u) { MEGA(2, 3); MEGA(3, 4); }
    else { hipLaunchKernelGGL(v0_cqn, dim3(M), dim3(256), 0, stream, PROJ, q_a_g, kv_a_g, CQN, CKVN);
        for (int h = 0; h < NH; ++h) hipLaunchKernelGGL(v0_gemm, dim3(M), dim3(128), 384 * 4, stream, CQN, 384, 384, w_q_b, 768, h * 96, QRAW, 1024, h * 128, 96);
        hipLaunchKernelGGL(v0_gemm, dim3(M), dim3(256), 256 * 4, stream, CKVN, 256, 256, w_kv_b, 1024, 0, KVRAW, 1024, 0, 1024);
        hipLaunchKernelGGL(v0_qkv, dim3(M * NH * 2 / 256), dim3(256), 0, stream, QRAW, KVRAW, PROJ, positions, q_norm_g, k_norm_g, Qb, Kb, Vb);
        hipLaunchKernelGGL(v0_ssm, dim3(BATCH * SSM_G), dim3(64), 0, stream, (bf16*)(ws + WS_USG), log_dt, lam_re, lam_im, b_re, b_im, c_re, c_im, d_skip, YPRE);
        hipLaunchKernelGGL(v0_attn, dim3(BATCH * NH * (SEQ / 256)), dim3(256), 0, stream, Qb, Kb, Vb, ZM, YCAT);
        hipLaunchKernelGGL(v0_glu, dim3(M), dim3(256), 0, stream, YPRE, w_glu, b_glu, PROJ, YCAT);
        hipLaunchKernelGGL(v0_out, dim3(M), dim3(256), 0, stream, YCAT, w_out, x, MOD, out); }
#endif
    const hipError_t le = hipPeekAtLastError();
    if (le != hipSuccess) fprintf(stderr, "kernel_launch: launch failed: %s\n", hipGetErrorName(le));
}
```

```cpp
#include <hip/hip_runtime.h>
#include <cstdio>
#include <cstdint>
#ifndef MK_CLAIM_BETWEEN
#define MK_CLAIM_BETWEEN 0
#endif
#ifndef MK_DOUBLE
#define MK_DOUBLE (-1)
#endif

constexpr int BATCH = 2, SEQ = 8192, DM = 1024, M = BATCH * SEQ;
constexpr int SSM_W = 512, SSM_G = 32, SSM_GC = 16, SSM_P = 64;
constexpr int NH = 8, QK_NOPE = 64, QK_ROPE = 32, QK_HEAD = 96, V_HEAD = 64, MLA_W = 512, Q_LORA = 384, KV_LORA = 256;
constexpr int D_IN = 2208;
constexpr float EPS = 1e-6f;
constexpr int NPROJ = 1792;
constexpr int LDP = 1280;
constexpr int PC_U = 0, PC_ZS = 0, PC_CKV = 512, PC_CQ = 768, PC_KR = 1152;
constexpr int GC_KR = 1664;
constexpr int WR_ZM = 1792;
constexpr int SC_U = 0, SC_ZS = 512, SC_CQ = 1024, SC_CKV = 1408, SC_KR = 1664, SC_ZM = 1696;

constexpr size_t MiB = 1u << 20;
constexpr size_t WS_CTL = 0, CTL_ZERO_BYTES = 1 * MiB;
constexpr size_t WS_MOD = 1 * MiB;
constexpr size_t WS_AC = 1 * MiB + 64 * 1024;
constexpr size_t WS_BB = 1 * MiB + 128 * 1024;
constexpr size_t WS_CB = 1 * MiB + 256 * 1024;
constexpr size_t WS_E = 2 * MiB;
constexpr size_t WS_WIN = 4 * MiB;
constexpr size_t WS_WQ = 9 * MiB;
constexpr size_t WS_WKV = 10 * MiB;
constexpr size_t WS_WGLU = 11 * MiB;
constexpr size_t WS_WOUT = 12 * MiB;
constexpr size_t WS_PROJ = 16 * MiB;
constexpr size_t WS_USG = 56 * MiB;
constexpr size_t WS_ZM = 80 * MiB;
constexpr size_t WS_HB = 96 * MiB;
constexpr size_t WS_YCAT = 128 * MiB;
constexpr size_t WS_KVRAW = 128 * MiB;
constexpr size_t WS_Q = 160 * MiB;
constexpr size_t WS_CQN = 160 * MiB;
constexpr size_t WS_CKVN = 172 * MiB;
constexpr size_t WS_K = 184 * MiB;
constexpr size_t WS_V = 208 * MiB;
constexpr size_t WS_YPRE = 224 * MiB;
constexpr size_t WS_TQ = 240 * MiB;
constexpr size_t WS_PP = 246 * MiB;
constexpr size_t WS_ROPE = 250 * MiB;
constexpr size_t WS_HAND = 252 * MiB;
constexpr size_t WS_RS = 14 * MiB;
constexpr size_t WS_END = 253 * MiB;

typedef unsigned short bf16;
__device__ __forceinline__ unsigned f2bf(float f) { return (unsigned)__builtin_bit_cast(unsigned short, (_Float16)f); }
__device__ __forceinline__ float bf2f(bf16 b) { return (float)__builtin_bit_cast(_Float16, b); }
__device__ __forceinline__ float silu_f(float v) { return v / (1.f + __expf(-v)); }
__device__ __forceinline__ float sigmoid_f(float v) { return 1.f / (1.f + __expf(-v)); }
__device__ __forceinline__ float gelu_tanh(float v) { const float z = 0.7978845608028654f * (v + 0.044715f * v * v * v); return v / (1.f + __expf(-2.f * z)); }

__device__ __forceinline__ float block_sum_256(float v, float* red) {
    for (int o = 32; o > 0; o >>= 1) v += __shfl_xor(v, o);
    const int w = threadIdx.x >> 6;
    __syncthreads();
    if ((threadIdx.x & 63) == 0) red[w] = v;
    __syncthreads();
    float s = 0.f; for (int i = 0; i < (int)(blockDim.x >> 6); ++i) s += red[i];
    return s;
}

__global__ void v0_mod(const float* c, const float* w_ada, const float* b_ada, float* mod) {
    const int idx = blockIdx.x * blockDim.x + threadIdx.x; if (idx >= BATCH * 3 * DM) return;
    const int b = idx / (3 * DM), n = idx % (3 * DM);
    float acc = b_ada[n];
    for (int k = 0; k < DM; ++k) acc += silu_f(c[b * DM + k]) * w_ada[(size_t)k * 3 * DM + n];
    mod[idx] = acc;
}
__global__ void v0_h(const float* x, const float* norm_g, const float* mod, bf16* hb) {
    __shared__ float red[8];
    const int m = blockIdx.x, b = m / SEQ, t = threadIdx.x;
    float v[4], ss = 0.f;
    for (int j = 0; j < 4; ++j) { v[j] = x[(size_t)m * DM + t + 256 * j]; ss += v[j] * v[j]; }
    ss = block_sum_256(ss, red);
    const float rstd = 1.f / sqrtf(ss / DM + EPS);
    for (int j = 0; j < 4; ++j) { const int e = t + 256 * j;
        const float hv = v[j] * rstd * norm_g[e] * (1.f + mod[b * 3 * DM + DM + e]) + mod[b * 3 * DM + e];
        hb[(size_t)m * DM + e] = (bf16)f2bf(hv); }
}
__global__ void v0_gemm(const bf16* A, int lda, int K, const float* W, int ldw, int src0, bf16* C, int ldc, int dst0, int width) {
    extern __shared__ float arow[];
    const int m = blockIdx.x;
    for (int k = threadIdx.x; k < K; k += blockDim.x) arow[k] = bf2f(A[(size_t)m * lda + k]);
    __syncthreads();
    for (int j = threadIdx.x; j < width; j += blockDim.x) {
        float acc = 0.f;
        for (int k = 0; k < K; ++k) acc += arow[k] * W[(size_t)k * ldw + src0 + j];
        C[(size_t)m * ldc + dst0 + j] = (bf16)f2bf(acc);
    }
}
__global__ void v0_usg(const bf16* A, const float* W, int ldw, bf16* USG) {
    extern __shared__ float arow[];
    const int m = blockIdx.x, b = m / SEQ, t = m % SEQ;
    for (int k = threadIdx.x; k < 1024; k += blockDim.x) arow[k] = bf2f(A[(size_t)m * 1024 + k]);
    __syncthreads();
    for (int c = threadIdx.x; c < 512; c += blockDim.x) { float acc = 0.f;
        for (int k = 0; k < 1024; ++k) acc += arow[k] * W[(size_t)k * ldw + c];
        USG[((size_t)(c >> 4) * 1024 + b * 512 + (t >> 4)) * 384 + (t & 15) * 16 + (c & 15)] = (bf16)f2bf(acc); }
}
__global__ void v0_cqn(const bf16* proj, const float* q_a_g, const float* kv_a_g, bf16* cqn, bf16* ckvn) {
    __shared__ float red[8];
    const int m = blockIdx.x, t = threadIdx.x;
    float a = 0.f, b2 = 0.f, ss = 0.f;
    if (t < 192) { a = bf2f(proj[(size_t)m * LDP + PC_CQ + t]); b2 = bf2f(proj[(size_t)m * LDP + PC_CQ + 192 + t]); ss = a * a + b2 * b2; }
    ss = block_sum_256(ss, red);
    float rstd = 1.f / sqrtf(ss / Q_LORA + EPS);
    if (t < 192) { cqn[(size_t)m * Q_LORA + t] = (bf16)f2bf(a * rstd * q_a_g[t]); cqn[(size_t)m * Q_LORA + 192 + t] = (bf16)f2bf(b2 * rstd * q_a_g[192 + t]); }
    const float cv = bf2f(proj[(size_t)m * LDP + PC_CKV + t]);
    ss = block_sum_256(cv * cv, red);
    rstd = 1.f / sqrtf(ss / KV_LORA + EPS);
    ckvn[(size_t)m * KV_LORA + t] = (bf16)f2bf(cv * rstd * kv_a_g[t]);
}
__device__ __forceinline__ int v0_vst(int k, int c) { const int kk = (k & ~0xC) | ((k & 4) << 1) | ((k & 8) >> 1); return ((kk >> 3) * 2 + (c >> 5)) * 512 + ((kk & 7) * 32 + (c & 31)) * 2; }
__global__ void __launch_bounds__(256) v0_qkv(const bf16* qraw, const bf16* kvraw, const bf16* proj, const int* positions, const float* q_norm_g, const float* k_norm_g, bf16* Q, bf16* K, bf16* V) {
    const int idx = blockIdx.x * blockDim.x + threadIdx.x; if (idx >= M * NH * 2) return;
    const int which = idx & 1, m = (idx >> 1) / NH, h = (idx >> 1) % NH;
    const float pos = (float)positions[m];
    const float* gn = which ? k_norm_g : q_norm_g;
    float q[96];
    float sq = 0.f;
    if (which == 0) {
#pragma unroll
        for (int d = 0; d < 96; ++d) q[d] = bf2f(qraw[(size_t)m * 1024 + h * 128 + d]);
    } else {
#pragma unroll
        for (int d = 0; d < 64; ++d) q[d] = bf2f(kvraw[(size_t)m * 1024 + h * 128 + d]);
#pragma unroll
        for (int d = 0; d < 32; ++d) q[64 + d] = bf2f(proj[(size_t)m * LDP + PC_KR + d]);
    }
#pragma unroll
    for (int d = 0; d < 96; ++d) sq += q[d] * q[d];
    const float rq = 1.f / sqrtf(sq / 96.f + EPS);
#pragma unroll
    for (int d = 0; d < 96; ++d) q[d] = q[d] * rq * gn[d];
#pragma unroll
    for (int i = 0; i < 16; ++i) {
        const float inv_freq = (float)pow(10000.0, -(double)i / 16.0);
        const float ang = pos * inv_freq;
        const double TWO_PI = 6.283185307179586476925286766559;
        const double r = (double)ang - TWO_PI * rint((double)ang / TWO_PI);
        const float rf = (float)r; const float cs = __cosf(rf), sn = __sinf(rf);
        const float q1 = q[64 + i], q2 = q[80 + i]; q[64 + i] = q1 * cs - q2 * sn; q[80 + i] = q2 * cs + q1 * sn;
    }
    if (which == 0) {
#pragma unroll
        for (int d = 0; d < 96; ++d) Q[(size_t)m * 768 + h * 96 + d] = (bf16)f2bf(q[d] * (0.10206207261596575f * 1.4426950408889634f));
    } else {
        const int bb = m / SEQ, tt = m % SEQ; const size_t tix = (size_t)(bb * 8 + h) * 128 + (tt >> 6); const int row = tt & 63;
#pragma unroll
        for (int d = 0; d < 96; ++d) K[tix * 6144 + (d >> 3) * 512 + row * 8 + (d & 7)] = (bf16)f2bf(q[d]);
        for (int d = 0; d < 64; ++d) V[tix * 4096 + v0_vst(row, d) / 2] = kvraw[(size_t)m * 1024 + h * 128 + 64 + d];
    }
}
__global__ void __launch_bounds__(64) v0_ssm(const bf16* proj, const float* log_dt, const float* lam_re, const float* lam_im, const float* b_re, const float* b_im,
                       const float* c_re, const float* c_im, const float* d_skip, bf16* ypre) {
    __shared__ float sre[64], sim[64], us[16];
    const int b = blockIdx.x / SSM_G, g = blockIdx.x % SSM_G, p = threadIdx.x;
    const double dt = exp((double)log_dt[g]);
    const double lr = lam_re[g * 64 + p], li = lam_im[g * 64 + p];
    const double er = exp(lr * dt), ar = er * cos(li * dt), ai = er * sin(li * dt);
    const double nr = ar - 1.0, ni = ai, den = lr * lr + li * li;
    const double cr = (nr * lr + ni * li) / den, ci = (ni * lr - nr * li) / den;
    float Br[16], Bi[16];
#pragma unroll
    for (int j = 0; j < 16; ++j) { const double br = b_re[(g * 64 + p) * 16 + j], bi = b_im[(g * 64 + p) * 16 + j];
        Br[j] = (float)(cr * br - ci * bi); Bi[j] = (float)(cr * bi + ci * br); }
    const float far = (float)ar, fai = (float)ai;
    float s_r = 0.f, s_i = 0.f;
    const float dsk = p < 16 ? d_skip[g * 16 + p] : 0.f;
    for (int t = 0; t < SEQ; ++t) {
        const size_t row = (size_t)(b * SEQ + t);
        if (p < 16) us[p] = bf2f(proj[((size_t)g * 1024 + b * 512 + (t >> 4)) * 384 + (t & 15) * 16 + p]);
        __syncthreads();
        float bur = 0.f, bui = 0.f;
#pragma unroll
        for (int j = 0; j < 16; ++j) { bur += Br[j] * us[j]; bui += Bi[j] * us[j]; }
        const float nr2 = far * s_r - fai * s_i + bur, ni2 = far * s_i + fai * s_r + bui;
        s_r = nr2; s_i = ni2; sre[p] = s_r; sim[p] = s_i;
        __syncthreads();
        if (p < 16) {
            float y = 0.f;
            for (int q = 0; q < 64; ++q) y += c_re[(g * 16 + p) * 64 + q] * sre[q] - c_im[(g * 16 + p) * 64 + q] * sim[q];
            y += dsk * us[p];
            ypre[row * SSM_W + g * 16 + p] = (bf16)f2bf(gelu_tanh(y));
        }
        __syncthreads();
    }
}
__global__ void __launch_bounds__(256) v0_attn(const bf16* Q, const bf16* K, const bf16* V, const bf16* zm, bf16* ycat) {
    const int qb = blockIdx.x % (SEQ / 256), bh = blockIdx.x / (SEQ / 256), b = bh / NH, h = bh % NH;
    const int qi = qb * 256 + threadIdx.x;
    const size_t qrow = (size_t)b * SEQ + qi;
    float q[96], o[64];
    const float sc = 0.10206207261596575f;
#pragma unroll
    for (int d = 0; d < 96; ++d) q[d] = bf2f(Q[qrow * 768 + h * 96 + d]) * sc;
#pragma unroll
    for (int d = 0; d < 64; ++d) o[d] = 0.f;
    float mx = -1e30f, l = 0.f;
    const int jmax = qb * 256 + 255;
    for (int j = 0; j <= jmax; ++j) {
        const size_t tix = (size_t)(b * 8 + h) * 128 + (j >> 6); const int jr = j & 63;
        const bf16* kp = K + tix * 6144 + jr * 8; const bf16* vp = V + tix * 4096;
        float s = 0.f;
#pragma unroll
        for (int d = 0; d < 96; ++d) s += q[d] * bf2f(kp[(d >> 3) * 512 + (d & 7)]);
        if (j <= qi) {
            const float mn = fmaxf(mx, s); const float al = exp2f(mx - mn), pp = exp2f(s - mn);
            l = l * al + pp;
#pragma unroll
            for (int d = 0; d < 64; ++d) o[d] = o[d] * al + pp * bf2f(vp[v0_vst(jr, d) / 2]);
            mx = mn;
        }
    }
    const float rl = 1.f / l;
#pragma unroll
    for (int d = 0; d < 64; ++d) {
        const float z = bf2f(zm[qrow * 512 + h * 64 + d]);
        ycat[qrow * 1024 + 512 + h * 64 + d] = (bf16)f2bf(o[d] * rl * silu_f(z));
    }
}
__global__ void v0_glu(const bf16* ypre, const float* w_glu, const float* b_glu, const bf16* proj, bf16* ycat) {
    __shared__ float arow[512];
    const int m = blockIdx.x;
    for (int k = threadIdx.x; k < 512; k += blockDim.x) arow[k] = bf2f(ypre[(size_t)m * 512 + k]);
    __syncthreads();
    for (int j = threadIdx.x; j < 512; j += blockDim.x) {
        float acc = b_glu[j];
        for (int k = 0; k < 512; ++k) acc += arow[k] * w_glu[(size_t)k * 512 + j];
        const float z = bf2f(proj[(size_t)m * LDP + PC_ZS + j]);
        ycat[(size_t)m * 1024 + j] = (bf16)f2bf(arow[j] * sigmoid_f(acc) * silu_f(z));
    }
}
__global__ void v0_out(const bf16* ycat, const float* w_out, const float* x, const float* mod, float* out) {
    __shared__ float arow[1024];
    const int m = blockIdx.x, b = m / SEQ;
    for (int k = threadIdx.x; k < 1024; k += blockDim.x) arow[k] = bf2f(ycat[(size_t)m * 1024 + k]);
    __syncthreads();
    for (int j = threadIdx.x; j < 1024; j += blockDim.x) {
        float acc = 0.f;
        for (int k = 0; k < 1024; ++k) acc += arow[k] * w_out[(size_t)k * 1024 + j];
        out[(size_t)m * DM + j] = x[(size_t)m * DM + j] + mod[b * 3 * DM + 2 * DM + j] * acc;
    }
}


typedef unsigned wt_u32x4 __attribute__((ext_vector_type(4)));
__device__ __forceinline__ void store16_wt(void* p, wt_u32x4 v) { asm volatile("global_store_dwordx4 %0, %1, off sc1\n\ts_nop 1" :: "v"(p), "v"(v) : "memory"); }

namespace pg8 {
#define PG8_LAS __attribute__((address_space(3)))
typedef unsigned short bf16_t;
typedef _Float16 bf16x8 __attribute__((ext_vector_type(8)));
typedef float f32x4 __attribute__((ext_vector_type(4)));
typedef unsigned u32x4 __attribute__((ext_vector_type(4)));
constexpr int BM = 256, BK = 64, HALF = 128, HTB = HALF * BK * 2  , STAGE_BYTES = 8 * HTB, NXCD = 8, WGM = 8;

__host__ __device__ __forceinline__ int lds_byte(int r, int c) { const int st = (r >> 4) * 2 + (c >> 5), rr = r & 15, cc = c & 31, ob = rr * 64 + cc * 2; return st * 1024 + (ob ^ (((ob >> 9) & 1) << 5)); }
__host__ __device__ __forceinline__ void stage_rc(int b, int& R, int& C) { const int st = b / 1024, sb = b % 1024, swz = sb ^ (((sb >> 9) & 1) << 5); R = (st >> 1) * 16 + swz / 64; C = (st & 1) * 32 + (swz % 64) / 2; }
__host__ __device__ __forceinline__ int perm32(int rho) { const int n = rho >> 4, i = rho & 15; return 8 * (i >> 2) + 4 * n + (i & 3); }

struct Unit { int pm, pn; };
struct Gemm { const bf16_t* A; const bf16_t* Bt; int M, N, K, lda; };

struct StaticOrder {
    int nM, nN, nwg, G, c;
    __host__ __device__ void init(int M, int N, int G_, int c_) { nM = M / BM; nN = N / BM; nwg = nM * nN; G = G_; c = c_; }
    __host__ __device__ bool next(int i, Unit& u) const {
        const long L = (long)i * G + c; if (L >= nwg) return false;
        int wgid = (int)L; { const int q = nwg / NXCD, r = nwg % NXCD, xcd = wgid % NXCD, off = wgid / NXCD; wgid = (xcd < r ? xcd * (q + 1) : r * (q + 1) + (xcd - r) * q) + off; }
        const int nig = WGM * nN, gid = wgid / nig, fm = gid * WGM, gsz = (nM - fm) < WGM ? (nM - fm) : WGM;
        u.pm = fm + ((wgid % nig) % gsz); u.pn = (wgid % nig) / gsz; return true;
    }
    __device__ __forceinline__ void a_ready(const Unit&) const {}
    __device__ __forceinline__ void done(const Unit&) const {}
};


struct DiagOrder {
    int nunits, per, G, c; unsigned* cnt; unsigned want; unsigned* tmo;
    __device__ __forceinline__ bool next(int i, Unit& u) const { const int L = i * G + c; if (L >= nunits) return false; u.pm = L; u.pn = L / per; return true; }
    __device__ __forceinline__ void a_ready(const Unit& u) const {
        if (!cnt) return;
        if (threadIdx.x < 64) { unsigned sp = 0;
            while (__hip_atomic_load(cnt + 64 * u.pm, __ATOMIC_RELAXED, __HIP_MEMORY_SCOPE_AGENT) < want) { __builtin_amdgcn_s_sleep(2);
                if (++sp > (1u << 22)) { if (threadIdx.x == 0) __hip_atomic_store(tmo, 1u, __ATOMIC_RELAXED, __HIP_MEMORY_SCOPE_AGENT); break; } }
            __builtin_amdgcn_fence(__ATOMIC_ACQUIRE, "agent"); asm volatile("s_waitcnt vmcnt(0)" ::: "memory"); }
        __syncthreads();
    }
    __device__ __forceinline__ void done(const Unit&) const {}
};
struct OneUnit { Unit u;
    __device__ __forceinline__ bool next(int i, Unit& x) const { if (i) return false; x = u; return true; }
    __device__ __forceinline__ void a_ready(const Unit&) const {}
    __device__ __forceinline__ void done(const Unit&) const {} };
struct PanelOrder : StaticOrder {
    unsigned* cnt; unsigned want; unsigned* tmo;
    __device__ __forceinline__ void a_ready(const Unit& u) const {
        if (threadIdx.x < 64) { unsigned sp = 0;
            while (__hip_atomic_load(cnt + 64 * u.pm, __ATOMIC_RELAXED, __HIP_MEMORY_SCOPE_AGENT) < want) { __builtin_amdgcn_s_sleep(2);
                if (++sp > (1u << 22)) { if (threadIdx.x == 0) __hip_atomic_store(tmo, 1u, __ATOMIC_RELAXED, __HIP_MEMORY_SCOPE_AGENT); break; } }
            __builtin_amdgcn_fence(__ATOMIC_ACQUIRE, "agent"); asm volatile("s_waitcnt vmcnt(0)" ::: "memory"); }
        __syncthreads();
    }
};

typedef float f32x2 __attribute__((ext_vector_type(2)));
typedef _Float16 f16x2 __attribute__((ext_vector_type(2)));
__device__ __forceinline__ unsigned cvt_pk_h(float lo, float hi) { const f16x2 v = __builtin_convertvector((f32x2){lo, hi}, f16x2); return __builtin_bit_cast(unsigned, v); }
__device__ __forceinline__ float h_lo(unsigned w) { return (float)__builtin_bit_cast(f16x2, w)[0]; }
__device__ __forceinline__ float h_hi(unsigned w) { return (float)__builtin_bit_cast(f16x2, w)[1]; }
__device__ __forceinline__ float fsilu(float v) { return v * __builtin_amdgcn_rcpf(1.f + __builtin_amdgcn_exp2f(-1.4426950408889634f * v)); }
__device__ __forceinline__ float fsigm(float v) { return __builtin_amdgcn_rcpf(1.f + __builtin_amdgcn_exp2f(-1.4426950408889634f * v)); }

struct EpiH16 {
    static constexpr bool PERM = true, AFTER_DRAIN = false;
    bf16_t* O; int ldc;
    __device__ __forceinline__ void operator()(const f32x4 (&acc)[2][2][4][2], const Unit& u, int wr, int wc, int fr, int fq) const {
        const int row0 = u.pm * BM + wr * 64 + fr, col0 = u.pn * BM + wc * 32 + 8 * fq;
#pragma unroll
        for (int ai = 0; ai < 2; ++ai)
#pragma unroll
            for (int m = 0; m < 4; ++m) { bf16_t* rowp = O + (size_t)(row0 + ai * HALF + m * 16) * ldc + col0;
#pragma unroll
                for (int bj = 0; bj < 2; ++bj) { const f32x4 v0 = acc[ai][bj][m][0], v1 = acc[ai][bj][m][1];
                    u32x4 w; w.x = cvt_pk_h(v0[0], v0[1]); w.y = cvt_pk_h(v0[2], v0[3]); w.z = cvt_pk_h(v1[0], v1[1]); w.w = cvt_pk_h(v1[2], v1[3]);
                    store16_wt(rowp + bj * HALF, w); } }
    }
};
struct EpiProj {
    static constexpr bool PERM = true, AFTER_DRAIN = false;
    bf16_t* O; int ldc; float* RS; int rs_pn0; bf16_t* USG; int seq;
    __device__ __forceinline__ void operator()(const f32x4 (&acc)[2][2][4][2], const Unit& u, int wr, int wc, int fr, int fq) const {
        const int row0 = u.pm * BM + wr * 64 + fr, col0 = u.pn * BM + wc * 32 + 8 * fq;
#pragma unroll
        for (int ai = 0; ai < 2; ++ai)
#pragma unroll
            for (int m = 0; m < 4; ++m) { const int grow = row0 + ai * HALF + m * 16; bf16_t* rowp = O + (size_t)grow * ldc + col0 - 512;
                const int bb = grow / seq, tt = grow % seq;
#pragma unroll
                for (int bj = 0; bj < 2; ++bj) { const f32x4 v0 = acc[ai][bj][m][0], v1 = acc[ai][bj][m][1];
                    u32x4 w; w.x = cvt_pk_h(v0[0], v0[1]); w.y = cvt_pk_h(v0[2], v0[3]); w.z = cvt_pk_h(v1[0], v1[1]); w.w = cvt_pk_h(v1[2], v1[3]);
                    if (u.pn < 2) { const int c = col0 + bj * HALF;
                        *(u32x4*)(USG + ((size_t)(c >> 4) * 1024 + bb * 512 + (tt >> 4)) * 384 + (tt & 15) * 16 + (c & 15)) = w;
                    }
                    else *(u32x4*)(rowp + bj * HALF) = w; } }
        if (u.pn >= rs_pn0) {
#pragma unroll
            for (int ai = 0; ai < 2; ++ai)
#pragma unroll
                for (int m = 0; m < 4; ++m)
#pragma unroll
                    for (int bj = 0; bj < 2; ++bj) { const f32x4 v0 = acc[ai][bj][m][0], v1 = acc[ai][bj][m][1];
                        float q = (v0[0] * v0[0] + v0[1] * v0[1]) + (v0[2] * v0[2] + v0[3] * v0[3]) + (v1[0] * v1[0] + v1[1] * v1[1]) + (v1[2] * v1[2] + v1[3] * v1[3]);
                        q += __shfl_xor(q, 16); q += __shfl_xor(q, 32);
                        if (fq == 0) RS[((size_t)(row0 + ai * HALF + m * 16) * 3 + (u.pn - rs_pn0)) * 8 + bj * 4 + wc] = q; }
        }
    }
};
struct MlaAux { const float* RS; const float* rope; const bf16_t* proj; int ldp, krcol0; };
constexpr int MLA_TBL = 8192, MLA_ROPE = 12288, MLA_KR = 45056;
__device__ __forceinline__ void mla_stage_rows(const MlaAux& A, const Unit& u, PG8_LAS unsigned char* lds, int tid, bool want_kr, float eps) {
    const size_t row0 = (size_t)u.pm * BM;
    u32x4 rp[4];
#pragma unroll
    for (int j = 0; j < 4; ++j) rp[j] = *(const u32x4*)((const char*)(A.rope + row0 * 32) + (size_t)(tid + 512 * j) * 16);
    u32x4 kr[2] = {{0u, 0u, 0u, 0u}, {0u, 0u, 0u, 0u}};
    if (want_kr) {
#pragma unroll
        for (int j = 0; j < 2; ++j) { const int c = tid + 512 * j; kr[j] = *(const u32x4*)(A.proj + (row0 + (c >> 2)) * A.ldp + A.krcol0 + 8 * (c & 3)); } }
    if (tid < 256) { const float* rs = A.RS + (row0 + tid) * 24;
        const f32x4 s6a = *(const f32x4*)rs, s6b = *(const f32x4*)(rs + 4), s7a = *(const f32x4*)(rs + 8), s7b = *(const f32x4*)(rs + 12), s8a = *(const f32x4*)(rs + 16); const float skr = rs[20];
        const float sq = ((s7a[0] + s7a[1]) + (s7a[2] + s7a[3])) + ((s7b[0] + s7b[1]) + (s7b[2] + s7b[3])) + ((s8a[0] + s8a[1]) + (s8a[2] + s8a[3]));
        const float skv = ((s6a[0] + s6a[1]) + (s6a[2] + s6a[3])) + ((s6b[0] + s6b[1]) + (s6b[2] + s6b[3]));
        *(PG8_LAS f32x4*)(lds + MLA_TBL + tid * 16) = (f32x4){1.f / sqrtf(sq * (1.f / 384.f) + eps), 1.f / sqrtf(skv * (1.f / 256.f) + eps), skr, 0.f}; }
#pragma unroll
    for (int j = 0; j < 4; ++j) *(PG8_LAS u32x4*)(lds + MLA_ROPE + (tid + 512 * j) * 16) = rp[j];
    if (want_kr) {
#pragma unroll
        for (int j = 0; j < 2; ++j) *(PG8_LAS u32x4*)(lds + MLA_KR + (tid + 512 * j) * 16) = kr[j]; }
}
struct EpiQ {
    static constexpr bool PERM = true, AFTER_DRAIN = true;
    MlaAux A; const float* gq; bf16_t* Q; float qscale, eps; int seq;
    __device__ __forceinline__ void fused(f32x4 (&acc)[2][2][4][2], const Unit& u, int wr, int wc, int fr, int fq, PG8_LAS unsigned char* lds, int wid, int lane) const {
        PG8_LAS float* P = (PG8_LAS float*)lds;
#pragma unroll
        for (int ai = 0; ai < 2; ++ai)
#pragma unroll
            for (int m = 0; m < 4; ++m)
#pragma unroll
                for (int bj = 0; bj < 2; ++bj) { const f32x4 v0 = acc[ai][bj][m][0], v1 = acc[ai][bj][m][1];
                    float q = (v0[0] * v0[0] + v0[1] * v0[1]) + (v0[2] * v0[2] + v0[3] * v0[3]) + (v1[0] * v1[0] + v1[1] * v1[1]) + (v1[2] * v1[2] + v1[3] * v1[3]);
                    q += __shfl_xor(q, 16); q += __shfl_xor(q, 32);
                    if (fq == 0) P[((ai * HALF + wr * 64 + m * 16 + fr) * 2 + bj) * 4 + wc] = q; }
        mla_stage_rows(A, u, lds, wid * 64 + lane, false, eps);
        asm volatile("s_waitcnt lgkmcnt(0)" ::: "memory"); __builtin_amdgcn_s_barrier(); asm volatile("" ::: "memory");
        if (wc == 3) return;
        const int d0 = 32 * wc + 8 * fq;
        const f32x4 g0 = *(const f32x4*)(gq + (wc == 2 ? 64 + 8 * fq : d0)), g1 = *(const f32x4*)(gq + (wc == 2 ? 64 + 8 * fq : d0) + 4);
#pragma unroll
        for (int ai = 0; ai < 2; ++ai)
#pragma unroll
            for (int m = 0; m < 4; ++m) { const int r = ai * HALF + wr * 64 + m * 16 + fr; const size_t grow = (size_t)u.pm * BM + r;
                const float rstd = (*(const PG8_LAS f32x4*)(lds + MLA_TBL + r * 16))[0];
                f32x4 cs0 = {0.f, 0.f, 0.f, 0.f}, cs1 = cs0, cs2 = cs0, cs3 = cs0;
                if (wc == 2) { const PG8_LAS float* rp = (const PG8_LAS float*)(lds + MLA_ROPE) + (r * 16 + 8 * (fq & 1)) * 2; cs0 = *(const PG8_LAS f32x4*)rp; cs1 = *(const PG8_LAS f32x4*)(rp + 4); cs2 = *(const PG8_LAS f32x4*)(rp + 8); cs3 = *(const PG8_LAS f32x4*)(rp + 12); }
#pragma unroll
                for (int bj = 0; bj < 2; ++bj) { const f32x4 pp = *(const PG8_LAS f32x4*)(P + (r * 2 + bj) * 4);
                    const float tot = (pp[0] + pp[1]) + pp[2];
                    const float rs = qscale * rstd * __builtin_amdgcn_rsqf(rstd * rstd * tot * (1.f / 96.f) + eps);
                    f32x4 v0 = acc[ai][bj][m][0] * rs * g0, v1 = acc[ai][bj][m][1] * rs * g1;
                    if (wc == 2) {
                        f32x4 o0, o1;
#pragma unroll
                        for (int e = 0; e < 4; ++e) { o0[e] = __shfl_xor(v0[e], 32); o1[e] = __shfl_xor(v1[e], 32); }
                        const float sg = (fq < 2) ? -1.f : 1.f;
                        v0[0] = v0[0] * cs0[0] + sg * o0[0] * cs0[1]; v0[1] = v0[1] * cs0[2] + sg * o0[1] * cs0[3]; v0[2] = v0[2] * cs1[0] + sg * o0[2] * cs1[1]; v0[3] = v0[3] * cs1[2] + sg * o0[3] * cs1[3];
                        v1[0] = v1[0] * cs2[0] + sg * o1[0] * cs2[1]; v1[1] = v1[1] * cs2[2] + sg * o1[1] * cs2[3]; v1[2] = v1[2] * cs3[0] + sg * o1[2] * cs3[1]; v1[3] = v1[3] * cs3[2] + sg * o1[3] * cs3[3]; }
                    u32x4 w; w.x = cvt_pk_h(v0[0], v0[1]); w.y = cvt_pk_h(v0[2], v0[3]); w.z = cvt_pk_h(v1[0], v1[1]); w.w = cvt_pk_h(v1[2], v1[3]);
                    *(u32x4*)(Q + grow * 768 + (2 * u.pn + bj) * 96 + d0) = w; } }
    }
};
struct EpiKV {
    static constexpr bool PERM = true, AFTER_DRAIN = true;
    MlaAux A; const float* gk; bf16_t* KIMG; bf16_t* VIMG; float eps; int seq;
    __device__ __forceinline__ static int vst(int k, int c) { return (c >> 5) * 4096 + k * 64 + (c & 31) * 2; }
    __device__ __forceinline__ void fused(f32x4 (&acc)[2][2][4][2], const Unit& u, int wr, int wc, int fr, int fq, PG8_LAS unsigned char* lds, int wid, int lane) const {
        PG8_LAS float* P = (PG8_LAS float*)lds;
        if (wc < 2) {
#pragma unroll
            for (int ai = 0; ai < 2; ++ai)
#pragma unroll
                for (int m = 0; m < 4; ++m)
#pragma unroll
                    for (int bj = 0; bj < 2; ++bj) { const f32x4 v0 = acc[ai][bj][m][0], v1 = acc[ai][bj][m][1];
                        float q = (v0[0] * v0[0] + v0[1] * v0[1]) + (v0[2] * v0[2] + v0[3] * v0[3]) + (v1[0] * v1[0] + v1[1] * v1[1]) + (v1[2] * v1[2] + v1[3] * v1[3]);
                        q += __shfl_xor(q, 16); q += __shfl_xor(q, 32);
                        if (fq == 0) P[((ai * HALF + wr * 64 + m * 16 + fr) * 2 + bj) * 2 + wc] = q; }
        }
        mla_stage_rows(A, u, lds, wid * 64 + lane, true, eps);
        asm volatile("s_waitcnt lgkmcnt(0)" ::: "memory"); __builtin_amdgcn_s_barrier(); asm volatile("" ::: "memory");
        const int q8 = 4 * (wc & 1) + fq;
        f32x4 g0 = {0.f, 0.f, 0.f, 0.f}, g1 = g0; float ga = 0.f, gb = 0.f, gc = 0.f, gd = 0.f;
        if (wc < 2) { g0 = *(const f32x4*)(gk + 32 * wc + 8 * fq); g1 = *(const f32x4*)(gk + 32 * wc + 8 * fq + 4); }
        else { ga = gk[64 + 2 * q8]; gb = gk[65 + 2 * q8]; gc = gk[80 + 2 * q8]; gd = gk[81 + 2 * q8]; }
#pragma unroll
        for (int ai = 0; ai < 2; ++ai)
#pragma unroll
            for (int m = 0; m < 4; ++m) { const int r = ai * HALF + wr * 64 + m * 16 + fr; const size_t grow = (size_t)u.pm * BM + r;
                const f32x4 tb = *(const PG8_LAS f32x4*)(lds + MLA_TBL + r * 16); const float rstd = tb[1], skr = tb[2];
                const int bb = (int)(grow / (size_t)seq), tt = (int)(grow % (size_t)seq), trow = tt & 63;
                float cA = 0.f, sA = 0.f, cB = 0.f, sB = 0.f, x1a = 0.f, x1b = 0.f, x2a = 0.f, x2b = 0.f;
                if (wc >= 2) { const f32x4 cs = *(const PG8_LAS f32x4*)((const PG8_LAS float*)(lds + MLA_ROPE) + (r * 16 + 2 * q8) * 2); cA = cs[0]; sA = cs[1]; cB = cs[2]; sB = cs[3];
                    const PG8_LAS bf16_t* krow = (const PG8_LAS bf16_t*)(lds + MLA_KR) + r * 32;
                    const unsigned ra = *(const PG8_LAS unsigned*)(krow + 2 * q8), rb = *(const PG8_LAS unsigned*)(krow + 16 + 2 * q8);
                    x1a = h_lo(ra); x1b = h_hi(ra); x2a = h_lo(rb); x2b = h_hi(rb); }
#pragma unroll
                for (int bj = 0; bj < 2; ++bj) { const f32x2 pp = *(const PG8_LAS f32x2*)(P + (r * 2 + bj) * 2);
                    const float rs = __builtin_amdgcn_rsqf((rstd * rstd * (pp[0] + pp[1]) + skr) * (1.f / 96.f) + eps);
                    const size_t tix = (size_t)(bb * 8 + 2 * u.pn + bj) * 128 + (tt >> 6);
                    if (wc < 2) { const float f = rstd * rs; const f32x4 v0 = acc[ai][bj][m][0] * f * g0, v1 = acc[ai][bj][m][1] * f * g1;
                        u32x4 w; w.x = cvt_pk_h(v0[0], v0[1]); w.y = cvt_pk_h(v0[2], v0[3]); w.z = cvt_pk_h(v1[0], v1[1]); w.w = cvt_pk_h(v1[2], v1[3]);
                        *(u32x4*)(KIMG + tix * 6144 + (4 * wc + fq) * 512 + trow * 8) = w; }
                    else { const f32x4 v0 = acc[ai][bj][m][0] * rstd, v1 = acc[ai][bj][m][1] * rstd;
                        u32x4 w; w.x = cvt_pk_h(v0[0], v0[1]); w.y = cvt_pk_h(v0[2], v0[3]); w.z = cvt_pk_h(v1[0], v1[1]); w.w = cvt_pk_h(v1[2], v1[3]);
                        *(u32x4*)(VIMG + tix * 4096 + vst(trow, 32 * (wc - 2) + 8 * fq) / 2) = w;
                        const float y1a = x1a * rs * ga, y1b = x1b * rs * gb, y2a = x2a * rs * gc, y2b = x2b * rs * gd;
                        bf16_t* kd = KIMG + tix * 6144 + trow * 8;
                        *(unsigned*)(kd + (8 + (q8 >> 2)) * 512 + ((2 * q8) & 7)) = cvt_pk_h(y1a * cA - y2a * sA, y1b * cB - y2b * sB);
                        *(unsigned*)(kd + (10 + (q8 >> 2)) * 512 + ((2 * q8) & 7)) = cvt_pk_h(y2a * cA + y1a * sA, y2b * cB + y1b * sB); } } }
    }
};
struct EpiELds {
    static constexpr bool PERM = true, AFTER_DRAIN = true;
    __device__ __forceinline__ void fused(f32x4 (&acc)[2][2][4][2], const Unit& u, int wr, int wc, int fr, int fq, PG8_LAS unsigned char* lds, int wid, int lane) const {
        PG8_LAS float* El = (PG8_LAS float*)lds;
#pragma unroll
        for (int ai = 0; ai < 2; ++ai)
#pragma unroll
            for (int m = 0; m < 4; ++m) { const int r = ai * HALF + wr * 64 + m * 16 + fr; PG8_LAS float* rp = El + r * 128 + wc * 32 + 8 * fq;
                *(PG8_LAS f32x4*)rp = acc[ai][0][m][0]; *(PG8_LAS f32x4*)(rp + 4) = acc[ai][0][m][1]; }
    }
};
__device__ __forceinline__ void ssm_chain_unit(const Unit& u, const PG8_LAS unsigned char* lds, bf16_t* USG, const float* AC, float* hand, unsigned* cnt, unsigned* tmo, int lane) {
        const PG8_LAS float* El = (const PG8_LAS float*)lds;
        const int g = u.pn, k4 = u.pm & 3, seqi = g * 2 + (k4 >> 1), p = lane;
        const f32x4 ac = *(const f32x4*)(AC + ((size_t)g * 64 + p) * 4);
        float sr = 0.f, si = 0.f;
        if (k4 & 1) { unsigned sp = 0;
            while (__hip_atomic_load(cnt + 64 * seqi, __ATOMIC_RELAXED, __HIP_MEMORY_SCOPE_AGENT) < 1u) { __builtin_amdgcn_s_sleep(2);
                if (++sp > (1u << 22)) { if (lane == 0) __hip_atomic_store(tmo, 1u, __ATOMIC_RELAXED, __HIP_MEMORY_SCOPE_AGENT); break; } }
            const unsigned long long hv = __hip_atomic_load((const unsigned long long*)(hand + ((size_t)seqi * 64 + p) * 2), __ATOMIC_RELAXED, __HIP_MEMORY_SCOPE_AGENT);
            sr = __uint_as_float((unsigned)hv); si = __uint_as_float((unsigned)(hv >> 32)); }
        bf16_t* srow = USG + (size_t)u.pm * BM * 384 + 256 + 2 * p;
#pragma unroll 8
        for (int t = 0; t < 256; ++t) { const f32x2 e = *(const PG8_LAS f32x2*)(El + t * 128 + 2 * p);
            *(unsigned*)(srow + (size_t)t * 384) = cvt_pk_h(sr, si);
            const float nr = ac[2] * sr - ac[3] * si + e[0], ni = ac[2] * si + ac[3] * sr + e[1]; sr = nr; si = ni; }
        if (!(k4 & 1)) { __hip_atomic_store((unsigned long long*)(hand + ((size_t)seqi * 64 + p) * 2), (unsigned long long)__float_as_uint(sr) | ((unsigned long long)__float_as_uint(si) << 32), __ATOMIC_RELAXED, __HIP_MEMORY_SCOPE_AGENT);
            asm volatile("s_waitcnt vmcnt(0)" ::: "memory");
            if (lane == 0) __hip_atomic_fetch_add(cnt + 64 * seqi, 1u, __ATOMIC_RELAXED, __HIP_MEMORY_SCOPE_AGENT); }
}
struct EpiY {
    static constexpr bool PERM = true, AFTER_DRAIN = false;
    const bf16_t* USG; const float* dskip; bf16_t* YPRE; int seq;
    __device__ __forceinline__ static float gelu_t(float v) { const float z = 0.7978845608028654f * (v + 0.044715f * v * v * v); return v * __builtin_amdgcn_rcpf(1.f + __builtin_amdgcn_exp2f(-2.885390081777927f * z)); }
    __device__ __forceinline__ void operator()(const f32x4 (&acc)[2][2][4][2], const Unit& u, int wr, int wc, int fr, int fq) const {
        const int g = u.pn, k4 = u.pm & 3, bb = k4 >> 1;
        const int i0 = (8 * fq) & 15;
        const f32x4 d0 = *(const f32x4*)(dskip + g * 16 + i0), d1 = *(const f32x4*)(dskip + g * 16 + i0 + 4);
#pragma unroll
        for (int ai = 0; ai < 2; ++ai)
#pragma unroll
            for (int m = 0; m < 4; ++m) { const int r = ai * HALF + wr * 64 + m * 16 + fr; const size_t arow = (size_t)u.pm * BM + r; const int tile = (k4 & 1) * 256 + r;
#pragma unroll
                for (int bj = 0; bj < 2; ++bj) { const int col = bj * HALF + wc * 32 + 8 * fq, t = col >> 4;
                    const u32x4 uv = *(const u32x4*)(USG + arow * 384 + col);
                    const f32x4 v0 = acc[ai][bj][m][0], v1 = acc[ai][bj][m][1];
                    u32x4 w;
                    w.x = cvt_pk_h(gelu_t(v0[0] + d0[0] * h_lo(uv.x)), gelu_t(v0[1] + d0[1] * h_hi(uv.x))); w.y = cvt_pk_h(gelu_t(v0[2] + d0[2] * h_lo(uv.y)), gelu_t(v0[3] + d0[3] * h_hi(uv.y)));
                    w.z = cvt_pk_h(gelu_t(v1[0] + d1[0] * h_lo(uv.z)), gelu_t(v1[1] + d1[1] * h_hi(uv.z))); w.w = cvt_pk_h(gelu_t(v1[2] + d1[2] * h_lo(uv.w)), gelu_t(v1[3] + d1[3] * h_hi(uv.w)));
                    store16_wt(YPRE + ((size_t)bb * seq + (size_t)tile * 16 + t) * 512 + g * 16 + i0, w); } }
    }
};
struct EpiGlu {
    static constexpr bool PERM = true, AFTER_DRAIN = false;
    const bf16_t* ypre; const bf16_t* proj; int ldp, zcol0; const float* bglu; bf16_t* ycat;
    __device__ __forceinline__ void operator()(const f32x4 (&acc)[2][2][4][2], const Unit& u, int wr, int wc, int fr, int fq) const {
        const int row0 = u.pm * BM + wr * 64 + fr, col0 = u.pn * BM + wc * 32 + 8 * fq;
        f32x4 bv[2][2];
#pragma unroll
        for (int bj = 0; bj < 2; ++bj)
#pragma unroll
            for (int n = 0; n < 2; ++n) bv[bj][n] = *(const f32x4*)(bglu + col0 + bj * HALF + 4 * n);
#pragma unroll
        for (int ai = 0; ai < 2; ++ai)
#pragma unroll
            for (int m = 0; m < 4; ++m) { const size_t row = (size_t)(row0 + ai * HALF + m * 16);
#pragma unroll
                for (int bj = 0; bj < 2; ++bj) { const int col = col0 + bj * HALF;
                    const u32x4 yv = __builtin_nontemporal_load((const u32x4*)(ypre + row * 512 + col)); const u32x4 zv = __builtin_nontemporal_load((const u32x4*)(proj + row * ldp + zcol0 + col));
                    const f32x4 t0 = acc[ai][bj][m][0] + bv[bj][0], t1 = acc[ai][bj][m][1] + bv[bj][1];
                    u32x4 w;
                    w.x = cvt_pk_h(h_lo(yv.x) * fsigm(t0[0]) * fsilu(h_lo(zv.x)), h_hi(yv.x) * fsigm(t0[1]) * fsilu(h_hi(zv.x)));
                    w.y = cvt_pk_h(h_lo(yv.y) * fsigm(t0[2]) * fsilu(h_lo(zv.y)), h_hi(yv.y) * fsigm(t0[3]) * fsilu(h_hi(zv.y)));
                    w.z = cvt_pk_h(h_lo(yv.z) * fsigm(t1[0]) * fsilu(h_lo(zv.z)), h_hi(yv.z) * fsigm(t1[1]) * fsilu(h_hi(zv.z)));
                    w.w = cvt_pk_h(h_lo(yv.w) * fsigm(t1[2]) * fsilu(h_lo(zv.w)), h_hi(yv.w) * fsigm(t1[3]) * fsilu(h_hi(zv.w)));
                    store16_wt(ycat + row * 1024 + col, w); } }
    }
};
struct EpiOutRows {
    static constexpr bool PERM = false, AFTER_DRAIN = true;
    const float* x; const float* gate; int gate_stride, rows_per_batch; float* out;
    __device__ __forceinline__ static int slot(int r, int s16) { return r * 1024 + ((s16 ^ (r & 15)) << 4); }
    __device__ __forceinline__ void fused(f32x4 (&acc)[2][2][4][2], const Unit& u, int wr, int wc, int fr, int fq, PG8_LAS unsigned char* lds, int wid, int lane) const {
        const int b = (u.pm * BM) / rows_per_batch;
        const f32x4 gv = *(const f32x4*)(gate + (size_t)b * gate_stride + u.pn * BM + 4 * lane);
#pragma unroll
        for (int ai = 0; ai < 2; ++ai) {
#pragma unroll
            for (int m = 0; m < 4; ++m) { const int rl = wr * 64 + m * 16 + fr;
#pragma unroll
                for (int bj = 0; bj < 2; ++bj)
#pragma unroll
                    for (int n = 0; n < 2; ++n) *(PG8_LAS f32x4*)(lds + slot(rl, 32 * bj + 8 * wc + 4 * n + fq)) = acc[ai][bj][m][n]; }
            asm volatile("s_waitcnt lgkmcnt(0)" ::: "memory"); __builtin_amdgcn_s_barrier(); asm volatile("" ::: "memory");
            const size_t g0 = ((size_t)u.pm * BM + ai * HALF + wid * 16) * 1024 + u.pn * BM + 4 * lane;
#pragma unroll
            for (int i0 = 0; i0 < 16; i0 += 8) { f32x4 xs[8];
#pragma unroll
                for (int i = 0; i < 8; ++i) xs[i] = __builtin_nontemporal_load((const f32x4*)(x + g0 + (size_t)(i0 + i) * 1024));
#pragma unroll
                for (int i = 0; i < 8; ++i) { const f32x4 v = *(const PG8_LAS f32x4*)(lds + slot(wid * 16 + i0 + i, lane)); __builtin_nontemporal_store(xs[i] + gv * v, (f32x4*)(out + g0 + (size_t)(i0 + i) * 1024)); } }
            if (ai == 0) { asm volatile("s_waitcnt lgkmcnt(0)" ::: "memory"); __builtin_amdgcn_s_barrier(); asm volatile("" ::: "memory"); }
        }
    }
};
template <class Epi, class Sched, bool ALIGN_EPI = false, bool SP2 = false>
__device__ __forceinline__ void gemm_phase(PG8_LAS unsigned char* lds, const Gemm g, const Sched& S, const Epi& E) {
    int tid_ = threadIdx.x; asm volatile("" : "+v"(tid_));
    const int tid = tid_, wid = __builtin_amdgcn_readfirstlane(tid >> 6), lane = tid & 63, wr = wid >> 2, wc = wid & 3, fr = lane & 15, fq = lane >> 4;
    const int K = g.K, nt = K / BK;
    unsigned voffA[2], voffB[2];
#pragma unroll
    for (int i = 0; i < 2; ++i) { int R, C; stage_rc(tid * 16 + i * 8192, R, C); const int Rb = Epi::PERM ? ((R & ~31) + perm32(R & 31)) : R;
        voffA[i] = (unsigned)(R * g.lda + C) * 2u; voffB[i] = (unsigned)(Rb * K + C) * 2u; }
    const size_t kstep = (size_t)(BK * 2);
    const size_t hstepA = (size_t)HALF * g.lda * 2, hstepB = (size_t)HALF * K * 2;
    const size_t tstepA = 2 * hstepA, tstepB = 2 * hstepB;
    const unsigned ldsw = (unsigned)wid * 1024u;
    const int aoff = lds_byte(wr * 64 + fr, fq * 8), boff = lds_byte(wc * 32 + fr, fq * 8);
#define PG8_SA(b, h) (((b) * 2 + (h)) * HTB)
#define PG8_SB(b, h) ((4 + (b) * 2 + (h)) * HTB)
#define PG8_STAGE(bufoff, gbase, voff) do { _Pragma("unroll") for (int _i = 0; _i < 2; ++_i) \
        __builtin_amdgcn_global_load_lds((const unsigned*)((const char*)(gbase) + (voff)[_i]), (PG8_LAS unsigned*)(lds + (bufoff) + ldsw + _i * 8192), 16, 0, 0); } while (0)
#define PG8_LDA(dst, b, h) do { _Pragma("unroll") for (int m = 0; m < 4; ++m) _Pragma("unroll") for (int k = 0; k < 2; ++k) dst[m][k] = *(const PG8_LAS bf16x8*)(lds + PG8_SA(b, h) + aoff + m * 2048 + k * 1024); } while (0)
#define PG8_LDB(dst, b, h) do { _Pragma("unroll") for (int n = 0; n < 2; ++n) _Pragma("unroll") for (int k = 0; k < 2; ++k) dst[n][k] = *(const PG8_LAS bf16x8*)(lds + PG8_SB(b, h) + boff + n * 2048 + k * 1024); } while (0)
#define PG8_MMA(ai, bj, At, Bt) do { __builtin_amdgcn_s_setprio(1); _Pragma("unroll") for (int m = 0; m < 4; ++m) _Pragma("unroll") for (int n = 0; n < 2; ++n) _Pragma("unroll") for (int k = 0; k < 2; ++k) \
        acc[ai][bj][m][n] = __builtin_amdgcn_mfma_f32_16x16x32_f16(Bt[n][k], At[m][k], acc[ai][bj][m][n], 0, 0, 0); __builtin_amdgcn_s_setprio(0); } while (0)
#define PG8_WAIT_V(n) asm volatile("s_waitcnt vmcnt(" #n ")" ::: "memory")
#define PG8_WAIT_L(n) asm volatile("s_waitcnt lgkmcnt(" #n ")" ::: "memory")
#define PG8_BAR __builtin_amdgcn_s_barrier()
#define PG8_SCHED __builtin_amdgcn_sched_barrier(0)
    Unit cur, nxt; int ui = 0;
    if (!S.next(0, cur)) return;
    f32x4 acc[2][2][4][2];
#pragma unroll
    for (int a = 0; a < 2; ++a)
#pragma unroll
        for (int b = 0; b < 2; ++b)
#pragma unroll
            for (int m = 0; m < 4; ++m)
#pragma unroll
                for (int n = 0; n < 2; ++n) acc[a][b][m][n] = (f32x4){0.f, 0.f, 0.f, 0.f};
    bf16x8 At[4][2], B0[2][2], B1[2][2];
    const char* cA = (const char*)g.A + (size_t)cur.pm * tstepA; const char* cB = (const char*)g.Bt + (size_t)cur.pn * tstepB;
    S.a_ready(cur);
    if constexpr (SP2) {
        PG8_STAGE(PG8_SB(0, 0), cB, voffB); PG8_STAGE(PG8_SB(0, 1), cB + hstepB, voffB); PG8_STAGE(PG8_SA(0, 0), cA, voffA); PG8_STAGE(PG8_SA(0, 1), cA + hstepA, voffA);
        if (wr == 1) PG8_BAR;
        PG8_WAIT_V(2); PG8_BAR;
        PG8_STAGE(PG8_SB(1, 0), cB + kstep, voffB); PG8_STAGE(PG8_SA(1, 0), cA + kstep, voffA); PG8_STAGE(PG8_SB(1, 1), cB + hstepB + kstep, voffB);
        PG8_WAIT_V(6); PG8_BAR;
    } else {
        PG8_STAGE(PG8_SB(0, 0), cB, voffB); PG8_STAGE(PG8_SA(0, 0), cA, voffA); PG8_STAGE(PG8_SB(0, 1), cB + hstepB, voffB); PG8_STAGE(PG8_SA(0, 1), cA + hstepA, voffA);
        if (wr == 1) PG8_BAR;
        PG8_WAIT_V(4); PG8_BAR;
        PG8_STAGE(PG8_SB(1, 0), cB + kstep, voffB); PG8_STAGE(PG8_SA(1, 0), cA + kstep, voffA); PG8_STAGE(PG8_SB(1, 1), cB + hstepB + kstep, voffB);
        PG8_WAIT_V(6); PG8_BAR;
    }
    for (;;) {
        const bool has_next = S.next(ui + 1, nxt);
        const char* nA = has_next ? (const char*)g.A + (size_t)nxt.pm * tstepA : cA; const char* nB = has_next ? (const char*)g.Bt + (size_t)nxt.pn * tstepB : cB;
        for (int t = 0; t < nt; t += 2) {
            const bool last = (t == nt - 2);
            const char* a1 = cA + (size_t)(t + 1) * kstep;
            const char* a2 = last ? nA : cA + (size_t)(t + 2) * kstep; const char* b2 = last ? nB : cB + (size_t)(t + 2) * kstep;
            const char* a3 = a2 + kstep; const char* b3 = b2 + kstep;
            if (last && has_next) S.a_ready(nxt);
            if constexpr (SP2) {
            PG8_LDB(B0, 0, 0); PG8_LDB(B1, 0, 1); PG8_SCHED; PG8_LDA(At, 0, 0); PG8_STAGE(PG8_SA(1, 1), a1 + hstepA, voffA);
            PG8_WAIT_V(8); PG8_WAIT_L(0); PG8_BAR; PG8_MMA(0, 0, At, B0); PG8_MMA(0, 1, At, B1); PG8_BAR; PG8_SCHED;
            PG8_LDA(At, 0, 1); PG8_STAGE(PG8_SB(0, 0), b2, voffB); PG8_STAGE(PG8_SB(0, 1), b2 + hstepB, voffB); PG8_STAGE(PG8_SA(0, 0), a2, voffA);
            PG8_WAIT_V(8); PG8_WAIT_L(0); PG8_BAR; PG8_MMA(1, 0, At, B0); PG8_MMA(1, 1, At, B1); PG8_BAR; PG8_SCHED;
            PG8_LDB(B0, 1, 0); PG8_LDB(B1, 1, 1); PG8_SCHED; PG8_LDA(At, 1, 0); PG8_STAGE(PG8_SA(0, 1), a2 + hstepA, voffA);
            PG8_WAIT_V(8); PG8_WAIT_L(0); PG8_BAR; PG8_MMA(0, 0, At, B0); PG8_MMA(0, 1, At, B1); PG8_BAR; PG8_SCHED;
            PG8_LDA(At, 1, 1); PG8_STAGE(PG8_SB(1, 0), b3, voffB); PG8_STAGE(PG8_SB(1, 1), b3 + hstepB, voffB); PG8_STAGE(PG8_SA(1, 0), a3, voffA);
            PG8_WAIT_V(8); PG8_WAIT_L(0); PG8_BAR; PG8_MMA(1, 0, At, B0); PG8_MMA(1, 1, At, B1); PG8_BAR; PG8_SCHED;
            } else {
            PG8_LDB(B0, 0, 0); PG8_SCHED; PG8_LDA(At, 0, 0); PG8_STAGE(PG8_SA(1, 1), a1 + hstepA, voffA);
            PG8_WAIT_L(8); PG8_BAR; PG8_WAIT_L(0); PG8_MMA(0, 0, At, B0); PG8_BAR; PG8_SCHED;
            PG8_LDB(B1, 0, 1); PG8_STAGE(PG8_SB(0, 0), b2, voffB);
            PG8_BAR; PG8_WAIT_L(0); PG8_MMA(0, 1, At, B1); PG8_BAR;
            PG8_LDA(At, 0, 1); PG8_STAGE(PG8_SA(0, 0), a2, voffA);
            PG8_BAR; PG8_WAIT_L(0); PG8_MMA(1, 0, At, B0); PG8_BAR; PG8_SCHED;
            PG8_STAGE(PG8_SB(0, 1), b2 + hstepB, voffB);
            PG8_WAIT_V(6); PG8_BAR; PG8_MMA(1, 1, At, B1); PG8_BAR;
            PG8_LDB(B0, 1, 0); PG8_SCHED; PG8_LDA(At, 1, 0); PG8_STAGE(PG8_SA(0, 1), a2 + hstepA, voffA);
            PG8_WAIT_L(8); PG8_BAR; PG8_WAIT_L(0); PG8_MMA(0, 0, At, B0); PG8_BAR; PG8_SCHED;
            PG8_LDB(B1, 1, 1); PG8_STAGE(PG8_SB(1, 0), b3, voffB);
            PG8_BAR; PG8_WAIT_L(0); PG8_MMA(0, 1, At, B1); PG8_BAR;
            PG8_LDA(At, 1, 1); PG8_STAGE(PG8_SA(1, 0), a3, voffA);
            PG8_BAR; PG8_WAIT_L(0); PG8_MMA(1, 0, At, B0); PG8_BAR; PG8_SCHED;
            PG8_STAGE(PG8_SB(1, 1), b3 + hstepB, voffB);
            PG8_WAIT_V(6); PG8_BAR; PG8_MMA(1, 1, At, B1); PG8_BAR;
            }
        }
        if constexpr (ALIGN_EPI) { if (wr == 0) PG8_BAR; }
        if constexpr (!Epi::AFTER_DRAIN) { E(acc, cur, wr, wc, fr, fq); S.done(cur); }
        if (!has_next) break;
#pragma unroll
        for (int a = 0; a < 2; ++a)
#pragma unroll
            for (int b = 0; b < 2; ++b)
#pragma unroll
                for (int m = 0; m < 4; ++m)
#pragma unroll
                    for (int n = 0; n < 2; ++n) acc[a][b][m][n] = (f32x4){0.f, 0.f, 0.f, 0.f};
        cur = nxt; cA = nA; cB = nB; ++ui;
        if constexpr (ALIGN_EPI) { if (wr == 1) PG8_BAR; }
    }
    PG8_WAIT_V(0);
    if constexpr (!ALIGN_EPI) { if (wr == 0) PG8_BAR; }
    PG8_BAR;
    if constexpr (Epi::AFTER_DRAIN) { E.fused(acc, cur, wr, wc, fr, fq, lds, wid, lane); S.done(cur); }
#undef PG8_SA
#undef PG8_SB
#undef PG8_STAGE
#undef PG8_LDA
#undef PG8_LDB
#undef PG8_MMA
#undef PG8_WAIT_V
#undef PG8_WAIT_L
#undef PG8_BAR
#undef PG8_SCHED
}
}

namespace att {
using h16x8 = __attribute__((ext_vector_type(8))) _Float16;
using s16x4 = __attribute__((ext_vector_type(4))) short;
using f32x16 = __attribute__((ext_vector_type(16))) float;
using u32x4 = __attribute__((ext_vector_type(4))) unsigned;
typedef float f32x2_t __attribute__((ext_vector_type(2))); typedef _Float16 f16x2_t __attribute__((ext_vector_type(2)));
constexpr int NW = 8, QBLK = 32, KVBLK = 64, QB = 256, ASEQ = 8192;
constexpr int LDQ = 768, LDK = 1024, LDV = 512;
constexpr float SCALE = 0.10206207261596575f;
constexpr float THR = 8.f;
#define SBAR() __builtin_amdgcn_sched_barrier(0)
__device__ __forceinline__ int crow(int r, int hi) { return (r & 3) + 8 * (r >> 2) + 4 * hi; }
__device__ __forceinline__ unsigned cvtpk(float lo, float hi) { const f16x2_t v = __builtin_convertvector((f32x2_t){lo, hi}, f16x2_t); return __builtin_bit_cast(unsigned, v); }

__device__ __forceinline__ void cmask(f32x16& p0, f32x16& p1, int jb, int qrel, int hi) {
  const float NEG = -INFINITY; const int kb = 64 * jb + 4 * hi;
#pragma unroll
  for (int r = 0; r < 16; ++r) { const int kv = kb + (r & 3) + 8 * (r >> 2); if (kv > qrel) p0[r] = NEG; if (kv + 32 > qrel) p1[r] = NEG; }
}
constexpr int KT_BYTES = 12288, VT_BYTES = 8192, NKS = 3, NVS = 4;
constexpr int LDS_V0 = NKS * KT_BYTES, LDS_WSC = LDS_V0 + NVS * VT_BYTES;
constexpr int LDS_OST = LDS_WSC + NW * 64 * 4;
constexpr int LDS_ATT2 = LDS_OST + NW * 4096;
typedef __attribute__((address_space(3))) unsigned char* lds3_t;
__device__ __forceinline__ unsigned gate2(unsigned ow, unsigned zw) {
  const f16x2_t o2 = __builtin_bit_cast(f16x2_t, ow), z2 = __builtin_bit_cast(f16x2_t, zw); const float z0 = (float)z2[0], z1 = (float)z2[1];
  return cvtpk((float)o2[0] * (z0 * __builtin_amdgcn_rcpf(1.f + __builtin_amdgcn_exp2f(-1.4426950408889634f * z0))), (float)o2[1] * (z1 * __builtin_amdgcn_rcpf(1.f + __builtin_amdgcn_exp2f(-1.4426950408889634f * z1))));
}
#define PIN(x) asm volatile("" : "+v"(x))
#define MFMAH(a, b, c) __builtin_amdgcn_mfma_f32_32x32x16_f16(a, b, c, 0, 0, 0)
typedef __attribute__((address_space(3))) const char* lds_cptr;
typedef short v4i16_t __attribute__((ext_vector_type(4)));
__device__ __forceinline__ void kload2(h16x8* kf, lds_cptr kp, int d0) { kf[2 * d0] = *(const __attribute__((address_space(3))) h16x8*)(kp + d0 * 2048); kf[2 * d0 + 1] = *(const __attribute__((address_space(3))) h16x8*)(kp + d0 * 2048 + 512); }
__device__ __forceinline__ s16x4 vtr(lds_cptr p) { return __builtin_bit_cast(s16x4, __builtin_amdgcn_ds_read_tr16_b64_v4i16((__attribute__((address_space(3))) v4i16_t*)p)); }
#define MX3(a, b, c) __builtin_fmaxf(__builtin_fmaxf((a), (b)), (c))
__device__ __forceinline__ float rowmax(const f32x16& p0, const f32x16& p1) {
  float a = MX3(p0[0], p0[1], p1[0]), b = MX3(p0[2], p0[3], p1[1]); a = MX3(a, p1[2], p1[3]);
#pragma unroll
  for (int r = 4; r < 16; r += 4) { a = MX3(a, p0[r], p0[r + 1]); b = MX3(b, p0[r + 2], p0[r + 3]); a = MX3(a, p1[r], p1[r + 1]); b = MX3(b, p1[r + 2], p1[r + 3]); }
  float m = __builtin_fmaxf(a, b); auto rr = __builtin_amdgcn_permlane32_swap(__float_as_uint(m), __float_as_uint(m), false, false);
  return __builtin_fmaxf(__uint_as_float(rr[0]), __uint_as_float(rr[1])); }
__device__ __forceinline__ void attn_unit(int b, int h, int qb, const unsigned short* __restrict__ Q, const unsigned short* __restrict__ KIMG, const unsigned short* __restrict__ VIMG,
                                          const unsigned short* __restrict__ PROJ, int ldp, int zcol0, unsigned short* __restrict__ YCAT, char* lds, lds3_t lds3, unsigned* done_cnt, unsigned* z_cnt, unsigned* tmo,
                                          int next_qword, int next_slot_off) {
  int tid_ = threadIdx.x; asm volatile("" : "+v"(tid_));
  const int tid = tid_, lane = tid & 63, r32 = lane & 31, hi = lane >> 5; const int wid = __builtin_amdgcn_readfirstlane(tid >> 6);
  float* ws = (float*)(lds + LDS_WSC) + wid * 64; float* li_l = ws; float* al_l = ws + 32;
  const long rowbase = (long)b * ASEQ; const int q0 = qb * QB;
  const int NT = (q0 + QB) / KVBLK;
  const char* Kg = (const char*)KIMG + (size_t)(b * 8 + h) * 128 * KT_BYTES;
  const char* Vg = (const char*)VIMG + (size_t)(b * 8 + h) * 128 * VT_BYTES;
  const unsigned lo16 = (unsigned)lane * 16u;
  const lds_cptr kp0 = (lds_cptr)lds3 + hi * 1024 + r32 * 16;
  const lds_cptr vp0 = (lds_cptr)lds3 + LDS_V0 + ((lane >> 4) & 1) * 32 + (lane & 3) * 8 + (4 * hi + ((lane & 15) >> 2)) * 64;
  constexpr float THRL = THR * 1.4426950408889634f;
#define GLDS(gp, loff) do { const char* gu_ = (gp); asm volatile("" : "+s"(gu_)); __builtin_amdgcn_global_load_lds((const unsigned*)(gu_ + lo16), (__attribute__((address_space(3))) unsigned*)(lds3 + (loff)), 16, 0, 0); } while (0)
#define DMA_K(t, slot) do { const char* kg_ = Kg + (size_t)(t) * KT_BYTES; const int ko_ = (slot) * KT_BYTES; GLDS(kg_ + wid * 1024, ko_ + wid * 1024); if (wid < 4) GLDS(kg_ + (8 + wid) * 1024, ko_ + (8 + wid) * 1024); } while (0)
#define DMA_V(t, slot) do { GLDS(Vg + (size_t)(t) * VT_BYTES + wid * 1024, LDS_V0 + (slot) * VT_BYTES + wid * 1024); } while (0)
#define WAITB(A, B) do { if (wid < 4) asm volatile("s_waitcnt vmcnt(" #A ") lgkmcnt(0)\n\ts_barrier" ::: "memory"); else asm volatile("s_waitcnt vmcnt(" #B ") lgkmcnt(0)\n\ts_barrier" ::: "memory"); } while (0)
  float mhat = 0.f, l_reg = 0.f; f32x16 o[2]; o[0] = f32x16{}; o[1] = f32x16{}; h16x8 qr[6]; f32x16 negm = {}; PIN(negm);
  const int qrel = wid * QBLK + r32; bool resc = false;
  f32x16 pA0, pA1, pB0, pB1; h16x8 kf[12]; s16x4 vlo[8], vhi[8]; u32x4 pw0, pw1, pw2, pw3;
  int s_prev = 0, s_cur = 0, s_next = 1;
#define ROT() do { s_prev = s_cur; s_cur = s_next; s_next = (s_next == 2) ? 0 : s_next + 1; } while (0)
#define RESC() do { if (resc) { _Pragma("unroll") for (int d_ = 0; d_ < 2; ++d_) _Pragma("unroll") for (int r = 0; r < 16; ++r) o[d_][r] *= al_l[crow(r, hi)]; } } while (0)
  DMA_K(0, 0); DMA_V(0, 0); DMA_K(1, 1);
  { const unsigned short* Qw = Q + (rowbase + q0 + wid * QBLK + r32) * LDQ + h * 96 + hi * 8;
#pragma unroll
    for (int d0 = 0; d0 < 6; ++d0) qr[d0] = __builtin_nontemporal_load(reinterpret_cast<const h16x8*>(Qw + d0 * 16)); }
  DMA_K(2, 2);
  WAITB(2, 1);
#pragma unroll
  for (int d0 = 0; d0 < 6; ++d0) kload2(kf, kp0, d0);
  pA0 = MFMAH(kf[0], qr[0], negm); pA1 = MFMAH(kf[1], qr[0], negm);
#pragma unroll
  for (int d0 = 1; d0 < 6; ++d0) { pA0 = MFMAH(kf[2 * d0], qr[d0], pA0); pA1 = MFMAH(kf[2 * d0 + 1], qr[d0], pA1); }
  if (NT == 4) cmask(pA0, pA1, 0, qrel, hi);
  { const float rm = rowmax(pA0, pA1); mhat = rm;
#pragma unroll
    for (int r = 0; r < 16; ++r) negm[r] = -rm;
    PIN(negm);
#pragma unroll
    for (int r = 0; r < 16; ++r) { pA0[r] = __builtin_amdgcn_exp2f(pA0[r] - rm); pA1[r] = __builtin_amdgcn_exp2f(pA1[r] - rm); } }
  WAITB(0, 0);
  DMA_K(3, 0); DMA_V(1, 1); ROT();
#pragma unroll
  for (int d0 = 0; d0 < 6; ++d0) kload2(kf, kp0 + s_cur * KT_BYTES, d0);
  WAITB(3, 2);
#define PKW(P, i) cvtpk(P[i], P[i + 1])
#define PAF(k) __builtin_bit_cast(h16x8, pw##k)
#define VFR(i) __builtin_bit_cast(h16x8, (__attribute__((ext_vector_type(8))) short){vlo[i][0], vlo[i][1], vlo[i][2], vlo[i][3], vhi[i][0], vhi[i][1], vhi[i][2], vhi[i][3]})
#define VRD(i) do { vlo[i] = vtr(vp_ + (((i) >> 2) * 4096 + ((i) & 3) * 1024)); vhi[i] = vtr(vp_ + (((i) >> 2) * 4096 + ((i) & 3) * 1024 + 512)); } while (0)
#define KRD(G, d0) do { if (G) { kload2(kf, kp0 + s_next * KT_BYTES, d0); SBAR(); } } while (0)
#define GAPA(MF, a0, a1, a2, W0, W1, PW) do { MF; sacc += a0; sacc += a1; sacc += a2; W0; W1; PIN(PW); PIN(sacc); SBAR(); } while (0)
#define GAPA3(MF, a0, a1, a2) do { MF; sacc += a0; sacc += a1; sacc += a2; PIN(sacc); SBAR(); } while (0)
#define GAPB(MF, X, i) do { MF; X[i] = __builtin_amdgcn_exp2f(X[i]); X[i + 1] = __builtin_amdgcn_exp2f(X[i + 1]); X[i + 2] = __builtin_amdgcn_exp2f(X[i + 2]); X[i + 3] = __builtin_amdgcn_exp2f(X[i + 3]); PIN(X); SBAR(); } while (0)
#define STEP(C0, C1, P0, P1, t, MASK, GK, GV, GL) do { SBAR(); \
    const lds_cptr vp_ = vp0 + s_prev * VT_BYTES; \
    VRD(0); SBAR(); float sacc = P0[0] + P0[1]; \
                    GAPA(C0 = MFMAH(kf[0], qr[0], negm), P0[2], P0[3], P0[4],     pw0[0] = PKW(P0, 0),  pw0[1] = PKW(P0, 2),  pw0); \
    VRD(4); SBAR(); GAPA(C1 = MFMAH(kf[1], qr[0], negm), P0[5], P0[6], P0[7],     pw0[2] = PKW(P0, 4),  pw0[3] = PKW(P0, 6),  pw0); \
    VRD(1); SBAR(); GAPA(C0 = MFMAH(kf[2], qr[1], C0),   P0[8], P0[9], P0[10],    pw1[0] = PKW(P0, 8),  pw1[1] = PKW(P0, 10), pw1); \
    VRD(5); SBAR(); GAPA(C1 = MFMAH(kf[3], qr[1], C1),   P0[11], P0[12], P0[13],  pw1[2] = PKW(P0, 12), pw1[3] = PKW(P0, 14), pw1); \
    VRD(2); SBAR(); GAPA(C0 = MFMAH(kf[4], qr[2], C0),   P0[14], P0[15], P1[0],   pw2[0] = PKW(P1, 0),  pw2[1] = PKW(P1, 2),  pw2); \
    VRD(6); SBAR(); GAPA(C1 = MFMAH(kf[5], qr[2], C1),   P1[1], P1[2], P1[3],     pw2[2] = PKW(P1, 4),  pw2[3] = PKW(P1, 6),  pw2); \
                    GAPA(C0 = MFMAH(kf[6], qr[3], C0),   P1[4], P1[5], P1[6],     pw3[0] = PKW(P1, 8),  pw3[1] = PKW(P1, 10), pw3); \
                    GAPA(C1 = MFMAH(kf[7], qr[3], C1),   P1[7], P1[8], P1[9],     pw3[2] = PKW(P1, 12), pw3[3] = PKW(P1, 14), pw3); \
    GAPA3(C0 = MFMAH(kf[8], qr[4], C0), P1[10], P1[11], P1[12]); \
    GAPA3(C1 = MFMAH(kf[9], qr[4], C1), P1[13], P1[14], P1[15]); \
    C0 = MFMAH(kf[10], qr[5], C0); C1 = MFMAH(kf[11], qr[5], C1); \
    l_reg += sacc; \
    if (GK) DMA_K((t) + 3, s_cur); if (GV) DMA_V((t) + 1, s_next);                                                         \
    KRD(GL, 0); KRD(GL, 1);                                                                                                   \
    if (MASK) cmask(C0, C1, (t) - (NT - 4), qrel, hi); \
    { const float rm = rowmax(C0, C1); resc = false;                                                                       \
      if (__builtin_expect(__any(rm > THRL), 0)) { const float dl = __builtin_fmaxf(rm, 0.f); mhat += dl;                  \
          const float f = __builtin_amdgcn_exp2f(-dl); l_reg *= f; if (hi == 0) al_l[r32] = f; resc = true; \
          _Pragma("unroll") for (int r = 0; r < 16; ++r) { C0[r] -= dl; C1[r] -= dl; } \
          _Pragma("unroll") for (int r = 0; r < 16; ++r) negm[r] = -mhat; \
          PIN(negm); } } \
    SBAR(); \
    VRD(3); SBAR(); KRD(GL, 2); GAPB(o[0] = MFMAH(PAF(0), VFR(0), o[0]), C0, 0);  VRD(7); SBAR(); KRD(GL, 3); GAPB(o[1] = MFMAH(PAF(0), VFR(4), o[1]), C0, 4);     \
    KRD(GL, 4); GAPB(o[0] = MFMAH(PAF(1), VFR(1), o[0]), C0, 8);  KRD(GL, 5); GAPB(o[1] = MFMAH(PAF(1), VFR(5), o[1]), C0, 12); \
    GAPB(o[0] = MFMAH(PAF(2), VFR(2), o[0]), C1, 0);              GAPB(o[1] = MFMAH(PAF(2), VFR(6), o[1]), C1, 4); \
    GAPB(o[0] = MFMAH(PAF(3), VFR(3), o[0]), C1, 8);              GAPB(o[1] = MFMAH(PAF(3), VFR(7), o[1]), C1, 12); \
    } while (0)
  int t = 1;
  for (; t + 5 < NT; t += 2) {
    STEP(pB0, pB1, pA0, pA1, t, false, true, true, true);     WAITB(3, 2); RESC(); ROT();
    STEP(pA0, pA1, pB0, pB1, t + 1, false, true, true, true); WAITB(3, 2); RESC(); ROT();
  }
#define ENDW(tt) do { if ((tt) + 3 < NT) { WAITB(3, 2); } else if ((tt) + 2 < NT) { WAITB(1, 1); } else { WAITB(0, 0); } } while (0)
  for (; t + 1 < NT; t += 2) {
    STEP(pB0, pB1, pA0, pA1, t, true, (t + 3 < NT), (t + 1 < NT), (t + 1 < NT));         ENDW(t);     RESC(); ROT();
    STEP(pA0, pA1, pB0, pB1, t + 1, true, (t + 4 < NT), (t + 2 < NT), (t + 2 < NT));     ENDW(t + 1); RESC(); ROT();
  }
  STEP(pB0, pB1, pA0, pA1, NT - 1, true, false, false, false); RESC();
  { float sacc = pB0[0] + pB0[1];
#pragma unroll
    for (int r = 2; r < 16; ++r) sacc += pB0[r];
#pragma unroll
    for (int r = 0; r < 16; ++r) sacc += pB1[r];
    l_reg += sacc;
    pw0 = (u32x4){PKW(pB0, 0), PKW(pB0, 2), PKW(pB0, 4), PKW(pB0, 6)}; pw1 = (u32x4){PKW(pB0, 8), PKW(pB0, 10), PKW(pB0, 12), PKW(pB0, 14)};
    pw2 = (u32x4){PKW(pB1, 0), PKW(pB1, 2), PKW(pB1, 4), PKW(pB1, 6)}; pw3 = (u32x4){PKW(pB1, 8), PKW(pB1, 10), PKW(pB1, 12), PKW(pB1, 14)};
    const lds_cptr vp_ = vp0 + s_cur * VT_BYTES;
#pragma unroll
    for (int i = 0; i < 8; ++i) VRD(i);
    o[0] = MFMAH(PAF(0), VFR(0), o[0]); o[1] = MFMAH(PAF(0), VFR(4), o[1]); o[0] = MFMAH(PAF(1), VFR(1), o[0]); o[1] = MFMAH(PAF(1), VFR(5), o[1]);
    o[0] = MFMAH(PAF(2), VFR(2), o[0]); o[1] = MFMAH(PAF(2), VFR(6), o[1]); o[0] = MFMAH(PAF(3), VFR(3), o[0]); o[1] = MFMAH(PAF(3), VFR(7), o[1]); }
  { auto rr = __builtin_amdgcn_permlane32_swap(__float_as_uint(l_reg), __float_as_uint(l_reg), false, false); l_reg = __uint_as_float(rr[0]) + __uint_as_float(rr[1]); }
  if (hi == 0) li_l[r32] = l_reg; asm volatile("s_waitcnt lgkmcnt(0)" ::: "memory");
  float rli[16];
#pragma unroll
  for (int r = 0; r < 16; ++r) rli[r] = __builtin_amdgcn_rcpf(li_l[crow(r, hi)]);
  if (z_cnt && wid == 0) { unsigned sp = 0;
    while (__hip_atomic_load(z_cnt, __ATOMIC_RELAXED, __HIP_MEMORY_SCOPE_AGENT) < 2u) { __builtin_amdgcn_s_sleep(2); if (++sp > (1u << 22)) { if (lane == 0) __hip_atomic_store(tmo, 1u, __ATOMIC_RELAXED, __HIP_MEMORY_SCOPE_AGENT); break; } }
    __builtin_amdgcn_fence(__ATOMIC_ACQUIRE, "agent"); asm volatile("s_waitcnt vmcnt(0)" ::: "memory"); }
  unsigned nxt_ = 0u; if (next_qword >= 0 && tid == 0) nxt_ = __hip_atomic_fetch_add(tmo + next_qword + 64 * (blockIdx.x & 7u), 1u, __ATOMIC_RELAXED, __HIP_MEMORY_SCOPE_AGENT);
  asm volatile("s_waitcnt lgkmcnt(0)\n\ts_barrier" ::: "memory");
  const long orow0 = rowbase + q0 + wid * QBLK;
  { unsigned short* stg = (unsigned short*)(lds + LDS_OST) + wid * 2048;
#pragma unroll
    for (int r = 0; r < 16; ++r) { const int orow = crow(r, hi);
#pragma unroll
      for (int d0 = 0; d0 < 2; ++d0) stg[orow * 64 + d0 * 32 + r32] = __builtin_bit_cast(unsigned short, (_Float16)(o[d0][r] * rli[r])); }
    asm volatile("s_waitcnt lgkmcnt(0)" ::: "memory");
#pragma unroll
    for (int i = 0; i < 4; ++i) { const int row = i * 8 + (lane >> 3), ch = lane & 7; const long grow = orow0 + row;
      const u32x4 ov = *(const u32x4*)(stg + row * 64 + ch * 8); const u32x4 zv = __builtin_nontemporal_load((const u32x4*)(PROJ + grow * ldp + zcol0 + h * 64 + ch * 8));
      u32x4 w;
      w.x = gate2(ov.x, zv.x); w.y = gate2(ov.y, zv.y); w.z = gate2(ov.z, zv.z); w.w = gate2(ov.w, zv.w);
      store16_wt(YCAT + grow * 1024 + 512 + h * 64 + ch * 8, w); } }
  if (next_qword >= 0 && tid == 0) *(volatile __attribute__((address_space(3))) unsigned*)(lds3 + next_slot_off) = nxt_;
  asm volatile("s_waitcnt vmcnt(0) lgkmcnt(0)\n\ts_barrier" ::: "memory");
  if (tid == 0) __hip_atomic_fetch_add(done_cnt, 1u, __ATOMIC_RELAXED, __HIP_MEMORY_SCOPE_AGENT);
#undef GLDS
#undef DMA_K
#undef DMA_V
#undef WAITB
#undef ROT
#undef RESC
#undef PKW
#undef PAF
#undef VFR
#undef VRD
#undef KRD
#undef GAPA
#undef GAPA3
#undef GAPB
#undef STEP
#undef ENDW
}
#undef PIN
#undef MFMAH
#undef MX3
#undef SBAR
}

#define GAS __attribute__((address_space(1)))
#define LAS __attribute__((address_space(3)))
typedef unsigned v4u __attribute__((ext_vector_type(4)));
typedef float f32x4 __attribute__((ext_vector_type(4)));
typedef short bf16x8 __attribute__((ext_vector_type(8)));
typedef GAS unsigned gu32;
typedef GAS unsigned long long gu64;
#define RLX_AGENT __ATOMIC_RELAXED, __HIP_MEMORY_SCOPE_AGENT
#define LDS_WAIT() asm volatile("s_waitcnt lgkmcnt(0)" ::: "memory")
#define VM_WAIT() asm volatile("s_waitcnt vmcnt(0)" ::: "memory")
__device__ __forceinline__ unsigned long long rt() { return __builtin_amdgcn_s_memrealtime(); }

#define XB_TMO      128
#define XB_XCNT(j)  (256  + 64 * (j))
#define XB_XSUB(j)  (1280 + 64 * (j))
#define XB_XGEN(j)  (2304 + 64 * (j))
#define XB_TOP      3328
#define XB_TOPGEN   3392
#define XCD_BAR_WORDS 3456
#define XB_SPIN_CAP (1u << 18)

__device__ __forceinline__ unsigned xb_ld(unsigned* p)              { return __hip_atomic_load(p, __ATOMIC_RELAXED, __HIP_MEMORY_SCOPE_AGENT); }
__device__ __forceinline__ unsigned xb_add(unsigned* p, unsigned v) { return __hip_atomic_fetch_add(p, v, __ATOMIC_RELAXED, __HIP_MEMORY_SCOPE_AGENT); }
__device__ __forceinline__ unsigned xb_xcc_id() { return (unsigned)__builtin_amdgcn_s_getreg((3 << 11) | 20) & 0xFu; }
#define XB_SPIN(cond, bar) do { unsigned _sp = 0; while (cond) { __builtin_amdgcn_s_sleep(1); \
    if ((++_sp & 255u) == 0u) { if (xb_ld(&(bar)[XB_TMO])) break; if (_sp > XB_SPIN_CAP) { atomicAdd(&(bar)[XB_TMO], 1u); break; } } } } while (0)

struct XcdBarrier {
    unsigned* bar; unsigned x;
    volatile LAS unsigned* st;
};

__device__ __forceinline__ XcdBarrier xcd_barrier_post(unsigned* bar, volatile LAS unsigned* st) {
    XcdBarrier b; b.bar = bar; b.x = xb_xcc_id(); b.st = st;
    if (threadIdx.x == 0) (void)xb_add(&bar[XB_XCNT(b.x)], 1u);
    return b;
}
__device__ __forceinline__ void xcd_barrier_complete(unsigned* bar, unsigned x, unsigned& nloc, unsigned& nx) {
    const unsigned G = gridDim.x * gridDim.y * gridDim.z;
    unsigned sum, cnt, mine, sp = 0u;
    for (;;) {
        sum = 0u; cnt = 0u; mine = 0u;
#pragma unroll
        for (unsigned j = 0; j < 16; ++j) { const unsigned c = xb_ld(&bar[XB_XCNT(j)]); sum += c; cnt += (c > 0u) ? 1u : 0u; mine = (j == x) ? c : mine; }
        if (sum == G) break;
        __builtin_amdgcn_s_sleep(1);
        if ((++sp & 255u) == 0u) { if (xb_ld(&bar[XB_TMO])) break; if (sp > XB_SPIN_CAP) { atomicAdd(&bar[XB_TMO], 1u); break; } }
    }
    nloc = mine > 0u ? mine : 1u; nx = cnt > 0u ? cnt : 1u;
}

__device__ __forceinline__ void xcd_barrier(const XcdBarrier& b) {
    asm volatile("s_waitcnt vmcnt(0)" ::: "memory");
    __syncthreads();
    if (threadIdx.x == 0) {
        unsigned* bar = b.bar;
        __builtin_amdgcn_s_waitcnt(0);
        unsigned nloc = b.st[0], nx = b.st[1];
        if (nloc == 0u) { xcd_barrier_complete(bar, b.x, nloc, nx); b.st[0] = nloc; b.st[1] = nx; }
        const unsigned old = xb_add(&bar[XB_XSUB(b.x)], 1u);
        const unsigned gen = old / nloc;
        if (old + 1u == (gen + 1u) * nloc) {
            __builtin_amdgcn_fence(__ATOMIC_RELEASE, "agent");
            asm volatile("s_waitcnt vmcnt(0)" ::: "memory");
            const unsigned og = xb_add(&bar[XB_TOP], 1u);
            const unsigned tg = og / nx;
            if (og + 1u == (tg + 1u) * nx) xb_add(&bar[XB_TOPGEN], 1u);
            else XB_SPIN(xb_ld(&bar[XB_TOPGEN]) == tg, bar);
            __builtin_amdgcn_fence(__ATOMIC_ACQUIRE, "agent");
            xb_add(&bar[XB_XGEN(b.x)], 1u);
            asm volatile("s_waitcnt vmcnt(0)" ::: "memory");
        } else {
            XB_SPIN(xb_ld(&bar[XB_XGEN(b.x)]) == gen, bar);
            __builtin_amdgcn_fence(__ATOMIC_ACQUIRE, "agent");
            asm volatile("s_waitcnt vmcnt(0)" ::: "memory");
        }
    }
    __syncthreads();
}

constexpr int NWAVES = 8;
constexpr int NPHASE = 4;
constexpr int CW_RDV = 98304;
constexpr int CW_TMO = 0, CW_CODE = 1, CW_MODC = 64, CW_OUTQ = 2048, CW_CHAIN = 81920, CW_ATTQ = 1024, CW_PANEL = 65536, CW_OUTP = 73728, CW_BAR = 4096;
constexpr int RING_OFF = 0, RING_BYTES = 131072;
constexpr int LDSCTL_OFF = RING_BYTES, MISC_OFF = LDSCTL_OFF + 320;
constexpr int SACT_OFF = LDSCTL_OFF + 1024;
constexpr int LDS_BYTES = 147456;
static_assert(MISC_OFF + 128 <= SACT_OFF && SACT_OFF + 8192 + 1024 <= LDS_BYTES, "LDS map");
static_assert(att::LDS_ATT2 <= RING_BYTES && pg8::STAGE_BYTES <= RING_BYTES, "phase scratch fits the ring");

struct Frame {
    LAS unsigned char* lds;
    volatile LAS unsigned* MISC;
    gu32* ctl;
    int tid, lane, wave, vcu, G;
};
__device__ __forceinline__ float wave_sum(float v) {
#pragma unroll
    for (int o = 1; o < 64; o <<= 1) v += __shfl_xor(v, o);
    return v;
}
__device__ __forceinline__ unsigned pk2h(float lo, float hi) { return pg8::cvt_pk_h(lo, hi); }

__device__ __forceinline__ void p0_transpose_item(const float* W, int ldw, int K, int src_n0, bf16* WT, int dst_row0, int k0, LAS float* scr, int lane, const float* gk = nullptr) {
    float t_[32];
#pragma unroll
    for (int i = 0; i < 32; ++i) t_[i] = __builtin_nontemporal_load(W + (size_t)(k0 + 2 * i + (lane >> 5)) * ldw + src_n0 + (lane & 31));
#pragma unroll
    for (int i = 0; i < 32; ++i) scr[(2 * i + (lane >> 5)) * 33 + (lane & 31)] = t_[i];
    LDS_WAIT(); asm volatile("" ::: "memory");
    const int c = lane & 7;
#pragma unroll
    for (int j = 0; j < 4; ++j) { const int n = (lane >> 3) + 8 * j; const LAS float* s = scr + (8 * c) * 33 + n;
        f32x4 g0 = {1.f, 1.f, 1.f, 1.f}, g1 = g0; if (gk) { g0 = *(const f32x4*)(gk + k0 + 8 * c); g1 = *(const f32x4*)(gk + k0 + 8 * c + 4); }
        v4u o; o.x = pk2h(s[0 * 33] * g0.x, s[1 * 33] * g0.y); o.y = pk2h(s[2 * 33] * g0.z, s[3 * 33] * g0.w); o.z = pk2h(s[4 * 33] * g1.x, s[5 * 33] * g1.y); o.w = pk2h(s[6 * 33] * g1.z, s[7 * 33] * g1.w);
        *(GAS v4u*)(WT + (size_t)(dst_row0 + n) * K + k0 + 8 * c) = o; }
    LDS_WAIT(); asm volatile("" ::: "memory");
}

struct Args {
    const float* in[24]; float* out; unsigned char* ws; int ph_lo, ph_hi, li, pad;
};

__device__ __forceinline__ void p0_mod_block(const LAS float* sact, LAS float* part, const float* w_ada, const float* b_ada, float* mod, gu32* cnt, int j, int wave, int lane) {
    const int kk = lane >> 2, c4 = lane & 3, col = 16 * j + 4 * c4;
    f32x4 w[8];
#pragma unroll
    for (int s = 0; s < 8; ++s) w[s] = __builtin_nontemporal_load((const GAS f32x4*)(w_ada + (size_t)(128 * wave + kk + 16 * s) * 3072 + col));
    f32x4 a0 = {0.f, 0.f, 0.f, 0.f}, a1 = {0.f, 0.f, 0.f, 0.f};
#pragma unroll
    for (int s = 0; s < 8; ++s) { const int k = 128 * wave + kk + 16 * s; a0 += w[s] * sact[k]; a1 += w[s] * sact[1024 + k]; }
#pragma unroll
    for (int o = 4; o < 64; o <<= 1) {
#pragma unroll
        for (int e = 0; e < 4; ++e) { a0[e] += __shfl_xor(a0[e], o); a1[e] += __shfl_xor(a1[e], o); } }
    if (lane < 4) {
#pragma unroll
        for (int e = 0; e < 4; ++e) { part[wave * 32 + 4 * c4 + e] = a0[e]; part[wave * 32 + 16 + 4 * c4 + e] = a1[e]; } }
    __syncthreads();
    if (wave == 0) {
        if (lane < 32) { float t = b_ada[16 * j + (lane & 15)];
#pragma unroll
            for (int ww = 0; ww < 8; ++ww) t += part[ww * 32 + lane];
            __hip_atomic_store((GAS float*)(mod + (lane >> 4) * 3072 + 16 * j + (lane & 15)), t, RLX_AGENT); }
        asm volatile("s_waitcnt vmcnt(0)" ::: "memory");
        if (lane == 0) __hip_atomic_fetch_add(cnt, 1u, RLX_AGENT);
    }
    __syncthreads();
}
__device__ __forceinline__ void cis_reduced(double ang, float& c, float& s) {
    const double TWO_PI = 6.283185307179586476925286766559;
    const float r = (float)(ang - TWO_PI * rint(ang / TWO_PI)); c = cosf(r); s = sinf(r);
}
__device__ __forceinline__ void ssm_pow(float lr, float li, float dtf, int n, float& pr, float& pi) {
    float c, s_; cis_reduced((double)n * (double)li * (double)dtf, c, s_); const float e = expf((float)n * lr * dtf); pr = e * c; pi = e * s_;
}
__device__ __forceinline__ void p0_ssm_item(const float* log_dt, const float* lam_re, const float* lam_im, float* AC, int g, int lane) {
    const float dtf = expf(log_dt[g]); const float lr = lam_re[g * 64 + lane], li = lam_im[g * 64 + lane];
    float a0, a1, a2, a3; ssm_pow(lr, li, dtf, 1, a0, a1); ssm_pow(lr, li, dtf, 16, a2, a3); const f32x4 v = {a0, a1, a2, a3};
    *(f32x4*)(AC + ((size_t)g * 64 + lane) * 4) = v;
}
__device__ __forceinline__ void ssm_coef_pow(const float* log_dt, const float* lam_re, const float* lam_im, int g, int lane, int n, float& cr, float& ci) {
    const float dtf = expf(log_dt[g]); const float lr = lam_re[g * 64 + lane], li = lam_im[g * 64 + lane];
    float ar, ai, pr, pi; ssm_pow(lr, li, dtf, 1, ar, ai); ssm_pow(lr, li, dtf, n, pr, pi);
    const float nr = ar - 1.f, ni = ai, den = lr * lr + li * li;
    const float kr = (nr * lr + ni * li) / den, ki = (ni * lr - nr * li) / den;
    cr = kr * pr - ki * pi; ci = kr * pi + ki * pr;
}
__device__ __forceinline__ void p0_ssm_K_item(const float* log_dt, const float* lam_re, const float* lam_im, const float* b_re, const float* b_im, const float* c_re, const float* c_im,
                                              bf16* TQ, int g, int d, LAS float* scr, int lane) {
    float cr, ci; ssm_coef_pow(log_dt, lam_re, lam_im, g, lane, d, cr, ci);
#pragma unroll
    for (int j = 0; j < 16; ++j) { const float br = b_re[(g * 64 + lane) * 16 + j], bi = b_im[(g * 64 + lane) * 16 + j];
        scr[(lane * 16 + j) * 2] = cr * br - ci * bi; scr[(lane * 16 + j) * 2 + 1] = cr * bi + ci * br; }
    LAS float* cl = scr + 2048;
#pragma unroll
    for (int q = 0; q < 16; ++q) { cl[(q * 64 + lane) * 2] = c_re[(g * 16 + q) * 64 + lane]; cl[(q * 64 + lane) * 2 + 1] = c_im[(g * 16 + q) * 64 + lane]; }
    LDS_WAIT(); asm volatile("" ::: "memory");
    const int i = lane & 15, jq = lane >> 4; float acc[4] = {0.f, 0.f, 0.f, 0.f};
#pragma unroll 8
    for (int p = 0; p < 64; ++p) { const float xr = cl[(i * 64 + p) * 2], xi = cl[(i * 64 + p) * 2 + 1];
#pragma unroll
        for (int e = 0; e < 4; ++e) acc[e] += xr * scr[(p * 16 + 4 * jq + e) * 2] - xi * scr[(p * 16 + 4 * jq + e) * 2 + 1]; }
    const unsigned long long kv = (unsigned long long)pk2h(acc[0], acc[1]) | ((unsigned long long)pk2h(acc[2], acc[3]) << 32);
    bf16* base = TQ + (size_t)g * 256 * 384;
    for (int t = d; t < 16; ++t) *(GAS unsigned long long*)(base + (size_t)(t * 16 + i) * 384 + (t - d) * 16 + 4 * jq) = kv;
    if (d > 0) for (int t = 0; t + d < 16; ++t) *(GAS unsigned long long*)(base + (size_t)(t * 16 + i) * 384 + (t + d) * 16 + 4 * jq) = 0ull;
    LDS_WAIT(); asm volatile("" ::: "memory");
}
__device__ __forceinline__ void p0_ssm_Q_item(const float* log_dt, const float* lam_re, const float* lam_im, const float* c_re, const float* c_im, bf16* TQ, int g, int t, int lane) {
    const float dtf = expf(log_dt[g]); float pr, pi; ssm_pow(lam_re[g * 64 + lane], lam_im[g * 64 + lane], dtf, t + 1, pr, pi);
#pragma unroll
    for (int i = 0; i < 16; ++i) { const float xr = c_re[(g * 16 + i) * 64 + lane], xi = c_im[(g * 16 + i) * 64 + lane];
        *(GAS unsigned*)(TQ + ((size_t)g * 256 + t * 16 + i) * 384 + 256 + 2 * lane) = pk2h(xr * pr - xi * pi, -(xr * pi + xi * pr)); }
}
__device__ __forceinline__ void p0_ssm_P_item(const float* log_dt, const float* lam_re, const float* lam_im, const float* b_re, const float* b_im, bf16* PP, int g, int s_, int lane) {
    float cr, ci; ssm_coef_pow(log_dt, lam_re, lam_im, g, lane, 15 - s_, cr, ci);
    float wr[16], wi[16];
#pragma unroll
    for (int j = 0; j < 16; ++j) { const float br = b_re[(g * 64 + lane) * 16 + j], bi = b_im[(g * 64 + lane) * 16 + j]; wr[j] = cr * br - ci * bi; wi[j] = cr * bi + ci * br; }
    bf16* r0 = PP + ((size_t)g * 256 + 2 * lane) * 256 + s_ * 16;
    v4u o; o.x = pk2h(wr[0], wr[1]); o.y = pk2h(wr[2], wr[3]); o.z = pk2h(wr[4], wr[5]); o.w = pk2h(wr[6], wr[7]); *(GAS v4u*)r0 = o;
    o.x = pk2h(wr[8], wr[9]); o.y = pk2h(wr[10], wr[11]); o.z = pk2h(wr[12], wr[13]); o.w = pk2h(wr[14], wr[15]); *(GAS v4u*)(r0 + 8) = o;
    o.x = pk2h(wi[0], wi[1]); o.y = pk2h(wi[2], wi[3]); o.z = pk2h(wi[4], wi[5]); o.w = pk2h(wi[6], wi[7]); *(GAS v4u*)(r0 + 256) = o;
    o.x = pk2h(wi[8], wi[9]); o.y = pk2h(wi[10], wi[11]); o.z = pk2h(wi[12], wi[13]); o.w = pk2h(wi[14], wi[15]); *(GAS v4u*)(r0 + 256 + 8) = o;
}

__global__ void __launch_bounds__(NWAVES * 64, 2) mega_fwd(Args args) {
    extern __shared__ __attribute__((aligned(16))) unsigned char lds[];
    Frame F;
    F.lds = (LAS unsigned char*)lds;
    F.MISC = (volatile LAS unsigned*)(F.lds + MISC_OFF);
    F.tid = threadIdx.x; F.lane = F.tid & 63; F.wave = __builtin_amdgcn_readfirstlane(F.tid >> 6);
    F.G = gridDim.x; { const int bx = blockIdx.x; F.vcu = (F.G % 8 == 0) ? (bx % 8) * (F.G / 8) + bx / 8 : bx; }
    unsigned char* ws = args.ws;
    F.ctl = (gu32*)(ws + WS_CTL);
    const float* x = args.in[0]; const float* cvec = args.in[1]; const int* positions = (const int*)args.in[2];
    const float* w_ada = args.in[3]; const float* b_ada = args.in[4]; const float* norm_g = args.in[5]; const float* w_in = args.in[6];
    const float* log_dt = args.in[7]; const float* lam_re = args.in[8]; const float* lam_im = args.in[9]; const float* b_re = args.in[10]; const float* b_im = args.in[11];
    const float* c_re = args.in[12]; const float* c_im = args.in[13]; const float* d_skip = args.in[14]; const float* w_glu = args.in[15]; const float* b_glu = args.in[16];
    const float* q_a_g = args.in[17]; const float* w_q_b = args.in[18]; const float* kv_a_g = args.in[19]; const float* w_kv_b = args.in[20];
    const float* q_norm_g = args.in[21]; const float* k_norm_g = args.in[22]; const float* w_out = args.in[23];
    float* MOD = (float*)(ws + WS_MOD); float* AC = (float*)(ws + WS_AC); bf16* BB = (bf16*)(ws + WS_BB); bf16* CB = (bf16*)(ws + WS_CB); float* EST = (float*)(ws + WS_E);
    bf16* WIN_T = (bf16*)(ws + WS_WIN); bf16* WQ_T = (bf16*)(ws + WS_WQ); bf16* WKV_T = (bf16*)(ws + WS_WKV); bf16* WGLU_T = (bf16*)(ws + WS_WGLU); bf16* WOUT_T = (bf16*)(ws + WS_WOUT);
    bf16* PROJ = (bf16*)(ws + WS_PROJ); bf16* HB = (bf16*)(ws + WS_HB); bf16* QRAW = (bf16*)(ws + WS_HB); bf16* YCAT = (bf16*)(ws + WS_YCAT); bf16* ZM = (bf16*)(ws + WS_ZM);
    bf16* KVRAW = (bf16*)(ws + WS_KVRAW); bf16* Qb = (bf16*)(ws + WS_Q); bf16* Kb = (bf16*)(ws + WS_K); bf16* Vb = (bf16*)(ws + WS_V);
    bf16* CQN = (bf16*)(ws + WS_CQN); bf16* CKVN = (bf16*)(ws + WS_CKVN); bf16* YPRE = (bf16*)(ws + WS_YPRE);
    float* RS = (float*)(ws + WS_RS); float* ROPE = (float*)(ws + WS_ROPE); bf16* USG = (bf16*)(ws + WS_USG); bf16* TQ = (bf16*)(ws + WS_TQ); bf16* PPM = (bf16*)(ws + WS_PP); float* HAND = (float*)(ws + WS_HAND); (void)BB; (void)CB; (void)EST; (void)CQN; (void)CKVN; (void)QRAW; (void)KVRAW;

    for (int u = F.tid; u < (LDS_BYTES - LDSCTL_OFF) / 4; u += NWAVES * 64) ((LAS unsigned*)(F.lds + LDSCTL_OFF))[u] = 0u;
    __syncthreads();
    const int lo = args.ph_lo, hi = args.ph_hi;
    const bool multi = (hi - lo) > 1;
    XcdBarrier bar; bar.bar = (unsigned*)(F.ctl + CW_BAR) + args.li * XCD_BAR_WORDS; bar.x = 0; bar.st = nullptr;
    if (multi) bar = xcd_barrier_post((unsigned*)(F.ctl + CW_BAR) + args.li * XCD_BAR_WORDS, F.MISC + 8);
#define IN(k) (lo <= (k) && (k) < hi)
#define SEAM(k) do { if (IN(k) && IN((k) + 1)) xcd_barrier(bar); } while (0)
    const int gw = F.vcu * NWAVES + F.wave, NGW = F.G * NWAVES;

    if (IN(0)) {
        LAS float* scr = (LAS float*)(F.lds + RING_OFF + F.wave * 16384);
        constexpr int I_MOD = 192, I_SSM = 32;
        constexpr int T_U = 256, T_ZS = 256, T_ZM = 256, T_CKV = 128, T_CQ = 192, T_KR = 16, T_WQ = 144, T_WKV = 128, T_WGLU = 128, T_WOUT = 512;
        constexpr int I_TR = T_U + T_ZS + T_ZM + T_CKV + T_CQ + T_KR + T_WQ + T_WKV + T_WGLU + T_WOUT;
        constexpr int I_Z1 = 96, I_Z2 = 256;
        constexpr int NITEMS = I_MOD + I_SSM + I_TR + I_Z1 + I_Z2;
        { LAS float* sact = (LAS float*)(F.lds + SACT_OFF); LAS float* part = (LAS float*)(F.lds + SACT_OFF + 8192);
          for (int e = F.tid; e < 2048; e += NWAVES * 64) { const float cv = cvec[e]; sact[e] = cv / (1.f + __expf(-cv)); }
          __syncthreads();
          for (int r = (int)blockIdx.x; r < I_MOD; r += F.G) p0_mod_block(sact, part, w_ada, b_ada, MOD, F.ctl + CW_MODC, r, F.wave, F.lane); }
        for (int it = I_MOD + gw; it < NITEMS; it += NGW) {
            int r = it - I_MOD;
            if (r < I_SSM) { p0_ssm_item(log_dt, lam_re, lam_im, AC, r, F.lane); continue; } r -= I_SSM;
            if (r < I_TR) {
                if (r < T_U)   { p0_transpose_item(w_in, D_IN, 1024, SC_U + 32 * (r % 16), WIN_T, 0 + 32 * (r % 16), 64 * (r / 16), scr, F.lane); continue; } r -= T_U;
                if (r < T_ZS)  { p0_transpose_item(w_in, D_IN, 1024, SC_ZS + 32 * (r % 16), WIN_T, 512 + 32 * (r % 16), 64 * (r / 16), scr, F.lane); continue; } r -= T_ZS;
                if (r < T_ZM)  { p0_transpose_item(w_in, D_IN, 1024, SC_ZM + 32 * (r % 16), WIN_T, WR_ZM + 32 * (r % 16), 64 * (r / 16), scr, F.lane); continue; } r -= T_ZM;
                if (r < T_CKV) { p0_transpose_item(w_in, D_IN, 1024, SC_CKV + 32 * (r % 8), WIN_T, 1024 + 32 * (r % 8), 64 * (r / 8), scr, F.lane); continue; } r -= T_CKV;
                if (r < T_CQ)  { p0_transpose_item(w_in, D_IN, 1024, SC_CQ + 32 * (r % 12), WIN_T, 1280 + 32 * (r % 12), 64 * (r / 12), scr, F.lane); continue; } r -= T_CQ;
                if (r < T_KR)  { p0_transpose_item(w_in, D_IN, 1024, SC_KR, WIN_T, GC_KR, 64 * r, scr, F.lane); continue; } r -= T_KR;
                if (r < T_WQ)  { const int nb = r % 24, kb = r / 24, n0 = 32 * nb;
                                 p0_transpose_item(w_q_b, 768, 384, n0, WQ_T, (n0 / 96) * 128 + (n0 % 96), 64 * kb, scr, F.lane, q_a_g); continue; } r -= T_WQ;
                if (r < T_WKV) { p0_transpose_item(w_kv_b, 1024, 256, 32 * (r % 32), WKV_T, 32 * (r % 32), 64 * (r / 32), scr, F.lane, kv_a_g); continue; } r -= T_WKV;
                if (r < T_WGLU){ p0_transpose_item(w_glu, 512, 512, 32 * (r % 16), WGLU_T, 32 * (r % 16), 64 * (r / 16), scr, F.lane); continue; } r -= T_WGLU;
                p0_transpose_item(w_out, 1024, 1024, 32 * (r % 32), WOUT_T, 32 * (r % 32), 64 * (r / 32), scr, F.lane); continue;
            }
            r -= I_TR;
            const v4u z = {0u, 0u, 0u, 0u};
            if (r < I_Z1) { GAS v4u* p = (GAS v4u*)(WIN_T + (size_t)(GC_KR + 32 + r) * 1024); p[F.lane] = z; p[64 + F.lane] = z; continue; } r -= I_Z1;
            { const int hh = r / 32, rr = r % 32; GAS v4u* p = (GAS v4u*)(WQ_T + (size_t)(hh * 128 + 96 + rr) * 384); if (F.lane < 48) p[F.lane] = z; }
        }
        f32x4 v0[4], v1[4], v2[4];
#define LDROW(dst, mm) do { const GAS f32x4* xr_ = (const GAS f32x4*)(x + (size_t)(mm) * DM) + F.lane; _Pragma("unroll") for (int j = 0; j < 4; ++j) dst[j] = __builtin_nontemporal_load(xr_ + 64 * j); } while (0)
        if (gw < M) LDROW(v0, gw);
        if (gw + NGW < M) LDROW(v1, gw + NGW);
        __syncthreads();
        if (F.wave == 0) { unsigned sp = 0;
            while (__hip_atomic_load(F.ctl + CW_MODC, RLX_AGENT) < 192u) { __builtin_amdgcn_s_sleep(2); if (++sp > (1u << 22)) { if (F.lane == 0) __hip_atomic_store(F.ctl + CW_TMO, 1u, RLX_AGENT); break; } }
            __builtin_amdgcn_fence(__ATOMIC_ACQUIRE, "agent"); asm volatile("s_waitcnt vmcnt(0)" ::: "memory"); }
        __syncthreads();
        { f32x4 PA[4], PB[4]; int curb = -1;
          const float ifq = (float)exp(-(double)(F.lane & 15) / 16.0 * 9.210340371976184);
          for (int m = gw; m < M; m += NGW) {
            if (m + 2 * NGW < M) LDROW(v2, m + 2 * NGW);
            const int b = m / SEQ;
            if (b != curb) { curb = b;
#pragma unroll
                for (int j = 0; j < 4; ++j) { const int e = 4 * F.lane + 256 * j;
                    const f32x4 g4 = *(const f32x4*)(norm_g + e), sc = *(const f32x4*)(MOD + b * 3072 + 1024 + e); PB[j] = *(const f32x4*)(MOD + b * 3072 + e); PA[j] = g4 * (sc + 1.f); } }
            if (F.lane < 16) { const double TWO_PI = 6.283185307179586476925286766559;
                const float ang = (float)positions[m] * ifq; const float kq = rintf(ang * 0.15915494309189535f);
                const float rr = fmaf(-kq, 0.0019353071795864769f, fmaf(-kq, 6.28125f, ang)); (void)TWO_PI;
                typedef float f32x2_ __attribute__((ext_vector_type(2))); *(f32x2_*)(ROPE + ((size_t)m * 16 + F.lane) * 2) = (f32x2_){__cosf(rr), __sinf(rr)}; }
            float s = 0.f;
#pragma unroll
            for (int j = 0; j < 4; ++j) s += (v0[j].x * v0[j].x + v0[j].y * v0[j].y) + (v0[j].z * v0[j].z + v0[j].w * v0[j].w);
            const float rstd = 1.f / sqrtf(wave_sum(s) * (1.f / DM) + EPS);
            GAS unsigned long long* o8 = (GAS unsigned long long*)(HB + (size_t)m * DM) + F.lane;
#pragma unroll
            for (int j = 0; j < 4; ++j) { const f32x4 hv = v0[j] * rstd * PA[j] + PB[j];
                o8[64 * j] = (unsigned long long)pk2h(hv.x, hv.y) | ((unsigned long long)pk2h(hv.z, hv.w) << 32); }
#pragma unroll
            for (int j = 0; j < 4; ++j) { v0[j] = v1[j]; v1[j] = v2[j]; }
          }
#undef LDROW
        }
    }
    SEAM(0);

    if (IN(1)) {
        pg8::Gemm g{HB, WIN_T, M, NPROJ, 1024, 1024}; pg8::StaticOrder S; S.init(M, NPROJ, F.G, (int)blockIdx.x);
        pg8::EpiProj E{PROJ, LDP, RS, 4, USG, SEQ};
        pg8::gemm_phase<pg8::EpiProj, pg8::StaticOrder, true, true>(F.lds + RING_OFF, g, S, E);
        if (F.G == 256 ? blockIdx.x >= 192 : true) { __syncthreads();
            LAS float* scr = (LAS float*)(F.lds + RING_OFF + F.wave * 16384);
            const int nw = (F.G == 256) ? 512 : NGW, w0 = (F.G == 256) ? ((int)blockIdx.x - 192) * NWAVES + F.wave : gw;
            for (int it = w0; it < 512 * 3 + 256; it += nw) { int r = it;
                if (r < 512) { p0_ssm_K_item(log_dt, lam_re, lam_im, b_re, b_im, c_re, c_im, TQ, r >> 4, r & 15, scr, F.lane); continue; } r -= 512;
                if (r < 512) { p0_ssm_Q_item(log_dt, lam_re, lam_im, c_re, c_im, TQ, r >> 4, r & 15, F.lane); continue; } r -= 512;
                if (r < 512) { p0_ssm_P_item(log_dt, lam_re, lam_im, b_re, b_im, PPM, r >> 4, r & 15, F.lane); continue; } r -= 512;
                { const v4u z0 = {0u, 0u, 0u, 0u}; GAS v4u* pz = (GAS v4u*)(PPM + ((size_t)(r >> 3) * 256 + 128 + (r & 7) * 16) * 256);
#pragma unroll
                  for (int q = 0; q < 8; ++q) pz[F.lane + 64 * q] = z0; } } }
    }
    SEAM(1);

    if (IN(2)) {
        { const pg8::MlaAux AUX{RS, ROPE, PROJ, LDP, PC_KR};
          if (F.G == 256) {
            { pg8::Gemm g{PROJ + PC_CQ, WQ_T, M, 1024, Q_LORA, LDP}; pg8::StaticOrder S; S.init(M, 1024, F.G, (int)blockIdx.x);
              pg8::EpiQ E{AUX, q_norm_g, Qb, 0.10206207261596575f * 1.4426950408889634f, EPS, SEQ};
              pg8::gemm_phase<pg8::EpiQ, pg8::StaticOrder, false, true>(F.lds + RING_OFF, g, S, E); }
            __syncthreads();
            { pg8::Gemm g{PROJ + PC_CKV, WKV_T, M, 1024, KV_LORA, LDP}; pg8::StaticOrder S; S.init(M, 1024, F.G, (int)blockIdx.x);
              pg8::EpiKV E{AUX, k_norm_g, Kb, Vb, EPS, SEQ};
              pg8::gemm_phase<pg8::EpiKV, pg8::StaticOrder, false, true>(F.lds + RING_OFF, g, S, E); }
          } else if (F.tid == 0) __hip_atomic_store(F.ctl + CW_TMO, 1u, RLX_AGENT);
        }
        __syncthreads();
        { pg8::Gemm g{USG, PPM, 32768, 8192, 256, 384}; pg8::DiagOrder S{128, 4, F.G, (int)blockIdx.x, nullptr, 0u, nullptr};
          pg8::EpiELds E{};
          if (F.G >= 128) { pg8::gemm_phase<pg8::EpiELds, pg8::DiagOrder, false, true>(F.lds + RING_OFF, g, S, E);
              pg8::Unit u; const bool has = S.next(0, u);
              __syncthreads();
              if (has && F.wave == 0) pg8::ssm_chain_unit(u, F.lds + RING_OFF, USG, AC, HAND, (unsigned*)(F.ctl + CW_CHAIN), (unsigned*)(F.ctl + CW_TMO), F.lane);
              __syncthreads(); }
          else if (F.tid == 0) __hip_atomic_store(F.ctl + CW_TMO, 1u, RLX_AGENT); }
        { pg8::Gemm g{HB, WIN_T + (size_t)WR_ZM * 1024, M, 512, 1024, 1024}; pg8::StaticOrder S; S.init(M, 512, F.G, (int)((blockIdx.x + 128u) % (unsigned)F.G));
          pg8::EpiH16 E{ZM, 512};
          pg8::gemm_phase<pg8::EpiH16, pg8::StaticOrder, true, true>(F.lds + RING_OFF, g, S, E); }
    }
    SEAM(2);

    if (IN(3)) {
        { pg8::Gemm g{USG, TQ, 32768, 8192, 384, 384}; pg8::DiagOrder S{128, 4, F.G, (int)blockIdx.x, nullptr, 0u, nullptr};
          pg8::EpiY E{USG, d_skip, YPRE, SEQ};
          pg8::gemm_phase<pg8::EpiY, pg8::DiagOrder, true, true>(F.lds + RING_OFF, g, S, E);
          if (F.tid == 0) { pg8::Unit u; for (int i = 0; S.next(i, u); ++i) { const int k4 = u.pm & 3;
              for (int q = 0; q < 16; ++q) __hip_atomic_fetch_add(F.ctl + CW_PANEL + 64 * ((k4 >> 1) * 32 + (k4 & 1) * 16 + q), 1u, RLX_AGENT); } } }
        __syncthreads();
        __syncthreads();
#define RUN_GLU_UNITS() do { \
        { pg8::Gemm g{YPRE, WGLU_T, M, 512, 512, 512}; pg8::PanelOrder S; S.init(M, 512, F.G, (int)((blockIdx.x + 128u) % (unsigned)F.G)); S.cnt = (unsigned*)(F.ctl + CW_PANEL); S.want = 32u; S.tmo = (unsigned*)(F.ctl + CW_TMO); \
          pg8::EpiGlu E{YPRE, PROJ, LDP, PC_ZS, b_glu, YCAT}; \
          pg8::gemm_phase<pg8::EpiGlu, pg8::PanelOrder, true, true>(F.lds + RING_OFF, g, S, E); \
          if (F.tid == 0) { pg8::Unit u; for (int i = 0; S.next(i, u); ++i) __hip_atomic_fetch_add(F.ctl + CW_OUTP + 64 * u.pm, 1u, RLX_AGENT); } } \
        __syncthreads(); } while (0)
#define OUT_UNIT_OF(k, uu) do { const int pk_ = (k) >> 2; (uu).pm = (pk_ & 1) * 32 + (24 - 8 * (pk_ >> 1)) + j; (uu).pn = (k) & 3; } while (0)
#define RUN_OUT_UNIT(uu) do { if (F.tid < 64) { __builtin_amdgcn_fence(__ATOMIC_ACQUIRE, "agent"); asm volatile("s_waitcnt vmcnt(0)" ::: "memory"); } __syncthreads(); \
            pg8::Gemm g_{YCAT, WOUT_T, M, 1024, 1024, 1024}; pg8::OneUnit S_; S_.u = (uu); pg8::EpiOutRows E_{x, MOD + 2048, 3072, SEQ, args.out}; \
            pg8::gemm_phase<pg8::EpiOutRows, pg8::OneUnit, false, true>(F.lds + RING_OFF, g_, S_, E_); __syncthreads(); } while (0)
        const int j = (int)(blockIdx.x & 7); bool glu_done = false;
        bool popped = false;
        for (;;) {
            if (!popped && F.tid == 0) F.MISC[16] = __hip_atomic_fetch_add(F.ctl + CW_ATTQ + 64 * j, 1u, RLX_AGENT);
            __syncthreads();
            const unsigned ua = (unsigned)__builtin_amdgcn_readfirstlane((int)F.MISC[16]);
            __syncthreads();
            if (ua >= 64u) break;
            const int bh = 2 * j + (int)(ua & 1u), qb = 31 - (int)(ua >> 1);
            const bool early = glu_done || ((blockIdx.x + 128u) % (unsigned)F.G) >= 128u;
            att::attn_unit(bh >> 3, bh & 7, qb, Qb, Kb, Vb, ZM, 512, 0, YCAT, (char*)lds + RING_OFF, F.lds + RING_OFF, (unsigned*)(F.ctl + CW_OUTP + 64 * ((bh >> 3) * 32 + qb)), nullptr, (unsigned*)(F.ctl + CW_TMO), early ? CW_ATTQ - CW_TMO : -1, MISC_OFF - RING_OFF + 16 * 4);
            popped = early;
            if (!glu_done) { glu_done = true; RUN_GLU_UNITS(); }
            if (F.tid == 0) { unsigned k = __hip_atomic_load(F.ctl + CW_OUTQ + 64 * j, RLX_AGENT), got = 0xffffffffu;
                if (MK_CLAIM_BETWEEN && k < 32u) { pg8::Unit t; OUT_UNIT_OF((int)k, t);
                    if (__hip_atomic_load(F.ctl + CW_OUTP + 64 * t.pm, RLX_AGENT) >= 10u) { unsigned e = k;
                        if (__hip_atomic_compare_exchange_strong(F.ctl + CW_OUTQ + 64 * j, &e, k + 1u, __ATOMIC_RELAXED, __ATOMIC_RELAXED, __HIP_MEMORY_SCOPE_AGENT)) got = k; } }
                F.MISC[17] = got; }
            __syncthreads();
            const unsigned ko = (unsigned)__builtin_amdgcn_readfirstlane((int)F.MISC[17]);
            __syncthreads();
            if (ko != 0xffffffffu) { pg8::Unit uo; OUT_UNIT_OF((int)ko, uo); RUN_OUT_UNIT(uo); }
        }
        if (!glu_done) { glu_done = true; RUN_GLU_UNITS(); }
        for (;;) {
            if (F.tid == 0) F.MISC[17] = __hip_atomic_fetch_add(F.ctl + CW_OUTQ + 64 * j, 1u, RLX_AGENT);
            __syncthreads();
            const unsigned ko = (unsigned)__builtin_amdgcn_readfirstlane((int)F.MISC[17]);
            __syncthreads();
            if (ko >= 32u) break;
            pg8::Unit uo; OUT_UNIT_OF((int)ko, uo);
            if (F.tid < 64) { unsigned sp = 0;
                while (__hip_atomic_load(F.ctl + CW_OUTP + 64 * uo.pm, RLX_AGENT) < 10u) { __builtin_amdgcn_s_sleep(4);
                    if (++sp > (1u << 22)) { if (F.tid == 0) __hip_atomic_store(F.ctl + CW_TMO, 1u, RLX_AGENT); break; } }
                if (F.tid == 0) __hip_atomic_fetch_add(F.ctl + CW_RDV + 64 * uo.pm, 1u, RLX_AGENT);
                sp = 0; while (__hip_atomic_load(F.ctl + CW_RDV + 64 * uo.pm, RLX_AGENT) < 4u && ++sp < 20000u) __builtin_amdgcn_s_sleep(2); }
            RUN_OUT_UNIT(uo);
        }
#undef OUT_UNIT_OF
#undef RUN_GLU_UNITS
#undef RUN_OUT_UNIT
    }
#undef IN
#undef SEAM
}

#ifndef MK_MODE
#define MK_MODE 2
#endif
#ifndef MK_FAST_MASK
#define MK_FAST_MASK 0x7
#endif
extern "C" void kernel_launch(void* const* d_in, const int* in_sizes, int n_in, void* d_out, int out_size, void* d_ws, size_t ws_size, hipStream_t stream) {
    static int grid = 0;
    if (grid == 0) {
        if (n_in != 24 || in_sizes[0] != M * DM || out_size != M * DM || ws_size < WS_END) { fprintf(stderr, "kernel_launch: unexpected shapes (n_in %d, in0 %d, out %d, ws %zu)\n", n_in, n_in > 0 ? in_sizes[0] : -1, out_size, ws_size); grid = -1; return; }
        int dev = 0, cus = 0, per_cu = 0;
        if (hipGetDevice(&dev) != hipSuccess || hipDeviceGetAttribute(&cus, hipDeviceAttributeMultiprocessorCount, dev) != hipSuccess) { fprintf(stderr, "kernel_launch: device query failed\n"); grid = -1; return; }
        if (hipFuncSetAttribute((const void*)mega_fwd, hipFuncAttributeMaxDynamicSharedMemorySize, LDS_BYTES) != hipSuccess) { fprintf(stderr, "kernel_launch: hipFuncSetAttribute failed\n"); grid = -1; return; }
        if (hipOccupancyMaxActiveBlocksPerMultiprocessor(&per_cu, (const void*)mega_fwd, NWAVES * 64, LDS_BYTES) != hipSuccess || per_cu < 1)
            fprintf(stderr, "kernel_launch: note: occupancy query reports %d workgroups per CU\n", per_cu);
        (void)hipGetLastError();
        grid = cus;
    }
    if (grid < 0) return;
    const float* x = (const float*)d_in[0]; const float* c = (const float*)d_in[1]; const int* positions = (const int*)d_in[2];
    const float* w_ada = (const float*)d_in[3]; const float* b_ada = (const float*)d_in[4]; const float* norm_g = (const float*)d_in[5];
    const float* w_in = (const float*)d_in[6]; const float* log_dt = (const float*)d_in[7]; const float* lam_re = (const float*)d_in[8];
    const float* lam_im = (const float*)d_in[9]; const float* b_re = (const float*)d_in[10]; const float* b_im = (const float*)d_in[11];
    const float* c_re = (const float*)d_in[12]; const float* c_im = (const float*)d_in[13]; const float* d_skip = (const float*)d_in[14];
    const float* w_glu = (const float*)d_in[15]; const float* b_glu = (const float*)d_in[16]; const float* q_a_g = (const float*)d_in[17];
    const float* w_q_b = (const float*)d_in[18]; const float* kv_a_g = (const float*)d_in[19]; const float* w_kv_b = (const float*)d_in[20];
    const float* q_norm_g = (const float*)d_in[21]; const float* k_norm_g = (const float*)d_in[22]; const float* w_out = (const float*)d_in[23];
    unsigned char* ws = (unsigned char*)d_ws; float* out = (float*)d_out;
    float* MOD = (float*)(ws + WS_MOD); bf16* PROJ = (bf16*)(ws + WS_PROJ); bf16* HB = (bf16*)(ws + WS_HB); bf16* QRAW = (bf16*)(ws + WS_HB); bf16* YCAT = (bf16*)(ws + WS_YCAT); bf16* ZM = (bf16*)(ws + WS_ZM);
    bf16* KVRAW = (bf16*)(ws + WS_KVRAW); bf16* Qb = (bf16*)(ws + WS_Q); bf16* Kb = (bf16*)(ws + WS_K); bf16* Vb = (bf16*)(ws + WS_V);
    bf16* CQN = (bf16*)(ws + WS_CQN); bf16* CKVN = (bf16*)(ws + WS_CKVN); bf16* YPRE = (bf16*)(ws + WS_YPRE);
    (void)x; (void)c; (void)positions; (void)w_ada; (void)b_ada; (void)norm_g; (void)w_in; (void)log_dt; (void)lam_re; (void)lam_im; (void)b_re; (void)b_im; (void)c_re; (void)c_im; (void)d_skip;
    (void)w_glu; (void)b_glu; (void)q_a_g; (void)w_q_b; (void)kv_a_g; (void)w_kv_b; (void)q_norm_g; (void)k_norm_g; (void)w_out; (void)MOD; (void)PROJ; (void)HB; (void)QRAW; (void)YCAT;
    (void)KVRAW; (void)Qb; (void)Kb; (void)Vb; (void)CQN; (void)CKVN; (void)YPRE; (void)out;

    Args a{}; int n_mega = 0;
    for (int i = 0; i < 24; ++i) a.in[i] = (const float*)d_in[i];
    a.out = out; a.ws = ws;
#define MEGA(lo_, hi_) do { a.ph_lo = (lo_); a.ph_hi = (hi_); a.li = n_mega++; hipLaunchKernelGGL(mega_fwd, dim3(grid), dim3(NWAVES * 64), LDS_BYTES, stream, a); } while (0)
#if MK_MODE == 2
    if (hipMemsetAsync(ws + WS_CTL, 0, CTL_ZERO_BYTES, stream) != hipSuccess) { fprintf(stderr, "kernel_launch: memset failed\n"); return; }
#if MK_DOUBLE >= 0
    MEGA(0, MK_DOUBLE + 1); MEGA(MK_DOUBLE, NPHASE);
#else
    MEGA(0, NPHASE);
#endif
#else
    const unsigned fast = (MK_MODE == 0) ? 0u : (unsigned)MK_FAST_MASK;
    (void)hipMemsetAsync(ws + WS_CTL, 0, CTL_ZERO_BYTES, stream);
    if (MK_MODE != 0) MEGA(0, 1);
    if (!(fast & 1u)) { hipLaunchKernelGGL(v0_mod, dim3(24), dim3(256), 0, stream, c, w_ada, b_ada, MOD); hipLaunchKernelGGL(v0_h, dim3(M), dim3(256), 0, stream, x, norm_g, MOD, HB); }
    if (fast & 2u) MEGA(1, 2); else {
        const int seg[5][3] = {{PC_U, SC_U, 512}, {PC_ZS, SC_ZS, 512}, {PC_CKV, SC_CKV, 256}, {PC_CQ, SC_CQ, 384}, {PC_KR, SC_KR, 32}};
        for (int s = 1; s < 5; ++s) hipLaunchKernelGGL(v0_gemm, dim3(M), dim3(256), 1024 * 4, stream, HB, 1024, 1024, w_in, D_IN, seg[s][1], PROJ, LDP, seg[s][0], seg[s][2]);
        hipLaunchKernelGGL(v0_usg, dim3(M), dim3(256), 1024 * 4, stream, HB, w_in, D_IN, (bf16*)(ws + WS_USG));
        hipLaunchKernelGGL(v0_gemm, dim3(M), dim3(256), 1024 * 4, stream, HB, 1024, 1024, w_in, D_IN, SC_ZM, ZM, 512, 0, 512); }
    if (fast & 4u) { MEGA(2, 3); MEGA(3, 4); }
    else { hipLaunchKernelGGL(v0_cqn, dim3(M), dim3(256), 0, stream, PROJ, q_a_g, kv_a_g, CQN, CKVN);
        for (int h = 0; h < NH; ++h) hipLaunchKernelGGL(v0_gemm, dim3(M), dim3(128), 384 * 4, stream, CQN, 384, 384, w_q_b, 768, h * 96, QRAW, 1024, h * 128, 96);
        hipLaunchKernelGGL(v0_gemm, dim3(M), dim3(256), 256 * 4, stream, CKVN, 256, 256, w_kv_b, 1024, 0, KVRAW, 1024, 0, 1024);
        hipLaunchKernelGGL(v0_qkv, dim3(M * NH * 2 / 256), dim3(256), 0, stream, QRAW, KVRAW, PROJ, positions, q_norm_g, k_norm_g, Qb, Kb, Vb);
        hipLaunchKernelGGL(v0_ssm, dim3(BATCH * SSM_G), dim3(64), 0, stream, (bf16*)(ws + WS_USG), log_dt, lam_re, lam_im, b_re, b_im, c_re, c_im, d_skip, YPRE);
        hipLaunchKernelGGL(v0_attn, dim3(BATCH * NH * (SEQ / 256)), dim3(256), 0, stream, Qb, Kb, Vb, ZM, YCAT);
        hipLaunchKernelGGL(v0_glu, dim3(M), dim3(256), 0, stream, YPRE, w_glu, b_glu, PROJ, YCAT);
        hipLaunchKernelGGL(v0_out, dim3(M), dim3(256), 0, stream, YCAT, w_out, x, MOD, out); }
#endif
    const hipError_t le = hipPeekAtLastError();
    if (le != hipSuccess) fprintf(stderr, "kernel_launch: launch failed: %s\n", hipGetErrorName(le));
}
```

```cpp
#include <hip/hip_runtime.h>
#include <cstdio>
#include <cstdint>
#ifndef MK_CLAIM_BETWEEN
#define MK_CLAIM_BETWEEN 0
#endif
#ifndef MK_DOUBLE
#define MK_DOUBLE (-1)
#endif

constexpr int BATCH = 2, SEQ = 8192, DM = 1024, M = BATCH * SEQ;
constexpr int SSM_W = 512, SSM_G = 32, SSM_GC = 16, SSM_P = 64;
constexpr int NH = 8, QK_NOPE = 64, QK_ROPE = 32, QK_HEAD = 96, V_HEAD = 64, MLA_W = 512, Q_LORA = 384, KV_LORA = 256;
constexpr int D_IN = 2208;
constexpr float EPS = 1e-6f;
constexpr int NPROJ = 1792;
constexpr int LDP = 1280;
constexpr int PC_U = 0, PC_ZS = 0, PC_CKV = 512, PC_CQ = 768, PC_KR = 1152;
constexpr int GC_KR = 1664;
constexpr int WR_ZM = 1792;
constexpr int SC_U = 0, SC_ZS = 512, SC_CQ = 1024, SC_CKV = 1408, SC_KR = 1664, SC_ZM = 1696;

constexpr size_t MiB = 1u << 20;
constexpr size_t WS_CTL = 0, CTL_ZERO_BYTES = 1 * MiB;
constexpr size_t WS_MOD = 1 * MiB;
constexpr size_t WS_AC = 1 * MiB + 64 * 1024;
constexpr size_t WS_BB = 1 * MiB + 128 * 1024;
constexpr size_t WS_CB = 1 * MiB + 256 * 1024;
constexpr size_t WS_E = 2 * MiB;
constexpr size_t WS_WIN = 4 * MiB;
constexpr size_t WS_WQ = 9 * MiB;
constexpr size_t WS_WKV = 10 * MiB;
constexpr size_t WS_WGLU = 11 * MiB;
constexpr size_t WS_WOUT = 12 * MiB;
constexpr size_t WS_PROJ = 16 * MiB;
constexpr size_t WS_USG = 56 * MiB;
constexpr size_t WS_ZM = 80 * MiB;
constexpr size_t WS_HB = 96 * MiB;
constexpr size_t WS_YCAT = 128 * MiB;
constexpr size_t WS_KVRAW = 128 * MiB;
constexpr size_t WS_Q = 160 * MiB;
constexpr size_t WS_CQN = 160 * MiB;
constexpr size_t WS_CKVN = 172 * MiB;
constexpr size_t WS_K = 184 * MiB;
constexpr size_t WS_V = 208 * MiB;
constexpr size_t WS_YPRE = 224 * MiB;
constexpr size_t WS_TQ = 240 * MiB;
constexpr size_t WS_PP = 246 * MiB;
constexpr size_t WS_ROPE = 250 * MiB;
constexpr size_t WS_HAND = 252 * MiB;
constexpr size_t WS_RS = 14 * MiB;
constexpr size_t WS_END = 253 * MiB;

typedef unsigned short bf16;
__device__ __forceinline__ unsigned f2bf(float f) { return (unsigned)__builtin_bit_cast(unsigned short, (_Float16)f); }
__device__ __forceinline__ float bf2f(bf16 b) { return (float)__builtin_bit_cast(_Float16, b); }
__device__ __forceinline__ float silu_f(float v) { return v / (1.f + __expf(-v)); }
__device__ __forceinline__ float sigmoid_f(float v) { return 1.f / (1.f + __expf(-v)); }
__device__ __forceinline__ float gelu_tanh(float v) { const float z = 0.7978845608028654f * (v + 0.044715f * v * v * v); return v / (1.f + __expf(-2.f * z)); }

__device__ __forceinline__ float block_sum_256(float v, float* red) {
    for (int o = 32; o > 0; o >>= 1) v += __shfl_xor(v, o);
    const int w = threadIdx.x >> 6;
    __syncthreads();
    if ((threadIdx.x & 63) == 0) red[w] = v;
    __syncthreads();
    float s = 0.f; for (int i = 0; i < (int)(blockDim.x >> 6); ++i) s += red[i];
    return s;
}

__global__ void v0_mod(const float* c, const float* w_ada, const float* b_ada, float* mod) {
    const int idx = blockIdx.x * blockDim.x + threadIdx.x; if (idx >= BATCH * 3 * DM) return;
    const int b = idx / (3 * DM), n = idx % (3 * DM);
    float acc = b_ada[n];
    for (int k = 0; k < DM; ++k) acc += silu_f(c[b * DM + k]) * w_ada[(size_t)k * 3 * DM + n];
    mod[idx] = acc;
}
__global__ void v0_h(const float* x, const float* norm_g, const float* mod, bf16* hb) {
    __shared__ float red[8];
    const int m = blockIdx.x, b = m / SEQ, t = threadIdx.x;
    float v[4], ss = 0.f;
    for (int j = 0; j < 4; ++j) { v[j] = x[(size_t)m * DM + t + 256 * j]; ss += v[j] * v[j]; }
    ss = block_sum_256(ss, red);
    const float rstd = 1.f / sqrtf(ss / DM + EPS);
    for (int j = 0; j < 4; ++j) { const int e = t + 256 * j;
        const float hv = v[j] * rstd * norm_g[e] * (1.f + mod[b * 3 * DM + DM + e]) + mod[b * 3 * DM + e];
        hb[(size_t)m * DM + e] = (bf16)f2bf(hv); }
}
__global__ void v0_gemm(const bf16* A, int lda, int K, const float* W, int ldw, int src0, bf16* C, int ldc, int dst0, int width) {
    extern __shared__ float arow[];
    const int m = blockIdx.x;
    for (int k = threadIdx.x; k < K; k += blockDim.x) arow[k] = bf2f(A[(size_t)m * lda + k]);
    __syncthreads();
    for (int j = threadIdx.x; j < width; j += blockDim.x) {
        float acc = 0.f;
        for (int k = 0; k < K; ++k) acc += arow[k] * W[(size_t)k * ldw + src0 + j];
        C[(size_t)m * ldc + dst0 + j] = (bf16)f2bf(acc);
    }
}
__global__ void v0_usg(const bf16* A, const float* W, int ldw, bf16* USG) {
    extern __shared__ float arow[];
    const int m = blockIdx.x, b = m / SEQ, t = m % SEQ;
    for (int k = threadIdx.x; k < 1024; k += blockDim.x) arow[k] = bf2f(A[(size_t)m * 1024 + k]);
    __syncthreads();
    for (int c = threadIdx.x; c < 512; c += blockDim.x) { float acc = 0.f;
        for (int k = 0; k < 1024; ++k) acc += arow[k] * W[(size_t)k * ldw + c];
        USG[((size_t)(c >> 4) * 1024 + b * 512 + (t >> 4)) * 384 + (t & 15) * 16 + (c & 15)] = (bf16)f2bf(acc); }
}
__global__ void v0_cqn(const bf16* proj, const float* q_a_g, const float* kv_a_g, bf16* cqn, bf16* ckvn) {
    __shared__ float red[8];
    const int m = blockIdx.x, t = threadIdx.x;
    float a = 0.f, b2 = 0.f, ss = 0.f;
    if (t < 192) { a = bf2f(proj[(size_t)m * LDP + PC_CQ + t]); b2 = bf2f(proj[(size_t)m * LDP + PC_CQ + 192 + t]); ss = a * a + b2 * b2; }
    ss = block_sum_256(ss, red);
    float rstd = 1.f / sqrtf(ss / Q_LORA + EPS);
    if (t < 192) { cqn[(size_t)m * Q_LORA + t] = (bf16)f2bf(a * rstd * q_a_g[t]); cqn[(size_t)m * Q_LORA + 192 + t] = (bf16)f2bf(b2 * rstd * q_a_g[192 + t]); }
    const float cv = bf2f(proj[(size_t)m * LDP + PC_CKV + t]);
    ss = block_sum_256(cv * cv, red);
    rstd = 1.f / sqrtf(ss / KV_LORA + EPS);
    ckvn[(size_t)m * KV_LORA + t] = (bf16)f2bf(cv * rstd * kv_a_g[t]);
}
__device__ __forceinline__ int v0_vst(int k, int c) { const int kk = (k & ~0xC) | ((k & 4) << 1) | ((k & 8) >> 1); return ((kk >> 3) * 2 + (c >> 5)) * 512 + ((kk & 7) * 32 + (c & 31)) * 2; }
__global__ void __launch_bounds__(256) v0_qkv(const bf16* qraw, const bf16* kvraw, const bf16* proj, const int* positions, const float* q_norm_g, const float* k_norm_g, bf16* Q, bf16* K, bf16* V) {
    const int idx = blockIdx.x * blockDim.x + threadIdx.x; if (idx >= M * NH * 2) return;
    const int which = idx & 1, m = (idx >> 1) / NH, h = (idx >> 1) % NH;
    const float pos = (float)positions[m];
    const float* gn = which ? k_norm_g : q_norm_g;
    float q[96];
    float sq = 0.f;
    if (which == 0) {
#pragma unroll
        for (int d = 0; d < 96; ++d) q[d] = bf2f(qraw[(size_t)m * 1024 + h * 128 + d]);
    } else {
#pragma unroll
        for (int d = 0; d < 64; ++d) q[d] = bf2f(kvraw[(size_t)m * 1024 + h * 128 + d]);
#pragma unroll
        for (int d = 0; d < 32; ++d) q[64 + d] = bf2f(proj[(size_t)m * LDP + PC_KR + d]);
    }
#pragma unroll
    for (int d = 0; d < 96; ++d) sq += q[d] * q[d];
    const float rq = 1.f / sqrtf(sq / 96.f + EPS);
#pragma unroll
    for (int d = 0; d < 96; ++d) q[d] = q[d] * rq * gn[d];
#pragma unroll
    for (int i = 0; i < 16; ++i) {
        const float inv_freq = (float)pow(10000.0, -(double)i / 16.0);
        const float ang = pos * inv_freq;
        const double TWO_PI = 6.283185307179586476925286766559;
        const double r = (double)ang - TWO_PI * rint((double)ang / TWO_PI);
        const float rf = (float)r; const float cs = __cosf(rf), sn = __sinf(rf);
        const float q1 = q[64 + i], q2 = q[80 + i]; q[64 + i] = q1 * cs - q2 * sn; q[80 + i] = q2 * cs + q1 * sn;
    }
    if (which == 0) {
#pragma unroll
        for (int d = 0; d < 96; ++d) Q[(size_t)m * 768 + h * 96 + d] = (bf16)f2bf(q[d] * (0.10206207261596575f * 1.4426950408889634f));
    } else {
        const int bb = m / SEQ, tt = m % SEQ; const size_t tix = (size_t)(bb * 8 + h) * 128 + (tt >> 6); const int row = tt & 63;
#pragma unroll
        for (int d = 0; d < 96; ++d) K[tix * 6144 + (d >> 3) * 512 + row * 8 + (d & 7)] = (bf16)f2bf(q[d]);
        for (int d = 0; d < 64; ++d) V[tix * 4096 + v0_vst(row, d) / 2] = kvraw[(size_t)m * 1024 + h * 128 + 64 + d];
    }
}
__global__ void __launch_bounds__(64) v0_ssm(const bf16* proj, const float* log_dt, const float* lam_re, const float* lam_im, const float* b_re, const float* b_im,
                       const float* c_re, const float* c_im, const float* d_skip, bf16* ypre) {
    __shared__ float sre[64], sim[64], us[16];
    const int b = blockIdx.x / SSM_G, g = blockIdx.x % SSM_G, p = threadIdx.x;
    const double dt = exp((double)log_dt[g]);
    const double lr = lam_re[g * 64 + p], li = lam_im[g * 64 + p];
    const double er = exp(lr * dt), ar = er * cos(li * dt), ai = er * sin(li * dt);
    const double nr = ar - 1.0, ni = ai, den = lr * lr + li * li;
    const double cr = (nr * lr + ni * li) / den, ci = (ni * lr - nr * li) / den;
    float Br[16], Bi[16];
#pragma unroll
    for (int j = 0; j < 16; ++j) { const double br = b_re[(g * 64 + p) * 16 + j], bi = b_im[(g * 64 + p) * 16 + j];
        Br[j] = (float)(cr * br - ci * bi); Bi[j] = (float)(cr * bi + ci * br); }
    const float far = (float)ar, fai = (float)ai;
    float s_r = 0.f, s_i = 0.f;
    const float dsk = p < 16 ? d_skip[g * 16 + p] : 0.f;
    for (int t = 0; t < SEQ; ++t) {
        const size_t row = (size_t)(b * SEQ + t);
        if (p < 16) us[p] = bf2f(proj[((size_t)g * 1024 + b * 512 + (t >> 4)) * 384 + (t & 15) * 16 + p]);
        __syncthreads();
        float bur = 0.f, bui = 0.f;
#pragma unroll
        for (int j = 0; j < 16; ++j) { bur += Br[j] * us[j]; bui += Bi[j] * us[j]; }
        const float nr2 = far * s_r - fai * s_i + bur, ni2 = far * s_i + fai * s_r + bui;
        s_r = nr2; s_i = ni2; sre[p] = s_r; sim[p] = s_i;
        __syncthreads();
        if (p < 16) {
            float y = 0.f;
            for (int q = 0; q < 64; ++q) y += c_re[(g * 16 + p) * 64 + q] * sre[q] - c_im[(g * 16 + p) * 64 + q] * sim[q];
            y += dsk * us[p];
            ypre[row * SSM_W + g * 16 + p] = (bf16)f2bf(gelu_tanh(y));
        }
        __syncthreads();
    }
}
__global__ void __launch_bounds__(256) v0_attn(const bf16* Q, const bf16* K, const bf16* V, const bf16* zm, bf16* ycat) {
    const int qb = blockIdx.x % (SEQ / 256), bh = blockIdx.x / (SEQ / 256), b = bh / NH, h = bh % NH;
    const int qi = qb * 256 + threadIdx.x;
    const size_t qrow = (size_t)b * SEQ + qi;
    float q[96], o[64];
    const float sc = 0.10206207261596575f;
#pragma unroll
    for (int d = 0; d < 96; ++d) q[d] = bf2f(Q[qrow * 768 + h * 96 + d]) * sc;
#pragma unroll
    for (int d = 0; d < 64; ++d) o[d] = 0.f;
    float mx = -1e30f, l = 0.f;
    const int jmax = qb * 256 + 255;
    for (int j = 0; j <= jmax; ++j) {
        const size_t tix = (size_t)(b * 8 + h) * 128 + (j >> 6); const int jr = j & 63;
        const bf16* kp = K + tix * 6144 + jr * 8; const bf16* vp = V + tix * 4096;
        float s = 0.f;
#pragma unroll
        for (int d = 0; d < 96; ++d) s += q[d] * bf2f(kp[(d >> 3) * 512 + (d & 7)]);
        if (j <= qi) {
            const float mn = fmaxf(mx, s); const float al = exp2f(mx - mn), pp = exp2f(s - mn);
            l = l * al + pp;
#pragma unroll
            for (int d = 0; d < 64; ++d) o[d] = o[d] * al + pp * bf2f(vp[v0_vst(jr, d) / 2]);
            mx = mn;
        }
    }
    const float rl = 1.f / l;
#pragma unroll
    for (int d = 0; d < 64; ++d) {
        const float z = bf2f(zm[qrow * 512 + h * 64 + d]);
        ycat[qrow * 1024 + 512 + h * 64 + d] = (bf16)f2bf(o[d] * rl * silu_f(z));
    }
}
__global__ void v0_glu(const bf16* ypre, const float* w_glu, const float* b_glu, const bf16* proj, bf16* ycat) {
    __shared__ float arow[512];
    const int m = blockIdx.x;
    for (int k = threadIdx.x; k < 512; k += blockDim.x) arow[k] = bf2f(ypre[(size_t)m * 512 + k]);
    __syncthreads();
    for (int j = threadIdx.x; j < 512; j += blockDim.x) {
        float acc = b_glu[j];
        for (int k = 0; k < 512; ++k) acc += arow[k] * w_glu[(size_t)k * 512 + j];
        const float z = bf2f(proj[(size_t)m * LDP + PC_ZS + j]);
        ycat[(size_t)m * 1024 + j] = (bf16)f2bf(arow[j] * sigmoid_f(acc) * silu_f(z));
    }
}
__global__ void v0_out(const bf16* ycat, const float* w_out, const float* x, const float* mod, float* out) {
    __shared__ float arow[1024];
    const int m = blockIdx.x, b = m / SEQ;
    for (int k = threadIdx.x; k < 1024; k += blockDim.x) arow[k] = bf2f(ycat[(size_t)m * 1024 + k]);
    __syncthreads();
    for (int j = threadIdx.x; j < 1024; j += blockDim.x) {
        float acc = 0.f;
        for (int k = 0; k < 1024; ++k) acc += arow[k] * w_out[(size_t)k * 1024 + j];
        out[(size_t)m * DM + j] = x[(size_t)m * DM + j] + mod[b * 3 * DM + 2 * DM + j] * acc;
    }
}


typedef unsigned wt_u32x4 __attribute__((ext_vector_type(4)));
__device__ __forceinline__ void store16_wt(void* p, wt_u32x4 v) { asm volatile("global_store_dwordx4 %0, %1, off sc1\n\ts_nop 1" :: "v"(p), "v"(v) : "memory"); }

namespace pg8 {
#define PG8_LAS __attribute__((address_space(3)))
typedef unsigned short bf16_t;
typedef _Float16 bf16x8 __attribute__((ext_vector_type(8)));
typedef float f32x4 __attribute__((ext_vector_type(4)));
typedef unsigned u32x4 __attribute__((ext_vector_type(4)));
constexpr int BM = 256, BK = 64, HALF = 128, HTB = HALF * BK * 2  , STAGE_BYTES = 8 * HTB, NXCD = 8, WGM = 8;

__host__ __device__ __forceinline__ int lds_byte(int r, int c) { const int st = (r >> 4) * 2 + (c >> 5), rr = r & 15, cc = c & 31, ob = rr * 64 + cc * 2; return st * 1024 + (ob ^ (((ob >> 9) & 1) << 5)); }
__host__ __device__ __forceinline__ void stage_rc(int b, int& R, int& C) { const int st = b / 1024, sb = b % 1024, swz = sb ^ (((sb >> 9) & 1) << 5); R = (st >> 1) * 16 + swz / 64; C = (st & 1) * 32 + (swz % 64) / 2; }
__host__ __device__ __forceinline__ int perm32(int rho) { const int n = rho >> 4, i = rho & 15; return 8 * (i >> 2) + 4 * n + (i & 3); }

struct Unit { int pm, pn; };
struct Gemm { const bf16_t* A; const bf16_t* Bt; int M, N, K, lda; };

struct StaticOrder {
    int nM, nN, nwg, G, c;
    __host__ __device__ void init(int M, int N, int G_, int c_) { nM = M / BM; nN = N / BM; nwg = nM * nN; G = G_; c = c_; }
    __host__ __device__ bool next(int i, Unit& u) const {
        const long L = (long)i * G + c; if (L >= nwg) return false;
        int wgid = (int)L; { const int q = nwg / NXCD, r = nwg % NXCD, xcd = wgid % NXCD, off = wgid / NXCD; wgid = (xcd < r ? xcd * (q + 1) : r * (q + 1) + (xcd - r) * q) + off; }
        const int nig = WGM * nN, gid = wgid / nig, fm = gid * WGM, gsz = (nM - fm) < WGM ? (nM - fm) : WGM;
        u.pm = fm + ((wgid % nig) % gsz); u.pn = (wgid % nig) / gsz; return true;
    }
    __device__ __forceinline__ void a_ready(const Unit&) const {}
    __device__ __forceinline__ void done(const Unit&) const {}
};


struct DiagOrder {
    int nunits, per, G, c; unsigned* cnt; unsigned want; unsigned* tmo;
    __device__ __forceinline__ bool next(int i, Unit& u) const { const int L = i * G + c; if (L >= nunits) return false; u.pm = L; u.pn = L / per; return true; }
    __device__ __forceinline__ void a_ready(const Unit& u) const {
        if (!cnt) return;
        if (threadIdx.x < 64) { unsigned sp = 0;
            while (__hip_atomic_load(cnt + 64 * u.pm, __ATOMIC_RELAXED, __HIP_MEMORY_SCOPE_AGENT) < want) { __builtin_amdgcn_s_sleep(2);
                if (++sp > (1u << 22)) { if (threadIdx.x == 0) __hip_atomic_store(tmo, 1u, __ATOMIC_RELAXED, __HIP_MEMORY_SCOPE_AGENT); break; } }
            __builtin_amdgcn_fence(__ATOMIC_ACQUIRE, "agent"); asm volatile("s_waitcnt vmcnt(0)" ::: "memory"); }
        __syncthreads();
    }
    __device__ __forceinline__ void done(const Unit&) const {}
};
struct OneUnit { Unit u;
    __device__ __forceinline__ bool next(int i, Unit& x) const { if (i) return false; x = u; return true; }
    __device__ __forceinline__ void a_ready(const Unit&) const {}
    __device__ __forceinline__ void done(const Unit&) const {} };
struct PanelOrder : StaticOrder {
    unsigned* cnt; unsigned want; unsigned* tmo;
    __device__ __forceinline__ void a_ready(const Unit& u) const {
        if (threadIdx.x < 64) { unsigned sp = 0;
            while (__hip_atomic_load(cnt + 64 * u.pm, __ATOMIC_RELAXED, __HIP_MEMORY_SCOPE_AGENT) < want) { __builtin_amdgcn_s_sleep(2);
                if (++sp > (1u << 22)) { if (threadIdx.x == 0) __hip_atomic_store(tmo, 1u, __ATOMIC_RELAXED, __HIP_MEMORY_SCOPE_AGENT); break; } }
            __builtin_amdgcn_fence(__ATOMIC_ACQUIRE, "agent"); asm volatile("s_waitcnt vmcnt(0)" ::: "memory"); }
        __syncthreads();
    }
};

typedef float f32x2 __attribute__((ext_vector_type(2)));
typedef _Float16 f16x2 __attribute__((ext_vector_type(2)));
__device__ __forceinline__ unsigned cvt_pk_h(float lo, float hi) { const f16x2 v = __builtin_convertvector((f32x2){lo, hi}, f16x2); return __builtin_bit_cast(unsigned, v); }
__device__ __forceinline__ float h_lo(unsigned w) { return (float)__builtin_bit_cast(f16x2, w)[0]; }
__device__ __forceinline__ float h_hi(unsigned w) { return (float)__builtin_bit_cast(f16x2, w)[1]; }
__device__ __forceinline__ float fsilu(float v) { return v * __builtin_amdgcn_rcpf(1.f + __builtin_amdgcn_exp2f(-1.4426950408889634f * v)); }
__device__ __forceinline__ float fsigm(float v) { return __builtin_amdgcn_rcpf(1.f + __builtin_amdgcn_exp2f(-1.4426950408889634f * v)); }
__device__ __forceinline__ float fglu3(float y, float t, float z) {
    return y * z * __builtin_amdgcn_rcpf((1.f + __builtin_amdgcn_exp2f(-1.4426950408889634f * t)) * (1.f + __builtin_amdgcn_exp2f(-1.4426950408889634f * z))); }

struct EpiH16 {
    static constexpr bool PERM = true, AFTER_DRAIN = false;
    bf16_t* O; int ldc;
    __device__ __forceinline__ void operator()(const f32x4 (&acc)[2][2][4][2], const Unit& u, int wr, int wc, int fr, int fq) const {
        const int row0 = u.pm * BM + wr * 64 + fr, col0 = u.pn * BM + wc * 32 + 8 * fq;
#pragma unroll
        for (int ai = 0; ai < 2; ++ai)
#pragma unroll
            for (int m = 0; m < 4; ++m) { bf16_t* rowp = O + (size_t)(row0 + ai * HALF + m * 16) * ldc + col0;
#pragma unroll
                for (int bj = 0; bj < 2; ++bj) { const f32x4 v0 = acc[ai][bj][m][0], v1 = acc[ai][bj][m][1];
                    u32x4 w; w.x = cvt_pk_h(v0[0], v0[1]); w.y = cvt_pk_h(v0[2], v0[3]); w.z = cvt_pk_h(v1[0], v1[1]); w.w = cvt_pk_h(v1[2], v1[3]);
                    store16_wt(rowp + bj * HALF, w); } }
    }
};
struct EpiProj {
    static constexpr bool PERM = true, AFTER_DRAIN = false;
    bf16_t* O; int ldc; float* RS; int rs_pn0; bf16_t* USG; int seq;
    __device__ __forceinline__ void operator()(const f32x4 (&acc)[2][2][4][2], const Unit& u, int wr, int wc, int fr, int fq) const {
        const int row0 = u.pm * BM + wr * 64 + fr, col0 = u.pn * BM + wc * 32 + 8 * fq;
#pragma unroll
        for (int ai = 0; ai < 2; ++ai)
#pragma unroll
            for (int m = 0; m < 4; ++m) { const int grow = row0 + ai * HALF + m * 16; bf16_t* rowp = O + (size_t)grow * ldc + col0 - 512;
                const int bb = grow / seq, tt = grow % seq;
#pragma unroll
                for (int bj = 0; bj < 2; ++bj) { const f32x4 v0 = acc[ai][bj][m][0], v1 = acc[ai][bj][m][1];
                    u32x4 w; w.x = cvt_pk_h(v0[0], v0[1]); w.y = cvt_pk_h(v0[2], v0[3]); w.z = cvt_pk_h(v1[0], v1[1]); w.w = cvt_pk_h(v1[2], v1[3]);
                    if (u.pn < 2) { const int c = col0 + bj * HALF;
                        *(u32x4*)(USG + ((size_t)(c >> 4) * 1024 + bb * 512 + (tt >> 4)) * 384 + (tt & 15) * 16 + (c & 15)) = w;
                    }
                    else *(u32x4*)(rowp + bj * HALF) = w; } }
        if (u.pn >= rs_pn0) {
#pragma unroll
            for (int ai = 0; ai < 2; ++ai)
#pragma unroll
                for (int m = 0; m < 4; ++m)
#pragma unroll
                    for (int bj = 0; bj < 2; ++bj) { const f32x4 v0 = acc[ai][bj][m][0], v1 = acc[ai][bj][m][1];
                        float q = (v0[0] * v0[0] + v0[1] * v0[1]) + (v0[2] * v0[2] + v0[3] * v0[3]) + (v1[0] * v1[0] + v1[1] * v1[1]) + (v1[2] * v1[2] + v1[3] * v1[3]);
                        q += __shfl_xor(q, 16); q += __shfl_xor(q, 32);
                        if (fq == 0) RS[((size_t)(row0 + ai * HALF + m * 16) * 3 + (u.pn - rs_pn0)) * 8 + bj * 4 + wc] = q; }
        }
    }
};
struct MlaAux { const float* RS; const float* rope; const bf16_t* proj; int ldp, krcol0; };
constexpr int MLA_TBL = 8192, MLA_ROPE = 12288, MLA_KR = 45056;
__device__ __forceinline__ void mla_stage_rows(const MlaAux& A, const Unit& u, PG8_LAS unsigned char* lds, int tid, bool want_kr, float eps) {
    const size_t row0 = (size_t)u.pm * BM;
    u32x4 rp[4];
#pragma unroll
    for (int j = 0; j < 4; ++j) rp[j] = *(const u32x4*)((const char*)(A.rope + row0 * 32) + (size_t)(tid + 512 * j) * 16);
    u32x4 kr[2] = {{0u, 0u, 0u, 0u}, {0u, 0u, 0u, 0u}};
    if (want_kr) {
#pragma unroll
        for (int j = 0; j < 2; ++j) { const int c = tid + 512 * j; kr[j] = *(const u32x4*)(A.proj + (row0 + (c >> 2)) * A.ldp + A.krcol0 + 8 * (c & 3)); } }
    if (tid < 256) { const float* rs = A.RS + (row0 + tid) * 24;
        const f32x4 s6a = *(const f32x4*)rs, s6b = *(const f32x4*)(rs + 4), s7a = *(const f32x4*)(rs + 8), s7b = *(const f32x4*)(rs + 12), s8a = *(const f32x4*)(rs + 16); const float skr = rs[20];
        const float sq = ((s7a[0] + s7a[1]) + (s7a[2] + s7a[3])) + ((s7b[0] + s7b[1]) + (s7b[2] + s7b[3])) + ((s8a[0] + s8a[1]) + (s8a[2] + s8a[3]));
        const float skv = ((s6a[0] + s6a[1]) + (s6a[2] + s6a[3])) + ((s6b[0] + s6b[1]) + (s6b[2] + s6b[3]));
        *(PG8_LAS f32x4*)(lds + MLA_TBL + tid * 16) = (f32x4){1.f / sqrtf(sq * (1.f / 384.f) + eps), 1.f / sqrtf(skv * (1.f / 256.f) + eps), skr, 0.f}; }
#pragma unroll
    for (int j = 0; j < 4; ++j) *(PG8_LAS u32x4*)(lds + MLA_ROPE + (tid + 512 * j) * 16) = rp[j];
    if (want_kr) {
#pragma unroll
        for (int j = 0; j < 2; ++j) *(PG8_LAS u32x4*)(lds + MLA_KR + (tid + 512 * j) * 16) = kr[j]; }
}
struct EpiQ {
    static constexpr bool PERM = true, AFTER_DRAIN = true;
    MlaAux A; const float* gq; bf16_t* Q; float qscale, eps; int seq;
    __device__ __forceinline__ void fused(f32x4 (&acc)[2][2][4][2], const Unit& u, int wr, int wc, int fr, int fq, PG8_LAS unsigned char* lds, int wid, int lane) const {
        PG8_LAS float* P = (PG8_LAS float*)lds;
#pragma unroll
        for (int ai = 0; ai < 2; ++ai)
#pragma unroll
            for (int m = 0; m < 4; ++m)
#pragma unroll
                for (int bj = 0; bj < 2; ++bj) { const f32x4 v0 = acc[ai][bj][m][0], v1 = acc[ai][bj][m][1];
                    float q = (v0[0] * v0[0] + v0[1] * v0[1]) + (v0[2] * v0[2] + v0[3] * v0[3]) + (v1[0] * v1[0] + v1[1] * v1[1]) + (v1[2] * v1[2] + v1[3] * v1[3]);
                    q += __shfl_xor(q, 16); q += __shfl_xor(q, 32);
                    if (fq == 0) P[((ai * HALF + wr * 64 + m * 16 + fr) * 2 + bj) * 4 + wc] = q; }
        mla_stage_rows(A, u, lds, wid * 64 + lane, false, eps);
        asm volatile("s_waitcnt lgkmcnt(0)" ::: "memory"); __builtin_amdgcn_s_barrier(); asm volatile("" ::: "memory");
        if (wc == 3) return;
        const int d0 = 32 * wc + 8 * fq;
        const f32x4 g0 = *(const f32x4*)(gq + (wc == 2 ? 64 + 8 * fq : d0)), g1 = *(const f32x4*)(gq + (wc == 2 ? 64 + 8 * fq : d0) + 4);
#pragma unroll
        for (int ai = 0; ai < 2; ++ai)
#pragma unroll
            for (int m = 0; m < 4; ++m) { const int r = ai * HALF + wr * 64 + m * 16 + fr; const size_t grow = (size_t)u.pm * BM + r;
                const float rstd = (*(const PG8_LAS f32x4*)(lds + MLA_TBL + r * 16))[0];
                f32x4 cs0 = {0.f, 0.f, 0.f, 0.f}, cs1 = cs0, cs2 = cs0, cs3 = cs0;
                if (wc == 2) { const PG8_LAS float* rp = (const PG8_LAS float*)(lds + MLA_ROPE) + (r * 16 + 8 * (fq & 1)) * 2; cs0 = *(const PG8_LAS f32x4*)rp; cs1 = *(const PG8_LAS f32x4*)(rp + 4); cs2 = *(const PG8_LAS f32x4*)(rp + 8); cs3 = *(const PG8_LAS f32x4*)(rp + 12); }
#pragma unroll
                for (int bj = 0; bj < 2; ++bj) { const f32x4 pp = *(const PG8_LAS f32x4*)(P + (r * 2 + bj) * 4);
                    const float tot = (pp[0] + pp[1]) + pp[2];
                    const float rs = qscale * rstd * __builtin_amdgcn_rsqf(rstd * rstd * tot * (1.f / 96.f) + eps);
                    f32x4 v0 = acc[ai][bj][m][0] * rs * g0, v1 = acc[ai][bj][m][1] * rs * g1;
                    if (wc == 2) {
                        f32x4 o0, o1;
#pragma unroll
                        for (int e = 0; e < 4; ++e) { o0[e] = __shfl_xor(v0[e], 32); o1[e] = __shfl_xor(v1[e], 32); }
                        const float sg = (fq < 2) ? -1.f : 1.f;
                        v0[0] = v0[0] * cs0[0] + sg * o0[0] * cs0[1]; v0[1] = v0[1] * cs0[2] + sg * o0[1] * cs0[3]; v0[2] = v0[2] * cs1[0] + sg * o0[2] * cs1[1]; v0[3] = v0[3] * cs1[2] + sg * o0[3] * cs1[3];
                        v1[0] = v1[0] * cs2[0] + sg * o1[0] * cs2[1]; v1[1] = v1[1] * cs2[2] + sg * o1[1] * cs2[3]; v1[2] = v1[2] * cs3[0] + sg * o1[2] * cs3[1]; v1[3] = v1[3] * cs3[2] + sg * o1[3] * cs3[3]; }
                    u32x4 w; w.x = cvt_pk_h(v0[0], v0[1]); w.y = cvt_pk_h(v0[2], v0[3]); w.z = cvt_pk_h(v1[0], v1[1]); w.w = cvt_pk_h(v1[2], v1[3]);
                    *(u32x4*)(Q + grow * 768 + (2 * u.pn + bj) * 96 + d0) = w; } }
    }
};
struct EpiKV {
    static constexpr bool PERM = true, AFTER_DRAIN = true;
    MlaAux A; const float* gk; bf16_t* KIMG; bf16_t* VIMG; float eps; int seq;
    __device__ __forceinline__ static int vst(int k, int c) { return (c >> 5) * 4096 + k * 64 + (c & 31) * 2; }
    __device__ __forceinline__ void fused(f32x4 (&acc)[2][2][4][2], const Unit& u, int wr, int wc, int fr, int fq, PG8_LAS unsigned char* lds, int wid, int lane) const {
        PG8_LAS float* P = (PG8_LAS float*)lds;
        if (wc < 2) {
#pragma unroll
            for (int ai = 0; ai < 2; ++ai)
#pragma unroll
                for (int m = 0; m < 4; ++m)
#pragma unroll
                    for (int bj = 0; bj < 2; ++bj) { const f32x4 v0 = acc[ai][bj][m][0], v1 = acc[ai][bj][m][1];
                        float q = (v0[0] * v0[0] + v0[1] * v0[1]) + (v0[2] * v0[2] + v0[3] * v0[3]) + (v1[0] * v1[0] + v1[1] * v1[1]) + (v1[2] * v1[2] + v1[3] * v1[3]);
                        q += __shfl_xor(q, 16); q += __shfl_xor(q, 32);
                        if (fq == 0) P[((ai * HALF + wr * 64 + m * 16 + fr) * 2 + bj) * 2 + wc] = q; }
        }
        mla_stage_rows(A, u, lds, wid * 64 + lane, true, eps);
        asm volatile("s_waitcnt lgkmcnt(0)" ::: "memory"); __builtin_amdgcn_s_barrier(); asm volatile("" ::: "memory");
        const int q8 = 4 * (wc & 1) + fq;
        f32x4 g0 = {0.f, 0.f, 0.f, 0.f}, g1 = g0; float ga = 0.f, gb = 0.f, gc = 0.f, gd = 0.f;
        if (wc < 2) { g0 = *(const f32x4*)(gk + 32 * wc + 8 * fq); g1 = *(const f32x4*)(gk + 32 * wc + 8 * fq + 4); }
        else { ga = gk[64 + 2 * q8]; gb = gk[65 + 2 * q8]; gc = gk[80 + 2 * q8]; gd = gk[81 + 2 * q8]; }
#pragma unroll
        for (int ai = 0; ai < 2; ++ai)
#pragma unroll
            for (int m = 0; m < 4; ++m) { const int r = ai * HALF + wr * 64 + m * 16 + fr; const size_t grow = (size_t)u.pm * BM + r;
                const f32x4 tb = *(const PG8_LAS f32x4*)(lds + MLA_TBL + r * 16); const float rstd = tb[1], skr = tb[2];
                const int bb = (int)(grow / (size_t)seq), tt = (int)(grow % (size_t)seq), trow = tt & 63;
                float cA = 0.f, sA = 0.f, cB = 0.f, sB = 0.f, x1a = 0.f, x1b = 0.f, x2a = 0.f, x2b = 0.f;
                if (wc >= 2) { const f32x4 cs = *(const PG8_LAS f32x4*)((const PG8_LAS float*)(lds + MLA_ROPE) + (r * 16 + 2 * q8) * 2); cA = cs[0]; sA = cs[1]; cB = cs[2]; sB = cs[3];
                    const PG8_LAS bf16_t* krow = (const PG8_LAS bf16_t*)(lds + MLA_KR) + r * 32;
                    const unsigned ra = *(const PG8_LAS unsigned*)(krow + 2 * q8), rb = *(const PG8_LAS unsigned*)(krow + 16 + 2 * q8);
                    x1a = h_lo(ra); x1b = h_hi(ra); x2a = h_lo(rb); x2b = h_hi(rb); }
#pragma unroll
                for (int bj = 0; bj < 2; ++bj) { const f32x2 pp = *(const PG8_LAS f32x2*)(P + (r * 2 + bj) * 2);
                    const float rs = __builtin_amdgcn_rsqf((rstd * rstd * (pp[0] + pp[1]) + skr) * (1.f / 96.f) + eps);
                    const size_t tix = (size_t)(bb * 8 + 2 * u.pn + bj) * 128 + (tt >> 6);
                    if (wc < 2) { const float f = rstd * rs; const f32x4 v0 = acc[ai][bj][m][0] * f * g0, v1 = acc[ai][bj][m][1] * f * g1;
                        u32x4 w; w.x = cvt_pk_h(v0[0], v0[1]); w.y = cvt_pk_h(v0[2], v0[3]); w.z = cvt_pk_h(v1[0], v1[1]); w.w = cvt_pk_h(v1[2], v1[3]);
                        *(u32x4*)(KIMG + tix * 6144 + (4 * wc + fq) * 512 + trow * 8) = w; }
                    else { const f32x4 v0 = acc[ai][bj][m][0] * rstd, v1 = acc[ai][bj][m][1] * rstd;
                        u32x4 w; w.x = cvt_pk_h(v0[0], v0[1]); w.y = cvt_pk_h(v0[2], v0[3]); w.z = cvt_pk_h(v1[0], v1[1]); w.w = cvt_pk_h(v1[2], v1[3]);
                        *(u32x4*)(VIMG + tix * 4096 + vst(trow, 32 * (wc - 2) + 8 * fq) / 2) = w;
                        const float y1a = x1a * rs * ga, y1b = x1b * rs * gb, y2a = x2a * rs * gc, y2b = x2b * rs * gd;
                        bf16_t* kd = KIMG + tix * 6144 + trow * 8;
                        *(unsigned*)(kd + (8 + (q8 >> 2)) * 512 + ((2 * q8) & 7)) = cvt_pk_h(y1a * cA - y2a * sA, y1b * cB - y2b * sB);
                        *(unsigned*)(kd + (10 + (q8 >> 2)) * 512 + ((2 * q8) & 7)) = cvt_pk_h(y2a * cA + y1a * sA, y2b * cB + y1b * sB); } } }
    }
};
struct EpiELds {
    static constexpr bool PERM = true, AFTER_DRAIN = true;
    __device__ __forceinline__ void fused(f32x4 (&acc)[2][2][4][2], const Unit& u, int wr, int wc, int fr, int fq, PG8_LAS unsigned char* lds, int wid, int lane) const {
        PG8_LAS float* El = (PG8_LAS float*)lds;
#pragma unroll
        for (int ai = 0; ai < 2; ++ai)
#pragma unroll
            for (int m = 0; m < 4; ++m) { const int r = ai * HALF + wr * 64 + m * 16 + fr; PG8_LAS float* rp = El + r * 128 + wc * 32 + 8 * fq;
                *(PG8_LAS f32x4*)rp = acc[ai][0][m][0]; *(PG8_LAS f32x4*)(rp + 4) = acc[ai][0][m][1]; }
    }
};
__device__ __forceinline__ void ssm_chain_unit(const Unit& u, const PG8_LAS unsigned char* lds, bf16_t* USG, const float* AC, float* hand, unsigned* cnt, unsigned* tmo, int lane) {
        const PG8_LAS float* El = (const PG8_LAS float*)lds;
        const int g = u.pn, k4 = u.pm & 3, seqi = g * 2 + (k4 >> 1), p = lane;
        const f32x4 ac = *(const f32x4*)(AC + ((size_t)g * 64 + p) * 4);
        float sr = 0.f, si = 0.f;
        if (k4 & 1) { unsigned sp = 0;
            while (__hip_atomic_load(cnt + 64 * seqi, __ATOMIC_RELAXED, __HIP_MEMORY_SCOPE_AGENT) < 1u) { __builtin_amdgcn_s_sleep(2);
                if (++sp > (1u << 22)) { if (lane == 0) __hip_atomic_store(tmo, 1u, __ATOMIC_RELAXED, __HIP_MEMORY_SCOPE_AGENT); break; } }
            const unsigned long long hv = __hip_atomic_load((const unsigned long long*)(hand + ((size_t)seqi * 64 + p) * 2), __ATOMIC_RELAXED, __HIP_MEMORY_SCOPE_AGENT);
            sr = __uint_as_float((unsigned)hv); si = __uint_as_float((unsigned)(hv >> 32)); }
        bf16_t* srow = USG + (size_t)u.pm * BM * 384 + 256 + 2 * p;
#pragma unroll 8
        for (int t = 0; t < 256; ++t) { const f32x2 e = *(const PG8_LAS f32x2*)(El + t * 128 + 2 * p);
            *(unsigned*)(srow + (size_t)t * 384) = cvt_pk_h(sr, si);
            const float nr = ac[2] * sr - ac[3] * si + e[0], ni = ac[2] * si + ac[3] * sr + e[1]; sr = nr; si = ni; }
        if (!(k4 & 1)) { __hip_atomic_store((unsigned long long*)(hand + ((size_t)seqi * 64 + p) * 2), (unsigned long long)__float_as_uint(sr) | ((unsigned long long)__float_as_uint(si) << 32), __ATOMIC_RELAXED, __HIP_MEMORY_SCOPE_AGENT);
            asm volatile("s_waitcnt vmcnt(0)" ::: "memory");
            if (lane == 0) __hip_atomic_fetch_add(cnt + 64 * seqi, 1u, __ATOMIC_RELAXED, __HIP_MEMORY_SCOPE_AGENT); }
}
struct EpiY {
    static constexpr bool PERM = true, AFTER_DRAIN = false;
    const bf16_t* USG; const float* dskip; bf16_t* YPRE; int seq;
    __device__ __forceinline__ static float gelu_t(float v) { const float z = 0.7978845608028654f * (v + 0.044715f * v * v * v); return v * __builtin_amdgcn_rcpf(1.f + __builtin_amdgcn_exp2f(-2.885390081777927f * z)); }
    __device__ __forceinline__ void operator()(const f32x4 (&acc)[2][2][4][2], const Unit& u, int wr, int wc, int fr, int fq) const {
        const int g = u.pn, k4 = u.pm & 3, bb = k4 >> 1;
        const int i0 = (8 * fq) & 15;
        const f32x4 d0 = *(const f32x4*)(dskip + g * 16 + i0), d1 = *(const f32x4*)(dskip + g * 16 + i0 + 4);
#pragma unroll
        for (int ai = 0; ai < 2; ++ai)
#pragma unroll
            for (int m = 0; m < 4; ++m) { const int r = ai * HALF + wr * 64 + m * 16 + fr; const size_t arow = (size_t)u.pm * BM + r; const int tile = (k4 & 1) * 256 + r;
#pragma unroll
                for (int bj = 0; bj < 2; ++bj) { const int col = bj * HALF + wc * 32 + 8 * fq, t = col >> 4;
                    const u32x4 uv = *(const u32x4*)(USG + arow * 384 + col);
                    const f32x4 v0 = acc[ai][bj][m][0], v1 = acc[ai][bj][m][1];
                    u32x4 w;
                    w.x = cvt_pk_h(gelu_t(v0[0] + d0[0] * h_lo(uv.x)), gelu_t(v0[1] + d0[1] * h_hi(uv.x))); w.y = cvt_pk_h(gelu_t(v0[2] + d0[2] * h_lo(uv.y)), gelu_t(v0[3] + d0[3] * h_hi(uv.y)));
                    w.z = cvt_pk_h(gelu_t(v1[0] + d1[0] * h_lo(uv.z)), gelu_t(v1[1] + d1[1] * h_hi(uv.z))); w.w = cvt_pk_h(gelu_t(v1[2] + d1[2] * h_lo(uv.w)), gelu_t(v1[3] + d1[3] * h_hi(uv.w)));
                    store16_wt(YPRE + ((size_t)bb * seq + (size_t)tile * 16 + t) * 512 + g * 16 + i0, w); } }
    }
};
struct EpiGlu {
    static constexpr bool PERM = true, AFTER_DRAIN = false;
    const bf16_t* ypre; const bf16_t* proj; int ldp, zcol0; const float* bglu; bf16_t* ycat;
    __device__ __forceinline__ void operator()(const f32x4 (&acc)[2][2][4][2], const Unit& u, int wr, int wc, int fr, int fq) const {
        const int row0 = u.pm * BM + wr * 64 + fr, col0 = u.pn * BM + wc * 32 + 8 * fq;
        f32x4 bv[2][2];
#pragma unroll
        for (int bj = 0; bj < 2; ++bj)
#pragma unroll
            for (int n = 0; n < 2; ++n) bv[bj][n] = *(const f32x4*)(bglu + col0 + bj * HALF + 4 * n);
#pragma unroll
        for (int ai = 0; ai < 2; ++ai)
#pragma unroll
            for (int m = 0; m < 4; ++m) { const size_t row = (size_t)(row0 + ai * HALF + m * 16);
#pragma unroll
                for (int bj = 0; bj < 2; ++bj) { const int col = col0 + bj * HALF;
                    const u32x4 yv = __builtin_nontemporal_load((const u32x4*)(ypre + row * 512 + col)); const u32x4 zv = __builtin_nontemporal_load((const u32x4*)(proj + row * ldp + zcol0 + col));
                    const f32x4 t0 = acc[ai][bj][m][0] + bv[bj][0], t1 = acc[ai][bj][m][1] + bv[bj][1];
                    u32x4 w;
                    w.x = cvt_pk_h(fglu3(h_lo(yv.x), t0[0], h_lo(zv.x)), fglu3(h_hi(yv.x), t0[1], h_hi(zv.x)));
                    w.y = cvt_pk_h(fglu3(h_lo(yv.y), t0[2], h_lo(zv.y)), fglu3(h_hi(yv.y), t0[3], h_hi(zv.y)));
                    w.z = cvt_pk_h(fglu3(h_lo(yv.z), t1[0], h_lo(zv.z)), fglu3(h_hi(yv.z), t1[1], h_hi(zv.z)));
                    w.w = cvt_pk_h(fglu3(h_lo(yv.w), t1[2], h_lo(zv.w)), fglu3(h_hi(yv.w), t1[3], h_hi(zv.w)));
                    store16_wt(ycat + row * 1024 + col, w); } }
    }
};
struct EpiOutRows {
    static constexpr bool PERM = false, AFTER_DRAIN = true;
    const float* x; const float* gate; int gate_stride, rows_per_batch; float* out;
    __device__ __forceinline__ static int slot(int r, int s16) { return r * 1024 + ((s16 ^ (r & 15)) << 4); }
    __device__ __forceinline__ void fused(f32x4 (&acc)[2][2][4][2], const Unit& u, int wr, int wc, int fr, int fq, PG8_LAS unsigned char* lds, int wid, int lane) const {
        const int b = (u.pm * BM) / rows_per_batch;
        const f32x4 gv = *(const f32x4*)(gate + (size_t)b * gate_stride + u.pn * BM + 4 * lane);
#pragma unroll
        for (int ai = 0; ai < 2; ++ai) {
#pragma unroll
            for (int m = 0; m < 4; ++m) { const int rl = wr * 64 + m * 16 + fr;
#pragma unroll
                for (int bj = 0; bj < 2; ++bj)
#pragma unroll
                    for (int n = 0; n < 2; ++n) *(PG8_LAS f32x4*)(lds + slot(rl, 32 * bj + 8 * wc + 4 * n + fq)) = acc[ai][bj][m][n]; }
            asm volatile("s_waitcnt lgkmcnt(0)" ::: "memory"); __builtin_amdgcn_s_barrier(); asm volatile("" ::: "memory");
            const size_t g0 = ((size_t)u.pm * BM + ai * HALF + wid * 16) * 1024 + u.pn * BM + 4 * lane;
#pragma unroll
            for (int i0 = 0; i0 < 16; i0 += 8) { f32x4 xs[8];
#pragma unroll
                for (int i = 0; i < 8; ++i) xs[i] = __builtin_nontemporal_load((const f32x4*)(x + g0 + (size_t)(i0 + i) * 1024));
#pragma unroll
                for (int i = 0; i < 8; ++i) { const f32x4 v = *(const PG8_LAS f32x4*)(lds + slot(wid * 16 + i0 + i, lane)); __builtin_nontemporal_store(xs[i] + gv * v, (f32x4*)(out + g0 + (size_t)(i0 + i) * 1024)); } }
            if (ai == 0) { asm volatile("s_waitcnt lgkmcnt(0)" ::: "memory"); __builtin_amdgcn_s_barrier(); asm volatile("" ::: "memory"); }
        }
    }
};
template <class Epi, class Sched, bool ALIGN_EPI = false, bool SP2 = false>
__device__ __forceinline__ void gemm_phase(PG8_LAS unsigned char* lds, const Gemm g, const Sched& S, const Epi& E) {
    int tid_ = threadIdx.x; asm volatile("" : "+v"(tid_));
    const int tid = tid_, wid = __builtin_amdgcn_readfirstlane(tid >> 6), lane = tid & 63, wr = wid >> 2, wc = wid & 3, fr = lane & 15, fq = lane >> 4;
    const int K = g.K, nt = K / BK;
    unsigned voffA[2], voffB[2];
#pragma unroll
    for (int i = 0; i < 2; ++i) { int R, C; stage_rc(tid * 16 + i * 8192, R, C); const int Rb = Epi::PERM ? ((R & ~31) + perm32(R & 31)) : R;
        voffA[i] = (unsigned)(R * g.lda + C) * 2u; voffB[i] = (unsigned)(Rb * K + C) * 2u; }
    const size_t kstep = (size_t)(BK * 2);
    const size_t hstepA = (size_t)HALF * g.lda * 2, hstepB = (size_t)HALF * K * 2;
    const size_t tstepA = 2 * hstepA, tstepB = 2 * hstepB;
    const unsigned ldsw = (unsigned)wid * 1024u;
    const int aoff = lds_byte(wr * 64 + fr, fq * 8), boff = lds_byte(wc * 32 + fr, fq * 8);
#define PG8_SA(b, h) (((b) * 2 + (h)) * HTB)
#define PG8_SB(b, h) ((4 + (b) * 2 + (h)) * HTB)
#define PG8_STAGE(bufoff, gbase, voff) do { _Pragma("unroll") for (int _i = 0; _i < 2; ++_i) \
        __builtin_amdgcn_global_load_lds((const unsigned*)((const char*)(gbase) + (voff)[_i]), (PG8_LAS unsigned*)(lds + (bufoff) + ldsw + _i * 8192), 16, 0, 0); } while (0)
#define PG8_LDA(dst, b, h) do { _Pragma("unroll") for (int m = 0; m < 4; ++m) _Pragma("unroll") for (int k = 0; k < 2; ++k) dst[m][k] = *(const PG8_LAS bf16x8*)(lds + PG8_SA(b, h) + aoff + m * 2048 + k * 1024); } while (0)
#define PG8_LDB(dst, b, h) do { _Pragma("unroll") for (int n = 0; n < 2; ++n) _Pragma("unroll") for (int k = 0; k < 2; ++k) dst[n][k] = *(const PG8_LAS bf16x8*)(lds + PG8_SB(b, h) + boff + n * 2048 + k * 1024); } while (0)
#define PG8_MMA(ai, bj, At, Bt) do { __builtin_amdgcn_s_setprio(1); _Pragma("unroll") for (int m = 0; m < 4; ++m) _Pragma("unroll") for (int n = 0; n < 2; ++n) _Pragma("unroll") for (int k = 0; k < 2; ++k) \
        acc[ai][bj][m][n] = __builtin_amdgcn_mfma_f32_16x16x32_f16(Bt[n][k], At[m][k], acc[ai][bj][m][n], 0, 0, 0); __builtin_amdgcn_s_setprio(0); } while (0)
#define PG8_WAIT_V(n) asm volatile("s_waitcnt vmcnt(" #n ")" ::: "memory")
#define PG8_WAIT_L(n) asm volatile("s_waitcnt lgkmcnt(" #n ")" ::: "memory")
#define PG8_BAR __builtin_amdgcn_s_barrier()
#define PG8_SCHED __builtin_amdgcn_sched_barrier(0)
    Unit cur, nxt; int ui = 0;
    if (!S.next(0, cur)) return;
    f32x4 acc[2][2][4][2];
#pragma unroll
    for (int a = 0; a < 2; ++a)
#pragma unroll
        for (int b = 0; b < 2; ++b)
#pragma unroll
            for (int m = 0; m < 4; ++m)
#pragma unroll
                for (int n = 0; n < 2; ++n) acc[a][b][m][n] = (f32x4){0.f, 0.f, 0.f, 0.f};
    bf16x8 At[4][2], B0[2][2], B1[2][2];
    const char* cA = (const char*)g.A + (size_t)cur.pm * tstepA; const char* cB = (const char*)g.Bt + (size_t)cur.pn * tstepB;
    S.a_ready(cur);
    if constexpr (SP2) {
        PG8_STAGE(PG8_SB(0, 0), cB, voffB); PG8_STAGE(PG8_SB(0, 1), cB + hstepB, voffB); PG8_STAGE(PG8_SA(0, 0), cA, voffA); PG8_STAGE(PG8_SA(0, 1), cA + hstepA, voffA);
        if (wr == 1) PG8_BAR;
        PG8_WAIT_V(2); PG8_BAR;
        PG8_STAGE(PG8_SB(1, 0), cB + kstep, voffB); PG8_STAGE(PG8_SA(1, 0), cA + kstep, voffA); PG8_STAGE(PG8_SB(1, 1), cB + hstepB + kstep, voffB);
        PG8_WAIT_V(6); PG8_BAR;
    } else {
        PG8_STAGE(PG8_SB(0, 0), cB, voffB); PG8_STAGE(PG8_SA(0, 0), cA, voffA); PG8_STAGE(PG8_SB(0, 1), cB + hstepB, voffB); PG8_STAGE(PG8_SA(0, 1), cA + hstepA, voffA);
        if (wr == 1) PG8_BAR;
        PG8_WAIT_V(4); PG8_BAR;
        PG8_STAGE(PG8_SB(1, 0), cB + kstep, voffB); PG8_STAGE(PG8_SA(1, 0), cA + kstep, voffA); PG8_STAGE(PG8_SB(1, 1), cB + hstepB + kstep, voffB);
        PG8_WAIT_V(6); PG8_BAR;
    }
    for (;;) {
        const bool has_next = S.next(ui + 1, nxt);
        const char* nA = has_next ? (const char*)g.A + (size_t)nxt.pm * tstepA : cA; const char* nB = has_next ? (const char*)g.Bt + (size_t)nxt.pn * tstepB : cB;
        for (int t = 0; t < nt; t += 2) {
            const bool last = (t == nt - 2);
            const char* a1 = cA + (size_t)(t + 1) * kstep;
            const char* a2 = last ? nA : cA + (size_t)(t + 2) * kstep; const char* b2 = last ? nB : cB + (size_t)(t + 2) * kstep;
            const char* a3 = a2 + kstep; const char* b3 = b2 + kstep;
            if (last && has_next) S.a_ready(nxt);
            if constexpr (SP2) {
            PG8_LDB(B0, 0, 0); PG8_LDB(B1, 0, 1); PG8_SCHED; PG8_LDA(At, 0, 0); PG8_STAGE(PG8_SA(1, 1), a1 + hstepA, voffA);
            PG8_WAIT_V(8); PG8_WAIT_L(0); PG8_BAR; PG8_MMA(0, 0, At, B0); PG8_MMA(0, 1, At, B1); PG8_BAR; PG8_SCHED;
            PG8_LDA(At, 0, 1); PG8_STAGE(PG8_SB(0, 0), b2, voffB); PG8_STAGE(PG8_SB(0, 1), b2 + hstepB, voffB); PG8_STAGE(PG8_SA(0, 0), a2, voffA);
            PG8_WAIT_V(8); PG8_WAIT_L(0); PG8_BAR; PG8_MMA(1, 0, At, B0); PG8_MMA(1, 1, At, B1); PG8_BAR; PG8_SCHED;
            PG8_LDB(B0, 1, 0); PG8_LDB(B1, 1, 1); PG8_SCHED; PG8_LDA(At, 1, 0); PG8_STAGE(PG8_SA(0, 1), a2 + hstepA, voffA);
            PG8_WAIT_V(8); PG8_WAIT_L(0); PG8_BAR; PG8_MMA(0, 0, At, B0); PG8_MMA(0, 1, At, B1); PG8_BAR; PG8_SCHED;
            PG8_LDA(At, 1, 1); PG8_STAGE(PG8_SB(1, 0), b3, voffB); PG8_STAGE(PG8_SB(1, 1), b3 + hstepB, voffB); PG8_STAGE(PG8_SA(1, 0), a3, voffA);
            PG8_WAIT_V(8); PG8_WAIT_L(0); PG8_BAR; PG8_MMA(1, 0, At, B0); PG8_MMA(1, 1, At, B1); PG8_BAR; PG8_SCHED;
            } else {
            PG8_LDB(B0, 0, 0); PG8_SCHED; PG8_LDA(At, 0, 0); PG8_STAGE(PG8_SA(1, 1), a1 + hstepA, voffA);
            PG8_WAIT_L(8); PG8_BAR; PG8_WAIT_L(0); PG8_MMA(0, 0, At, B0); PG8_BAR; PG8_SCHED;
            PG8_LDB(B1, 0, 1); PG8_STAGE(PG8_SB(0, 0), b2, voffB);
            PG8_BAR; PG8_WAIT_L(0); PG8_MMA(0, 1, At, B1); PG8_BAR;
            PG8_LDA(At, 0, 1); PG8_STAGE(PG8_SA(0, 0), a2, voffA);
            PG8_BAR; PG8_WAIT_L(0); PG8_MMA(1, 0, At, B0); PG8_BAR; PG8_SCHED;
            PG8_STAGE(PG8_SB(0, 1), b2 + hstepB, voffB);
            PG8_WAIT_V(6); PG8_BAR; PG8_MMA(1, 1, At, B1); PG8_BAR;
            PG8_LDB(B0, 1, 0); PG8_SCHED; PG8_LDA(At, 1, 0); PG8_STAGE(PG8_SA(0, 1), a2 + hstepA, voffA);
            PG8_WAIT_L(8); PG8_BAR; PG8_WAIT_L(0); PG8_MMA(0, 0, At, B0); PG8_BAR; PG8_SCHED;
            PG8_LDB(B1, 1, 1); PG8_STAGE(PG8_SB(1, 0), b3, voffB);
            PG8_BAR; PG8_WAIT_L(0); PG8_MMA(0, 1, At, B1); PG8_BAR;
            PG8_LDA(At, 1, 1); PG8_STAGE(PG8_SA(1, 0), a3, voffA);
            PG8_BAR; PG8_WAIT_L(0); PG8_MMA(1, 0, At, B0); PG8_BAR; PG8_SCHED;
            PG8_STAGE(PG8_SB(1, 1), b3 + hstepB, voffB);
            PG8_WAIT_V(6); PG8_BAR; PG8_MMA(1, 1, At, B1); PG8_BAR;
            }
        }
        if constexpr (ALIGN_EPI) { if (wr == 0) PG8_BAR; }
        if constexpr (!Epi::AFTER_DRAIN) { E(acc, cur, wr, wc, fr, fq); S.done(cur); }
        if (!has_next) break;
#pragma unroll
        for (int a = 0; a < 2; ++a)
#pragma unroll
            for (int b = 0; b < 2; ++b)
#pragma unroll
                for (int m = 0; m < 4; ++m)
#pragma unroll
                    for (int n = 0; n < 2; ++n) acc[a][b][m][n] = (f32x4){0.f, 0.f, 0.f, 0.f};
        cur = nxt; cA = nA; cB = nB; ++ui;
        if constexpr (ALIGN_EPI) { if (wr == 1) PG8_BAR; }
    }
    PG8_WAIT_V(0);
    if constexpr (!ALIGN_EPI) { if (wr == 0) PG8_BAR; }
    PG8_BAR;
    if constexpr (Epi::AFTER_DRAIN) { E.fused(acc, cur, wr, wc, fr, fq, lds, wid, lane); S.done(cur); }
#undef PG8_SA
#undef PG8_SB
#undef PG8_STAGE
#undef PG8_LDA
#undef PG8_LDB
#undef PG8_MMA
#undef PG8_WAIT_V
#undef PG8_WAIT_L
#undef PG8_BAR
#undef PG8_SCHED
}
}

namespace att {
using h16x8 = __attribute__((ext_vector_type(8))) _Float16;
using s16x4 = __attribute__((ext_vector_type(4))) short;
using f32x16 = __attribute__((ext_vector_type(16))) float;
using u32x4 = __attribute__((ext_vector_type(4))) unsigned;
typedef float f32x2_t __attribute__((ext_vector_type(2))); typedef _Float16 f16x2_t __attribute__((ext_vector_type(2)));
constexpr int NW = 8, QBLK = 32, KVBLK = 64, QB = 256, ASEQ = 8192;
constexpr int LDQ = 768, LDK = 1024, LDV = 512;
constexpr float SCALE = 0.10206207261596575f;
constexpr float THR = 8.f;
#define SBAR() __builtin_amdgcn_sched_barrier(0)
__device__ __forceinline__ int crow(int r, int hi) { return (r & 3) + 8 * (r >> 2) + 4 * hi; }
__device__ __forceinline__ unsigned cvtpk(float lo, float hi) { const f16x2_t v = __builtin_convertvector((f32x2_t){lo, hi}, f16x2_t); return __builtin_bit_cast(unsigned, v); }

__device__ __forceinline__ void cmask(f32x16& p0, f32x16& p1, int jb, int qrel, int hi) {
  const float NEG = -INFINITY; const int kb = 64 * jb + 4 * hi;
#pragma unroll
  for (int r = 0; r < 16; ++r) { const int kv = kb + (r & 3) + 8 * (r >> 2); if (kv > qrel) p0[r] = NEG; if (kv + 32 > qrel) p1[r] = NEG; }
}
constexpr int KT_BYTES = 12288, VT_BYTES = 8192, NKS = 3, NVS = 4;
constexpr int LDS_V0 = NKS * KT_BYTES, LDS_WSC = LDS_V0 + NVS * VT_BYTES;
constexpr int LDS_OST = LDS_WSC + NW * 64 * 4;
constexpr int LDS_ATT2 = LDS_OST + NW * 4096;
typedef __attribute__((address_space(3))) unsigned char* lds3_t;
__device__ __forceinline__ unsigned gate2(unsigned ow, unsigned zw) {
  const f16x2_t o2 = __builtin_bit_cast(f16x2_t, ow), z2 = __builtin_bit_cast(f16x2_t, zw); const float z0 = (float)z2[0], z1 = (float)z2[1];
  return cvtpk((float)o2[0] * (z0 * __builtin_amdgcn_rcpf(1.f + __builtin_amdgcn_exp2f(-1.4426950408889634f * z0))), (float)o2[1] * (z1 * __builtin_amdgcn_rcpf(1.f + __builtin_amdgcn_exp2f(-1.4426950408889634f * z1))));
}
#define PIN(x) asm volatile("" : "+v"(x))
#define MFMAH(a, b, c) __builtin_amdgcn_mfma_f32_32x32x16_f16(a, b, c, 0, 0, 0)
typedef __attribute__((address_space(3))) const char* lds_cptr;
typedef short v4i16_t __attribute__((ext_vector_type(4)));
__device__ __forceinline__ void kload2(h16x8* kf, lds_cptr kp, int d0) { kf[2 * d0] = *(const __attribute__((address_space(3))) h16x8*)(kp + d0 * 2048); kf[2 * d0 + 1] = *(const __attribute__((address_space(3))) h16x8*)(kp + d0 * 2048 + 512); }
__device__ __forceinline__ s16x4 vtr(lds_cptr p) { return __builtin_bit_cast(s16x4, __builtin_amdgcn_ds_read_tr16_b64_v4i16((__attribute__((address_space(3))) v4i16_t*)p)); }
#define MX3(a, b, c) __builtin_fmaxf(__builtin_fmaxf((a), (b)), (c))
__device__ __forceinline__ float rowmax(const f32x16& p0, const f32x16& p1) {
  float a = MX3(p0[0], p0[1], p1[0]), b = MX3(p0[2], p0[3], p1[1]); a = MX3(a, p1[2], p1[3]);
#pragma unroll
  for (int r = 4; r < 16; r += 4) { a = MX3(a, p0[r], p0[r + 1]); b = MX3(b, p0[r + 2], p0[r + 3]); a = MX3(a, p1[r], p1[r + 1]); b = MX3(b, p1[r + 2], p1[r + 3]); }
  float m = __builtin_fmaxf(a, b); auto rr = __builtin_amdgcn_permlane32_swap(__float_as_uint(m), __float_as_uint(m), false, false);
  return __builtin_fmaxf(__uint_as_float(rr[0]), __uint_as_float(rr[1])); }
__device__ __forceinline__ void attn_unit(int b, int h, int qb, const unsigned short* __restrict__ Q, const unsigned short* __restrict__ KIMG, const unsigned short* __restrict__ VIMG,
                                          const unsigned short* __restrict__ PROJ, int ldp, int zcol0, unsigned short* __restrict__ YCAT, char* lds, lds3_t lds3, unsigned* done_cnt, unsigned* z_cnt, unsigned* tmo,
                                          int next_qword, int next_slot_off) {
  int tid_ = threadIdx.x; asm volatile("" : "+v"(tid_));
  const int tid = tid_, lane = tid & 63, r32 = lane & 31, hi = lane >> 5; const int wid = __builtin_amdgcn_readfirstlane(tid >> 6);
  float* ws = (float*)(lds + LDS_WSC) + wid * 64; float* li_l = ws; float* al_l = ws + 32;
  const long rowbase = (long)b * ASEQ; const int q0 = qb * QB;
  const int NT = (q0 + QB) / KVBLK;
  const char* Kg = (const char*)KIMG + (size_t)(b * 8 + h) * 128 * KT_BYTES;
  const char* Vg = (const char*)VIMG + (size_t)(b * 8 + h) * 128 * VT_BYTES;
  const unsigned lo16 = (unsigned)lane * 16u;
  const lds_cptr kp0 = (lds_cptr)lds3 + hi * 1024 + r32 * 16;
  const lds_cptr vp0 = (lds_cptr)lds3 + LDS_V0 + ((lane >> 4) & 1) * 32 + (lane & 3) * 8 + (4 * hi + ((lane & 15) >> 2)) * 64;
  constexpr float THRL = THR * 1.4426950408889634f;
#define GLDS(gp, loff) do { const char* gu_ = (gp); asm volatile("" : "+s"(gu_)); __builtin_amdgcn_global_load_lds((const unsigned*)(gu_ + lo16), (__attribute__((address_space(3))) unsigned*)(lds3 + (loff)), 16, 0, 0); } while (0)
#define DMA_K(t, slot) do { const char* kg_ = Kg + (size_t)(t) * KT_BYTES; const int ko_ = (slot) * KT_BYTES; GLDS(kg_ + wid * 1024, ko_ + wid * 1024); if (wid < 4) GLDS(kg_ + (8 + wid) * 1024, ko_ + (8 + wid) * 1024); } while (0)
#define DMA_V(t, slot) do { GLDS(Vg + (size_t)(t) * VT_BYTES + wid * 1024, LDS_V0 + (slot) * VT_BYTES + wid * 1024); } while (0)
#define WAITB(A, B) do { if (wid < 4) asm volatile("s_waitcnt vmcnt(" #A ") lgkmcnt(0)\n\ts_barrier" ::: "memory"); else asm volatile("s_waitcnt vmcnt(" #B ") lgkmcnt(0)\n\ts_barrier" ::: "memory"); } while (0)
  float mhat = 0.f, l_reg = 0.f; f32x16 o[2]; o[0] = f32x16{}; o[1] = f32x16{}; h16x8 qr[6]; f32x16 negm = {}; PIN(negm);
  const int qrel = wid * QBLK + r32; bool resc = false;
  f32x16 pA0, pA1, pB0, pB1; h16x8 kf[12]; s16x4 vlo[8], vhi[8]; u32x4 pw0, pw1, pw2, pw3;
  int s_prev = 0, s_cur = 0, s_next = 1;
#define ROT() do { s_prev = s_cur; s_cur = s_next; s_next = (s_next == 2) ? 0 : s_next + 1; } while (0)
#define RESC() do { if (resc) { _Pragma("unroll") for (int d_ = 0; d_ < 2; ++d_) _Pragma("unroll") for (int r = 0; r < 16; ++r) o[d_][r] *= al_l[crow(r, hi)]; } } while (0)
  DMA_K(0, 0); DMA_V(0, 0); DMA_K(1, 1);
  { const unsigned short* Qw = Q + (rowbase + q0 + wid * QBLK + r32) * LDQ + h * 96 + hi * 8;
#pragma unroll
    for (int d0 = 0; d0 < 6; ++d0) qr[d0] = __builtin_nontemporal_load(reinterpret_cast<const h16x8*>(Qw + d0 * 16)); }
  DMA_K(2, 2);
  WAITB(2, 1);
#pragma unroll
  for (int d0 = 0; d0 < 6; ++d0) kload2(kf, kp0, d0);
  pA0 = MFMAH(kf[0], qr[0], negm); pA1 = MFMAH(kf[1], qr[0], negm);
#pragma unroll
  for (int d0 = 1; d0 < 6; ++d0) { pA0 = MFMAH(kf[2 * d0], qr[d0], pA0); pA1 = MFMAH(kf[2 * d0 + 1], qr[d0], pA1); }
  if (NT == 4) cmask(pA0, pA1, 0, qrel, hi);
  { const float rm = rowmax(pA0, pA1); mhat = rm;
#pragma unroll
    for (int r = 0; r < 16; ++r) negm[r] = -rm;
    PIN(negm);
#pragma unroll
    for (int r = 0; r < 16; ++r) { pA0[r] = __builtin_amdgcn_exp2f(pA0[r] - rm); pA1[r] = __builtin_amdgcn_exp2f(pA1[r] - rm); } }
  WAITB(0, 0);
  DMA_K(3, 0); DMA_V(1, 1); ROT();
#pragma unroll
  for (int d0 = 0; d0 < 6; ++d0) kload2(kf, kp0 + s_cur * KT_BYTES, d0);
  WAITB(3, 2);
#define PKW(P, i) cvtpk(P[i], P[i + 1])
#define PAF(k) __builtin_bit_cast(h16x8, pw##k)
#define VFR(i) __builtin_bit_cast(h16x8, (__attribute__((ext_vector_type(8))) short){vlo[i][0], vlo[i][1], vlo[i][2], vlo[i][3], vhi[i][0], vhi[i][1], vhi[i][2], vhi[i][3]})
#define VRD(i) do { vlo[i] = vtr(vp_ + (((i) >> 2) * 4096 + ((i) & 3) * 1024)); vhi[i] = vtr(vp_ + (((i) >> 2) * 4096 + ((i) & 3) * 1024 + 512)); } while (0)
#define KRD(G, d0) do { if (G) { kload2(kf, kp0 + s_next * KT_BYTES, d0); SBAR(); } } while (0)
#define GAPA(MF, a0, a1, a2, W0, W1, PW) do { MF; sacc += a0; sacc += a1; sacc += a2; W0; W1; PIN(PW); PIN(sacc); SBAR(); } while (0)
#define GAPA3(MF, a0, a1, a2) do { MF; sacc += a0; sacc += a1; sacc += a2; PIN(sacc); SBAR(); } while (0)
#define GAPB(MF, X, i) do { MF; X[i] = __builtin_amdgcn_exp2f(X[i]); X[i + 1] = __builtin_amdgcn_exp2f(X[i + 1]); X[i + 2] = __builtin_amdgcn_exp2f(X[i + 2]); X[i + 3] = __builtin_amdgcn_exp2f(X[i + 3]); PIN(X); SBAR(); } while (0)
#define STEP(C0, C1, P0, P1, t, MASK, GK, GV, GL) do { SBAR(); \
    const lds_cptr vp_ = vp0 + s_prev * VT_BYTES; \
    VRD(0); SBAR(); float sacc = P0[0] + P0[1]; \
                    GAPA(C0 = MFMAH(kf[0], qr[0], negm), P0[2], P0[3], P0[4],     pw0[0] = PKW(P0, 0),  pw0[1] = PKW(P0, 2),  pw0); \
    VRD(4); SBAR(); GAPA(C1 = MFMAH(kf[1], qr[0], negm), P0[5], P0[6], P0[7],     pw0[2] = PKW(P0, 4),  pw0[3] = PKW(P0, 6),  pw0); \
    VRD(1); SBAR(); GAPA(C0 = MFMAH(kf[2], qr[1], C0),   P0[8], P0[9], P0[10],    pw1[0] = PKW(P0, 8),  pw1[1] = PKW(P0, 10), pw1); \
    VRD(5); SBAR(); GAPA(C1 = MFMAH(kf[3], qr[1], C1),   P0[11], P0[12], P0[13],  pw1[2] = PKW(P0, 12), pw1[3] = PKW(P0, 14), pw1); \
    VRD(2); SBAR(); GAPA(C0 = MFMAH(kf[4], qr[2], C0),   P0[14], P0[15], P1[0],   pw2[0] = PKW(P1, 0),  pw2[1] = PKW(P1, 2),  pw2); \
    VRD(6); SBAR(); GAPA(C1 = MFMAH(kf[5], qr[2], C1),   P1[1], P1[2], P1[3],     pw2[2] = PKW(P1, 4),  pw2[3] = PKW(P1, 6),  pw2); \
                    GAPA(C0 = MFMAH(kf[6], qr[3], C0),   P1[4], P1[5], P1[6],     pw3[0] = PKW(P1, 8),  pw3[1] = PKW(P1, 10), pw3); \
                    GAPA(C1 = MFMAH(kf[7], qr[3], C1),   P1[7], P1[8], P1[9],     pw3[2] = PKW(P1, 12), pw3[3] = PKW(P1, 14), pw3); \
    GAPA3(C0 = MFMAH(kf[8], qr[4], C0), P1[10], P1[11], P1[12]); \
    GAPA3(C1 = MFMAH(kf[9], qr[4], C1), P1[13], P1[14], P1[15]); \
    C0 = MFMAH(kf[10], qr[5], C0); C1 = MFMAH(kf[11], qr[5], C1); \
    l_reg += sacc; \
    if (GK) DMA_K((t) + 3, s_cur); if (GV) DMA_V((t) + 1, s_next);                                                         \
    KRD(GL, 0); KRD(GL, 1);                                                                                                   \
    if (MASK) cmask(C0, C1, (t) - (NT - 4), qrel, hi); \
    { const float rm = rowmax(C0, C1); resc = false;                                                                       \
      if (__builtin_expect(__any(rm > THRL), 0)) { const float dl = __builtin_fmaxf(rm, 0.f); mhat += dl;                  \
          const float f = __builtin_amdgcn_exp2f(-dl); l_reg *= f; if (hi == 0) al_l[r32] = f; resc = true; \
          _Pragma("unroll") for (int r = 0; r < 16; ++r) { C0[r] -= dl; C1[r] -= dl; } \
          _Pragma("unroll") for (int r = 0; r < 16; ++r) negm[r] = -mhat; \
          PIN(negm); } } \
    SBAR(); \
    VRD(3); SBAR(); KRD(GL, 2); GAPB(o[0] = MFMAH(PAF(0), VFR(0), o[0]), C0, 0);  VRD(7); SBAR(); KRD(GL, 3); GAPB(o[1] = MFMAH(PAF(0), VFR(4), o[1]), C0, 4);     \
    KRD(GL, 4); GAPB(o[0] = MFMAH(PAF(1), VFR(1), o[0]), C0, 8);  KRD(GL, 5); GAPB(o[1] = MFMAH(PAF(1), VFR(5), o[1]), C0, 12); \
    GAPB(o[0] = MFMAH(PAF(2), VFR(2), o[0]), C1, 0);              GAPB(o[1] = MFMAH(PAF(2), VFR(6), o[1]), C1, 4); \
    GAPB(o[0] = MFMAH(PAF(3), VFR(3), o[0]), C1, 8);              GAPB(o[1] = MFMAH(PAF(3), VFR(7), o[1]), C1, 12); \
    } while (0)
  int t = 1;
  for (; t + 5 < NT; t += 2) {
    STEP(pB0, pB1, pA0, pA1, t, false, true, true, true);     WAITB(3, 2); RESC(); ROT();
    STEP(pA0, pA1, pB0, pB1, t + 1, false, true, true, true); WAITB(3, 2); RESC(); ROT();
  }
#define ENDW(tt) do { if ((tt) + 3 < NT) { WAITB(3, 2); } else if ((tt) + 2 < NT) { WAITB(1, 1); } else { WAITB(0, 0); } } while (0)
  for (; t + 1 < NT; t += 2) {
    STEP(pB0, pB1, pA0, pA1, t, true, (t + 3 < NT), (t + 1 < NT), (t + 1 < NT));         ENDW(t);     RESC(); ROT();
    STEP(pA0, pA1, pB0, pB1, t + 1, true, (t + 4 < NT), (t + 2 < NT), (t + 2 < NT));     ENDW(t + 1); RESC(); ROT();
  }
  STEP(pB0, pB1, pA0, pA1, NT - 1, true, false, false, false); RESC();
  { float sacc = pB0[0] + pB0[1];
#pragma unroll
    for (int r = 2; r < 16; ++r) sacc += pB0[r];
#pragma unroll
    for (int r = 0; r < 16; ++r) sacc += pB1[r];
    l_reg += sacc;
    pw0 = (u32x4){PKW(pB0, 0), PKW(pB0, 2), PKW(pB0, 4), PKW(pB0, 6)}; pw1 = (u32x4){PKW(pB0, 8), PKW(pB0, 10), PKW(pB0, 12), PKW(pB0, 14)};
    pw2 = (u32x4){PKW(pB1, 0), PKW(pB1, 2), PKW(pB1, 4), PKW(pB1, 6)}; pw3 = (u32x4){PKW(pB1, 8), PKW(pB1, 10), PKW(pB1, 12), PKW(pB1, 14)};
    const lds_cptr vp_ = vp0 + s_cur * VT_BYTES;
#pragma unroll
    for (int i = 0; i < 8; ++i) VRD(i);
    o[0] = MFMAH(PAF(0), VFR(0), o[0]); o[1] = MFMAH(PAF(0), VFR(4), o[1]); o[0] = MFMAH(PAF(1), VFR(1), o[0]); o[1] = MFMAH(PAF(1), VFR(5), o[1]);
    o[0] = MFMAH(PAF(2), VFR(2), o[0]); o[1] = MFMAH(PAF(2), VFR(6), o[1]); o[0] = MFMAH(PAF(3), VFR(3), o[0]); o[1] = MFMAH(PAF(3), VFR(7), o[1]); }
  { auto rr = __builtin_amdgcn_permlane32_swap(__float_as_uint(l_reg), __float_as_uint(l_reg), false, false); l_reg = __uint_as_float(rr[0]) + __uint_as_float(rr[1]); }
  if (hi == 0) li_l[r32] = l_reg; asm volatile("s_waitcnt lgkmcnt(0)" ::: "memory");
  float rli[16];
#pragma unroll
  for (int r = 0; r < 16; ++r) rli[r] = __builtin_amdgcn_rcpf(li_l[crow(r, hi)]);
  if (z_cnt && wid == 0) { unsigned sp = 0;
    while (__hip_atomic_load(z_cnt, __ATOMIC_RELAXED, __HIP_MEMORY_SCOPE_AGENT) < 2u) { __builtin_amdgcn_s_sleep(2); if (++sp > (1u << 22)) { if (lane == 0) __hip_atomic_store(tmo, 1u, __ATOMIC_RELAXED, __HIP_MEMORY_SCOPE_AGENT); break; } }
    __builtin_amdgcn_fence(__ATOMIC_ACQUIRE, "agent"); asm volatile("s_waitcnt vmcnt(0)" ::: "memory"); }
  unsigned nxt_ = 0u; if (next_qword >= 0 && tid == 0) nxt_ = __hip_atomic_fetch_add(tmo + next_qword + 64 * (blockIdx.x & 7u), 1u, __ATOMIC_RELAXED, __HIP_MEMORY_SCOPE_AGENT);
  asm volatile("s_waitcnt lgkmcnt(0)\n\ts_barrier" ::: "memory");
  const long orow0 = rowbase + q0 + wid * QBLK;
  { unsigned short* stg = (unsigned short*)(lds + LDS_OST) + wid * 2048;
#pragma unroll
    for (int r = 0; r < 16; ++r) { const int orow = crow(r, hi);
#pragma unroll
      for (int d0 = 0; d0 < 2; ++d0) stg[orow * 64 + d0 * 32 + r32] = __builtin_bit_cast(unsigned short, (_Float16)(o[d0][r] * rli[r])); }
    asm volatile("s_waitcnt lgkmcnt(0)" ::: "memory");
#pragma unroll
    for (int i = 0; i < 4; ++i) { const int row = i * 8 + (lane >> 3), ch = lane & 7; const long grow = orow0 + row;
      const u32x4 ov = *(const u32x4*)(stg + row * 64 + ch * 8); const u32x4 zv = __builtin_nontemporal_load((const u32x4*)(PROJ + grow * ldp + zcol0 + h * 64 + ch * 8));
      u32x4 w;
      w.x = gate2(ov.x, zv.x); w.y = gate2(ov.y, zv.y); w.z = gate2(ov.z, zv.z); w.w = gate2(ov.w, zv.w);
      store16_wt(YCAT + grow * 1024 + 512 + h * 64 + ch * 8, w); } }
  if (next_qword >= 0 && tid == 0) *(volatile __attribute__((address_space(3))) unsigned*)(lds3 + next_slot_off) = nxt_;
  asm volatile("s_waitcnt vmcnt(0) lgkmcnt(0)\n\ts_barrier" ::: "memory");
  if (tid == 0) __hip_atomic_fetch_add(done_cnt, 1u, __ATOMIC_RELAXED, __HIP_MEMORY_SCOPE_AGENT);
#undef GLDS
#undef DMA_K
#undef DMA_V
#undef WAITB
#undef ROT
#undef RESC
#undef PKW
#undef PAF
#undef VFR
#undef VRD
#undef KRD
#undef GAPA
#undef GAPA3
#undef GAPB
#undef STEP
#undef ENDW
}
#undef PIN
#undef MFMAH
#undef MX3
#undef SBAR
}

#define GAS __attribute__((address_space(1)))
#define LAS __attribute__((address_space(3)))
typedef unsigned v4u __attribute__((ext_vector_type(4)));
typedef float f32x4 __attribute__((ext_vector_type(4)));
typedef short bf16x8 __attribute__((ext_vector_type(8)));
typedef GAS unsigned gu32;
typedef GAS unsigned long long gu64;
#define RLX_AGENT __ATOMIC_RELAXED, __HIP_MEMORY_SCOPE_AGENT
#define LDS_WAIT() asm volatile("s_waitcnt lgkmcnt(0)" ::: "memory")
#define VM_WAIT() asm volatile("s_waitcnt vmcnt(0)" ::: "memory")
__device__ __forceinline__ unsigned long long rt() { return __builtin_amdgcn_s_memrealtime(); }

#define XB_TMO      128
#define XB_XCNT(j)  (256  + 64 * (j))
#define XB_XSUB(j)  (1280 + 64 * (j))
#define XB_XGEN(j)  (2304 + 64 * (j))
#define XB_TOP      3328
#define XB_TOPGEN   3392
#define XCD_BAR_WORDS 3456
#define XB_SPIN_CAP (1u << 18)

__device__ __forceinline__ unsigned xb_ld(unsigned* p)              { return __hip_atomic_load(p, __ATOMIC_RELAXED, __HIP_MEMORY_SCOPE_AGENT); }
__device__ __forceinline__ unsigned xb_add(unsigned* p, unsigned v) { return __hip_atomic_fetch_add(p, v, __ATOMIC_RELAXED, __HIP_MEMORY_SCOPE_AGENT); }
__device__ __forceinline__ unsigned xb_xcc_id() { return (unsigned)__builtin_amdgcn_s_getreg((3 << 11) | 20) & 0xFu; }
#define XB_SPIN(cond, bar) do { unsigned _sp = 0; while (cond) { __builtin_amdgcn_s_sleep(1); \
    if ((++_sp & 255u) == 0u) { if (xb_ld(&(bar)[XB_TMO])) break; if (_sp > XB_SPIN_CAP) { atomicAdd(&(bar)[XB_TMO], 1u); break; } } } } while (0)

struct XcdBarrier {
    unsigned* bar; unsigned x;
    volatile LAS unsigned* st;
};

__device__ __forceinline__ XcdBarrier xcd_barrier_post(unsigned* bar, volatile LAS unsigned* st) {
    XcdBarrier b; b.bar = bar; b.x = xb_xcc_id(); b.st = st;
    if (threadIdx.x == 0) (void)xb_add(&bar[XB_XCNT(b.x)], 1u);
    return b;
}
__device__ __forceinline__ void xcd_barrier_complete(unsigned* bar, unsigned x, unsigned& nloc, unsigned& nx) {
    const unsigned G = gridDim.x * gridDim.y * gridDim.z;
    unsigned sum, cnt, mine, sp = 0u;
    for (;;) {
        sum = 0u; cnt = 0u; mine = 0u;
#pragma unroll
        for (unsigned j = 0; j < 16; ++j) { const unsigned c = xb_ld(&bar[XB_XCNT(j)]); sum += c; cnt += (c > 0u) ? 1u : 0u; mine = (j == x) ? c : mine; }
        if (sum == G) break;
        __builtin_amdgcn_s_sleep(1);
        if ((++sp & 255u) == 0u) { if (xb_ld(&bar[XB_TMO])) break; if (sp > XB_SPIN_CAP) { atomicAdd(&bar[XB_TMO], 1u); break; } }
    }
    nloc = mine > 0u ? mine : 1u; nx = cnt > 0u ? cnt : 1u;
}

__device__ __forceinline__ void xcd_barrier(const XcdBarrier& b) {
    asm volatile("s_waitcnt vmcnt(0)" ::: "memory");
    __syncthreads();
    if (threadIdx.x == 0) {
        unsigned* bar = b.bar;
        __builtin_amdgcn_s_waitcnt(0);
        unsigned nloc = b.st[0], nx = b.st[1];
        if (nloc == 0u) { xcd_barrier_complete(bar, b.x, nloc, nx); b.st[0] = nloc; b.st[1] = nx; }
        const unsigned old = xb_add(&bar[XB_XSUB(b.x)], 1u);
        const unsigned gen = old / nloc;
        if (old + 1u == (gen + 1u) * nloc) {
            __builtin_amdgcn_fence(__ATOMIC_RELEASE, "agent");
            asm volatile("s_waitcnt vmcnt(0)" ::: "memory");
            const unsigned og = xb_add(&bar[XB_TOP], 1u);
            const unsigned tg = og / nx;
            if (og + 1u == (tg + 1u) * nx) xb_add(&bar[XB_TOPGEN], 1u);
            else XB_SPIN(xb_ld(&bar[XB_TOPGEN]) == tg, bar);
            __builtin_amdgcn_fence(__ATOMIC_ACQUIRE, "agent");
            xb_add(&bar[XB_XGEN(b.x)], 1u);
            asm volatile("s_waitcnt vmcnt(0)" ::: "memory");
        } else {
            XB_SPIN(xb_ld(&bar[XB_XGEN(b.x)]) == gen, bar);
            __builtin_amdgcn_fence(__ATOMIC_ACQUIRE, "agent");
            asm volatile("s_waitcnt vmcnt(0)" ::: "memory");
        }
    }
    __syncthreads();
}

constexpr int NWAVES = 8;
constexpr int NPHASE = 4;
constexpr int CW_RDV = 98304;
constexpr int CW_TMO = 0, CW_CODE = 1, CW_MODC = 64, CW_OUTQ = 2048, CW_CHAIN = 81920, CW_ATTQ = 1024, CW_PANEL = 65536, CW_OUTP = 73728, CW_BAR = 4096;
constexpr int RING_OFF = 0, RING_BYTES = 131072;
constexpr int LDSCTL_OFF = RING_BYTES, MISC_OFF = LDSCTL_OFF + 320;
constexpr int SACT_OFF = LDSCTL_OFF + 1024;
constexpr int LDS_BYTES = 147456;
static_assert(MISC_OFF + 128 <= SACT_OFF && SACT_OFF + 8192 + 1024 <= LDS_BYTES, "LDS map");
static_assert(att::LDS_ATT2 <= RING_BYTES && pg8::STAGE_BYTES <= RING_BYTES, "phase scratch fits the ring");

struct Frame {
    LAS unsigned char* lds;
    volatile LAS unsigned* MISC;
    gu32* ctl;
    int tid, lane, wave, vcu, G;
};
__device__ __forceinline__ float wave_sum(float v) {
#pragma unroll
    for (int o = 1; o < 64; o <<= 1) v += __shfl_xor(v, o);
    return v;
}
__device__ __forceinline__ unsigned pk2h(float lo, float hi) { return pg8::cvt_pk_h(lo, hi); }

__device__ __forceinline__ void p0_transpose_item(const float* W, int ldw, int K, int src_n0, bf16* WT, int dst_row0, int k0, LAS float* scr, int lane, const float* gk = nullptr) {
    float t_[32];
#pragma unroll
    for (int i = 0; i < 32; ++i) t_[i] = __builtin_nontemporal_load(W + (size_t)(k0 + 2 * i + (lane >> 5)) * ldw + src_n0 + (lane & 31));
#pragma unroll
    for (int i = 0; i < 32; ++i) scr[(2 * i + (lane >> 5)) * 33 + (lane & 31)] = t_[i];
    LDS_WAIT(); asm volatile("" ::: "memory");
    const int c = lane & 7;
#pragma unroll
    for (int j = 0; j < 4; ++j) { const int n = (lane >> 3) + 8 * j; const LAS float* s = scr + (8 * c) * 33 + n;
        f32x4 g0 = {1.f, 1.f, 1.f, 1.f}, g1 = g0; if (gk) { g0 = *(const f32x4*)(gk + k0 + 8 * c); g1 = *(const f32x4*)(gk + k0 + 8 * c + 4); }
        v4u o; o.x = pk2h(s[0 * 33] * g0.x, s[1 * 33] * g0.y); o.y = pk2h(s[2 * 33] * g0.z, s[3 * 33] * g0.w); o.z = pk2h(s[4 * 33] * g1.x, s[5 * 33] * g1.y); o.w = pk2h(s[6 * 33] * g1.z, s[7 * 33] * g1.w);
        *(GAS v4u*)(WT + (size_t)(dst_row0 + n) * K + k0 + 8 * c) = o; }
    LDS_WAIT(); asm volatile("" ::: "memory");
}

struct Args {
    const float* in[24]; float* out; unsigned char* ws; int ph_lo, ph_hi, li, pad;
};

__device__ __forceinline__ void p0_mod_block(const LAS float* sact, LAS float* part, const float* w_ada, const float* b_ada, float* mod, gu32* cnt, int j, int wave, int lane) {
    const int kk = lane >> 2, c4 = lane & 3, col = 16 * j + 4 * c4;
    f32x4 w[8];
#pragma unroll
    for (int s = 0; s < 8; ++s) w[s] = __builtin_nontemporal_load((const GAS f32x4*)(w_ada + (size_t)(128 * wave + kk + 16 * s) * 3072 + col));
    f32x4 a0 = {0.f, 0.f, 0.f, 0.f}, a1 = {0.f, 0.f, 0.f, 0.f};
#pragma unroll
    for (int s = 0; s < 8; ++s) { const int k = 128 * wave + kk + 16 * s; a0 += w[s] * sact[k]; a1 += w[s] * sact[1024 + k]; }
#pragma unroll
    for (int o = 4; o < 64; o <<= 1) {
#pragma unroll
        for (int e = 0; e < 4; ++e) { a0[e] += __shfl_xor(a0[e], o); a1[e] += __shfl_xor(a1[e], o); } }
    if (lane < 4) {
#pragma unroll
        for (int e = 0; e < 4; ++e) { part[wave * 32 + 4 * c4 + e] = a0[e]; part[wave * 32 + 16 + 4 * c4 + e] = a1[e]; } }
    __syncthreads();
    if (wave == 0) {
        if (lane < 32) { float t = b_ada[16 * j + (lane & 15)];
#pragma unroll
            for (int ww = 0; ww < 8; ++ww) t += part[ww * 32 + lane];
            __hip_atomic_store((GAS float*)(mod + (lane >> 4) * 3072 + 16 * j + (lane & 15)), t, RLX_AGENT); }
        asm volatile("s_waitcnt vmcnt(0)" ::: "memory");
        if (lane == 0) __hip_atomic_fetch_add(cnt, 1u, RLX_AGENT);
    }
    __syncthreads();
}
__device__ __forceinline__ void cis_reduced(double ang, float& c, float& s) {
    const double TWO_PI = 6.283185307179586476925286766559;
    const float r = (float)(ang - TWO_PI * rint(ang / TWO_PI)); c = cosf(r); s = sinf(r);
}
__device__ __forceinline__ void ssm_pow(float lr, float li, float dtf, int n, float& pr, float& pi) {
    float c, s_; cis_reduced((double)n * (double)li * (double)dtf, c, s_); const float e = expf((float)n * lr * dtf); pr = e * c; pi = e * s_;
}
__device__ __forceinline__ void p0_ssm_item(const float* log_dt, const float* lam_re, const float* lam_im, float* AC, int g, int lane) {
    const float dtf = expf(log_dt[g]); const float lr = lam_re[g * 64 + lane], li = lam_im[g * 64 + lane];
    float a0, a1, a2, a3; ssm_pow(lr, li, dtf, 1, a0, a1); ssm_pow(lr, li, dtf, 16, a2, a3); const f32x4 v = {a0, a1, a2, a3};
    *(f32x4*)(AC + ((size_t)g * 64 + lane) * 4) = v;
}
__device__ __forceinline__ void ssm_coef_pow(const float* log_dt, const float* lam_re, const float* lam_im, int g, int lane, int n, float& cr, float& ci) {
    const float dtf = expf(log_dt[g]); const float lr = lam_re[g * 64 + lane], li = lam_im[g * 64 + lane];
    float ar, ai, pr, pi; ssm_pow(lr, li, dtf, 1, ar, ai); ssm_pow(lr, li, dtf, n, pr, pi);
    const float nr = ar - 1.f, ni = ai, den = lr * lr + li * li;
    const float kr = (nr * lr + ni * li) / den, ki = (ni * lr - nr * li) / den;
    cr = kr * pr - ki * pi; ci = kr * pi + ki * pr;
}
__device__ __forceinline__ void p0_ssm_K_item(const float* log_dt, const float* lam_re, const float* lam_im, const float* b_re, const float* b_im, const float* c_re, const float* c_im,
                                              bf16* TQ, int g, int d, LAS float* scr, int lane) {
    float cr, ci; ssm_coef_pow(log_dt, lam_re, lam_im, g, lane, d, cr, ci);
#pragma unroll
    for (int j = 0; j < 16; ++j) { const float br = b_re[(g * 64 + lane) * 16 + j], bi = b_im[(g * 64 + lane) * 16 + j];
        scr[(lane * 16 + j) * 2] = cr * br - ci * bi; scr[(lane * 16 + j) * 2 + 1] = cr * bi + ci * br; }
    LAS float* cl = scr + 2048;
#pragma unroll
    for (int q = 0; q < 16; ++q) { cl[(q * 64 + lane) * 2] = c_re[(g * 16 + q) * 64 + lane]; cl[(q * 64 + lane) * 2 + 1] = c_im[(g * 16 + q) * 64 + lane]; }
    LDS_WAIT(); asm volatile("" ::: "memory");
    const int i = lane & 15, jq = lane >> 4; float acc[4] = {0.f, 0.f, 0.f, 0.f};
#pragma unroll 8
    for (int p = 0; p < 64; ++p) { const float xr = cl[(i * 64 + p) * 2], xi = cl[(i * 64 + p) * 2 + 1];
#pragma unroll
        for (int e = 0; e < 4; ++e) acc[e] += xr * scr[(p * 16 + 4 * jq + e) * 2] - xi * scr[(p * 16 + 4 * jq + e) * 2 + 1]; }
    const unsigned long long kv = (unsigned long long)pk2h(acc[0], acc[1]) | ((unsigned long long)pk2h(acc[2], acc[3]) << 32);
    bf16* base = TQ + (size_t)g * 256 * 384;
    for (int t = d; t < 16; ++t) *(GAS unsigned long long*)(base + (size_t)(t * 16 + i) * 384 + (t - d) * 16 + 4 * jq) = kv;
    if (d > 0) for (int t = 0; t + d < 16; ++t) *(GAS unsigned long long*)(base + (size_t)(t * 16 + i) * 384 + (t + d) * 16 + 4 * jq) = 0ull;
    LDS_WAIT(); asm volatile("" ::: "memory");
}
__device__ __forceinline__ void p0_ssm_Q_item(const float* log_dt, const float* lam_re, const float* lam_im, const float* c_re, const float* c_im, bf16* TQ, int g, int t, int lane) {
    const float dtf = expf(log_dt[g]); float pr, pi; ssm_pow(lam_re[g * 64 + lane], lam_im[g * 64 + lane], dtf, t + 1, pr, pi);
#pragma unroll
    for (int i = 0; i < 16; ++i) { const float xr = c_re[(g * 16 + i) * 64 + lane], xi = c_im[(g * 16 + i) * 64 + lane];
        *(GAS unsigned*)(TQ + ((size_t)g * 256 + t * 16 + i) * 384 + 256 + 2 * lane) = pk2h(xr * pr - xi * pi, -(xr * pi + xi * pr)); }
}
__device__ __forceinline__ void p0_ssm_P_item(const float* log_dt, const float* lam_re, const float* lam_im, const float* b_re, const float* b_im, bf16* PP, int g, int s_, int lane) {
    float cr, ci; ssm_coef_pow(log_dt, lam_re, lam_im, g, lane, 15 - s_, cr, ci);
    float wr[16], wi[16];
#pragma unroll
    for (int j = 0; j < 16; ++j) { const float br = b_re[(g * 64 + lane) * 16 + j], bi = b_im[(g * 64 + lane) * 16 + j]; wr[j] = cr * br - ci * bi; wi[j] = cr * bi + ci * br; }
    bf16* r0 = PP + ((size_t)g * 256 + 2 * lane) * 256 + s_ * 16;
    v4u o; o.x = pk2h(wr[0], wr[1]); o.y = pk2h(wr[2], wr[3]); o.z = pk2h(wr[4], wr[5]); o.w = pk2h(wr[6], wr[7]); *(GAS v4u*)r0 = o;
    o.x = pk2h(wr[8], wr[9]); o.y = pk2h(wr[10], wr[11]); o.z = pk2h(wr[12], wr[13]); o.w = pk2h(wr[14], wr[15]); *(GAS v4u*)(r0 + 8) = o;
    o.x = pk2h(wi[0], wi[1]); o.y = pk2h(wi[2], wi[3]); o.z = pk2h(wi[4], wi[5]); o.w = pk2h(wi[6], wi[7]); *(GAS v4u*)(r0 + 256) = o;
    o.x = pk2h(wi[8], wi[9]); o.y = pk2h(wi[10], wi[11]); o.z = pk2h(wi[12], wi[13]); o.w = pk2h(wi[14], wi[15]); *(GAS v4u*)(r0 + 256 + 8) = o;
}

__global__ void __launch_bounds__(NWAVES * 64, 2) mega_fwd(Args args) {
    extern __shared__ __attribute__((aligned(16))) unsigned char lds[];
    Frame F;
    F.lds = (LAS unsigned char*)lds;
    F.MISC = (volatile LAS unsigned*)(F.lds + MISC_OFF);
    F.tid = threadIdx.x; F.lane = F.tid & 63; F.wave = __builtin_amdgcn_readfirstlane(F.tid >> 6);
    F.G = gridDim.x; { const int bx = blockIdx.x; F.vcu = (F.G % 8 == 0) ? (bx % 8) * (F.G / 8) + bx / 8 : bx; }
    unsigned char* ws = args.ws;
    F.ctl = (gu32*)(ws + WS_CTL);
    const float* x = args.in[0]; const float* cvec = args.in[1]; const int* positions = (const int*)args.in[2];
    const float* w_ada = args.in[3]; const float* b_ada = args.in[4]; const float* norm_g = args.in[5]; const float* w_in = args.in[6];
    const float* log_dt = args.in[7]; const float* lam_re = args.in[8]; const float* lam_im = args.in[9]; const float* b_re = args.in[10]; const float* b_im = args.in[11];
    const float* c_re = args.in[12]; const float* c_im = args.in[13]; const float* d_skip = args.in[14]; const float* w_glu = args.in[15]; const float* b_glu = args.in[16];
    const float* q_a_g = args.in[17]; const float* w_q_b = args.in[18]; const float* kv_a_g = args.in[19]; const float* w_kv_b = args.in[20];
    const float* q_norm_g = args.in[21]; const float* k_norm_g = args.in[22]; const float* w_out = args.in[23];
    float* MOD = (float*)(ws + WS_MOD); float* AC = (float*)(ws + WS_AC); bf16* BB = (bf16*)(ws + WS_BB); bf16* CB = (bf16*)(ws + WS_CB); float* EST = (float*)(ws + WS_E);
    bf16* WIN_T = (bf16*)(ws + WS_WIN); bf16* WQ_T = (bf16*)(ws + WS_WQ); bf16* WKV_T = (bf16*)(ws + WS_WKV); bf16* WGLU_T = (bf16*)(ws + WS_WGLU); bf16* WOUT_T = (bf16*)(ws + WS_WOUT);
    bf16* PROJ = (bf16*)(ws + WS_PROJ); bf16* HB = (bf16*)(ws + WS_HB); bf16* QRAW = (bf16*)(ws + WS_HB); bf16* YCAT = (bf16*)(ws + WS_YCAT); bf16* ZM = (bf16*)(ws + WS_ZM);
    bf16* KVRAW = (bf16*)(ws + WS_KVRAW); bf16* Qb = (bf16*)(ws + WS_Q); bf16* Kb = (bf16*)(ws + WS_K); bf16* Vb = (bf16*)(ws + WS_V);
    bf16* CQN = (bf16*)(ws + WS_CQN); bf16* CKVN = (bf16*)(ws + WS_CKVN); bf16* YPRE = (bf16*)(ws + WS_YPRE);
    float* RS = (float*)(ws + WS_RS); float* ROPE = (float*)(ws + WS_ROPE); bf16* USG = (bf16*)(ws + WS_USG); bf16* TQ = (bf16*)(ws + WS_TQ); bf16* PPM = (bf16*)(ws + WS_PP); float* HAND = (float*)(ws + WS_HAND); (void)BB; (void)CB; (void)EST; (void)CQN; (void)CKVN; (void)QRAW; (void)KVRAW;

    for (int u = F.tid; u < (LDS_BYTES - LDSCTL_OFF) / 4; u += NWAVES * 64) ((LAS unsigned*)(F.lds + LDSCTL_OFF))[u] = 0u;
    __syncthreads();
    const int lo = args.ph_lo, hi = args.ph_hi;
    const bool multi = (hi - lo) > 1;
    XcdBarrier bar; bar.bar = (unsigned*)(F.ctl + CW_BAR) + args.li * XCD_BAR_WORDS; bar.x = 0; bar.st = nullptr;
    if (multi) bar = xcd_barrier_post((unsigned*)(F.ctl + CW_BAR) + args.li * XCD_BAR_WORDS, F.MISC + 8);
#define IN(k) (lo <= (k) && (k) < hi)
#define SEAM(k) do { if (IN(k) && IN((k) + 1)) xcd_barrier(bar); } while (0)
    const int gw = F.vcu * NWAVES + F.wave, NGW = F.G * NWAVES;

    if (IN(0)) {
        LAS float* scr = (LAS float*)(F.lds + RING_OFF + F.wave * 16384);
        constexpr int I_MOD = 192, I_SSM = 32;
        constexpr int T_U = 256, T_ZS = 256, T_ZM = 256, T_CKV = 128, T_CQ = 192, T_KR = 16, T_WQ = 144, T_WKV = 128, T_WGLU = 128, T_WOUT = 512;
        constexpr int I_TR = T_U + T_ZS + T_ZM + T_CKV + T_CQ + T_KR + T_WQ + T_WKV + T_WGLU + T_WOUT;
        constexpr int I_Z1 = 96, I_Z2 = 256;
        constexpr int NITEMS = I_MOD + I_SSM + I_TR + I_Z1 + I_Z2;
        { LAS float* sact = (LAS float*)(F.lds + SACT_OFF); LAS float* part = (LAS float*)(F.lds + SACT_OFF + 8192);
          for (int e = F.tid; e < 2048; e += NWAVES * 64) { const float cv = cvec[e]; sact[e] = cv / (1.f + __expf(-cv)); }
          __syncthreads();
          for (int r = (int)blockIdx.x; r < I_MOD; r += F.G) p0_mod_block(sact, part, w_ada, b_ada, MOD, F.ctl + CW_MODC, r, F.wave, F.lane); }
        for (int it = I_MOD + gw; it < NITEMS; it += NGW) {
            int r = it - I_MOD;
            if (r < I_SSM) { p0_ssm_item(log_dt, lam_re, lam_im, AC, r, F.lane); continue; } r -= I_SSM;
            if (r < I_TR) {
                if (r < T_U)   { p0_transpose_item(w_in, D_IN, 1024, SC_U + 32 * (r % 16), WIN_T, 0 + 32 * (r % 16), 64 * (r / 16), scr, F.lane); continue; } r -= T_U;
                if (r < T_ZS)  { p0_transpose_item(w_in, D_IN, 1024, SC_ZS + 32 * (r % 16), WIN_T, 512 + 32 * (r % 16), 64 * (r / 16), scr, F.lane); continue; } r -= T_ZS;
                if (r < T_ZM)  { p0_transpose_item(w_in, D_IN, 1024, SC_ZM + 32 * (r % 16), WIN_T, WR_ZM + 32 * (r % 16), 64 * (r / 16), scr, F.lane); continue; } r -= T_ZM;
                if (r < T_CKV) { p0_transpose_item(w_in, D_IN, 1024, SC_CKV + 32 * (r % 8), WIN_T, 1024 + 32 * (r % 8), 64 * (r / 8), scr, F.lane); continue; } r -= T_CKV;
                if (r < T_CQ)  { p0_transpose_item(w_in, D_IN, 1024, SC_CQ + 32 * (r % 12), WIN_T, 1280 + 32 * (r % 12), 64 * (r / 12), scr, F.lane); continue; } r -= T_CQ;
                if (r < T_KR)  { p0_transpose_item(w_in, D_IN, 1024, SC_KR, WIN_T, GC_KR, 64 * r, scr, F.lane); continue; } r -= T_KR;
                if (r < T_WQ)  { const int nb = r % 24, kb = r / 24, n0 = 32 * nb;
                                 p0_transpose_item(w_q_b, 768, 384, n0, WQ_T, (n0 / 96) * 128 + (n0 % 96), 64 * kb, scr, F.lane, q_a_g); continue; } r -= T_WQ;
                if (r < T_WKV) { p0_transpose_item(w_kv_b, 1024, 256, 32 * (r % 32), WKV_T, 32 * (r % 32), 64 * (r / 32), scr, F.lane, kv_a_g); continue; } r -= T_WKV;
                if (r < T_WGLU){ p0_transpose_item(w_glu, 512, 512, 32 * (r % 16), WGLU_T, 32 * (r % 16), 64 * (r / 16), scr, F.lane); continue; } r -= T_WGLU;
                p0_transpose_item(w_out, 1024, 1024, 32 * (r % 32), WOUT_T, 32 * (r % 32), 64 * (r / 32), scr, F.lane); continue;
            }
            r -= I_TR;
            const v4u z = {0u, 0u, 0u, 0u};
            if (r < I_Z1) { GAS v4u* p = (GAS v4u*)(WIN_T + (size_t)(GC_KR + 32 + r) * 1024); p[F.lane] = z; p[64 + F.lane] = z; continue; } r -= I_Z1;
            { const int hh = r / 32, rr = r % 32; GAS v4u* p = (GAS v4u*)(WQ_T + (size_t)(hh * 128 + 96 + rr) * 384); if (F.lane < 48) p[F.lane] = z; }
        }
        f32x4 v0[4], v1[4], v2[4];
#define LDROW(dst, mm) do { const GAS f32x4* xr_ = (const GAS f32x4*)(x + (size_t)(mm) * DM) + F.lane; _Pragma("unroll") for (int j = 0; j < 4; ++j) dst[j] = __builtin_nontemporal_load(xr_ + 64 * j); } while (0)
        if (gw < M) LDROW(v0, gw);
        if (gw + NGW < M) LDROW(v1, gw + NGW);
        __syncthreads();
        if (F.wave == 0) { unsigned sp = 0;
            while (__hip_atomic_load(F.ctl + CW_MODC, RLX_AGENT) < 192u) { __builtin_amdgcn_s_sleep(2); if (++sp > (1u << 22)) { if (F.lane == 0) __hip_atomic_store(F.ctl + CW_TMO, 1u, RLX_AGENT); break; } }
            __builtin_amdgcn_fence(__ATOMIC_ACQUIRE, "agent"); asm volatile("s_waitcnt vmcnt(0)" ::: "memory"); }
        __syncthreads();
        { f32x4 PA[4], PB[4]; int curb = -1;
          const float ifq = (float)exp(-(double)(F.lane & 15) / 16.0 * 9.210340371976184);
          for (int m = gw; m < M; m += NGW) {
            if (m + 2 * NGW < M) LDROW(v2, m + 2 * NGW);
            const int b = m / SEQ;
            if (b != curb) { curb = b;
#pragma unroll
                for (int j = 0; j < 4; ++j) { const int e = 4 * F.lane + 256 * j;
                    const f32x4 g4 = *(const f32x4*)(norm_g + e), sc = *(const f32x4*)(MOD + b * 3072 + 1024 + e); PB[j] = *(const f32x4*)(MOD + b * 3072 + e); PA[j] = g4 * (sc + 1.f); } }
            if (F.lane < 16) { const double TWO_PI = 6.283185307179586476925286766559;
                const float ang = (float)positions[m] * ifq; const float kq = rintf(ang * 0.15915494309189535f);
                const float rr = fmaf(-kq, 0.0019353071795864769f, fmaf(-kq, 6.28125f, ang)); (void)TWO_PI;
                typedef float f32x2_ __attribute__((ext_vector_type(2))); *(f32x2_*)(ROPE + ((size_t)m * 16 + F.lane) * 2) = (f32x2_){__cosf(rr), __sinf(rr)}; }
            float s = 0.f;
#pragma unroll
            for (int j = 0; j < 4; ++j) s += (v0[j].x * v0[j].x + v0[j].y * v0[j].y) + (v0[j].z * v0[j].z + v0[j].w * v0[j].w);
            const float rstd = 1.f / sqrtf(wave_sum(s) * (1.f / DM) + EPS);
            GAS unsigned long long* o8 = (GAS unsigned long long*)(HB + (size_t)m * DM) + F.lane;
#pragma unroll
            for (int j = 0; j < 4; ++j) { const f32x4 hv = v0[j] * rstd * PA[j] + PB[j];
                o8[64 * j] = (unsigned long long)pk2h(hv.x, hv.y) | ((unsigned long long)pk2h(hv.z, hv.w) << 32); }
#pragma unroll
            for (int j = 0; j < 4; ++j) { v0[j] = v1[j]; v1[j] = v2[j]; }
          }
#undef LDROW
        }
    }
    SEAM(0);

    if (IN(1)) {
        pg8::Gemm g{HB, WIN_T, M, NPROJ, 1024, 1024}; pg8::StaticOrder S; S.init(M, NPROJ, F.G, (int)blockIdx.x);
        pg8::EpiProj E{PROJ, LDP, RS, 4, USG, SEQ};
        pg8::gemm_phase<pg8::EpiProj, pg8::StaticOrder, true, true>(F.lds + RING_OFF, g, S, E);
        if (F.G == 256 ? blockIdx.x >= 192 : true) { __syncthreads();
            LAS float* scr = (LAS float*)(F.lds + RING_OFF + F.wave * 16384);
            const int nw = (F.G == 256) ? 512 : NGW, w0 = (F.G == 256) ? ((int)blockIdx.x - 192) * NWAVES + F.wave : gw;
            for (int it = w0; it < 512 * 3 + 256; it += nw) { int r = it;
                if (r < 512) { p0_ssm_K_item(log_dt, lam_re, lam_im, b_re, b_im, c_re, c_im, TQ, r >> 4, r & 15, scr, F.lane); continue; } r -= 512;
                if (r < 512) { p0_ssm_Q_item(log_dt, lam_re, lam_im, c_re, c_im, TQ, r >> 4, r & 15, F.lane); continue; } r -= 512;
                if (r < 512) { p0_ssm_P_item(log_dt, lam_re, lam_im, b_re, b_im, PPM, r >> 4, r & 15, F.lane); continue; } r -= 512;
                { const v4u z0 = {0u, 0u, 0u, 0u}; GAS v4u* pz = (GAS v4u*)(PPM + ((size_t)(r >> 3) * 256 + 128 + (r & 7) * 16) * 256);
#pragma unroll
                  for (int q = 0; q < 8; ++q) pz[F.lane + 64 * q] = z0; } } }
    }
    SEAM(1);

    if (IN(2)) {
        { const pg8::MlaAux AUX{RS, ROPE, PROJ, LDP, PC_KR};
          if (F.G == 256) {
            { pg8::Gemm g{PROJ + PC_CQ, WQ_T, M, 1024, Q_LORA, LDP}; pg8::StaticOrder S; S.init(M, 1024, F.G, (int)blockIdx.x);
              pg8::EpiQ E{AUX, q_norm_g, Qb, 0.10206207261596575f * 1.4426950408889634f, EPS, SEQ};
              pg8::gemm_phase<pg8::EpiQ, pg8::StaticOrder, false, true>(F.lds + RING_OFF, g, S, E); }
            __syncthreads();
            { pg8::Gemm g{PROJ + PC_CKV, WKV_T, M, 1024, KV_LORA, LDP}; pg8::StaticOrder S; S.init(M, 1024, F.G, (int)blockIdx.x);
              pg8::EpiKV E{AUX, k_norm_g, Kb, Vb, EPS, SEQ};
              pg8::gemm_phase<pg8::EpiKV, pg8::StaticOrder, false, true>(F.lds + RING_OFF, g, S, E); }
          } else if (F.tid == 0) __hip_atomic_store(F.ctl + CW_TMO, 1u, RLX_AGENT);
        }
        __syncthreads();
        { pg8::Gemm g{USG, PPM, 32768, 8192, 256, 384}; pg8::DiagOrder S{128, 4, F.G, (int)blockIdx.x, nullptr, 0u, nullptr};
          pg8::EpiELds E{};
          if (F.G >= 128) { pg8::gemm_phase<pg8::EpiELds, pg8::DiagOrder, false, true>(F.lds + RING_OFF, g, S, E);
              pg8::Unit u; const bool has = S.next(0, u);
              __syncthreads();
              if (has && F.wave == 0) pg8::ssm_chain_unit(u, F.lds + RING_OFF, USG, AC, HAND, (unsigned*)(F.ctl + CW_CHAIN), (unsigned*)(F.ctl + CW_TMO), F.lane);
              __syncthreads(); }
          else if (F.tid == 0) __hip_atomic_store(F.ctl + CW_TMO, 1u, RLX_AGENT); }
        { pg8::Gemm g{HB, WIN_T + (size_t)WR_ZM * 1024, M, 512, 1024, 1024}; pg8::StaticOrder S; S.init(M, 512, F.G, (int)((blockIdx.x + 128u) % (unsigned)F.G));
          pg8::EpiH16 E{ZM, 512};
          pg8::gemm_phase<pg8::EpiH16, pg8::StaticOrder, true, true>(F.lds + RING_OFF, g, S, E); }
    }
    SEAM(2);

    if (IN(3)) {
        { pg8::Gemm g{USG, TQ, 32768, 8192, 384, 384}; pg8::DiagOrder S{128, 4, F.G, (int)blockIdx.x, nullptr, 0u, nullptr};
          pg8::EpiY E{USG, d_skip, YPRE, SEQ};
          pg8::gemm_phase<pg8::EpiY, pg8::DiagOrder, true, true>(F.lds + RING_OFF, g, S, E);
          if (F.tid == 0) { pg8::Unit u; for (int i = 0; S.next(i, u); ++i) { const int k4 = u.pm & 3;
              for (int q = 0; q < 16; ++q) __hip_atomic_fetch_add(F.ctl + CW_PANEL + 64 * ((k4 >> 1) * 32 + (k4 & 1) * 16 + q), 1u, RLX_AGENT); } } }
        __syncthreads();
        __syncthreads();
#define RUN_GLU_UNITS() do { \
        { pg8::Gemm g{YPRE, WGLU_T, M, 512, 512, 512}; pg8::PanelOrder S; S.init(M, 512, F.G, (int)((blockIdx.x + 128u) % (unsigned)F.G)); S.cnt = (unsigned*)(F.ctl + CW_PANEL); S.want = 32u; S.tmo = (unsigned*)(F.ctl + CW_TMO); \
          pg8::EpiGlu E{YPRE, PROJ, LDP, PC_ZS, b_glu, YCAT}; \
          pg8::gemm_phase<pg8::EpiGlu, pg8::PanelOrder, true, true>(F.lds + RING_OFF, g, S, E); \
          if (F.tid == 0) { pg8::Unit u; for (int i = 0; S.next(i, u); ++i) __hip_atomic_fetch_add(F.ctl + CW_OUTP + 64 * u.pm, 1u, RLX_AGENT); } } \
        __syncthreads(); } while (0)
#define OUT_UNIT_OF(k, uu) do { const int pk_ = (k) >> 2; (uu).pm = (pk_ & 1) * 32 + (24 - 8 * (pk_ >> 1)) + j; (uu).pn = (k) & 3; } while (0)
#define RUN_OUT_UNIT(uu) do { if (F.tid < 64) { __builtin_amdgcn_fence(__ATOMIC_ACQUIRE, "agent"); asm volatile("s_waitcnt vmcnt(0)" ::: "memory"); } __syncthreads(); \
            pg8::Gemm g_{YCAT, WOUT_T, M, 1024, 1024, 1024}; pg8::OneUnit S_; S_.u = (uu); pg8::EpiOutRows E_{x, MOD + 2048, 3072, SEQ, args.out}; \
            pg8::gemm_phase<pg8::EpiOutRows, pg8::OneUnit, false, true>(F.lds + RING_OFF, g_, S_, E_); __syncthreads(); } while (0)
        const int j = (int)(blockIdx.x & 7); bool glu_done = false;
        bool popped = false;
        for (;;) {
            if (!popped && F.tid == 0) F.MISC[16] = __hip_atomic_fetch_add(F.ctl + CW_ATTQ + 64 * j, 1u, RLX_AGENT);
            __syncthreads();
            const unsigned ua = (unsigned)__builtin_amdgcn_readfirstlane((int)F.MISC[16]);
            __syncthreads();
            if (ua >= 64u) break;
            const int bh = 2 * j + (int)(ua & 1u), qb = 31 - (int)(ua >> 1);
            const bool early = glu_done || ((blockIdx.x + 128u) % (unsigned)F.G) >= 128u;
            att::attn_unit(bh >> 3, bh & 7, qb, Qb, Kb, Vb, ZM, 512, 0, YCAT, (char*)lds + RING_OFF, F.lds + RING_OFF, (unsigned*)(F.ctl + CW_OUTP + 64 * ((bh >> 3) * 32 + qb)), nullptr, (unsigned*)(F.ctl + CW_TMO), early ? CW_ATTQ - CW_TMO : -1, MISC_OFF - RING_OFF + 16 * 4);
            popped = early;
            if (!glu_done) { glu_done = true; RUN_GLU_UNITS(); }
            if (F.tid == 0) { unsigned k = __hip_atomic_load(F.ctl + CW_OUTQ + 64 * j, RLX_AGENT), got = 0xffffffffu;
                if (MK_CLAIM_BETWEEN && k < 32u) { pg8::Unit t; OUT_UNIT_OF((int)k, t);
                    if (__hip_atomic_load(F.ctl + CW_OUTP + 64 * t.pm, RLX_AGENT) >= 10u) { unsigned e = k;
                        if (__hip_atomic_compare_exchange_strong(F.ctl + CW_OUTQ + 64 * j, &e, k + 1u, __ATOMIC_RELAXED, __ATOMIC_RELAXED, __HIP_MEMORY_SCOPE_AGENT)) got = k; } }
                F.MISC[17] = got; }
            __syncthreads();
            const unsigned ko = (unsigned)__builtin_amdgcn_readfirstlane((int)F.MISC[17]);
            __syncthreads();
            if (ko != 0xffffffffu) { pg8::Unit uo; OUT_UNIT_OF((int)ko, uo); RUN_OUT_UNIT(uo); }
        }
        if (!glu_done) { glu_done = true; RUN_GLU_UNITS(); }
        for (;;) {
            if (F.tid == 0) F.MISC[17] = __hip_atomic_fetch_add(F.ctl + CW_OUTQ + 64 * j, 1u, RLX_AGENT);
            __syncthreads();
            const unsigned ko = (unsigned)__builtin_amdgcn_readfirstlane((int)F.MISC[17]);
            __syncthreads();
            if (ko >= 32u) break;
            pg8::Unit uo; OUT_UNIT_OF((int)ko, uo);
            if (F.tid < 64) { unsigned sp = 0;
                while (__hip_atomic_load(F.ctl + CW_OUTP + 64 * uo.pm, RLX_AGENT) < 10u) { __builtin_amdgcn_s_sleep(4);
                    if (++sp > (1u << 22)) { if (F.tid == 0) __hip_atomic_store(F.ctl + CW_TMO, 1u, RLX_AGENT); break; } }
                if (F.tid == 0) __hip_atomic_fetch_add(F.ctl + CW_RDV + 64 * uo.pm, 1u, RLX_AGENT);
                sp = 0; while (__hip_atomic_load(F.ctl + CW_RDV + 64 * uo.pm, RLX_AGENT) < 4u && ++sp < 20000u) __builtin_amdgcn_s_sleep(2); }
            RUN_OUT_UNIT(uo);
        }
#undef OUT_UNIT_OF
#undef RUN_GLU_UNITS
#undef RUN_OUT_UNIT
    }
#undef IN
#undef SEAM
}

#ifndef MK_MODE
#define MK_MODE 2
#endif
#ifndef MK_FAST_MASK
#define MK_FAST_MASK 0x7
#endif
extern "C" void kernel_launch(void* const* d_in, const int* in_sizes, int n_in, void* d_out, int out_size, void* d_ws, size_t ws_size, hipStream_t stream) {
    static int grid = 0;
    if (grid == 0) {
        if (n_in != 24 || in_sizes[0] != M * DM || out_size != M * DM || ws_size < WS_END) { fprintf(stderr, "kernel_launch: unexpected shapes (n_in %d, in0 %d, out %d, ws %zu)\n", n_in, n_in > 0 ? in_sizes[0] : -1, out_size, ws_size); grid = -1; return; }
        int dev = 0, cus = 0, per_cu = 0;
        if (hipGetDevice(&dev) != hipSuccess || hipDeviceGetAttribute(&cus, hipDeviceAttributeMultiprocessorCount, dev) != hipSuccess) { fprintf(stderr, "kernel_launch: device query failed\n"); grid = -1; return; }
        if (hipFuncSetAttribute((const void*)mega_fwd, hipFuncAttributeMaxDynamicSharedMemorySize, LDS_BYTES) != hipSuccess) { fprintf(stderr, "kernel_launch: hipFuncSetAttribute failed\n"); grid = -1; return; }
        if (hipOccupancyMaxActiveBlocksPerMultiprocessor(&per_cu, (const void*)mega_fwd, NWAVES * 64, LDS_BYTES) != hipSuccess || per_cu < 1)
            fprintf(stderr, "kernel_launch: note: occupancy query reports %d workgroups per CU\n", per_cu);
        (void)hipGetLastError();
        grid = cus;
    }
    if (grid < 0) return;
    const float* x = (const float*)d_in[0]; const float* c = (const float*)d_in[1]; const int* positions = (const int*)d_in[2];
    const float* w_ada = (const float*)d_in[3]; const float* b_ada = (const float*)d_in[4]; const float* norm_g = (const float*)d_in[5];
    const float* w_in = (const float*)d_in[6]; const float* log_dt = (const float*)d_in[7]; const float* lam_re = (const float*)d_in[8];
    const float* lam_im = (const float*)d_in[9]; const float* b_re = (const float*)d_in[10]; const float* b_im = (const float*)d_in[11];
    const float* c_re = (const float*)d_in[12]; const float* c_im = (const float*)d_in[13]; const float* d_skip = (const float*)d_in[14];
    const float* w_glu = (const float*)d_in[15]; const float* b_glu = (const float*)d_in[16]; const float* q_a_g = (const float*)d_in[17];
    const float* w_q_b = (const float*)d_in[18]; const float* kv_a_g = (const float*)d_in[19]; const float* w_kv_b = (const float*)d_in[20];
    const float* q_norm_g = (const float*)d_in[21]; const float* k_norm_g = (const float*)d_in[22]; const float* w_out = (const float*)d_in[23];
    unsigned char* ws = (unsigned char*)d_ws; float* out = (float*)d_out;
    float* MOD = (float*)(ws + WS_MOD); bf16* PROJ = (bf16*)(ws + WS_PROJ); bf16* HB = (bf16*)(ws + WS_HB); bf16* QRAW = (bf16*)(ws + WS_HB); bf16* YCAT = (bf16*)(ws + WS_YCAT); bf16* ZM = (bf16*)(ws + WS_ZM);
    bf16* KVRAW = (bf16*)(ws + WS_KVRAW); bf16* Qb = (bf16*)(ws + WS_Q); bf16* Kb = (bf16*)(ws + WS_K); bf16* Vb = (bf16*)(ws + WS_V);
    bf16* CQN = (bf16*)(ws + WS_CQN); bf16* CKVN = (bf16*)(ws + WS_CKVN); bf16* YPRE = (bf16*)(ws + WS_YPRE);
    (void)x; (void)c; (void)positions; (void)w_ada; (void)b_ada; (void)norm_g; (void)w_in; (void)log_dt; (void)lam_re; (void)lam_im; (void)b_re; (void)b_im; (void)c_re; (void)c_im; (void)d_skip;
    (void)w_glu; (void)b_glu; (void)q_a_g; (void)w_q_b; (void)kv_a_g; (void)w_kv_b; (void)q_norm_g; (void)k_norm_g; (void)w_out; (void)MOD; (void)PROJ; (void)HB; (void)QRAW; (void)YCAT;
    (void)KVRAW; (void)Qb; (void)Kb; (void)Vb; (void)CQN; (void)CKVN; (void)YPRE; (void)out;

    Args a{}; int n_mega = 0;
    for (int i = 0; i < 24; ++i) a.in[i] = (const float*)d_in[i];
    a.out = out; a.ws = ws;
#define MEGA(lo_, hi_) do { a.ph_lo = (lo_); a.ph_hi = (hi_); a.li = n_mega++; hipLaunchKernelGGL(mega_fwd, dim3(grid), dim3(NWAVES * 64), LDS_BYTES, stream, a); } while (0)
#if MK_MODE == 2
    if (hipMemsetAsync(ws + WS_CTL, 0, CTL_ZERO_BYTES, stream) != hipSuccess) { fprintf(stderr, "kernel_launch: memset failed\n"); return; }
#if MK_DOUBLE >= 0
    MEGA(0, MK_DOUBLE + 1); MEGA(MK_DOUBLE, NPHASE);
#else
    MEGA(0, NPHASE);
#endif
#else
    const unsigned fast = (MK_MODE == 0) ? 0u : (unsigned)MK_FAST_MASK;
    (void)hipMemsetAsync(ws + WS_CTL, 0, CTL_ZERO_BYTES, stream);
    if (MK_MODE != 0) MEGA(0, 1);
    if (!(fast & 1u)) { hipLaunchKernelGGL(v0_mod, dim3(24), dim3(256), 0, stream, c, w_ada, b_ada, MOD); hipLaunchKernelGGL(v0_h, dim3(M), dim3(256), 0, stream, x, norm_g, MOD, HB); }
    if (fast & 2u) MEGA(1, 2); else {
        const int seg[5][3] = {{PC_U, SC_U, 512}, {PC_ZS, SC_ZS, 512}, {PC_CKV, SC_CKV, 256}, {PC_CQ, SC_CQ, 384}, {PC_KR, SC_KR, 32}};
        for (int s = 1; s < 5; ++s) hipLaunchKernelGGL(v0_gemm, dim3(M), dim3(256), 1024 * 4, stream, HB, 1024, 1024, w_in, D_IN, seg[s][1], PROJ, LDP, seg[s][0], seg[s][2]);
        hipLaunchKernelGGL(v0_usg, dim3(M), dim3(256), 1024 * 4, stream, HB, w_in, D_IN, (bf16*)(ws + WS_USG));
        hipLaunchKernelGGL(v0_gemm, dim3(M), dim3(256), 1024 * 4, stream, HB, 1024, 1024, w_in, D_IN, SC_ZM, ZM, 512, 0, 512); }
    if (fast & 4u) { MEGA(2, 3); MEGA(3, 4); }
    else { hipLaunchKernelGGL(v0_cqn, dim3(M), dim3(256), 0, stream, PROJ, q_a_g, kv_a_g, CQN, CKVN);
        for (int h = 0; h < NH; ++h) hipLaunchKernelGGL(v0_gemm, dim3(M), dim3(128), 384 * 4, stream, CQN, 384, 384, w_q_b, 768, h * 96, QRAW, 1024, h * 128, 96);
        hipLaunchKernelGGL(v0_gemm, dim3(M), dim3(256), 256 * 4, stream, CKVN, 256, 256, w_kv_b, 1024, 0, KVRAW, 1024, 0, 1024);
        hipLaunchKernelGGL(v0_qkv, dim3(M * NH * 2 / 256), dim3(256), 0, stream, QRAW, KVRAW, PROJ, positions, q_norm_g, k_norm_g, Qb, Kb, Vb);
        hipLaunchKernelGGL(v0_ssm, dim3(BATCH * SSM_G), dim3(64), 0, stream, (bf16*)(ws + WS_USG), log_dt, lam_re, lam_im, b_re, b_im, c_re, c_im, d_skip, YPRE);
        hipLaunchKernelGGL(v0_attn, dim3(BATCH * NH * (SEQ / 256)), dim3(256), 0, stream, Qb, Kb, Vb, ZM, YCAT);
        hipLaunchKernelGGL(v0_glu, dim3(M), dim3(256), 0, stream, YPRE, w_glu, b_glu, PROJ, YCAT);
        hipLaunchKernelGGL(v0_out, dim3(M), dim3(256), 0, stream, YCAT, w_out, x, MOD, out); }
#endif
    const hipError_t le = hipPeekAtLastError();
    if (le != hipSuccess) fprintf(stderr, "kernel_launch: launch failed: %s\n", hipGetErrorName(le));
}
```

```cpp
#include <hip/hip_runtime.h>
#include <cstdio>
#include <cstdint>
#ifndef MK_CLAIM_BETWEEN
#define MK_CLAIM_BETWEEN 0
#endif
#ifndef MK_DOUBLE
#define MK_DOUBLE (-1)
#endif

constexpr int BATCH = 2, SEQ = 8192, DM = 1024, M = BATCH * SEQ;
constexpr int SSM_W = 512, SSM_G = 32, SSM_GC = 16, SSM_P = 64;
constexpr int NH = 8, QK_NOPE = 64, QK_ROPE = 32, QK_HEAD = 96, V_HEAD = 64, MLA_W = 512, Q_LORA = 384, KV_LORA = 256;
constexpr int D_IN = 2208;
constexpr float EPS = 1e-6f;
constexpr int NPROJ = 1792;
constexpr int LDP = 1280;
constexpr int PC_U = 0, PC_ZS = 0, PC_CKV = 512, PC_CQ = 768, PC_KR = 1152;
constexpr int GC_KR = 1664;
constexpr int WR_ZM = 1792;
constexpr int SC_U = 0, SC_ZS = 512, SC_CQ = 1024, SC_CKV = 1408, SC_KR = 1664, SC_ZM = 1696;

constexpr size_t MiB = 1u << 20;
constexpr size_t WS_CTL = 0, CTL_ZERO_BYTES = 1 * MiB;
constexpr size_t WS_MOD = 1 * MiB;
constexpr size_t WS_AC = 1 * MiB + 64 * 1024;
constexpr size_t WS_BB = 1 * MiB + 128 * 1024;
constexpr size_t WS_CB = 1 * MiB + 256 * 1024;
constexpr size_t WS_E = 2 * MiB;
constexpr size_t WS_WIN = 4 * MiB;
constexpr size_t WS_WQ = 9 * MiB;
constexpr size_t WS_WKV = 10 * MiB;
constexpr size_t WS_WGLU = 11 * MiB;
constexpr size_t WS_WOUT = 12 * MiB;
constexpr size_t WS_PROJ = 16 * MiB;
constexpr size_t WS_USG = 56 * MiB;
constexpr size_t WS_ZM = 80 * MiB;
constexpr size_t WS_HB = 96 * MiB;
constexpr size_t WS_YCAT = 128 * MiB;
constexpr size_t WS_KVRAW = 128 * MiB;
constexpr size_t WS_Q = 160 * MiB;
constexpr size_t WS_CQN = 160 * MiB;
constexpr size_t WS_CKVN = 172 * MiB;
constexpr size_t WS_K = 184 * MiB;
constexpr size_t WS_V = 208 * MiB;
constexpr size_t WS_YPRE = 224 * MiB;
constexpr size_t WS_TQ = 240 * MiB;
constexpr size_t WS_PP = 246 * MiB;
constexpr size_t WS_ROPE = 250 * MiB;
constexpr size_t WS_HAND = 252 * MiB;
constexpr size_t WS_RS = 14 * MiB;
constexpr size_t WS_END = 253 * MiB;

typedef unsigned short bf16;
__device__ __forceinline__ unsigned f2bf(float f) { return (unsigned)__builtin_bit_cast(unsigned short, (_Float16)f); }
__device__ __forceinline__ float bf2f(bf16 b) { return (float)__builtin_bit_cast(_Float16, b); }
__device__ __forceinline__ float silu_f(float v) { return v / (1.f + __expf(-v)); }
__device__ __forceinline__ float sigmoid_f(float v) { return 1.f / (1.f + __expf(-v)); }
__device__ __forceinline__ float gelu_tanh(float v) { const float z = 0.7978845608028654f * (v + 0.044715f * v * v * v); return v / (1.f + __expf(-2.f * z)); }

__device__ __forceinline__ float block_sum_256(float v, float* red) {
    for (int o = 32; o > 0; o >>= 1) v += __shfl_xor(v, o);
    const int w = threadIdx.x >> 6;
    __syncthreads();
    if ((threadIdx.x & 63) == 0) red[w] = v;
    __syncthreads();
    float s = 0.f; for (int i = 0; i < (int)(blockDim.x >> 6); ++i) s += red[i];
    return s;
}

__global__ void v0_mod(const float* c, const float* w_ada, const float* b_ada, float* mod) {
    const int idx = blockIdx.x * blockDim.x + threadIdx.x; if (idx >= BATCH * 3 * DM) return;
    const int b = idx / (3 * DM), n = idx % (3 * DM);
    float acc = b_ada[n];
    for (int k = 0; k < DM; ++k) acc += silu_f(c[b * DM + k]) * w_ada[(size_t)k * 3 * DM + n];
    mod[idx] = acc;
}
__global__ void v0_h(const float* x, const float* norm_g, const float* mod, bf16* hb) {
    __shared__ float red[8];
    const int m = blockIdx.x, b = m / SEQ, t = threadIdx.x;
    float v[4], ss = 0.f;
    for (int j = 0; j < 4; ++j) { v[j] = x[(size_t)m * DM + t + 256 * j]; ss += v[j] * v[j]; }
    ss = block_sum_256(ss, red);
    const float rstd = 1.f / sqrtf(ss / DM + EPS);
    for (int j = 0; j < 4; ++j) { const int e = t + 256 * j;
        const float hv = v[j] * rstd * norm_g[e] * (1.f + mod[b * 3 * DM + DM + e]) + mod[b * 3 * DM + e];
        hb[(size_t)m * DM + e] = (bf16)f2bf(hv); }
}
__global__ void v0_gemm(const bf16* A, int lda, int K, const float* W, int ldw, int src0, bf16* C, int ldc, int dst0, int width) {
    extern __shared__ float arow[];
    const int m = blockIdx.x;
    for (int k = threadIdx.x; k < K; k += blockDim.x) arow[k] = bf2f(A[(size_t)m * lda + k]);
    __syncthreads();
    for (int j = threadIdx.x; j < width; j += blockDim.x) {
        float acc = 0.f;
        for (int k = 0; k < K; ++k) acc += arow[k] * W[(size_t)k * ldw + src0 + j];
        C[(size_t)m * ldc + dst0 + j] = (bf16)f2bf(acc);
    }
}
__global__ void v0_usg(const bf16* A, const float* W, int ldw, bf16* USG) {
    extern __shared__ float arow[];
    const int m = blockIdx.x, b = m / SEQ, t = m % SEQ;
    for (int k = threadIdx.x; k < 1024; k += blockDim.x) arow[k] = bf2f(A[(size_t)m * 1024 + k]);
    __syncthreads();
    for (int c = threadIdx.x; c < 512; c += blockDim.x) { float acc = 0.f;
        for (int k = 0; k < 1024; ++k) acc += arow[k] * W[(size_t)k * ldw + c];
        USG[((size_t)(c >> 4) * 1024 + b * 512 + (t >> 4)) * 384 + (t & 15) * 16 + (c & 15)] = (bf16)f2bf(acc); }
}
__global__ void v0_cqn(const bf16* proj, const float* q_a_g, const float* kv_a_g, bf16* cqn, bf16* ckvn) {
    __shared__ float red[8];
    const int m = blockIdx.x, t = threadIdx.x;
    float a = 0.f, b2 = 0.f, ss = 0.f;
    if (t < 192) { a = bf2f(proj[(size_t)m * LDP + PC_CQ + t]); b2 = bf2f(proj[(size_t)m * LDP + PC_CQ + 192 + t]); ss = a * a + b2 * b2; }
    ss = block_sum_256(ss, red);
    float rstd = 1.f / sqrtf(ss / Q_LORA + EPS);
    if (t < 192) { cqn[(size_t)m * Q_LORA + t] = (bf16)f2bf(a * rstd * q_a_g[t]); cqn[(size_t)m * Q_LORA + 192 + t] = (bf16)f2bf(b2 * rstd * q_a_g[192 + t]); }
    const float cv = bf2f(proj[(size_t)m * LDP + PC_CKV + t]);
    ss = block_sum_256(cv * cv, red);
    rstd = 1.f / sqrtf(ss / KV_LORA + EPS);
    ckvn[(size_t)m * KV_LORA + t] = (bf16)f2bf(cv * rstd * kv_a_g[t]);
}
__device__ __forceinline__ int v0_vst(int k, int c) { const int kk = (k & ~0xC) | ((k & 4) << 1) | ((k & 8) >> 1); return ((kk >> 3) * 2 + (c >> 5)) * 512 + ((kk & 7) * 32 + (c & 31)) * 2; }
__global__ void __launch_bounds__(256) v0_qkv(const bf16* qraw, const bf16* kvraw, const bf16* proj, const int* positions, const float* q_norm_g, const float* k_norm_g, bf16* Q, bf16* K, bf16* V) {
    const int idx = blockIdx.x * blockDim.x + threadIdx.x; if (idx >= M * NH * 2) return;
    const int which = idx & 1, m = (idx >> 1) / NH, h = (idx >> 1) % NH;
    const float pos = (float)positions[m];
    const float* gn = which ? k_norm_g : q_norm_g;
    float q[96];
    float sq = 0.f;
    if (which == 0) {
#pragma unroll
        for (int d = 0; d < 96; ++d) q[d] = bf2f(qraw[(size_t)m * 1024 + h * 128 + d]);
    } else {
#pragma unroll
        for (int d = 0; d < 64; ++d) q[d] = bf2f(kvraw[(size_t)m * 1024 + h * 128 + d]);
#pragma unroll
        for (int d = 0; d < 32; ++d) q[64 + d] = bf2f(proj[(size_t)m * LDP + PC_KR + d]);
    }
#pragma unroll
    for (int d = 0; d < 96; ++d) sq += q[d] * q[d];
    const float rq = 1.f / sqrtf(sq / 96.f + EPS);
#pragma unroll
    for (int d = 0; d < 96; ++d) q[d] = q[d] * rq * gn[d];
#pragma unroll
    for (int i = 0; i < 16; ++i) {
        const float inv_freq = (float)pow(10000.0, -(double)i / 16.0);
        const float ang = pos * inv_freq;
        const double TWO_PI = 6.283185307179586476925286766559;
        const double r = (double)ang - TWO_PI * rint((double)ang / TWO_PI);
        const float rf = (float)r; const float cs = __cosf(rf), sn = __sinf(rf);
        const float q1 = q[64 + i], q2 = q[80 + i]; q[64 + i] = q1 * cs - q2 * sn; q[80 + i] = q2 * cs + q1 * sn;
    }
    if (which == 0) {
#pragma unroll
        for (int d = 0; d < 96; ++d) Q[(size_t)m * 768 + h * 96 + d] = (bf16)f2bf(q[d] * (0.10206207261596575f * 1.4426950408889634f));
    } else {
        const int bb = m / SEQ, tt = m % SEQ; const size_t tix = (size_t)(bb * 8 + h) * 128 + (tt >> 6); const int row = tt & 63;
#pragma unroll
        for (int d = 0; d < 96; ++d) K[tix * 6144 + (d >> 3) * 512 + row * 8 + (d & 7)] = (bf16)f2bf(q[d]);
        for (int d = 0; d < 64; ++d) V[tix * 4096 + v0_vst(row, d) / 2] = kvraw[(size_t)m * 1024 + h * 128 + 64 + d];
    }
}
__global__ void __launch_bounds__(64) v0_ssm(const bf16* proj, const float* log_dt, const float* lam_re, const float* lam_im, const float* b_re, const float* b_im,
                       const float* c_re, const float* c_im, const float* d_skip, bf16* ypre) {
    __shared__ float sre[64], sim[64], us[16];
    const int b = blockIdx.x / SSM_G, g = blockIdx.x % SSM_G, p = threadIdx.x;
    const double dt = exp((double)log_dt[g]);
    const double lr = lam_re[g * 64 + p], li = lam_im[g * 64 + p];
    const double er = exp(lr * dt), ar = er * cos(li * dt), ai = er * sin(li * dt);
    const double nr = ar - 1.0, ni = ai, den = lr * lr + li * li;
    const double cr = (nr * lr + ni * li) / den, ci = (ni * lr - nr * li) / den;
    float Br[16], Bi[16];
#pragma unroll
    for (int j = 0; j < 16; ++j) { const double br = b_re[(g * 64 + p) * 16 + j], bi = b_im[(g * 64 + p) * 16 + j];
        Br[j] = (float)(cr * br - ci * bi); Bi[j] = (float)(cr * bi + ci * br); }
    const float far = (float)ar, fai = (float)ai;
    float s_r = 0.f, s_i = 0.f;
    const float dsk = p < 16 ? d_skip[g * 16 + p] : 0.f;
    for (int t = 0; t < SEQ; ++t) {
        const size_t row = (size_t)(b * SEQ + t);
        if (p < 16) us[p] = bf2f(proj[((size_t)g * 1024 + b * 512 + (t >> 4)) * 384 + (t & 15) * 16 + p]);
        __syncthreads();
        float bur = 0.f, bui = 0.f;
#pragma unroll
        for (int j = 0; j < 16; ++j) { bur += Br[j] * us[j]; bui += Bi[j] * us[j]; }
        const float nr2 = far * s_r - fai * s_i + bur, ni2 = far * s_i + fai * s_r + bui;
        s_r = nr2; s_i = ni2; sre[p] = s_r; sim[p] = s_i;
        __syncthreads();
        if (p < 16) {
            float y = 0.f;
            for (int q = 0; q < 64; ++q) y += c_re[(g * 16 + p) * 64 + q] * sre[q] - c_im[(g * 16 + p) * 64 + q] * sim[q];
            y += dsk * us[p];
            ypre[row * SSM_W + g * 16 + p] = (bf16)f2bf(gelu_tanh(y));
        }
        __syncthreads();
    }
}
__global__ void __launch_bounds__(256) v0_attn(const bf16* Q, const bf16* K, const bf16* V, const bf16* zm, bf16* ycat) {
    const int qb = blockIdx.x % (SEQ / 256), bh = blockIdx.x / (SEQ / 256), b = bh / NH, h = bh % NH;
    const int qi = qb * 256 + threadIdx.x;
    const size_t qrow = (size_t)b * SEQ + qi;
    float q[96], o[64];
    const float sc = 0.10206207261596575f;
#pragma unroll
    for (int d = 0; d < 96; ++d) q[d] = bf2f(Q[qrow * 768 + h * 96 + d]) * sc;
#pragma unroll
    for (int d = 0; d < 64; ++d) o[d] = 0.f;
    float mx = -1e30f, l = 0.f;
    const int jmax = qb * 256 + 255;
    for (int j = 0; j <= jmax; ++j) {
        const size_t tix = (size_t)(b * 8 + h) * 128 + (j >> 6); const int jr = j & 63;
        const bf16* kp = K + tix * 6144 + jr * 8; const bf16* vp = V + tix * 4096;
        float s = 0.f;
#pragma unroll
        for (int d = 0; d < 96; ++d) s += q[d] * bf2f(kp[(d >> 3) * 512 + (d & 7)]);
        if (j <= qi) {
            const float mn = fmaxf(mx, s); const float al = exp2f(mx - mn), pp = exp2f(s - mn);
            l = l * al + pp;
#pragma unroll
            for (int d = 0; d < 64; ++d) o[d] = o[d] * al + pp * bf2f(vp[v0_vst(jr, d) / 2]);
            mx = mn;
        }
    }
    const float rl = 1.f / l;
#pragma unroll
    for (int d = 0; d < 64; ++d) {
        const float z = bf2f(zm[qrow * 512 + h * 64 + d]);
        ycat[qrow * 1024 + 512 + h * 64 + d] = (bf16)f2bf(o[d] * rl * silu_f(z));
    }
}
__global__ void v0_glu(const bf16* ypre, const float* w_glu, const float* b_glu, const bf16* proj, bf16* ycat) {
    __shared__ float arow[512];
    const int m = blockIdx.x;
    for (int k = threadIdx.x; k < 512; k += blockDim.x) arow[k] = bf2f(ypre[(size_t)m * 512 + k]);
    __syncthreads();
    for (int j = threadIdx.x; j < 512; j += blockDim.x) {
        float acc = b_glu[j];
        for (int k = 0; k < 512; ++k) acc += arow[k] * w_glu[(size_t)k * 512 + j];
        const float z = bf2f(proj[(size_t)m * LDP + PC_ZS + j]);
        ycat[(size_t)m * 1024 + j] = (bf16)f2bf(arow[j] * sigmoid_f(acc) * silu_f(z));
    }
}
__global__ void v0_out(const bf16* ycat, const float* w_out, const float* x, const float* mod, float* out) {
    __shared__ float arow[1024];
    const int m = blockIdx.x, b = m / SEQ;
    for (int k = threadIdx.x; k < 1024; k += blockDim.x) arow[k] = bf2f(ycat[(size_t)m * 1024 + k]);
    __syncthreads();
    for (int j = threadIdx.x; j < 1024; j += blockDim.x) {
        float acc = 0.f;
        for (int k = 0; k < 1024; ++k) acc += arow[k] * w_out[(size_t)k * 1024 + j];
        out[(size_t)m * DM + j] = x[(size_t)m * DM + j] + mod[b * 3 * DM + 2 * DM + j] * acc;
    }
}


typedef unsigned wt_u32x4 __attribute__((ext_vector_type(4)));
__device__ __forceinline__ void store16_wt(void* p, wt_u32x4 v) { asm volatile("global_store_dwordx4 %0, %1, off sc1\n\ts_nop 1" :: "v"(p), "v"(v) : "memory"); }

namespace pg8 {
#define PG8_LAS __attribute__((address_space(3)))
typedef unsigned short bf16_t;
typedef _Float16 bf16x8 __attribute__((ext_vector_type(8)));
typedef float f32x4 __attribute__((ext_vector_type(4)));
typedef unsigned u32x4 __attribute__((ext_vector_type(4)));
constexpr int BM = 256, BK = 64, HALF = 128, HTB = HALF * BK * 2  , STAGE_BYTES = 8 * HTB, NXCD = 8, WGM = 8;

__host__ __device__ __forceinline__ int lds_byte(int r, int c) { const int st = (r >> 4) * 2 + (c >> 5), rr = r & 15, cc = c & 31, ob = rr * 64 + cc * 2; return st * 1024 + (ob ^ (((ob >> 9) & 1) << 5)); }
__host__ __device__ __forceinline__ void stage_rc(int b, int& R, int& C) { const int st = b / 1024, sb = b % 1024, swz = sb ^ (((sb >> 9) & 1) << 5); R = (st >> 1) * 16 + swz / 64; C = (st & 1) * 32 + (swz % 64) / 2; }
__host__ __device__ __forceinline__ int perm32(int rho) { const int n = rho >> 4, i = rho & 15; return 8 * (i >> 2) + 4 * n + (i & 3); }

struct Unit { int pm, pn; };
struct Gemm { const bf16_t* A; const bf16_t* Bt; int M, N, K, lda; };

struct StaticOrder {
    int nM, nN, nwg, G, c;
    __host__ __device__ void init(int M, int N, int G_, int c_) { nM = M / BM; nN = N / BM; nwg = nM * nN; G = G_; c = c_; }
    __host__ __device__ bool next(int i, Unit& u) const {
        const long L = (long)i * G + c; if (L >= nwg) return false;
        int wgid = (int)L; { const int q = nwg / NXCD, r = nwg % NXCD, xcd = wgid % NXCD, off = wgid / NXCD; wgid = (xcd < r ? xcd * (q + 1) : r * (q + 1) + (xcd - r) * q) + off; }
        const int nig = WGM * nN, gid = wgid / nig, fm = gid * WGM, gsz = (nM - fm) < WGM ? (nM - fm) : WGM;
        u.pm = fm + ((wgid % nig) % gsz); u.pn = (wgid % nig) / gsz; return true;
    }
    __device__ __forceinline__ void a_ready(const Unit&) const {}
    __device__ __forceinline__ void done(const Unit&) const {}
};


struct DiagOrder {
    int nunits, per, G, c; unsigned* cnt; unsigned want; unsigned* tmo;
    __device__ __forceinline__ bool next(int i, Unit& u) const { const int L = i * G + c; if (L >= nunits) return false; u.pm = L; u.pn = L / per; return true; }
    __device__ __forceinline__ void a_ready(const Unit& u) const {
        if (!cnt) return;
        if (threadIdx.x < 64) { unsigned sp = 0;
            while (__hip_atomic_load(cnt + 64 * u.pm, __ATOMIC_RELAXED, __HIP_MEMORY_SCOPE_AGENT) < want) { __builtin_amdgcn_s_sleep(2);
                if (++sp > (1u << 22)) { if (threadIdx.x == 0) __hip_atomic_store(tmo, 1u, __ATOMIC_RELAXED, __HIP_MEMORY_SCOPE_AGENT); break; } }
            __builtin_amdgcn_fence(__ATOMIC_ACQUIRE, "agent"); asm volatile("s_waitcnt vmcnt(0)" ::: "memory"); }
        __syncthreads();
    }
    __device__ __forceinline__ void done(const Unit&) const {}
};
struct OneUnit { Unit u;
    __device__ __forceinline__ bool next(int i, Unit& x) const { if (i) return false; x = u; return true; }
    __device__ __forceinline__ void a_ready(const Unit&) const {}
    __device__ __forceinline__ void done(const Unit&) const {} };
struct PanelOrder : StaticOrder {
    unsigned* cnt; unsigned want; unsigned* tmo;
    __device__ __forceinline__ void a_ready(const Unit& u) const {
        if (threadIdx.x < 64) { unsigned sp = 0;
            while (__hip_atomic_load(cnt + 64 * u.pm, __ATOMIC_RELAXED, __HIP_MEMORY_SCOPE_AGENT) < want) { __builtin_amdgcn_s_sleep(2);
                if (++sp > (1u << 22)) { if (threadIdx.x == 0) __hip_atomic_store(tmo, 1u, __ATOMIC_RELAXED, __HIP_MEMORY_SCOPE_AGENT); break; } }
            __builtin_amdgcn_fence(__ATOMIC_ACQUIRE, "agent"); asm volatile("s_waitcnt vmcnt(0)" ::: "memory"); }
        __syncthreads();
    }
};

typedef float f32x2 __attribute__((ext_vector_type(2)));
typedef _Float16 f16x2 __attribute__((ext_vector_type(2)));
__device__ __forceinline__ unsigned cvt_pk_h(float lo, float hi) { const f16x2 v = __builtin_convertvector((f32x2){lo, hi}, f16x2); return __builtin_bit_cast(unsigned, v); }
__device__ __forceinline__ float h_lo(unsigned w) { return (float)__builtin_bit_cast(f16x2, w)[0]; }
__device__ __forceinline__ float h_hi(unsigned w) { return (float)__builtin_bit_cast(f16x2, w)[1]; }
__device__ __forceinline__ float fsilu(float v) { return v * __builtin_amdgcn_rcpf(1.f + __builtin_amdgcn_exp2f(-1.4426950408889634f * v)); }
__device__ __forceinline__ float fsigm(float v) { return __builtin_amdgcn_rcpf(1.f + __builtin_amdgcn_exp2f(-1.4426950408889634f * v)); }
__device__ __forceinline__ float fglu3(float y, float t, float z) {
    return y * z * __builtin_amdgcn_rcpf((1.f + __builtin_amdgcn_exp2f(-1.4426950408889634f * t)) * (1.f + __builtin_amdgcn_exp2f(-1.4426950408889634f * z))); }

struct EpiH16 {
    static constexpr bool PERM = true, AFTER_DRAIN = false;
    bf16_t* O; int ldc;
    __device__ __forceinline__ void operator()(const f32x4 (&acc)[2][2][4][2], const Unit& u, int wr, int wc, int fr, int fq) const {
        const int row0 = u.pm * BM + wr * 64 + fr, col0 = u.pn * BM + wc * 32 + 8 * fq;
#pragma unroll
        for (int ai = 0; ai < 2; ++ai)
#pragma unroll
            for (int m = 0; m < 4; ++m) { bf16_t* rowp = O + (size_t)(row0 + ai * HALF + m * 16) * ldc + col0;
#pragma unroll
                for (int bj = 0; bj < 2; ++bj) { const f32x4 v0 = acc[ai][bj][m][0], v1 = acc[ai][bj][m][1];
                    u32x4 w; w.x = cvt_pk_h(v0[0], v0[1]); w.y = cvt_pk_h(v0[2], v0[3]); w.z = cvt_pk_h(v1[0], v1[1]); w.w = cvt_pk_h(v1[2], v1[3]);
                    store16_wt(rowp + bj * HALF, w); } }
    }
};
struct EpiProj {
    static constexpr bool PERM = true, AFTER_DRAIN = false;
    bf16_t* O; int ldc; float* RS; int rs_pn0; bf16_t* USG; int seq;
    __device__ __forceinline__ void operator()(const f32x4 (&acc)[2][2][4][2], const Unit& u, int wr, int wc, int fr, int fq) const {
        const int row0 = u.pm * BM + wr * 64 + fr, col0 = u.pn * BM + wc * 32 + 8 * fq;
#pragma unroll
        for (int ai = 0; ai < 2; ++ai)
#pragma unroll
            for (int m = 0; m < 4; ++m) { const int grow = row0 + ai * HALF + m * 16; bf16_t* rowp = O + (size_t)grow * ldc + col0 - 512;
                const int bb = grow / seq, tt = grow % seq;
#pragma unroll
                for (int bj = 0; bj < 2; ++bj) { const f32x4 v0 = acc[ai][bj][m][0], v1 = acc[ai][bj][m][1];
                    u32x4 w; w.x = cvt_pk_h(v0[0], v0[1]); w.y = cvt_pk_h(v0[2], v0[3]); w.z = cvt_pk_h(v1[0], v1[1]); w.w = cvt_pk_h(v1[2], v1[3]);
                    if (u.pn < 2) { const int c = col0 + bj * HALF;
                        *(u32x4*)(USG + ((size_t)(c >> 4) * 1024 + bb * 512 + (tt >> 4)) * 384 + (tt & 15) * 16 + (c & 15)) = w;
                    }
                    else *(u32x4*)(rowp + bj * HALF) = w; } }
        if (u.pn >= rs_pn0) {
#pragma unroll
            for (int ai = 0; ai < 2; ++ai)
#pragma unroll
                for (int m = 0; m < 4; ++m)
#pragma unroll
                    for (int bj = 0; bj < 2; ++bj) { const f32x4 v0 = acc[ai][bj][m][0], v1 = acc[ai][bj][m][1];
                        float q = (v0[0] * v0[0] + v0[1] * v0[1]) + (v0[2] * v0[2] + v0[3] * v0[3]) + (v1[0] * v1[0] + v1[1] * v1[1]) + (v1[2] * v1[2] + v1[3] * v1[3]);
                        q += __shfl_xor(q, 16); q += __shfl_xor(q, 32);
                        if (fq == 0) RS[((size_t)(row0 + ai * HALF + m * 16) * 3 + (u.pn - rs_pn0)) * 8 + bj * 4 + wc] = q; }
        }
    }
};
struct MlaAux { const float* RS; const float* rope; const bf16_t* proj; int ldp, krcol0; };
constexpr int MLA_TBL = 8192, MLA_ROPE = 12288, MLA_KR = 45056;
__device__ __forceinline__ void mla_stage_rows(const MlaAux& A, const Unit& u, PG8_LAS unsigned char* lds, int tid, bool want_kr, float eps) {
    const size_t row0 = (size_t)u.pm * BM;
    u32x4 rp[4];
#pragma unroll
    for (int j = 0; j < 4; ++j) rp[j] = *(const u32x4*)((const char*)(A.rope + row0 * 32) + (size_t)(tid + 512 * j) * 16);
    u32x4 kr[2] = {{0u, 0u, 0u, 0u}, {0u, 0u, 0u, 0u}};
    if (want_kr) {
#pragma unroll
        for (int j = 0; j < 2; ++j) { const int c = tid + 512 * j; kr[j] = *(const u32x4*)(A.proj + (row0 + (c >> 2)) * A.ldp + A.krcol0 + 8 * (c & 3)); } }
    if (tid < 256) { const float* rs = A.RS + (row0 + tid) * 24;
        const f32x4 s6a = *(const f32x4*)rs, s6b = *(const f32x4*)(rs + 4), s7a = *(const f32x4*)(rs + 8), s7b = *(const f32x4*)(rs + 12), s8a = *(const f32x4*)(rs + 16); const float skr = rs[20];
        const float sq = ((s7a[0] + s7a[1]) + (s7a[2] + s7a[3])) + ((s7b[0] + s7b[1]) + (s7b[2] + s7b[3])) + ((s8a[0] + s8a[1]) + (s8a[2] + s8a[3]));
        const float skv = ((s6a[0] + s6a[1]) + (s6a[2] + s6a[3])) + ((s6b[0] + s6b[1]) + (s6b[2] + s6b[3]));
        *(PG8_LAS f32x4*)(lds + MLA_TBL + tid * 16) = (f32x4){1.f / sqrtf(sq * (1.f / 384.f) + eps), 1.f / sqrtf(skv * (1.f / 256.f) + eps), skr, 0.f}; }
#pragma unroll
    for (int j = 0; j < 4; ++j) *(PG8_LAS u32x4*)(lds + MLA_ROPE + (tid + 512 * j) * 16) = rp[j];
    if (want_kr) {
#pragma unroll
        for (int j = 0; j < 2; ++j) *(PG8_LAS u32x4*)(lds + MLA_KR + (tid + 512 * j) * 16) = kr[j]; }
}
struct EpiQ {
    static constexpr bool PERM = true, AFTER_DRAIN = true;
    MlaAux A; const float* gq; bf16_t* Q; float qscale, eps; int seq;
    __device__ __forceinline__ void fused(f32x4 (&acc)[2][2][4][2], const Unit& u, int wr, int wc, int fr, int fq, PG8_LAS unsigned char* lds, int wid, int lane) const {
        PG8_LAS float* P = (PG8_LAS float*)lds;
#pragma unroll
        for (int ai = 0; ai < 2; ++ai)
#pragma unroll
            for (int m = 0; m < 4; ++m)
#pragma unroll
                for (int bj = 0; bj < 2; ++bj) { const f32x4 v0 = acc[ai][bj][m][0], v1 = acc[ai][bj][m][1];
                    float q = (v0[0] * v0[0] + v0[1] * v0[1]) + (v0[2] * v0[2] + v0[3] * v0[3]) + (v1[0] * v1[0] + v1[1] * v1[1]) + (v1[2] * v1[2] + v1[3] * v1[3]);
                    q += __shfl_xor(q, 16); q += __shfl_xor(q, 32);
                    if (fq == 0) P[((ai * HALF + wr * 64 + m * 16 + fr) * 2 + bj) * 4 + wc] = q; }
        mla_stage_rows(A, u, lds, wid * 64 + lane, false, eps);
        asm volatile("s_waitcnt lgkmcnt(0)" ::: "memory"); __builtin_amdgcn_s_barrier(); asm volatile("" ::: "memory");
        if (wc == 3) return;
        const int d0 = 32 * wc + 8 * fq;
        const f32x4 g0 = *(const f32x4*)(gq + (wc == 2 ? 64 + 8 * fq : d0)), g1 = *(const f32x4*)(gq + (wc == 2 ? 64 + 8 * fq : d0) + 4);
#pragma unroll
        for (int ai = 0; ai < 2; ++ai)
#pragma unroll
            for (int m = 0; m < 4; ++m) { const int r = ai * HALF + wr * 64 + m * 16 + fr; const size_t grow = (size_t)u.pm * BM + r;
                const float rstd = (*(const PG8_LAS f32x4*)(lds + MLA_TBL + r * 16))[0];
                f32x4 cs0 = {0.f, 0.f, 0.f, 0.f}, cs1 = cs0, cs2 = cs0, cs3 = cs0;
                if (wc == 2) { const PG8_LAS float* rp = (const PG8_LAS float*)(lds + MLA_ROPE) + (r * 16 + 8 * (fq & 1)) * 2; cs0 = *(const PG8_LAS f32x4*)rp; cs1 = *(const PG8_LAS f32x4*)(rp + 4); cs2 = *(const PG8_LAS f32x4*)(rp + 8); cs3 = *(const PG8_LAS f32x4*)(rp + 12); }
#pragma unroll
                for (int bj = 0; bj < 2; ++bj) { const f32x4 pp = *(const PG8_LAS f32x4*)(P + (r * 2 + bj) * 4);
                    const float tot = (pp[0] + pp[1]) + pp[2];
                    const float rs = qscale * rstd * __builtin_amdgcn_rsqf(rstd * rstd * tot * (1.f / 96.f) + eps);
                    f32x4 v0 = acc[ai][bj][m][0] * rs * g0, v1 = acc[ai][bj][m][1] * rs * g1;
                    if (wc == 2) {
                        f32x4 o0, o1;
#pragma unroll
                        for (int e = 0; e < 4; ++e) { o0[e] = __shfl_xor(v0[e], 32); o1[e] = __shfl_xor(v1[e], 32); }
                        const float sg = (fq < 2) ? -1.f : 1.f;
                        v0[0] = v0[0] * cs0[0] + sg * o0[0] * cs0[1]; v0[1] = v0[1] * cs0[2] + sg * o0[1] * cs0[3]; v0[2] = v0[2] * cs1[0] + sg * o0[2] * cs1[1]; v0[3] = v0[3] * cs1[2] + sg * o0[3] * cs1[3];
                        v1[0] = v1[0] * cs2[0] + sg * o1[0] * cs2[1]; v1[1] = v1[1] * cs2[2] + sg * o1[1] * cs2[3]; v1[2] = v1[2] * cs3[0] + sg * o1[2] * cs3[1]; v1[3] = v1[3] * cs3[2] + sg * o1[3] * cs3[3]; }
                    u32x4 w; w.x = cvt_pk_h(v0[0], v0[1]); w.y = cvt_pk_h(v0[2], v0[3]); w.z = cvt_pk_h(v1[0], v1[1]); w.w = cvt_pk_h(v1[2], v1[3]);
                    *(u32x4*)(Q + grow * 768 + (2 * u.pn + bj) * 96 + d0) = w; } }
    }
};
struct EpiKV {
    static constexpr bool PERM = true, AFTER_DRAIN = true;
    MlaAux A; const float* gk; bf16_t* KIMG; bf16_t* VIMG; float eps; int seq;
    __device__ __forceinline__ static int vst(int k, int c) { return (c >> 5) * 4096 + k * 64 + (c & 31) * 2; }
    __device__ __forceinline__ void fused(f32x4 (&acc)[2][2][4][2], const Unit& u, int wr, int wc, int fr, int fq, PG8_LAS unsigned char* lds, int wid, int lane) const {
        PG8_LAS float* P = (PG8_LAS float*)lds;
        if (wc < 2) {
#pragma unroll
            for (int ai = 0; ai < 2; ++ai)
#pragma unroll
                for (int m = 0; m < 4; ++m)
#pragma unroll
                    for (int bj = 0; bj < 2; ++bj) { const f32x4 v0 = acc[ai][bj][m][0], v1 = acc[ai][bj][m][1];
                        float q = (v0[0] * v0[0] + v0[1] * v0[1]) + (v0[2] * v0[2] + v0[3] * v0[3]) + (v1[0] * v1[0] + v1[1] * v1[1]) + (v1[2] * v1[2] + v1[3] * v1[3]);
                        q += __shfl_xor(q, 16); q += __shfl_xor(q, 32);
                        if (fq == 0) P[((ai * HALF + wr * 64 + m * 16 + fr) * 2 + bj) * 2 + wc] = q; }
        }
        mla_stage_rows(A, u, lds, wid * 64 + lane, true, eps);
        asm volatile("s_waitcnt lgkmcnt(0)" ::: "memory"); __builtin_amdgcn_s_barrier(); asm volatile("" ::: "memory");
        const int q8 = 4 * (wc & 1) + fq;
        f32x4 g0 = {0.f, 0.f, 0.f, 0.f}, g1 = g0; float ga = 0.f, gb = 0.f, gc = 0.f, gd = 0.f;
        if (wc < 2) { g0 = *(const f32x4*)(gk + 32 * wc + 8 * fq); g1 = *(const f32x4*)(gk + 32 * wc + 8 * fq + 4); }
        else { ga = gk[64 + 2 * q8]; gb = gk[65 + 2 * q8]; gc = gk[80 + 2 * q8]; gd = gk[81 + 2 * q8]; }
#pragma unroll
        for (int ai = 0; ai < 2; ++ai)
#pragma unroll
            for (int m = 0; m < 4; ++m) { const int r = ai * HALF + wr * 64 + m * 16 + fr; const size_t grow = (size_t)u.pm * BM + r;
                const f32x4 tb = *(const PG8_LAS f32x4*)(lds + MLA_TBL + r * 16); const float rstd = tb[1], skr = tb[2];
                const int bb = (int)(grow / (size_t)seq), tt = (int)(grow % (size_t)seq), trow = tt & 63;
                float cA = 0.f, sA = 0.f, cB = 0.f, sB = 0.f, x1a = 0.f, x1b = 0.f, x2a = 0.f, x2b = 0.f;
                if (wc >= 2) { const f32x4 cs = *(const PG8_LAS f32x4*)((const PG8_LAS float*)(lds + MLA_ROPE) + (r * 16 + 2 * q8) * 2); cA = cs[0]; sA = cs[1]; cB = cs[2]; sB = cs[3];
                    const PG8_LAS bf16_t* krow = (const PG8_LAS bf16_t*)(lds + MLA_KR) + r * 32;
                    const unsigned ra = *(const PG8_LAS unsigned*)(krow + 2 * q8), rb = *(const PG8_LAS unsigned*)(krow + 16 + 2 * q8);
                    x1a = h_lo(ra); x1b = h_hi(ra); x2a = h_lo(rb); x2b = h_hi(rb); }
#pragma unroll
                for (int bj = 0; bj < 2; ++bj) { const f32x2 pp = *(const PG8_LAS f32x2*)(P + (r * 2 + bj) * 2);
                    const float rs = __builtin_amdgcn_rsqf((rstd * rstd * (pp[0] + pp[1]) + skr) * (1.f / 96.f) + eps);
                    const size_t tix = (size_t)(bb * 8 + 2 * u.pn + bj) * 128 + (tt >> 6);
                    if (wc < 2) { const float f = rstd * rs; const f32x4 v0 = acc[ai][bj][m][0] * f * g0, v1 = acc[ai][bj][m][1] * f * g1;
                        u32x4 w; w.x = cvt_pk_h(v0[0], v0[1]); w.y = cvt_pk_h(v0[2], v0[3]); w.z = cvt_pk_h(v1[0], v1[1]); w.w = cvt_pk_h(v1[2], v1[3]);
                        *(u32x4*)(KIMG + tix * 6144 + (4 * wc + fq) * 512 + trow * 8) = w; }
                    else { const f32x4 v0 = acc[ai][bj][m][0] * rstd, v1 = acc[ai][bj][m][1] * rstd;
                        u32x4 w; w.x = cvt_pk_h(v0[0], v0[1]); w.y = cvt_pk_h(v0[2], v0[3]); w.z = cvt_pk_h(v1[0], v1[1]); w.w = cvt_pk_h(v1[2], v1[3]);
                        *(u32x4*)(VIMG + tix * 4096 + vst(trow, 32 * (wc - 2) + 8 * fq) / 2) = w;
                        const float y1a = x1a * rs * ga, y1b = x1b * rs * gb, y2a = x2a * rs * gc, y2b = x2b * rs * gd;
                        bf16_t* kd = KIMG + tix * 6144 + trow * 8;
                        *(unsigned*)(kd + (8 + (q8 >> 2)) * 512 + ((2 * q8) & 7)) = cvt_pk_h(y1a * cA - y2a * sA, y1b * cB - y2b * sB);
                        *(unsigned*)(kd + (10 + (q8 >> 2)) * 512 + ((2 * q8) & 7)) = cvt_pk_h(y2a * cA + y1a * sA, y2b * cB + y1b * sB); } } }
    }
};
struct EpiELds {
    static constexpr bool PERM = true, AFTER_DRAIN = true;
    __device__ __forceinline__ void fused(f32x4 (&acc)[2][2][4][2], const Unit& u, int wr, int wc, int fr, int fq, PG8_LAS unsigned char* lds, int wid, int lane) const {
        PG8_LAS float* El = (PG8_LAS float*)lds;
#pragma unroll
        for (int ai = 0; ai < 2; ++ai)
#pragma unroll
            for (int m = 0; m < 4; ++m) { const int r = ai * HALF + wr * 64 + m * 16 + fr; PG8_LAS float* rp = El + r * 128 + wc * 32 + 8 * fq;
                *(PG8_LAS f32x4*)rp = acc[ai][0][m][0]; *(PG8_LAS f32x4*)(rp + 4) = acc[ai][0][m][1]; }
    }
};
__device__ __forceinline__ void ssm_chain_unit(const Unit& u, const PG8_LAS unsigned char* lds, bf16_t* USG, const float* AC, float* hand, unsigned* cnt, unsigned* tmo, int lane) {
        const PG8_LAS float* El = (const PG8_LAS float*)lds;
        const int g = u.pn, k4 = u.pm & 3, seqi = g * 2 + (k4 >> 1), p = lane;
        const f32x4 ac = *(const f32x4*)(AC + ((size_t)g * 64 + p) * 4);
        float sr = 0.f, si = 0.f;
        if (k4 & 1) { unsigned sp = 0;
            while (__hip_atomic_load(cnt + 64 * seqi, __ATOMIC_RELAXED, __HIP_MEMORY_SCOPE_AGENT) < 1u) { __builtin_amdgcn_s_sleep(2);
                if (++sp > (1u << 22)) { if (lane == 0) __hip_atomic_store(tmo, 1u, __ATOMIC_RELAXED, __HIP_MEMORY_SCOPE_AGENT); break; } }
            const unsigned long long hv = __hip_atomic_load((const unsigned long long*)(hand + ((size_t)seqi * 64 + p) * 2), __ATOMIC_RELAXED, __HIP_MEMORY_SCOPE_AGENT);
            sr = __uint_as_float((unsigned)hv); si = __uint_as_float((unsigned)(hv >> 32)); }
        bf16_t* srow = USG + (size_t)u.pm * BM * 384 + 256 + 2 * p;
#pragma unroll 8
        for (int t = 0; t < 256; ++t) { const f32x2 e = *(const PG8_LAS f32x2*)(El + t * 128 + 2 * p);
            *(unsigned*)(srow + (size_t)t * 384) = cvt_pk_h(sr, si);
            const float nr = ac[2] * sr - ac[3] * si + e[0], ni = ac[2] * si + ac[3] * sr + e[1]; sr = nr; si = ni; }
        if (!(k4 & 1)) { __hip_atomic_store((unsigned long long*)(hand + ((size_t)seqi * 64 + p) * 2), (unsigned long long)__float_as_uint(sr) | ((unsigned long long)__float_as_uint(si) << 32), __ATOMIC_RELAXED, __HIP_MEMORY_SCOPE_AGENT);
            asm volatile("s_waitcnt vmcnt(0)" ::: "memory");
            if (lane == 0) __hip_atomic_fetch_add(cnt + 64 * seqi, 1u, __ATOMIC_RELAXED, __HIP_MEMORY_SCOPE_AGENT); }
}
struct EpiY {
    static constexpr bool PERM = true, AFTER_DRAIN = false;
    const bf16_t* USG; const float* dskip; bf16_t* YPRE; int seq;
    __device__ __forceinline__ static float gelu_t(float v) { const float z = 0.7978845608028654f * (v + 0.044715f * v * v * v); return v * __builtin_amdgcn_rcpf(1.f + __builtin_amdgcn_exp2f(-2.885390081777927f * z)); }
    __device__ __forceinline__ void operator()(const f32x4 (&acc)[2][2][4][2], const Unit& u, int wr, int wc, int fr, int fq) const {
        const int g = u.pn, k4 = u.pm & 3, bb = k4 >> 1;
        const int i0 = (8 * fq) & 15;
        const f32x4 d0 = *(const f32x4*)(dskip + g * 16 + i0), d1 = *(const f32x4*)(dskip + g * 16 + i0 + 4);
#pragma unroll
        for (int ai = 0; ai < 2; ++ai)
#pragma unroll
            for (int m = 0; m < 4; ++m) { const int r = ai * HALF + wr * 64 + m * 16 + fr; const size_t arow = (size_t)u.pm * BM + r; const int tile = (k4 & 1) * 256 + r;
#pragma unroll
                for (int bj = 0; bj < 2; ++bj) { const int col = bj * HALF + wc * 32 + 8 * fq, t = col >> 4;
                    const u32x4 uv = *(const u32x4*)(USG + arow * 384 + col);
                    const f32x4 v0 = acc[ai][bj][m][0], v1 = acc[ai][bj][m][1];
                    u32x4 w;
                    w.x = cvt_pk_h(gelu_t(v0[0] + d0[0] * h_lo(uv.x)), gelu_t(v0[1] + d0[1] * h_hi(uv.x))); w.y = cvt_pk_h(gelu_t(v0[2] + d0[2] * h_lo(uv.y)), gelu_t(v0[3] + d0[3] * h_hi(uv.y)));
                    w.z = cvt_pk_h(gelu_t(v1[0] + d1[0] * h_lo(uv.z)), gelu_t(v1[1] + d1[1] * h_hi(uv.z))); w.w = cvt_pk_h(gelu_t(v1[2] + d1[2] * h_lo(uv.w)), gelu_t(v1[3] + d1[3] * h_hi(uv.w)));
                    store16_wt(YPRE + ((size_t)bb * seq + (size_t)tile * 16 + t) * 512 + g * 16 + i0, w); } }
    }
};
struct EpiGlu {
    static constexpr bool PERM = true, AFTER_DRAIN = false;
    const bf16_t* ypre; const bf16_t* proj; int ldp, zcol0; const float* bglu; bf16_t* ycat;
    __device__ __forceinline__ void operator()(const f32x4 (&acc)[2][2][4][2], const Unit& u, int wr, int wc, int fr, int fq) const {
        const int row0 = u.pm * BM + wr * 64 + fr, col0 = u.pn * BM + wc * 32 + 8 * fq;
        f32x4 bv[2][2];
#pragma unroll
        for (int bj = 0; bj < 2; ++bj)
#pragma unroll
            for (int n = 0; n < 2; ++n) bv[bj][n] = *(const f32x4*)(bglu + col0 + bj * HALF + 4 * n);
#pragma unroll
        for (int ai = 0; ai < 2; ++ai)
#pragma unroll
            for (int m = 0; m < 4; ++m) { const size_t row = (size_t)(row0 + ai * HALF + m * 16);
#pragma unroll
                for (int bj = 0; bj < 2; ++bj) { const int col = col0 + bj * HALF;
                    const u32x4 yv = __builtin_nontemporal_load((const u32x4*)(ypre + row * 512 + col)); const u32x4 zv = __builtin_nontemporal_load((const u32x4*)(proj + row * ldp + zcol0 + col));
                    const f32x4 t0 = acc[ai][bj][m][0] + bv[bj][0], t1 = acc[ai][bj][m][1] + bv[bj][1];
                    u32x4 w;
                    w.x = cvt_pk_h(fglu3(h_lo(yv.x), t0[0], h_lo(zv.x)), fglu3(h_hi(yv.x), t0[1], h_hi(zv.x)));
                    w.y = cvt_pk_h(fglu3(h_lo(yv.y), t0[2], h_lo(zv.y)), fglu3(h_hi(yv.y), t0[3], h_hi(zv.y)));
                    w.z = cvt_pk_h(fglu3(h_lo(yv.z), t1[0], h_lo(zv.z)), fglu3(h_hi(yv.z), t1[1], h_hi(zv.z)));
                    w.w = cvt_pk_h(fglu3(h_lo(yv.w), t1[2], h_lo(zv.w)), fglu3(h_hi(yv.w), t1[3], h_hi(zv.w)));
                    store16_wt(ycat + row * 1024 + col, w); } }
    }
};
struct EpiOutRows {
    static constexpr bool PERM = false, AFTER_DRAIN = true;
    const float* x; const float* gate; int gate_stride, rows_per_batch; float* out;
    __device__ __forceinline__ static int slot(int r, int s16) { return r * 1024 + ((s16 ^ (r & 15)) << 4); }
    __device__ __forceinline__ void fused(f32x4 (&acc)[2][2][4][2], const Unit& u, int wr, int wc, int fr, int fq, PG8_LAS unsigned char* lds, int wid, int lane) const {
        const int b = (u.pm * BM) / rows_per_batch;
        const f32x4 gv = *(const f32x4*)(gate + (size_t)b * gate_stride + u.pn * BM + 4 * lane);
#pragma unroll
        for (int ai = 0; ai < 2; ++ai) {
#pragma unroll
            for (int m = 0; m < 4; ++m) { const int rl = wr * 64 + m * 16 + fr;
#pragma unroll
                for (int bj = 0; bj < 2; ++bj)
#pragma unroll
                    for (int n = 0; n < 2; ++n) *(PG8_LAS f32x4*)(lds + slot(rl, 32 * bj + 8 * wc + 4 * n + fq)) = acc[ai][bj][m][n]; }
            asm volatile("s_waitcnt lgkmcnt(0)" ::: "memory"); __builtin_amdgcn_s_barrier(); asm volatile("" ::: "memory");
            const size_t g0 = ((size_t)u.pm * BM + ai * HALF + wid * 16) * 1024 + u.pn * BM + 4 * lane;
#pragma unroll
            for (int i0 = 0; i0 < 16; i0 += 8) { f32x4 xs[8];
#pragma unroll
                for (int i = 0; i < 8; ++i) xs[i] = __builtin_nontemporal_load((const f32x4*)(x + g0 + (size_t)(i0 + i) * 1024));
#pragma unroll
                for (int i = 0; i < 8; ++i) { const f32x4 v = *(const PG8_LAS f32x4*)(lds + slot(wid * 16 + i0 + i, lane)); __builtin_nontemporal_store(xs[i] + gv * v, (f32x4*)(out + g0 + (size_t)(i0 + i) * 1024)); } }
            if (ai == 0) { asm volatile("s_waitcnt lgkmcnt(0)" ::: "memory"); __builtin_amdgcn_s_barrier(); asm volatile("" ::: "memory"); }
        }
    }
};
template <class Epi, class Sched, bool ALIGN_EPI = false, bool SP2 = false>
__device__ __forceinline__ void gemm_phase(PG8_LAS unsigned char* lds, const Gemm g, const Sched& S, const Epi& E) {
    int tid_ = threadIdx.x; asm volatile("" : "+v"(tid_));
    const int tid = tid_, wid = __builtin_amdgcn_readfirstlane(tid >> 6), lane = tid & 63, wr = wid >> 2, wc = wid & 3, fr = lane & 15, fq = lane >> 4;
    const int K = g.K, nt = K / BK;
    unsigned voffA[2], voffB[2];
#pragma unroll
    for (int i = 0; i < 2; ++i) { int R, C; stage_rc(tid * 16 + i * 8192, R, C); const int Rb = Epi::PERM ? ((R & ~31) + perm32(R & 31)) : R;
        voffA[i] = (unsigned)(R * g.lda + C) * 2u; voffB[i] = (unsigned)(Rb * K + C) * 2u; }
    const size_t kstep = (size_t)(BK * 2);
    const size_t hstepA = (size_t)HALF * g.lda * 2, hstepB = (size_t)HALF * K * 2;
    const size_t tstepA = 2 * hstepA, tstepB = 2 * hstepB;
    const unsigned ldsw = (unsigned)wid * 1024u;
    const int aoff = lds_byte(wr * 64 + fr, fq * 8), boff = lds_byte(wc * 32 + fr, fq * 8);
#define PG8_SA(b, h) (((b) * 2 + (h)) * HTB)
#define PG8_SB(b, h) ((4 + (b) * 2 + (h)) * HTB)
#define PG8_STAGE(bufoff, gbase, voff) do { _Pragma("unroll") for (int _i = 0; _i < 2; ++_i) \
        __builtin_amdgcn_global_load_lds((const unsigned*)((const char*)(gbase) + (voff)[_i]), (PG8_LAS unsigned*)(lds + (bufoff) + ldsw + _i * 8192), 16, 0, 0); } while (0)
#define PG8_LDA(dst, b, h) do { _Pragma("unroll") for (int m = 0; m < 4; ++m) _Pragma("unroll") for (int k = 0; k < 2; ++k) dst[m][k] = *(const PG8_LAS bf16x8*)(lds + PG8_SA(b, h) + aoff + m * 2048 + k * 1024); } while (0)
#define PG8_LDB(dst, b, h) do { _Pragma("unroll") for (int n = 0; n < 2; ++n) _Pragma("unroll") for (int k = 0; k < 2; ++k) dst[n][k] = *(const PG8_LAS bf16x8*)(lds + PG8_SB(b, h) + boff + n * 2048 + k * 1024); } while (0)
#define PG8_MMA(ai, bj, At, Bt) do { __builtin_amdgcn_s_setprio(1); _Pragma("unroll") for (int m = 0; m < 4; ++m) _Pragma("unroll") for (int n = 0; n < 2; ++n) _Pragma("unroll") for (int k = 0; k < 2; ++k) \
        acc[ai][bj][m][n] = __builtin_amdgcn_mfma_f32_16x16x32_f16(Bt[n][k], At[m][k], acc[ai][bj][m][n], 0, 0, 0); __builtin_amdgcn_s_setprio(0); } while (0)
#define PG8_WAIT_V(n) asm volatile("s_waitcnt vmcnt(" #n ")" ::: "memory")
#define PG8_WAIT_L(n) asm volatile("s_waitcnt lgkmcnt(" #n ")" ::: "memory")
#define PG8_BAR __builtin_amdgcn_s_barrier()
#define PG8_SCHED __builtin_amdgcn_sched_barrier(0)
    Unit cur, nxt; int ui = 0;
    if (!S.next(0, cur)) return;
    f32x4 acc[2][2][4][2];
#pragma unroll
    for (int a = 0; a < 2; ++a)
#pragma unroll
        for (int b = 0; b < 2; ++b)
#pragma unroll
            for (int m = 0; m < 4; ++m)
#pragma unroll
                for (int n = 0; n < 2; ++n) acc[a][b][m][n] = (f32x4){0.f, 0.f, 0.f, 0.f};
    bf16x8 At[4][2], B0[2][2], B1[2][2];
    const char* cA = (const char*)g.A + (size_t)cur.pm * tstepA; const char* cB = (const char*)g.Bt + (size_t)cur.pn * tstepB;
    S.a_ready(cur);
    if constexpr (SP2) {
        PG8_STAGE(PG8_SB(0, 0), cB, voffB); PG8_STAGE(PG8_SB(0, 1), cB + hstepB, voffB); PG8_STAGE(PG8_SA(0, 0), cA, voffA); PG8_STAGE(PG8_SA(0, 1), cA + hstepA, voffA);
        if (wr == 1) PG8_BAR;
        PG8_WAIT_V(2); PG8_BAR;
        PG8_STAGE(PG8_SB(1, 0), cB + kstep, voffB); PG8_STAGE(PG8_SA(1, 0), cA + kstep, voffA); PG8_STAGE(PG8_SB(1, 1), cB + hstepB + kstep, voffB);
        PG8_WAIT_V(6); PG8_BAR;
    } else {
        PG8_STAGE(PG8_SB(0, 0), cB, voffB); PG8_STAGE(PG8_SA(0, 0), cA, voffA); PG8_STAGE(PG8_SB(0, 1), cB + hstepB, voffB); PG8_STAGE(PG8_SA(0, 1), cA + hstepA, voffA);
        if (wr == 1) PG8_BAR;
        PG8_WAIT_V(4); PG8_BAR;
        PG8_STAGE(PG8_SB(1, 0), cB + kstep, voffB); PG8_STAGE(PG8_SA(1, 0), cA + kstep, voffA); PG8_STAGE(PG8_SB(1, 1), cB + hstepB + kstep, voffB);
        PG8_WAIT_V(6); PG8_BAR;
    }
    for (;;) {
        const bool has_next = S.next(ui + 1, nxt);
        const char* nA = has_next ? (const char*)g.A + (size_t)nxt.pm * tstepA : cA; const char* nB = has_next ? (const char*)g.Bt + (size_t)nxt.pn * tstepB : cB;
        for (int t = 0; t < nt; t += 2) {
            const bool last = (t == nt - 2);
            const char* a1 = cA + (size_t)(t + 1) * kstep;
            const char* a2 = last ? nA : cA + (size_t)(t + 2) * kstep; const char* b2 = last ? nB : cB + (size_t)(t + 2) * kstep;
            const char* a3 = a2 + kstep; const char* b3 = b2 + kstep;
            if (last && has_next) S.a_ready(nxt);
            if constexpr (SP2) {
            PG8_LDB(B0, 0, 0); PG8_LDB(B1, 0, 1); PG8_SCHED; PG8_LDA(At, 0, 0); PG8_STAGE(PG8_SA(1, 1), a1 + hstepA, voffA);
            PG8_WAIT_V(8); PG8_WAIT_L(0); PG8_BAR; PG8_MMA(0, 0, At, B0); PG8_MMA(0, 1, At, B1); PG8_BAR; PG8_SCHED;
            PG8_LDA(At, 0, 1); PG8_STAGE(PG8_SB(0, 0), b2, voffB); PG8_STAGE(PG8_SB(0, 1), b2 + hstepB, voffB); PG8_STAGE(PG8_SA(0, 0), a2, voffA);
            PG8_WAIT_V(8); PG8_WAIT_L(0); PG8_BAR; PG8_MMA(1, 0, At, B0); PG8_MMA(1, 1, At, B1); PG8_BAR; PG8_SCHED;
            PG8_LDB(B0, 1, 0); PG8_LDB(B1, 1, 1); PG8_SCHED; PG8_LDA(At, 1, 0); PG8_STAGE(PG8_SA(0, 1), a2 + hstepA, voffA);
            PG8_WAIT_V(8); PG8_WAIT_L(0); PG8_BAR; PG8_MMA(0, 0, At, B0); PG8_MMA(0, 1, At, B1); PG8_BAR; PG8_SCHED;
            PG8_LDA(At, 1, 1); PG8_STAGE(PG8_SB(1, 0), b3, voffB); PG8_STAGE(PG8_SB(1, 1), b3 + hstepB, voffB); PG8_STAGE(PG8_SA(1, 0), a3, voffA);
            PG8_WAIT_V(8); PG8_WAIT_L(0); PG8_BAR; PG8_MMA(1, 0, At, B0); PG8_MMA(1, 1, At, B1); PG8_BAR; PG8_SCHED;
            } else {
            PG8_LDB(B0, 0, 0); PG8_SCHED; PG8_LDA(At, 0, 0); PG8_STAGE(PG8_SA(1, 1), a1 + hstepA, voffA);
            PG8_WAIT_L(8); PG8_BAR; PG8_WAIT_L(0); PG8_MMA(0, 0, At, B0); PG8_BAR; PG8_SCHED;
            PG8_LDB(B1, 0, 1); PG8_STAGE(PG8_SB(0, 0), b2, voffB);
            PG8_BAR; PG8_WAIT_L(0); PG8_MMA(0, 1, At, B1); PG8_BAR;
            PG8_LDA(At, 0, 1); PG8_STAGE(PG8_SA(0, 0), a2, voffA);
            PG8_BAR; PG8_WAIT_L(0); PG8_MMA(1, 0, At, B0); PG8_BAR; PG8_SCHED;
            PG8_STAGE(PG8_SB(0, 1), b2 + hstepB, voffB);
            PG8_WAIT_V(6); PG8_BAR; PG8_MMA(1, 1, At, B1); PG8_BAR;
            PG8_LDB(B0, 1, 0); PG8_SCHED; PG8_LDA(At, 1, 0); PG8_STAGE(PG8_SA(0, 1), a2 + hstepA, voffA);
            PG8_WAIT_L(8); PG8_BAR; PG8_WAIT_L(0); PG8_MMA(0, 0, At, B0); PG8_BAR; PG8_SCHED;
            PG8_LDB(B1, 1, 1); PG8_STAGE(PG8_SB(1, 0), b3, voffB);
            PG8_BAR; PG8_WAIT_L(0); PG8_MMA(0, 1, At, B1); PG8_BAR;
            PG8_LDA(At, 1, 1); PG8_STAGE(PG8_SA(1, 0), a3, voffA);
            PG8_BAR; PG8_WAIT_L(0); PG8_MMA(1, 0, At, B0); PG8_BAR; PG8_SCHED;
            PG8_STAGE(PG8_SB(1, 1), b3 + hstepB, voffB);
            PG8_WAIT_V(6); PG8_BAR; PG8_MMA(1, 1, At, B1); PG8_BAR;
            }
        }
        if constexpr (ALIGN_EPI) { if (wr == 0) PG8_BAR; }
        if constexpr (!Epi::AFTER_DRAIN) { E(acc, cur, wr, wc, fr, fq); S.done(cur); }
        if (!has_next) break;
#pragma unroll
        for (int a = 0; a < 2; ++a)
#pragma unroll
            for (int b = 0; b < 2; ++b)
#pragma unroll
                for (int m = 0; m < 4; ++m)
#pragma unroll
                    for (int n = 0; n < 2; ++n) acc[a][b][m][n] = (f32x4){0.f, 0.f, 0.f, 0.f};
        cur = nxt; cA = nA; cB = nB; ++ui;
        if constexpr (ALIGN_EPI) { if (wr == 1) PG8_BAR; }
    }
    PG8_WAIT_V(0);
    if constexpr (!ALIGN_EPI) { if (wr == 0) PG8_BAR; }
    PG8_BAR;
    if constexpr (Epi::AFTER_DRAIN) { E.fused(acc, cur, wr, wc, fr, fq, lds, wid, lane); S.done(cur); }
#undef PG8_SA
#undef PG8_SB
#undef PG8_STAGE
#undef PG8_LDA
#undef PG8_LDB
#undef PG8_MMA
#undef PG8_WAIT_V
#undef PG8_WAIT_L
#undef PG8_BAR
#undef PG8_SCHED
}
}

namespace att {
using h16x8 = __attribute__((ext_vector_type(8))) _Float16;
using s16x4 = __attribute__((ext_vector_type(4))) short;
using f32x16 = __attribute__((ext_vector_type(16))) float;
using u32x4 = __attribute__((ext_vector_type(4))) unsigned;
typedef float f32x2_t __attribute__((ext_vector_type(2))); typedef _Float16 f16x2_t __attribute__((ext_vector_type(2)));
constexpr int NW = 8, QBLK = 32, KVBLK = 64, QB = 256, ASEQ = 8192;
constexpr int LDQ = 768, LDK = 1024, LDV = 512;
constexpr float SCALE = 0.10206207261596575f;
constexpr float THR = 8.f;
#define SBAR() __builtin_amdgcn_sched_barrier(0)
__device__ __forceinline__ int crow(int r, int hi) { return (r & 3) + 8 * (r >> 2) + 4 * hi; }
__device__ __forceinline__ unsigned cvtpk(float lo, float hi) { const f16x2_t v = __builtin_convertvector((f32x2_t){lo, hi}, f16x2_t); return __builtin_bit_cast(unsigned, v); }

__device__ __forceinline__ void cmask(f32x16& p0, f32x16& p1, int jb, int qrel, int hi) {
  const float NEG = -INFINITY; const int kb = 64 * jb + 4 * hi;
#pragma unroll
  for (int r = 0; r < 16; ++r) { const int kv = kb + (r & 3) + 8 * (r >> 2); if (kv > qrel) p0[r] = NEG; if (kv + 32 > qrel) p1[r] = NEG; }
}
__device__ __forceinline__ void cmask0(f32x16& p0, int jb, int qrel, int hi) {
  const float NEG = -INFINITY; const int kb = 64 * jb + 4 * hi;
#pragma unroll
  for (int r = 0; r < 16; ++r) { const int kv = kb + (r & 3) + 8 * (r >> 2); if (kv > qrel) p0[r] = NEG; }
}
__device__ __forceinline__ void cmask1(f32x16& p1, int jb, int qrel, int hi) {
  const float NEG = -INFINITY; const int kb = 64 * jb + 4 * hi + 32;
#pragma unroll
  for (int r = 0; r < 16; ++r) { const int kv = kb + (r & 3) + 8 * (r >> 2); if (kv > qrel) p1[r] = NEG; }
}
constexpr int KT_BYTES = 12288, VT_BYTES = 8192, NKS = 3, NVS = 4;
constexpr int LDS_V0 = NKS * KT_BYTES, LDS_WSC = LDS_V0 + NVS * VT_BYTES;
constexpr int LDS_OST = LDS_WSC + NW * 64 * 4;
constexpr int LDS_ATT2 = LDS_OST + NW * 4096;
typedef __attribute__((address_space(3))) unsigned char* lds3_t;
__device__ __forceinline__ unsigned gate2(unsigned ow, unsigned zw) {
  const f16x2_t o2 = __builtin_bit_cast(f16x2_t, ow), z2 = __builtin_bit_cast(f16x2_t, zw); const float z0 = (float)z2[0], z1 = (float)z2[1];
  return cvtpk((float)o2[0] * (z0 * __builtin_amdgcn_rcpf(1.f + __builtin_amdgcn_exp2f(-1.4426950408889634f * z0))), (float)o2[1] * (z1 * __builtin_amdgcn_rcpf(1.f + __builtin_amdgcn_exp2f(-1.4426950408889634f * z1))));
}
#define PIN(x) asm volatile("" : "+v"(x))
#define MFMAH(a, b, c) __builtin_amdgcn_mfma_f32_32x32x16_f16(a, b, c, 0, 0, 0)
typedef __attribute__((address_space(3))) const char* lds_cptr;
typedef short v4i16_t __attribute__((ext_vector_type(4)));
__device__ __forceinline__ void kload2(h16x8* kf, lds_cptr kp, int d0) { kf[2 * d0] = *(const __attribute__((address_space(3))) h16x8*)(kp + d0 * 2048); kf[2 * d0 + 1] = *(const __attribute__((address_space(3))) h16x8*)(kp + d0 * 2048 + 512); }
__device__ __forceinline__ s16x4 vtr(lds_cptr p) { return __builtin_bit_cast(s16x4, __builtin_amdgcn_ds_read_tr16_b64_v4i16((__attribute__((address_space(3))) v4i16_t*)p)); }
#define MX3(a, b, c) __builtin_fmaxf(__builtin_fmaxf((a), (b)), (c))
__device__ __forceinline__ float rowmax(const f32x16& p0, const f32x16& p1) {
  float a = MX3(p0[0], p0[1], p1[0]), b = MX3(p0[2], p0[3], p1[1]); a = MX3(a, p1[2], p1[3]);
#pragma unroll
  for (int r = 4; r < 16; r += 4) { a = MX3(a, p0[r], p0[r + 1]); b = MX3(b, p0[r + 2], p0[r + 3]); a = MX3(a, p1[r], p1[r + 1]); b = MX3(b, p1[r + 2], p1[r + 3]); }
  float m = __builtin_fmaxf(a, b); auto rr = __builtin_amdgcn_permlane32_swap(__float_as_uint(m), __float_as_uint(m), false, false);
  return __builtin_fmaxf(__uint_as_float(rr[0]), __uint_as_float(rr[1])); }
template <bool FIXED> __device__ __forceinline__ void attn_unit(int b, int h, int qb, const unsigned short* __restrict__ Q, const unsigned short* __restrict__ KIMG, const unsigned short* __restrict__ VIMG,
                                          const unsigned short* __restrict__ PROJ, int ldp, int zcol0, unsigned short* __restrict__ YCAT, char* lds, lds3_t lds3, unsigned* done_cnt, unsigned* z_cnt, unsigned* tmo,
                                          int next_qword, int next_slot_off, float mfix) {
  int tid_ = threadIdx.x; asm volatile("" : "+v"(tid_));
  const int tid = tid_, lane = tid & 63, r32 = lane & 31, hi = lane >> 5; const int wid = __builtin_amdgcn_readfirstlane(tid >> 6);
  float* ws = (float*)(lds + LDS_WSC) + wid * 64; float* li_l = ws; float* al_l = ws + 32;
  const long rowbase = (long)b * ASEQ; const int q0 = qb * QB;
  const int NT = (q0 + QB) / KVBLK;
  const char* Kg = (const char*)KIMG + (size_t)(b * 8 + h) * 128 * KT_BYTES;
  const char* Vg = (const char*)VIMG + (size_t)(b * 8 + h) * 128 * VT_BYTES;
  const unsigned lo16 = (unsigned)lane * 16u;
  const lds_cptr kp0 = (lds_cptr)lds3 + hi * 1024 + r32 * 16;
  const lds_cptr vp0 = (lds_cptr)lds3 + LDS_V0 + ((lane >> 4) & 1) * 32 + (lane & 3) * 8 + (4 * hi + ((lane & 15) >> 2)) * 64;
  constexpr float THRL = THR * 1.4426950408889634f;
#define GLDS(gp, loff) do { const char* gu_ = (gp); asm volatile("" : "+s"(gu_)); __builtin_amdgcn_global_load_lds((const unsigned*)(gu_ + lo16), (__attribute__((address_space(3))) unsigned*)(lds3 + (loff)), 16, 0, 0); } while (0)
#define DMA_K(t, slot) do { const char* kg_ = Kg + (size_t)(t) * KT_BYTES; const int ko_ = (slot) * KT_BYTES; GLDS(kg_ + wid * 1024, ko_ + wid * 1024); if (wid < 4) GLDS(kg_ + (8 + wid) * 1024, ko_ + (8 + wid) * 1024); } while (0)
#define DMA_V(t, slot) do { GLDS(Vg + (size_t)(t) * VT_BYTES + wid * 1024, LDS_V0 + (slot) * VT_BYTES + wid * 1024); } while (0)
#define WAITB(A, B) do { if (wid < 4) asm volatile("s_waitcnt vmcnt(" #A ") lgkmcnt(0)\n\ts_barrier" ::: "memory"); else asm volatile("s_waitcnt vmcnt(" #B ") lgkmcnt(0)\n\ts_barrier" ::: "memory"); } while (0)
  float mhat = 0.f, l_reg = 0.f; f32x16 o[2]; o[0] = f32x16{}; o[1] = f32x16{}; h16x8 qr[6]; f32x16 negm = {}; PIN(negm);
  if (FIXED) { float mf_ = -mfix; asm volatile("" : "+v"(mf_));
#pragma unroll
    for (int r = 0; r < 16; ++r) negm[r] = mf_;
    PIN(negm); }
  const int qrel = wid * QBLK + r32; bool resc = false;
  f32x16 pA0, pA1, pB0, pB1; h16x8 kf[12]; s16x4 vlo[8], vhi[8]; u32x4 pw0, pw1, pw2, pw3;
  int s_prev = 0, s_cur = 0, s_next = 1;
#define ROT() do { s_prev = s_cur; s_cur = s_next; s_next = (s_next == 2) ? 0 : s_next + 1; } while (0)
#define RESC() do { if (resc) { _Pragma("unroll") for (int d_ = 0; d_ < 2; ++d_) _Pragma("unroll") for (int r = 0; r < 16; ++r) o[d_][r] *= al_l[crow(r, hi)]; } } while (0)
  DMA_K(0, 0); DMA_V(0, 0); DMA_K(1, 1);
  { const unsigned short* Qw = Q + (rowbase + q0 + wid * QBLK + r32) * LDQ + h * 96 + hi * 8;
#pragma unroll
    for (int d0 = 0; d0 < 6; ++d0) qr[d0] = __builtin_nontemporal_load(reinterpret_cast<const h16x8*>(Qw + d0 * 16)); }
  DMA_K(2, 2);
  WAITB(2, 1);
#pragma unroll
  for (int d0 = 0; d0 < 6; ++d0) kload2(kf, kp0, d0);
  pA0 = MFMAH(kf[0], qr[0], negm); pA1 = MFMAH(kf[1], qr[0], negm);
#pragma unroll
  for (int d0 = 1; d0 < 6; ++d0) { pA0 = MFMAH(kf[2 * d0], qr[d0], pA0); pA1 = MFMAH(kf[2 * d0 + 1], qr[d0], pA1); }
  if (NT == 4) cmask(pA0, pA1, 0, qrel, hi);
  if (FIXED) {
#pragma unroll
    for (int r = 0; r < 16; ++r) { pA0[r] = __builtin_amdgcn_exp2f(pA0[r]); pA1[r] = __builtin_amdgcn_exp2f(pA1[r]); } }
  else { const float rm = rowmax(pA0, pA1); mhat = rm;
#pragma unroll
    for (int r = 0; r < 16; ++r) negm[r] = -rm;
    PIN(negm);
#pragma unroll
    for (int r = 0; r < 16; ++r) { pA0[r] = __builtin_amdgcn_exp2f(pA0[r] - rm); pA1[r] = __builtin_amdgcn_exp2f(pA1[r] - rm); } }
  WAITB(0, 0);
  DMA_K(3, 0); DMA_V(1, 1); ROT();
#pragma unroll
  for (int d0 = 0; d0 < 6; ++d0) kload2(kf, kp0 + s_cur * KT_BYTES, d0);
  WAITB(3, 2);
#define PKW(P, i) cvtpk(P[i], P[i + 1])
#define PAF(k) __builtin_bit_cast(h16x8, pw##k)
#define VFR(i) __builtin_bit_cast(h16x8, (__attribute__((ext_vector_type(8))) short){vlo[i][0], vlo[i][1], vlo[i][2], vlo[i][3], vhi[i][0], vhi[i][1], vhi[i][2], vhi[i][3]})
#define VRD(i) do { vlo[i] = vtr(vp_ + (((i) >> 2) * 4096 + ((i) & 3) * 1024)); vhi[i] = vtr(vp_ + (((i) >> 2) * 4096 + ((i) & 3) * 1024 + 512)); } while (0)
#define KRD(G, d0) do { if (G) { kload2(kf, kp0 + s_next * KT_BYTES, d0); SBAR(); } } while (0)
#define GAPA(MF, a0, a1, a2, W0, W1, PW) do { MF; sacc += a0; sacc += a1; sacc += a2; W0; W1; PIN(PW); PIN(sacc); SBAR(); } while (0)
#define GAPA3(MF, a0, a1, a2) do { MF; sacc += a0; sacc += a1; sacc += a2; PIN(sacc); SBAR(); } while (0)
#define GAPB(MF, X, i) do { MF; X[i] = __builtin_amdgcn_exp2f(X[i]); X[i + 1] = __builtin_amdgcn_exp2f(X[i + 1]); X[i + 2] = __builtin_amdgcn_exp2f(X[i + 2]); X[i + 3] = __builtin_amdgcn_exp2f(X[i + 3]); PIN(X); SBAR(); } while (0)
#define STEP(C0, C1, P0, P1, t, MASK, GK, GV, GL) do { SBAR(); \
    const lds_cptr vp_ = vp0 + s_prev * VT_BYTES; \
    VRD(0); SBAR(); float sacc = P0[0] + P0[1]; \
                    GAPA(C0 = MFMAH(kf[0], qr[0], negm), P0[2], P0[3], P0[4],     pw0[0] = PKW(P0, 0),  pw0[1] = PKW(P0, 2),  pw0); \
    VRD(4); SBAR(); GAPA(C1 = MFMAH(kf[1], qr[0], negm), P0[5], P0[6], P0[7],     pw0[2] = PKW(P0, 4),  pw0[3] = PKW(P0, 6),  pw0); \
    VRD(1); SBAR(); GAPA(C0 = MFMAH(kf[2], qr[1], C0),   P0[8], P0[9], P0[10],    pw1[0] = PKW(P0, 8),  pw1[1] = PKW(P0, 10), pw1); \
    VRD(5); SBAR(); GAPA(C1 = MFMAH(kf[3], qr[1], C1),   P0[11], P0[12], P0[13],  pw1[2] = PKW(P0, 12), pw1[3] = PKW(P0, 14), pw1); \
    VRD(2); SBAR(); GAPA(C0 = MFMAH(kf[4], qr[2], C0),   P0[14], P0[15], P1[0],   pw2[0] = PKW(P1, 0),  pw2[1] = PKW(P1, 2),  pw2); \
    VRD(6); SBAR(); GAPA(C1 = MFMAH(kf[5], qr[2], C1),   P1[1], P1[2], P1[3],     pw2[2] = PKW(P1, 4),  pw2[3] = PKW(P1, 6),  pw2); \
                    GAPA(C0 = MFMAH(kf[6], qr[3], C0),   P1[4], P1[5], P1[6],     pw3[0] = PKW(P1, 8),  pw3[1] = PKW(P1, 10), pw3); \
                    GAPA(C1 = MFMAH(kf[7], qr[3], C1),   P1[7], P1[8], P1[9],     pw3[2] = PKW(P1, 12), pw3[3] = PKW(P1, 14), pw3); \
    GAPA3(C0 = MFMAH(kf[8], qr[4], C0), P1[10], P1[11], P1[12]); \
    GAPA3(C1 = MFMAH(kf[9], qr[4], C1), P1[13], P1[14], P1[15]); \
    C0 = MFMAH(kf[10], qr[5], C0); C1 = MFMAH(kf[11], qr[5], C1); \
    l_reg += sacc; \
    if (GK) DMA_K((t) + 3, s_cur); if (GV) DMA_V((t) + 1, s_next);                                                         \
    KRD(GL, 0); KRD(GL, 1);                                                                                                   \
    if (MASK) cmask(C0, C1, (t) - (NT - 4), qrel, hi); \
    if (!FIXED) { const float rm = rowmax(C0, C1); resc = false;                                                                       \
      if (__builtin_expect(__any(rm > THRL), 0)) { const float dl = __builtin_fmaxf(rm, 0.f); mhat += dl;                  \
          const float f = __builtin_amdgcn_exp2f(-dl); l_reg *= f; if (hi == 0) al_l[r32] = f; resc = true; \
          _Pragma("unroll") for (int r = 0; r < 16; ++r) { C0[r] -= dl; C1[r] -= dl; } \
          _Pragma("unroll") for (int r = 0; r < 16; ++r) negm[r] = -mhat; \
          PIN(negm); } } \
    SBAR(); \
    VRD(3); SBAR(); KRD(GL, 2); GAPB(o[0] = MFMAH(PAF(0), VFR(0), o[0]), C0, 0);  VRD(7); SBAR(); KRD(GL, 3); GAPB(o[1] = MFMAH(PAF(0), VFR(4), o[1]), C0, 4);     \
    KRD(GL, 4); GAPB(o[0] = MFMAH(PAF(1), VFR(1), o[0]), C0, 8);  KRD(GL, 5); GAPB(o[1] = MFMAH(PAF(1), VFR(5), o[1]), C0, 12); \
    GAPB(o[0] = MFMAH(PAF(2), VFR(2), o[0]), C1, 0);              GAPB(o[1] = MFMAH(PAF(2), VFR(6), o[1]), C1, 4); \
    GAPB(o[0] = MFMAH(PAF(3), VFR(3), o[0]), C1, 8);              GAPB(o[1] = MFMAH(PAF(3), VFR(7), o[1]), C1, 12); \
    } while (0)
#define EX1(X, i) X[i] = __builtin_amdgcn_exp2f(X[i])
#define STEP_F(C0, C1, P0, P1, t, MASK, GK, GV, GL) do { SBAR(); \
    const lds_cptr vp_ = vp0 + s_prev * VT_BYTES; \
    VRD(0); SBAR(); float sacc = P0[0] + P0[1]; \
                    GAPA(C0 = MFMAH(kf[0], qr[0], negm), P0[2], P0[3], P0[4],     pw0[0] = PKW(P0, 0),  pw0[1] = PKW(P0, 2),  pw0); \
    VRD(4); SBAR(); GAPA(C0 = MFMAH(kf[2], qr[1], C0),   P0[5], P0[6], P0[7],     pw0[2] = PKW(P0, 4),  pw0[3] = PKW(P0, 6),  pw0); \
    VRD(1); SBAR(); GAPA(C0 = MFMAH(kf[4], qr[2], C0),   P0[8], P0[9], P0[10],    pw1[0] = PKW(P0, 8),  pw1[1] = PKW(P0, 10), pw1); \
    VRD(5); SBAR(); GAPA(C0 = MFMAH(kf[6], qr[3], C0),   P0[11], P0[12], P0[13],  pw1[2] = PKW(P0, 12), pw1[3] = PKW(P0, 14), pw1); \
    VRD(2); SBAR(); GAPA(C0 = MFMAH(kf[8], qr[4], C0),   P0[14], P0[15], P1[0],   pw2[0] = PKW(P1, 0),  pw2[1] = PKW(P1, 2),  pw2); \
    VRD(6); SBAR(); GAPA(C0 = MFMAH(kf[10], qr[5], C0),  P1[1], P1[2], P1[3],     pw2[2] = PKW(P1, 4),  pw2[3] = PKW(P1, 6),  pw2); \
                    GAPA(C1 = MFMAH(kf[1], qr[0], negm), P1[4], P1[5], P1[6],     pw3[0] = PKW(P1, 8),  pw3[1] = PKW(P1, 10), pw3); \
                    GAPA(C1 = MFMAH(kf[3], qr[1], C1),   P1[7], P1[8], P1[9],     pw3[2] = PKW(P1, 12), pw3[3] = PKW(P1, 14), pw3); \
    if (MASK) { cmask0(C0, (t) - (NT - 4), qrel, hi); PIN(C0); SBAR(); } \
    C1 = MFMAH(kf[5], qr[2], C1);  sacc += P1[10]; sacc += P1[11]; sacc += P1[12]; EX1(C0, 0);  EX1(C0, 1);  EX1(C0, 2);  EX1(C0, 3);  PIN(C0); PIN(sacc); SBAR(); \
    C1 = MFMAH(kf[7], qr[3], C1);  sacc += P1[13]; sacc += P1[14]; sacc += P1[15]; EX1(C0, 4);  EX1(C0, 5);  EX1(C0, 6);  EX1(C0, 7);  PIN(C0); PIN(sacc); SBAR(); \
    C1 = MFMAH(kf[9], qr[4], C1);  EX1(C0, 8);  EX1(C0, 9);  EX1(C0, 10); EX1(C0, 11); PIN(C0); SBAR(); \
    C1 = MFMAH(kf[11], qr[5], C1); EX1(C0, 12); EX1(C0, 13); EX1(C0, 14); EX1(C0, 15); PIN(C0); SBAR(); \
    l_reg += sacc; \
    if (GK) DMA_K((t) + 3, s_cur); if (GV) DMA_V((t) + 1, s_next);                                                         \
    KRD(GL, 0); KRD(GL, 1);                                                                                                   \
    if (MASK) { cmask1(C1, (t) - (NT - 4), qrel, hi); PIN(C1); } \
    SBAR(); \
    VRD(3); SBAR(); KRD(GL, 2); o[0] = MFMAH(PAF(0), VFR(0), o[0]); SBAR();  VRD(7); SBAR(); KRD(GL, 3); o[1] = MFMAH(PAF(0), VFR(4), o[1]); SBAR(); \
    KRD(GL, 4); o[0] = MFMAH(PAF(1), VFR(1), o[0]); EX1(C1, 0);  EX1(C1, 1);  EX1(C1, 2);  PIN(C1); SBAR();  KRD(GL, 5); o[1] = MFMAH(PAF(1), VFR(5), o[1]); EX1(C1, 3);  EX1(C1, 4);  EX1(C1, 5);  PIN(C1); SBAR(); \
    o[0] = MFMAH(PAF(2), VFR(2), o[0]); EX1(C1, 6);  EX1(C1, 7);  EX1(C1, 8);  PIN(C1); SBAR();              o[1] = MFMAH(PAF(2), VFR(6), o[1]); EX1(C1, 9);  EX1(C1, 10); EX1(C1, 11); PIN(C1); SBAR(); \
    o[0] = MFMAH(PAF(3), VFR(3), o[0]); EX1(C1, 12); EX1(C1, 13); PIN(C1); SBAR();                            o[1] = MFMAH(PAF(3), VFR(7), o[1]); EX1(C1, 14); EX1(C1, 15); PIN(C1); SBAR(); \
    } while (0)
#define STEPX(...) do { if (FIXED) STEP_F(__VA_ARGS__); else STEP(__VA_ARGS__); } while (0)
  int t = 1;
  for (; t + 5 < NT; t += 2) {
    STEPX(pB0, pB1, pA0, pA1, t, false, true, true, true);     WAITB(3, 2); RESC(); ROT();
    STEPX(pA0, pA1, pB0, pB1, t + 1, false, true, true, true); WAITB(3, 2); RESC(); ROT();
  }
#define ENDW(tt) do { if ((tt) + 3 < NT) { WAITB(3, 2); } else if ((tt) + 2 < NT) { WAITB(1, 1); } else { WAITB(0, 0); } } while (0)
  for (; t + 1 < NT; t += 2) {
    STEPX(pB0, pB1, pA0, pA1, t, true, (t + 3 < NT), (t + 1 < NT), (t + 1 < NT));         ENDW(t);     RESC(); ROT();
    STEPX(pA0, pA1, pB0, pB1, t + 1, true, (t + 4 < NT), (t + 2 < NT), (t + 2 < NT));     ENDW(t + 1); RESC(); ROT();
  }
  STEPX(pB0, pB1, pA0, pA1, NT - 1, true, false, false, false); RESC();
  { float sacc = pB0[0] + pB0[1];
#pragma unroll
    for (int r = 2; r < 16; ++r) sacc += pB0[r];
#pragma unroll
    for (int r = 0; r < 16; ++r) sacc += pB1[r];
    l_reg += sacc;
    pw0 = (u32x4){PKW(pB0, 0), PKW(pB0, 2), PKW(pB0, 4), PKW(pB0, 6)}; pw1 = (u32x4){PKW(pB0, 8), PKW(pB0, 10), PKW(pB0, 12), PKW(pB0, 14)};
    pw2 = (u32x4){PKW(pB1, 0), PKW(pB1, 2), PKW(pB1, 4), PKW(pB1, 6)}; pw3 = (u32x4){PKW(pB1, 8), PKW(pB1, 10), PKW(pB1, 12), PKW(pB1, 14)};
    const lds_cptr vp_ = vp0 + s_cur * VT_BYTES;
#pragma unroll
    for (int i = 0; i < 8; ++i) VRD(i);
    o[0] = MFMAH(PAF(0), VFR(0), o[0]); o[1] = MFMAH(PAF(0), VFR(4), o[1]); o[0] = MFMAH(PAF(1), VFR(1), o[0]); o[1] = MFMAH(PAF(1), VFR(5), o[1]);
    o[0] = MFMAH(PAF(2), VFR(2), o[0]); o[1] = MFMAH(PAF(2), VFR(6), o[1]); o[0] = MFMAH(PAF(3), VFR(3), o[0]); o[1] = MFMAH(PAF(3), VFR(7), o[1]); }
  { auto rr = __builtin_amdgcn_permlane32_swap(__float_as_uint(l_reg), __float_as_uint(l_reg), false, false); l_reg = __uint_as_float(rr[0]) + __uint_as_float(rr[1]); }
  if (hi == 0) li_l[r32] = l_reg; asm volatile("s_waitcnt lgkmcnt(0)" ::: "memory");
  float rli[16];
#pragma unroll
  for (int r = 0; r < 16; ++r) rli[r] = __builtin_amdgcn_rcpf(li_l[crow(r, hi)]);
  if (z_cnt && wid == 0) { unsigned sp = 0;
    while (__hip_atomic_load(z_cnt, __ATOMIC_RELAXED, __HIP_MEMORY_SCOPE_AGENT) < 2u) { __builtin_amdgcn_s_sleep(2); if (++sp > (1u << 22)) { if (lane == 0) __hip_atomic_store(tmo, 1u, __ATOMIC_RELAXED, __HIP_MEMORY_SCOPE_AGENT); break; } }
    __builtin_amdgcn_fence(__ATOMIC_ACQUIRE, "agent"); asm volatile("s_waitcnt vmcnt(0)" ::: "memory"); }
  unsigned nxt_ = 0u; if (next_qword >= 0 && tid == 0) nxt_ = __hip_atomic_fetch_add(tmo + next_qword + 64 * (blockIdx.x & 7u), 1u, __ATOMIC_RELAXED, __HIP_MEMORY_SCOPE_AGENT);
  asm volatile("s_waitcnt lgkmcnt(0)\n\ts_barrier" ::: "memory");
  const long orow0 = rowbase + q0 + wid * QBLK;
  { unsigned short* stg = (unsigned short*)(lds + LDS_OST) + wid * 2048;
#pragma unroll
    for (int r = 0; r < 16; ++r) { const int orow = crow(r, hi);
#pragma unroll
      for (int d0 = 0; d0 < 2; ++d0) stg[orow * 64 + d0 * 32 + r32] = __builtin_bit_cast(unsigned short, (_Float16)(o[d0][r] * rli[r])); }
    asm volatile("s_waitcnt lgkmcnt(0)" ::: "memory");
#pragma unroll
    for (int i = 0; i < 4; ++i) { const int row = i * 8 + (lane >> 3), ch = lane & 7; const long grow = orow0 + row;
      const u32x4 ov = *(const u32x4*)(stg + row * 64 + ch * 8); const u32x4 zv = __builtin_nontemporal_load((const u32x4*)(PROJ + grow * ldp + zcol0 + h * 64 + ch * 8));
      u32x4 w;
      w.x = gate2(ov.x, zv.x); w.y = gate2(ov.y, zv.y); w.z = gate2(ov.z, zv.z); w.w = gate2(ov.w, zv.w);
      store16_wt(YCAT + grow * 1024 + 512 + h * 64 + ch * 8, w); } }
  if (next_qword >= 0 && tid == 0) *(volatile __attribute__((address_space(3))) unsigned*)(lds3 + next_slot_off) = nxt_;
  asm volatile("s_waitcnt vmcnt(0) lgkmcnt(0)\n\ts_barrier" ::: "memory");
  if (tid == 0) __hip_atomic_fetch_add(done_cnt, 1u, __ATOMIC_RELAXED, __HIP_MEMORY_SCOPE_AGENT);
#undef GLDS
#undef DMA_K
#undef DMA_V
#undef WAITB
#undef ROT
#undef RESC
#undef PKW
#undef PAF
#undef VFR
#undef VRD
#undef KRD
#undef GAPA
#undef GAPA3
#undef GAPB
#undef STEP
#undef STEP_F
#undef STEPX
#undef EX1
#undef ENDW
}
#undef PIN
#undef MFMAH
#undef MX3
#undef SBAR
}

#define GAS __attribute__((address_space(1)))
#define LAS __attribute__((address_space(3)))
typedef unsigned v4u __attribute__((ext_vector_type(4)));
typedef float f32x4 __attribute__((ext_vector_type(4)));
typedef short bf16x8 __attribute__((ext_vector_type(8)));
typedef GAS unsigned gu32;
typedef GAS unsigned long long gu64;
#define RLX_AGENT __ATOMIC_RELAXED, __HIP_MEMORY_SCOPE_AGENT
#define LDS_WAIT() asm volatile("s_waitcnt lgkmcnt(0)" ::: "memory")
#define VM_WAIT() asm volatile("s_waitcnt vmcnt(0)" ::: "memory")
__device__ __forceinline__ unsigned long long rt() { return __builtin_amdgcn_s_memrealtime(); }

#define XB_TMO      128
#define XB_XCNT(j)  (256  + 64 * (j))
#define XB_XSUB(j)  (1280 + 64 * (j))
#define XB_XGEN(j)  (2304 + 64 * (j))
#define XB_TOP      3328
#define XB_TOPGEN   3392
#define XCD_BAR_WORDS 3456
#define XB_SPIN_CAP (1u << 18)

__device__ __forceinline__ unsigned xb_ld(unsigned* p)              { return __hip_atomic_load(p, __ATOMIC_RELAXED, __HIP_MEMORY_SCOPE_AGENT); }
__device__ __forceinline__ unsigned xb_add(unsigned* p, unsigned v) { return __hip_atomic_fetch_add(p, v, __ATOMIC_RELAXED, __HIP_MEMORY_SCOPE_AGENT); }
__device__ __forceinline__ unsigned xb_xcc_id() { return (unsigned)__builtin_amdgcn_s_getreg((3 << 11) | 20) & 0xFu; }
#define XB_SPIN(cond, bar) do { unsigned _sp = 0; while (cond) { __builtin_amdgcn_s_sleep(1); \
    if ((++_sp & 255u) == 0u) { if (xb_ld(&(bar)[XB_TMO])) break; if (_sp > XB_SPIN_CAP) { atomicAdd(&(bar)[XB_TMO], 1u); break; } } } } while (0)

struct XcdBarrier {
    unsigned* bar; unsigned x;
    volatile LAS unsigned* st;
};

__device__ __forceinline__ XcdBarrier xcd_barrier_post(unsigned* bar, volatile LAS unsigned* st) {
    XcdBarrier b; b.bar = bar; b.x = xb_xcc_id(); b.st = st;
    if (threadIdx.x == 0) (void)xb_add(&bar[XB_XCNT(b.x)], 1u);
    return b;
}
__device__ __forceinline__ void xcd_barrier_complete(unsigned* bar, unsigned x, unsigned& nloc, unsigned& nx) {
    const unsigned G = gridDim.x * gridDim.y * gridDim.z;
    unsigned sum, cnt, mine, sp = 0u;
    for (;;) {
        sum = 0u; cnt = 0u; mine = 0u;
#pragma unroll
        for (unsigned j = 0; j < 16; ++j) { const unsigned c = xb_ld(&bar[XB_XCNT(j)]); sum += c; cnt += (c > 0u) ? 1u : 0u; mine = (j == x) ? c : mine; }
        if (sum == G) break;
        __builtin_amdgcn_s_sleep(1);
        if ((++sp & 255u) == 0u) { if (xb_ld(&bar[XB_TMO])) break; if (sp > XB_SPIN_CAP) { atomicAdd(&bar[XB_TMO], 1u); break; } }
    }
    nloc = mine > 0u ? mine : 1u; nx = cnt > 0u ? cnt : 1u;
}

__device__ __forceinline__ void xcd_barrier(const XcdBarrier& b) {
    asm volatile("s_waitcnt vmcnt(0)" ::: "memory");
    __syncthreads();
    if (threadIdx.x == 0) {
        unsigned* bar = b.bar;
        __builtin_amdgcn_s_waitcnt(0);
        unsigned nloc = b.st[0], nx = b.st[1];
        if (nloc == 0u) { xcd_barrier_complete(bar, b.x, nloc, nx); b.st[0] = nloc; b.st[1] = nx; }
        const unsigned old = xb_add(&bar[XB_XSUB(b.x)], 1u);
        const unsigned gen = old / nloc;
        if (old + 1u == (gen + 1u) * nloc) {
            __builtin_amdgcn_fence(__ATOMIC_RELEASE, "agent");
            asm volatile("s_waitcnt vmcnt(0)" ::: "memory");
            const unsigned og = xb_add(&bar[XB_TOP], 1u);
            const unsigned tg = og / nx;
            if (og + 1u == (tg + 1u) * nx) xb_add(&bar[XB_TOPGEN], 1u);
            else XB_SPIN(xb_ld(&bar[XB_TOPGEN]) == tg, bar);
            __builtin_amdgcn_fence(__ATOMIC_ACQUIRE, "agent");
            xb_add(&bar[XB_XGEN(b.x)], 1u);
            asm volatile("s_waitcnt vmcnt(0)" ::: "memory");
        } else {
            XB_SPIN(xb_ld(&bar[XB_XGEN(b.x)]) == gen, bar);
            __builtin_amdgcn_fence(__ATOMIC_ACQUIRE, "agent");
            asm volatile("s_waitcnt vmcnt(0)" ::: "memory");
        }
    }
    __syncthreads();
}

constexpr int NWAVES = 8;
constexpr int NPHASE = 4;
constexpr int CW_RDV = 98304;
constexpr int CW_TMO = 0, CW_CODE = 1, CW_MODC = 64, CW_OUTQ = 2048, CW_CHAIN = 81920, CW_ATTQ = 1024, CW_PANEL = 65536, CW_OUTP = 73728, CW_BAR = 4096;
constexpr int RING_OFF = 0, RING_BYTES = 131072;
constexpr int LDSCTL_OFF = RING_BYTES, MISC_OFF = LDSCTL_OFF + 320;
constexpr int SACT_OFF = LDSCTL_OFF + 1024;
constexpr int LDS_BYTES = 147456;
static_assert(MISC_OFF + 128 <= SACT_OFF && SACT_OFF + 8192 + 1024 <= LDS_BYTES, "LDS map");
static_assert(att::LDS_ATT2 <= RING_BYTES && pg8::STAGE_BYTES <= RING_BYTES, "phase scratch fits the ring");

struct Frame {
    LAS unsigned char* lds;
    volatile LAS unsigned* MISC;
    gu32* ctl;
    int tid, lane, wave, vcu, G;
};
__device__ __forceinline__ float wave_sum(float v) {
#pragma unroll
    for (int o = 1; o < 64; o <<= 1) v += __shfl_xor(v, o);
    return v;
}
__device__ __forceinline__ unsigned pk2h(float lo, float hi) { return pg8::cvt_pk_h(lo, hi); }

__device__ __forceinline__ void p0_transpose_item(const float* W, int ldw, int K, int src_n0, bf16* WT, int dst_row0, int k0, LAS float* scr, int lane, const float* gk = nullptr) {
    float t_[32];
#pragma unroll
    for (int i = 0; i < 32; ++i) t_[i] = __builtin_nontemporal_load(W + (size_t)(k0 + 2 * i + (lane >> 5)) * ldw + src_n0 + (lane & 31));
#pragma unroll
    for (int i = 0; i < 32; ++i) scr[(2 * i + (lane >> 5)) * 33 + (lane & 31)] = t_[i];
    LDS_WAIT(); asm volatile("" ::: "memory");
    const int c = lane & 7;
#pragma unroll
    for (int j = 0; j < 4; ++j) { const int n = (lane >> 3) + 8 * j; const LAS float* s = scr + (8 * c) * 33 + n;
        f32x4 g0 = {1.f, 1.f, 1.f, 1.f}, g1 = g0; if (gk) { g0 = *(const f32x4*)(gk + k0 + 8 * c); g1 = *(const f32x4*)(gk + k0 + 8 * c + 4); }
        v4u o; o.x = pk2h(s[0 * 33] * g0.x, s[1 * 33] * g0.y); o.y = pk2h(s[2 * 33] * g0.z, s[3 * 33] * g0.w); o.z = pk2h(s[4 * 33] * g1.x, s[5 * 33] * g1.y); o.w = pk2h(s[6 * 33] * g1.z, s[7 * 33] * g1.w);
        *(GAS v4u*)(WT + (size_t)(dst_row0 + n) * K + k0 + 8 * c) = o; }
    LDS_WAIT(); asm volatile("" ::: "memory");
}

struct Args {
    const float* in[24]; float* out; unsigned char* ws; int ph_lo, ph_hi, li, pad;
};

__device__ __forceinline__ void p0_mod_block(const LAS float* sact, LAS float* part, const float* w_ada, const float* b_ada, float* mod, gu32* cnt, int j, int wave, int lane) {
    const int kk = lane >> 2, c4 = lane & 3, col = 16 * j + 4 * c4;
    f32x4 w[8];
#pragma unroll
    for (int s = 0; s < 8; ++s) w[s] = __builtin_nontemporal_load((const GAS f32x4*)(w_ada + (size_t)(128 * wave + kk + 16 * s) * 3072 + col));
    f32x4 a0 = {0.f, 0.f, 0.f, 0.f}, a1 = {0.f, 0.f, 0.f, 0.f};
#pragma unroll
    for (int s = 0; s < 8; ++s) { const int k = 128 * wave + kk + 16 * s; a0 += w[s] * sact[k]; a1 += w[s] * sact[1024 + k]; }
#pragma unroll
    for (int o = 4; o < 64; o <<= 1) {
#pragma unroll
        for (int e = 0; e < 4; ++e) { a0[e] += __shfl_xor(a0[e], o); a1[e] += __shfl_xor(a1[e], o); } }
    if (lane < 4) {
#pragma unroll
        for (int e = 0; e < 4; ++e) { part[wave * 32 + 4 * c4 + e] = a0[e]; part[wave * 32 + 16 + 4 * c4 + e] = a1[e]; } }
    __syncthreads();
    if (wave == 0) {
        if (lane < 32) { float t = b_ada[16 * j + (lane & 15)];
#pragma unroll
            for (int ww = 0; ww < 8; ++ww) t += part[ww * 32 + lane];
            __hip_atomic_store((GAS float*)(mod + (lane >> 4) * 3072 + 16 * j + (lane & 15)), t, RLX_AGENT); }
        asm volatile("s_waitcnt vmcnt(0)" ::: "memory");
        if (lane == 0) __hip_atomic_fetch_add(cnt, 1u, RLX_AGENT);
    }
    __syncthreads();
}
__device__ __forceinline__ void cis_reduced(double ang, float& c, float& s) {
    const double TWO_PI = 6.283185307179586476925286766559;
    const float r = (float)(ang - TWO_PI * rint(ang / TWO_PI)); c = cosf(r); s = sinf(r);
}
__device__ __forceinline__ void ssm_pow(float lr, float li, float dtf, int n, float& pr, float& pi) {
    float c, s_; cis_reduced((double)n * (double)li * (double)dtf, c, s_); const float e = expf((float)n * lr * dtf); pr = e * c; pi = e * s_;
}
__device__ __forceinline__ void p0_ssm_item(const float* log_dt, const float* lam_re, const float* lam_im, float* AC, int g, int lane) {
    const float dtf = expf(log_dt[g]); const float lr = lam_re[g * 64 + lane], li = lam_im[g * 64 + lane];
    float a0, a1, a2, a3; ssm_pow(lr, li, dtf, 1, a0, a1); ssm_pow(lr, li, dtf, 16, a2, a3); const f32x4 v = {a0, a1, a2, a3};
    *(f32x4*)(AC + ((size_t)g * 64 + lane) * 4) = v;
}
__device__ __forceinline__ void ssm_coef_pow(const float* log_dt, const float* lam_re, const float* lam_im, int g, int lane, int n, float& cr, float& ci) {
    const float dtf = expf(log_dt[g]); const float lr = lam_re[g * 64 + lane], li = lam_im[g * 64 + lane];
    float ar, ai, pr, pi; ssm_pow(lr, li, dtf, 1, ar, ai); ssm_pow(lr, li, dtf, n, pr, pi);
    const float nr = ar - 1.f, ni = ai, den = lr * lr + li * li;
    const float kr = (nr * lr + ni * li) / den, ki = (ni * lr - nr * li) / den;
    cr = kr * pr - ki * pi; ci = kr * pi + ki * pr;
}
__device__ __forceinline__ void p0_ssm_K_item(const float* log_dt, const float* lam_re, const float* lam_im, const float* b_re, const float* b_im, const float* c_re, const float* c_im,
                                              bf16* TQ, int g, int d, LAS float* scr, int lane) {
    float cr, ci; ssm_coef_pow(log_dt, lam_re, lam_im, g, lane, d, cr, ci);
#pragma unroll
    for (int j = 0; j < 16; ++j) { const float br = b_re[(g * 64 + lane) * 16 + j], bi = b_im[(g * 64 + lane) * 16 + j];
        scr[(lane * 16 + j) * 2] = cr * br - ci * bi; scr[(lane * 16 + j) * 2 + 1] = cr * bi + ci * br; }
    LAS float* cl = scr + 2048;
#pragma unroll
    for (int q = 0; q < 16; ++q) { cl[(q * 64 + lane) * 2] = c_re[(g * 16 + q) * 64 + lane]; cl[(q * 64 + lane) * 2 + 1] = c_im[(g * 16 + q) * 64 + lane]; }
    LDS_WAIT(); asm volatile("" ::: "memory");
    const int i = lane & 15, jq = lane >> 4; float acc[4] = {0.f, 0.f, 0.f, 0.f};
#pragma unroll 8
    for (int p = 0; p < 64; ++p) { const float xr = cl[(i * 64 + p) * 2], xi = cl[(i * 64 + p) * 2 + 1];
#pragma unroll
        for (int e = 0; e < 4; ++e) acc[e] += xr * scr[(p * 16 + 4 * jq + e) * 2] - xi * scr[(p * 16 + 4 * jq + e) * 2 + 1]; }
    const unsigned long long kv = (unsigned long long)pk2h(acc[0], acc[1]) | ((unsigned long long)pk2h(acc[2], acc[3]) << 32);
    bf16* base = TQ + (size_t)g * 256 * 384;
    for (int t = d; t < 16; ++t) *(GAS unsigned long long*)(base + (size_t)(t * 16 + i) * 384 + (t - d) * 16 + 4 * jq) = kv;
    if (d > 0) for (int t = 0; t + d < 16; ++t) *(GAS unsigned long long*)(base + (size_t)(t * 16 + i) * 384 + (t + d) * 16 + 4 * jq) = 0ull;
    LDS_WAIT(); asm volatile("" ::: "memory");
}
__device__ __forceinline__ void p0_ssm_Q_item(const float* log_dt, const float* lam_re, const float* lam_im, const float* c_re, const float* c_im, bf16* TQ, int g, int t, int lane) {
    const float dtf = expf(log_dt[g]); float pr, pi; ssm_pow(lam_re[g * 64 + lane], lam_im[g * 64 + lane], dtf, t + 1, pr, pi);
#pragma unroll
    for (int i = 0; i < 16; ++i) { const float xr = c_re[(g * 16 + i) * 64 + lane], xi = c_im[(g * 16 + i) * 64 + lane];
        *(GAS unsigned*)(TQ + ((size_t)g * 256 + t * 16 + i) * 384 + 256 + 2 * lane) = pk2h(xr * pr - xi * pi, -(xr * pi + xi * pr)); }
}
__device__ __forceinline__ void p0_ssm_P_item(const float* log_dt, const float* lam_re, const float* lam_im, const float* b_re, const float* b_im, bf16* PP, int g, int s_, int lane) {
    float cr, ci; ssm_coef_pow(log_dt, lam_re, lam_im, g, lane, 15 - s_, cr, ci);
    float wr[16], wi[16];
#pragma unroll
    for (int j = 0; j < 16; ++j) { const float br = b_re[(g * 64 + lane) * 16 + j], bi = b_im[(g * 64 + lane) * 16 + j]; wr[j] = cr * br - ci * bi; wi[j] = cr * bi + ci * br; }
    bf16* r0 = PP + ((size_t)g * 256 + 2 * lane) * 256 + s_ * 16;
    v4u o; o.x = pk2h(wr[0], wr[1]); o.y = pk2h(wr[2], wr[3]); o.z = pk2h(wr[4], wr[5]); o.w = pk2h(wr[6], wr[7]); *(GAS v4u*)r0 = o;
    o.x = pk2h(wr[8], wr[9]); o.y = pk2h(wr[10], wr[11]); o.z = pk2h(wr[12], wr[13]); o.w = pk2h(wr[14], wr[15]); *(GAS v4u*)(r0 + 8) = o;
    o.x = pk2h(wi[0], wi[1]); o.y = pk2h(wi[2], wi[3]); o.z = pk2h(wi[4], wi[5]); o.w = pk2h(wi[6], wi[7]); *(GAS v4u*)(r0 + 256) = o;
    o.x = pk2h(wi[8], wi[9]); o.y = pk2h(wi[10], wi[11]); o.z = pk2h(wi[12], wi[13]); o.w = pk2h(wi[14], wi[15]); *(GAS v4u*)(r0 + 256 + 8) = o;
}

__global__ void __launch_bounds__(NWAVES * 64, 2) mega_fwd(Args args) {
    extern __shared__ __attribute__((aligned(16))) unsigned char lds[];
    Frame F;
    F.lds = (LAS unsigned char*)lds;
    F.MISC = (volatile LAS unsigned*)(F.lds + MISC_OFF);
    F.tid = threadIdx.x; F.lane = F.tid & 63; F.wave = __builtin_amdgcn_readfirstlane(F.tid >> 6);
    F.G = gridDim.x; { const int bx = blockIdx.x; F.vcu = (F.G % 8 == 0) ? (bx % 8) * (F.G / 8) + bx / 8 : bx; }
    unsigned char* ws = args.ws;
    F.ctl = (gu32*)(ws + WS_CTL);
    const float* x = args.in[0]; const float* cvec = args.in[1]; const int* positions = (const int*)args.in[2];
    const float* w_ada = args.in[3]; const float* b_ada = args.in[4]; const float* norm_g = args.in[5]; const float* w_in = args.in[6];
    const float* log_dt = args.in[7]; const float* lam_re = args.in[8]; const float* lam_im = args.in[9]; const float* b_re = args.in[10]; const float* b_im = args.in[11];
    const float* c_re = args.in[12]; const float* c_im = args.in[13]; const float* d_skip = args.in[14]; const float* w_glu = args.in[15]; const float* b_glu = args.in[16];
    const float* q_a_g = args.in[17]; const float* w_q_b = args.in[18]; const float* kv_a_g = args.in[19]; const float* w_kv_b = args.in[20];
    const float* q_norm_g = args.in[21]; const float* k_norm_g = args.in[22]; const float* w_out = args.in[23];
    float* MOD = (float*)(ws + WS_MOD); float* AC = (float*)(ws + WS_AC); bf16* BB = (bf16*)(ws + WS_BB); bf16* CB = (bf16*)(ws + WS_CB); float* EST = (float*)(ws + WS_E);
    bf16* WIN_T = (bf16*)(ws + WS_WIN); bf16* WQ_T = (bf16*)(ws + WS_WQ); bf16* WKV_T = (bf16*)(ws + WS_WKV); bf16* WGLU_T = (bf16*)(ws + WS_WGLU); bf16* WOUT_T = (bf16*)(ws + WS_WOUT);
    bf16* PROJ = (bf16*)(ws + WS_PROJ); bf16* HB = (bf16*)(ws + WS_HB); bf16* QRAW = (bf16*)(ws + WS_HB); bf16* YCAT = (bf16*)(ws + WS_YCAT); bf16* ZM = (bf16*)(ws + WS_ZM);
    bf16* KVRAW = (bf16*)(ws + WS_KVRAW); bf16* Qb = (bf16*)(ws + WS_Q); bf16* Kb = (bf16*)(ws + WS_K); bf16* Vb = (bf16*)(ws + WS_V);
    bf16* CQN = (bf16*)(ws + WS_CQN); bf16* CKVN = (bf16*)(ws + WS_CKVN); bf16* YPRE = (bf16*)(ws + WS_YPRE);
    float* RS = (float*)(ws + WS_RS); float* ROPE = (float*)(ws + WS_ROPE); bf16* USG = (bf16*)(ws + WS_USG); bf16* TQ = (bf16*)(ws + WS_TQ); bf16* PPM = (bf16*)(ws + WS_PP); float* HAND = (float*)(ws + WS_HAND); (void)BB; (void)CB; (void)EST; (void)CQN; (void)CKVN; (void)QRAW; (void)KVRAW;

    for (int u = F.tid; u < (LDS_BYTES - LDSCTL_OFF) / 4; u += NWAVES * 64) ((LAS unsigned*)(F.lds + LDSCTL_OFF))[u] = 0u;
    __syncthreads();
    const int lo = args.ph_lo, hi = args.ph_hi;
    const bool multi = (hi - lo) > 1;
    XcdBarrier bar; bar.bar = (unsigned*)(F.ctl + CW_BAR) + args.li * XCD_BAR_WORDS; bar.x = 0; bar.st = nullptr;
    if (multi) bar = xcd_barrier_post((unsigned*)(F.ctl + CW_BAR) + args.li * XCD_BAR_WORDS, F.MISC + 8);
#define IN(k) (lo <= (k) && (k) < hi)
#define SEAM(k) do { if (IN(k) && IN((k) + 1)) xcd_barrier(bar); } while (0)
    const int gw = F.vcu * NWAVES + F.wave, NGW = F.G * NWAVES;

    if (IN(0)) {
        LAS float* scr = (LAS float*)(F.lds + RING_OFF + F.wave * 16384);
        constexpr int I_MOD = 192, I_SSM = 32;
        constexpr int T_U = 256, T_ZS = 256, T_ZM = 256, T_CKV = 128, T_CQ = 192, T_KR = 16, T_WQ = 144, T_WKV = 128, T_WGLU = 128, T_WOUT = 512;
        constexpr int I_TR = T_U + T_ZS + T_ZM + T_CKV + T_CQ + T_KR + T_WQ + T_WKV + T_WGLU + T_WOUT;
        constexpr int I_Z1 = 96, I_Z2 = 256;
        constexpr int NITEMS = I_MOD + I_SSM + I_TR + I_Z1 + I_Z2;
        { LAS float* sact = (LAS float*)(F.lds + SACT_OFF); LAS float* part = (LAS float*)(F.lds + SACT_OFF + 8192);
          for (int e = F.tid; e < 2048; e += NWAVES * 64) { const float cv = cvec[e]; sact[e] = cv / (1.f + __expf(-cv)); }
          __syncthreads();
          for (int r = (int)blockIdx.x; r < I_MOD; r += F.G) p0_mod_block(sact, part, w_ada, b_ada, MOD, F.ctl + CW_MODC, r, F.wave, F.lane); }
        for (int it = I_MOD + gw; it < NITEMS; it += NGW) {
            int r = it - I_MOD;
            if (r < I_SSM) { p0_ssm_item(log_dt, lam_re, lam_im, AC, r, F.lane); continue; } r -= I_SSM;
            if (r < I_TR) {
                if (r < T_U)   { p0_transpose_item(w_in, D_IN, 1024, SC_U + 32 * (r % 16), WIN_T, 0 + 32 * (r % 16), 64 * (r / 16), scr, F.lane); continue; } r -= T_U;
                if (r < T_ZS)  { p0_transpose_item(w_in, D_IN, 1024, SC_ZS + 32 * (r % 16), WIN_T, 512 + 32 * (r % 16), 64 * (r / 16), scr, F.lane); continue; } r -= T_ZS;
                if (r < T_ZM)  { p0_transpose_item(w_in, D_IN, 1024, SC_ZM + 32 * (r % 16), WIN_T, WR_ZM + 32 * (r % 16), 64 * (r / 16), scr, F.lane); continue; } r -= T_ZM;
                if (r < T_CKV) { p0_transpose_item(w_in, D_IN, 1024, SC_CKV + 32 * (r % 8), WIN_T, 1024 + 32 * (r % 8), 64 * (r / 8), scr, F.lane); continue; } r -= T_CKV;
                if (r < T_CQ)  { p0_transpose_item(w_in, D_IN, 1024, SC_CQ + 32 * (r % 12), WIN_T, 1280 + 32 * (r % 12), 64 * (r / 12), scr, F.lane); continue; } r -= T_CQ;
                if (r < T_KR)  { p0_transpose_item(w_in, D_IN, 1024, SC_KR, WIN_T, GC_KR, 64 * r, scr, F.lane); continue; } r -= T_KR;
                if (r < T_WQ)  { const int nb = r % 24, kb = r / 24, n0 = 32 * nb;
                                 p0_transpose_item(w_q_b, 768, 384, n0, WQ_T, (n0 / 96) * 128 + (n0 % 96), 64 * kb, scr, F.lane, q_a_g); continue; } r -= T_WQ;
                if (r < T_WKV) { p0_transpose_item(w_kv_b, 1024, 256, 32 * (r % 32), WKV_T, 32 * (r % 32), 64 * (r / 32), scr, F.lane, kv_a_g); continue; } r -= T_WKV;
                if (r < T_WGLU){ p0_transpose_item(w_glu, 512, 512, 32 * (r % 16), WGLU_T, 32 * (r % 16), 64 * (r / 16), scr, F.lane); continue; } r -= T_WGLU;
                p0_transpose_item(w_out, 1024, 1024, 32 * (r % 32), WOUT_T, 32 * (r % 32), 64 * (r / 32), scr, F.lane); continue;
            }
            r -= I_TR;
            const v4u z = {0u, 0u, 0u, 0u};
            if (r < I_Z1) { GAS v4u* p = (GAS v4u*)(WIN_T + (size_t)(GC_KR + 32 + r) * 1024); p[F.lane] = z; p[64 + F.lane] = z; continue; } r -= I_Z1;
            { const int hh = r / 32, rr = r % 32; GAS v4u* p = (GAS v4u*)(WQ_T + (size_t)(hh * 128 + 96 + rr) * 384); if (F.lane < 48) p[F.lane] = z; }
        }
        f32x4 v0[4], v1[4], v2[4];
#define LDROW(dst, mm) do { const GAS f32x4* xr_ = (const GAS f32x4*)(x + (size_t)(mm) * DM) + F.lane; _Pragma("unroll") for (int j = 0; j < 4; ++j) dst[j] = __builtin_nontemporal_load(xr_ + 64 * j); } while (0)
        if (gw < M) LDROW(v0, gw);
        if (gw + NGW < M) LDROW(v1, gw + NGW);
        __syncthreads();
        if (F.wave == 0) { unsigned sp = 0;
            while (__hip_atomic_load(F.ctl + CW_MODC, RLX_AGENT) < 192u) { __builtin_amdgcn_s_sleep(2); if (++sp > (1u << 22)) { if (F.lane == 0) __hip_atomic_store(F.ctl + CW_TMO, 1u, RLX_AGENT); break; } }
            __builtin_amdgcn_fence(__ATOMIC_ACQUIRE, "agent"); asm volatile("s_waitcnt vmcnt(0)" ::: "memory"); }
        __syncthreads();
        { f32x4 PA[4], PB[4]; int curb = -1;
          const float ifq = (float)exp(-(double)(F.lane & 15) / 16.0 * 9.210340371976184);
          for (int m = gw; m < M; m += NGW) {
            if (m + 2 * NGW < M) LDROW(v2, m + 2 * NGW);
            const int b = m / SEQ;
            if (b != curb) { curb = b;
#pragma unroll
                for (int j = 0; j < 4; ++j) { const int e = 4 * F.lane + 256 * j;
                    const f32x4 g4 = *(const f32x4*)(norm_g + e), sc = *(const f32x4*)(MOD + b * 3072 + 1024 + e); PB[j] = *(const f32x4*)(MOD + b * 3072 + e); PA[j] = g4 * (sc + 1.f); } }
            if (F.lane < 16) { const double TWO_PI = 6.283185307179586476925286766559;
                const float ang = (float)positions[m] * ifq; const float kq = rintf(ang * 0.15915494309189535f);
                const float rr = fmaf(-kq, 0.0019353071795864769f, fmaf(-kq, 6.28125f, ang)); (void)TWO_PI;
                typedef float f32x2_ __attribute__((ext_vector_type(2))); *(f32x2_*)(ROPE + ((size_t)m * 16 + F.lane) * 2) = (f32x2_){__cosf(rr), __sinf(rr)}; }
            float s = 0.f;
#pragma unroll
            for (int j = 0; j < 4; ++j) s += (v0[j].x * v0[j].x + v0[j].y * v0[j].y) + (v0[j].z * v0[j].z + v0[j].w * v0[j].w);
            const float rstd = 1.f / sqrtf(wave_sum(s) * (1.f / DM) + EPS);
            GAS unsigned long long* o8 = (GAS unsigned long long*)(HB + (size_t)m * DM) + F.lane;
#pragma unroll
            for (int j = 0; j < 4; ++j) { const f32x4 hv = v0[j] * rstd * PA[j] + PB[j];
                o8[64 * j] = (unsigned long long)pk2h(hv.x, hv.y) | ((unsigned long long)pk2h(hv.z, hv.w) << 32); }
#pragma unroll
            for (int j = 0; j < 4; ++j) { v0[j] = v1[j]; v1[j] = v2[j]; }
          }
#undef LDROW
        }
    }
    SEAM(0);

    if (IN(1)) {
        pg8::Gemm g{HB, WIN_T, M, NPROJ, 1024, 1024}; pg8::StaticOrder S; S.init(M, NPROJ, F.G, (int)blockIdx.x);
        pg8::EpiProj E{PROJ, LDP, RS, 4, USG, SEQ};
        pg8::gemm_phase<pg8::EpiProj, pg8::StaticOrder, true, true>(F.lds + RING_OFF, g, S, E);
        if (F.G == 256 ? blockIdx.x >= 192 : true) { __syncthreads();
            LAS float* scr = (LAS float*)(F.lds + RING_OFF + F.wave * 16384);
            const int nw = (F.G == 256) ? 512 : NGW, w0 = (F.G == 256) ? ((int)blockIdx.x - 192) * NWAVES + F.wave : gw;
            for (int it = w0; it < 512 * 3 + 256; it += nw) { int r = it;
                if (r < 512) { p0_ssm_K_item(log_dt, lam_re, lam_im, b_re, b_im, c_re, c_im, TQ, r >> 4, r & 15, scr, F.lane); continue; } r -= 512;
                if (r < 512) { p0_ssm_Q_item(log_dt, lam_re, lam_im, c_re, c_im, TQ, r >> 4, r & 15, F.lane); continue; } r -= 512;
                if (r < 512) { p0_ssm_P_item(log_dt, lam_re, lam_im, b_re, b_im, PPM, r >> 4, r & 15, F.lane); continue; } r -= 512;
                { const v4u z0 = {0u, 0u, 0u, 0u}; GAS v4u* pz = (GAS v4u*)(PPM + ((size_t)(r >> 3) * 256 + 128 + (r & 7) * 16) * 256);
#pragma unroll
                  for (int q = 0; q < 8; ++q) pz[F.lane + 64 * q] = z0; } } }
    }
    SEAM(1);

    if (IN(2)) {
        { const pg8::MlaAux AUX{RS, ROPE, PROJ, LDP, PC_KR};
          if (F.G == 256) {
            { pg8::Gemm g{PROJ + PC_CQ, WQ_T, M, 1024, Q_LORA, LDP}; pg8::StaticOrder S; S.init(M, 1024, F.G, (int)blockIdx.x);
              pg8::EpiQ E{AUX, q_norm_g, Qb, 0.10206207261596575f * 1.4426950408889634f, EPS, SEQ};
              pg8::gemm_phase<pg8::EpiQ, pg8::StaticOrder, false, true>(F.lds + RING_OFF, g, S, E); }
            __syncthreads();
            { pg8::Gemm g{PROJ + PC_CKV, WKV_T, M, 1024, KV_LORA, LDP}; pg8::StaticOrder S; S.init(M, 1024, F.G, (int)blockIdx.x);
              pg8::EpiKV E{AUX, k_norm_g, Kb, Vb, EPS, SEQ};
              pg8::gemm_phase<pg8::EpiKV, pg8::StaticOrder, false, true>(F.lds + RING_OFF, g, S, E); }
          } else if (F.tid == 0) __hip_atomic_store(F.ctl + CW_TMO, 1u, RLX_AGENT);
        }
        __syncthreads();
        { pg8::Gemm g{USG, PPM, 32768, 8192, 256, 384}; pg8::DiagOrder S{128, 4, F.G, (int)blockIdx.x, nullptr, 0u, nullptr};
          pg8::EpiELds E{};
          if (F.G >= 128) { pg8::gemm_phase<pg8::EpiELds, pg8::DiagOrder, false, true>(F.lds + RING_OFF, g, S, E);
              pg8::Unit u; const bool has = S.next(0, u);
              __syncthreads();
              if (has && F.wave == 0) pg8::ssm_chain_unit(u, F.lds + RING_OFF, USG, AC, HAND, (unsigned*)(F.ctl + CW_CHAIN), (unsigned*)(F.ctl + CW_TMO), F.lane);
              __syncthreads(); }
          else if (F.tid == 0) __hip_atomic_store(F.ctl + CW_TMO, 1u, RLX_AGENT); }
        { pg8::Gemm g{HB, WIN_T + (size_t)WR_ZM * 1024, M, 512, 1024, 1024}; pg8::StaticOrder S; S.init(M, 512, F.G, (int)((blockIdx.x + 128u) % (unsigned)F.G));
          pg8::EpiH16 E{ZM, 512};
          pg8::gemm_phase<pg8::EpiH16, pg8::StaticOrder, true, true>(F.lds + RING_OFF, g, S, E); }
    }
    SEAM(2);

    if (IN(3)) {
        { pg8::Gemm g{USG, TQ, 32768, 8192, 384, 384}; pg8::DiagOrder S{128, 4, F.G, (int)blockIdx.x, nullptr, 0u, nullptr};
          pg8::EpiY E{USG, d_skip, YPRE, SEQ};
          pg8::gemm_phase<pg8::EpiY, pg8::DiagOrder, true, true>(F.lds + RING_OFF, g, S, E);
          if (F.tid == 0) { pg8::Unit u; for (int i = 0; S.next(i, u); ++i) { const int k4 = u.pm & 3;
              for (int q = 0; q < 16; ++q) __hip_atomic_fetch_add(F.ctl + CW_PANEL + 64 * ((k4 >> 1) * 32 + (k4 & 1) * 16 + q), 1u, RLX_AGENT); } } }
        __syncthreads();
        __syncthreads();
#define RUN_GLU_UNITS() do { \
        { pg8::Gemm g{YPRE, WGLU_T, M, 512, 512, 512}; pg8::PanelOrder S; S.init(M, 512, F.G, (int)((blockIdx.x + 128u) % (unsigned)F.G)); S.cnt = (unsigned*)(F.ctl + CW_PANEL); S.want = 32u; S.tmo = (unsigned*)(F.ctl + CW_TMO); \
          pg8::EpiGlu E{YPRE, PROJ, LDP, PC_ZS, b_glu, YCAT}; \
          pg8::gemm_phase<pg8::EpiGlu, pg8::PanelOrder, true, true>(F.lds + RING_OFF, g, S, E); \
          if (F.tid == 0) { pg8::Unit u; for (int i = 0; S.next(i, u); ++i) __hip_atomic_fetch_add(F.ctl + CW_OUTP + 64 * u.pm, 1u, RLX_AGENT); } } \
        __syncthreads(); } while (0)
#define OUT_UNIT_OF(k, uu) do { const int pk_ = (k) >> 2; (uu).pm = (pk_ & 1) * 32 + (24 - 8 * (pk_ >> 1)) + j; (uu).pn = (k) & 3; } while (0)
#define RUN_OUT_UNIT(uu) do { if (F.tid < 64) { __builtin_amdgcn_fence(__ATOMIC_ACQUIRE, "agent"); asm volatile("s_waitcnt vmcnt(0)" ::: "memory"); } __syncthreads(); \
            pg8::Gemm g_{YCAT, WOUT_T, M, 1024, 1024, 1024}; pg8::OneUnit S_; S_.u = (uu); pg8::EpiOutRows E_{x, MOD + 2048, 3072, SEQ, args.out}; \
            pg8::gemm_phase<pg8::EpiOutRows, pg8::OneUnit, false, true>(F.lds + RING_OFF, g_, S_, E_); __syncthreads(); } while (0)
        const int j = (int)(blockIdx.x & 7); bool glu_done = false;
        float gqm = 0.f, gkm = 0.f;
        for (int d = F.lane; d < 96; d += 64) { gqm = fmaxf(gqm, fabsf(q_norm_g[d])); gkm = fmaxf(gkm, fabsf(k_norm_g[d])); }
#pragma unroll
        for (int o_ = 32; o_ > 0; o_ >>= 1) { gqm = fmaxf(gqm, __shfl_xor(gqm, o_)); gkm = fmaxf(gkm, __shfl_xor(gkm, o_)); }
        const float sbound = __uint_as_float((unsigned)__builtin_amdgcn_readfirstlane((int)__float_as_uint(96.f * 0.14724445f * 1.01f * gqm * gkm + 0.1f)));
        const bool fixed_ok = sbound <= 17.5f; const float mfix = sbound - 15.f;
        bool popped = false;
        for (;;) {
            if (!popped && F.tid == 0) F.MISC[16] = __hip_atomic_fetch_add(F.ctl + CW_ATTQ + 64 * j, 1u, RLX_AGENT);
            __syncthreads();
            const unsigned ua = (unsigned)__builtin_amdgcn_readfirstlane((int)F.MISC[16]);
            __syncthreads();
            if (ua >= 64u) break;
            const int bh = 2 * j + (int)(ua & 1u), qb = 31 - (int)(ua >> 1);
            const bool early = glu_done || ((blockIdx.x + 128u) % (unsigned)F.G) >= 128u;
            if (fixed_ok) att::attn_unit<true>(bh >> 3, bh & 7, qb, Qb, Kb, Vb, ZM, 512, 0, YCAT, (char*)lds + RING_OFF, F.lds + RING_OFF, (unsigned*)(F.ctl + CW_OUTP + 64 * ((bh >> 3) * 32 + qb)), nullptr, (unsigned*)(F.ctl + CW_TMO), early ? CW_ATTQ - CW_TMO : -1, MISC_OFF - RING_OFF + 16 * 4, mfix);
            else att::attn_unit<false>(bh >> 3, bh & 7, qb, Qb, Kb, Vb, ZM, 512, 0, YCAT, (char*)lds + RING_OFF, F.lds + RING_OFF, (unsigned*)(F.ctl + CW_OUTP + 64 * ((bh >> 3) * 32 + qb)), nullptr, (unsigned*)(F.ctl + CW_TMO), early ? CW_ATTQ - CW_TMO : -1, MISC_OFF - RING_OFF + 16 * 4, 0.f);
            popped = early;
            if (!glu_done) { glu_done = true; RUN_GLU_UNITS(); }
            if (F.tid == 0) { unsigned k = __hip_atomic_load(F.ctl + CW_OUTQ + 64 * j, RLX_AGENT), got = 0xffffffffu;
                if (MK_CLAIM_BETWEEN && k < 32u) { pg8::Unit t; OUT_UNIT_OF((int)k, t);
                    if (__hip_atomic_load(F.ctl + CW_OUTP + 64 * t.pm, RLX_AGENT) >= 10u) { unsigned e = k;
                        if (__hip_atomic_compare_exchange_strong(F.ctl + CW_OUTQ + 64 * j, &e, k + 1u, __ATOMIC_RELAXED, __ATOMIC_RELAXED, __HIP_MEMORY_SCOPE_AGENT)) got = k; } }
                F.MISC[17] = got; }
            __syncthreads();
            const unsigned ko = (unsigned)__builtin_amdgcn_readfirstlane((int)F.MISC[17]);
            __syncthreads();
            if (ko != 0xffffffffu) { pg8::Unit uo; OUT_UNIT_OF((int)ko, uo); RUN_OUT_UNIT(uo); }
        }
        if (!glu_done) { glu_done = true; RUN_GLU_UNITS(); }
        for (;;) {
            if (F.tid == 0) F.MISC[17] = __hip_atomic_fetch_add(F.ctl + CW_OUTQ + 64 * j, 1u, RLX_AGENT);
            __syncthreads();
            const unsigned ko = (unsigned)__builtin_amdgcn_readfirstlane((int)F.MISC[17]);
            __syncthreads();
            if (ko >= 32u) break;
            pg8::Unit uo; OUT_UNIT_OF((int)ko, uo);
            if (F.tid < 64) { unsigned sp = 0;
                while (__hip_atomic_load(F.ctl + CW_OUTP + 64 * uo.pm, RLX_AGENT) < 10u) { __builtin_amdgcn_s_sleep(4);
                    if (++sp > (1u << 22)) { if (F.tid == 0) __hip_atomic_store(F.ctl + CW_TMO, 1u, RLX_AGENT); break; } }
                if (F.tid == 0) __hip_atomic_fetch_add(F.ctl + CW_RDV + 64 * uo.pm, 1u, RLX_AGENT);
                sp = 0; while (__hip_atomic_load(F.ctl + CW_RDV + 64 * uo.pm, RLX_AGENT) < 4u && ++sp < 20000u) __builtin_amdgcn_s_sleep(2); }
            RUN_OUT_UNIT(uo);
        }
#undef OUT_UNIT_OF
#undef RUN_GLU_UNITS
#undef RUN_OUT_UNIT
    }
#undef IN
#undef SEAM
}

#ifndef MK_MODE
#define MK_MODE 2
#endif
#ifndef MK_FAST_MASK
#define MK_FAST_MASK 0x7
#endif
extern "C" void kernel_launch(void* const* d_in, const int* in_sizes, int n_in, void* d_out, int out_size, void* d_ws, size_t ws_size, hipStream_t stream) {
    static int grid = 0;
    if (grid == 0) {
        if (n_in != 24 || in_sizes[0] != M * DM || out_size != M * DM || ws_size < WS_END) { fprintf(stderr, "kernel_launch: unexpected shapes (n_in %d, in0 %d, out %d, ws %zu)\n", n_in, n_in > 0 ? in_sizes[0] : -1, out_size, ws_size); grid = -1; return; }
        int dev = 0, cus = 0, per_cu = 0;
        if (hipGetDevice(&dev) != hipSuccess || hipDeviceGetAttribute(&cus, hipDeviceAttributeMultiprocessorCount, dev) != hipSuccess) { fprintf(stderr, "kernel_launch: device query failed\n"); grid = -1; return; }
        if (hipFuncSetAttribute((const void*)mega_fwd, hipFuncAttributeMaxDynamicSharedMemorySize, LDS_BYTES) != hipSuccess) { fprintf(stderr, "kernel_launch: hipFuncSetAttribute failed\n"); grid = -1; return; }
        if (hipOccupancyMaxActiveBlocksPerMultiprocessor(&per_cu, (const void*)mega_fwd, NWAVES * 64, LDS_BYTES) != hipSuccess || per_cu < 1)
            fprintf(stderr, "kernel_launch: note: occupancy query reports %d workgroups per CU\n", per_cu);
        (void)hipGetLastError();
        grid = cus;
    }
    if (grid < 0) return;
    const float* x = (const float*)d_in[0]; const float* c = (const float*)d_in[1]; const int* positions = (const int*)d_in[2];
    const float* w_ada = (const float*)d_in[3]; const float* b_ada = (const float*)d_in[4]; const float* norm_g = (const float*)d_in[5];
    const float* w_in = (const float*)d_in[6]; const float* log_dt = (const float*)d_in[7]; const float* lam_re = (const float*)d_in[8];
    const float* lam_im = (const float*)d_in[9]; const float* b_re = (const float*)d_in[10]; const float* b_im = (const float*)d_in[11];
    const float* c_re = (const float*)d_in[12]; const float* c_im = (const float*)d_in[13]; const float* d_skip = (const float*)d_in[14];
    const float* w_glu = (const float*)d_in[15]; const float* b_glu = (const float*)d_in[16]; const float* q_a_g = (const float*)d_in[17];
    const float* w_q_b = (const float*)d_in[18]; const float* kv_a_g = (const float*)d_in[19]; const float* w_kv_b = (const float*)d_in[20];
    const float* q_norm_g = (const float*)d_in[21]; const float* k_norm_g = (const float*)d_in[22]; const float* w_out = (const float*)d_in[23];
    unsigned char* ws = (unsigned char*)d_ws; float* out = (float*)d_out;
    float* MOD = (float*)(ws + WS_MOD); bf16* PROJ = (bf16*)(ws + WS_PROJ); bf16* HB = (bf16*)(ws + WS_HB); bf16* QRAW = (bf16*)(ws + WS_HB); bf16* YCAT = (bf16*)(ws + WS_YCAT); bf16* ZM = (bf16*)(ws + WS_ZM);
    bf16* KVRAW = (bf16*)(ws + WS_KVRAW); bf16* Qb = (bf16*)(ws + WS_Q); bf16* Kb = (bf16*)(ws + WS_K); bf16* Vb = (bf16*)(ws + WS_V);
    bf16* CQN = (bf16*)(ws + WS_CQN); bf16* CKVN = (bf16*)(ws + WS_CKVN); bf16* YPRE = (bf16*)(ws + WS_YPRE);
    (void)x; (void)c; (void)positions; (void)w_ada; (void)b_ada; (void)norm_g; (void)w_in; (void)log_dt; (void)lam_re; (void)lam_im; (void)b_re; (void)b_im; (void)c_re; (void)c_im; (void)d_skip;
    (void)w_glu; (void)b_glu; (void)q_a_g; (void)w_q_b; (void)kv_a_g; (void)w_kv_b; (void)q_norm_g; (void)k_norm_g; (void)w_out; (void)MOD; (void)PROJ; (void)HB; (void)QRAW; (void)YCAT;
    (void)KVRAW; (void)Qb; (void)Kb; (void)Vb; (void)CQN; (void)CKVN; (void)YPRE; (void)out;

    Args a{}; int n_mega = 0;
    for (int i = 0; i < 24; ++i) a.in[i] = (const float*)d_in[i];
    a.out = out; a.ws = ws;
#define MEGA(lo_, hi_) do { a.ph_lo = (lo_); a.ph_hi = (hi_); a.li = n_mega++; hipLaunchKernelGGL(mega_fwd, dim3(grid), dim3(NWAVES * 64), LDS_BYTES, stream, a); } while (0)
#if MK_MODE == 2
    if (hipMemsetAsync(ws + WS_CTL, 0, CTL_ZERO_BYTES, stream) != hipSuccess) { fprintf(stderr, "kernel_launch: memset failed\n"); return; }
#if MK_DOUBLE >= 0
    MEGA(0, MK_DOUBLE + 1); MEGA(MK_DOUBLE, NPHASE);
#else
    MEGA(0, NPHASE);
#endif
#else
    const unsigned fast = (MK_MODE == 0) ? 0u : (unsigned)MK_FAST_MASK;
    (void)hipMemsetAsync(ws + WS_CTL, 0, CTL_ZERO_BYTES, stream);
    if (MK_MODE != 0) MEGA(0, 1);
    if (!(fast & 1u)) { hipLaunchKernelGGL(v0_mod, dim3(24), dim3(256), 0, stream, c, w_ada, b_ada, MOD); hipLaunchKernelGGL(v0_h, dim3(M), dim3(256), 0, stream, x, norm_g, MOD, HB); }
    if (fast & 2u) MEGA(1, 2); else {
        const int seg[5][3] = {{PC_U, SC_U, 512}, {PC_ZS, SC_ZS, 512}, {PC_CKV, SC_CKV, 256}, {PC_CQ, SC_CQ, 384}, {PC_KR, SC_KR, 32}};
        for (int s = 1; s < 5; ++s) hipLaunchKernelGGL(v0_gemm, dim3(M), dim3(256), 1024 * 4, stream, HB, 1024, 1024, w_in, D_IN, seg[s][1], PROJ, LDP, seg[s][0], seg[s][2]);
        hipLaunchKernelGGL(v0_usg, dim3(M), dim3(256), 1024 * 4, stream, HB, w_in, D_IN, (bf16*)(ws + WS_USG));
        hipLaunchKernelGGL(v0_gemm, dim3(M), dim3(256), 1024 * 4, stream, HB, 1024, 1024, w_in, D_IN, SC_ZM, ZM, 512, 0, 512); }
    if (fast & 4u) { MEGA(2, 3); MEGA(3, 4); }
    else { hipLaunchKernelGGL(v0_cqn, dim3(M), dim3(256), 0, stream, PROJ, q_a_g, kv_a_g, CQN, CKVN);
        for (int h = 0; h < NH; ++h) hipLaunchKernelGGL(v0_gemm, dim3(M), dim3(128), 384 * 4, stream, CQN, 384, 384, w_q_b, 768, h * 96, QRAW, 1024, h * 128, 96);
        hipLaunchKernelGGL(v0_gemm, dim3(M), dim3(256), 256 * 4, stream, CKVN, 256, 256, w_kv_b, 1024, 0, KVRAW, 1024, 0, 1024);
        hipLaunchKernelGGL(v0_qkv, dim3(M * NH * 2 / 256), dim3(256), 0, stream, QRAW, KVRAW, PROJ, positions, q_norm_g, k_norm_g, Qb, Kb, Vb);
        hipLaunchKernelGGL(v0_ssm, dim3(BATCH * SSM_G), dim3(64), 0, stream, (bf16*)(ws + WS_USG), log_dt, lam_re, lam_im, b_re, b_im, c_re, c_im, d_skip, YPRE);
        hipLaunchKernelGGL(v0_attn, dim3(BATCH * NH * (SEQ / 256)), dim3(256), 0, stream, Qb, Kb, Vb, ZM, YCAT);
        hipLaunchKernelGGL(v0_glu, dim3(M), dim3(256), 0, stream, YPRE, w_glu, b_glu, PROJ, YCAT);
        hipLaunchKernelGGL(v0_out, dim3(M), dim3(256), 0, stream, YCAT, w_out, x, MOD, out); }
#endif
    const hipError_t le = hipPeekAtLastError();
    if (le != hipSuccess) fprintf(stderr, "kernel_launch: launch failed: %s\n", hipGetErrorName(le));
}
```

```cpp
#include <hip/hip_runtime.h>
#include <cstdio>
#include <cstdint>
#ifndef MK_CLAIM_BETWEEN
#define MK_CLAIM_BETWEEN 0
#endif
#ifndef MK_DOUBLE
#define MK_DOUBLE (-1)
#endif

constexpr int BATCH = 2, SEQ = 8192, DM = 1024, M = BATCH * SEQ;
constexpr int SSM_W = 512, SSM_G = 32, SSM_GC = 16, SSM_P = 64;
constexpr int NH = 8, QK_NOPE = 64, QK_ROPE = 32, QK_HEAD = 96, V_HEAD = 64, MLA_W = 512, Q_LORA = 384, KV_LORA = 256;
constexpr int D_IN = 2208;
constexpr float EPS = 1e-6f;
constexpr int NPROJ = 1792;
constexpr int LDP = 1280;
constexpr int PC_U = 0, PC_ZS = 0, PC_CKV = 512, PC_CQ = 768, PC_KR = 1152;
constexpr int GC_KR = 1664;
constexpr int WR_ZM = 1792;
constexpr int SC_U = 0, SC_ZS = 512, SC_CQ = 1024, SC_CKV = 1408, SC_KR = 1664, SC_ZM = 1696;

constexpr size_t MiB = 1u << 20;
constexpr size_t WS_CTL = 0, CTL_ZERO_BYTES = 416 * 1024;
constexpr size_t WS_MOD = 1 * MiB;
constexpr size_t WS_AC = 1 * MiB + 64 * 1024;
constexpr size_t WS_BB = 1 * MiB + 128 * 1024;
constexpr size_t WS_CB = 1 * MiB + 256 * 1024;
constexpr size_t WS_E = 2 * MiB;
constexpr size_t WS_WIN = 4 * MiB;
constexpr size_t WS_WQ = 9 * MiB;
constexpr size_t WS_WKV = 10 * MiB;
constexpr size_t WS_WGLU = 11 * MiB;
constexpr size_t WS_WOUT = 12 * MiB;
constexpr size_t WS_PROJ = 16 * MiB;
constexpr size_t WS_USG = 56 * MiB;
constexpr size_t WS_ZM = 80 * MiB;
constexpr size_t WS_HB = 96 * MiB;
constexpr size_t WS_YCAT = 128 * MiB;
constexpr size_t WS_KVRAW = 128 * MiB;
constexpr size_t WS_Q = 160 * MiB;
constexpr size_t WS_CQN = 160 * MiB;
constexpr size_t WS_CKVN = 172 * MiB;
constexpr size_t WS_K = 184 * MiB;
constexpr size_t WS_V = 208 * MiB;
constexpr size_t WS_YPRE = 224 * MiB;
constexpr size_t WS_TQ = 240 * MiB;
constexpr size_t WS_PP = 246 * MiB;
constexpr size_t WS_ROPE = 250 * MiB;
constexpr size_t WS_HAND = 252 * MiB;
constexpr size_t WS_RS = 14 * MiB;
constexpr size_t WS_END = 253 * MiB;

typedef unsigned short bf16;
__device__ __forceinline__ unsigned f2bf(float f) { return (unsigned)__builtin_bit_cast(unsigned short, (_Float16)f); }
__device__ __forceinline__ float bf2f(bf16 b) { return (float)__builtin_bit_cast(_Float16, b); }
__device__ __forceinline__ float silu_f(float v) { return v / (1.f + __expf(-v)); }
__device__ __forceinline__ float sigmoid_f(float v) { return 1.f / (1.f + __expf(-v)); }
__device__ __forceinline__ float gelu_tanh(float v) { const float z = 0.7978845608028654f * (v + 0.044715f * v * v * v); return v / (1.f + __expf(-2.f * z)); }

__device__ __forceinline__ float block_sum_256(float v, float* red) {
    for (int o = 32; o > 0; o >>= 1) v += __shfl_xor(v, o);
    const int w = threadIdx.x >> 6;
    __syncthreads();
    if ((threadIdx.x & 63) == 0) red[w] = v;
    __syncthreads();
    float s = 0.f; for (int i = 0; i < (int)(blockDim.x >> 6); ++i) s += red[i];
    return s;
}

__global__ void v0_mod(const float* c, const float* w_ada, const float* b_ada, float* mod) {
    const int idx = blockIdx.x * blockDim.x + threadIdx.x; if (idx >= BATCH * 3 * DM) return;
    const int b = idx / (3 * DM), n = idx % (3 * DM);
    float acc = b_ada[n];
    for (int k = 0; k < DM; ++k) acc += silu_f(c[b * DM + k]) * w_ada[(size_t)k * 3 * DM + n];
    mod[idx] = acc;
}
__global__ void v0_h(const float* x, const float* norm_g, const float* mod, bf16* hb) {
    __shared__ float red[8];
    const int m = blockIdx.x, b = m / SEQ, t = threadIdx.x;
    float v[4], ss = 0.f;
    for (int j = 0; j < 4; ++j) { v[j] = x[(size_t)m * DM + t + 256 * j]; ss += v[j] * v[j]; }
    ss = block_sum_256(ss, red);
    const float rstd = 1.f / sqrtf(ss / DM + EPS);
    for (int j = 0; j < 4; ++j) { const int e = t + 256 * j;
        const float hv = v[j] * rstd * norm_g[e] * (1.f + mod[b * 3 * DM + DM + e]) + mod[b * 3 * DM + e];
        hb[(size_t)m * DM + e] = (bf16)f2bf(hv); }
}
__global__ void v0_gemm(const bf16* A, int lda, int K, const float* W, int ldw, int src0, bf16* C, int ldc, int dst0, int width) {
    extern __shared__ float arow[];
    const int m = blockIdx.x;
    for (int k = threadIdx.x; k < K; k += blockDim.x) arow[k] = bf2f(A[(size_t)m * lda + k]);
    __syncthreads();
    for (int j = threadIdx.x; j < width; j += blockDim.x) {
        float acc = 0.f;
        for (int k = 0; k < K; ++k) acc += arow[k] * W[(size_t)k * ldw + src0 + j];
        C[(size_t)m * ldc + dst0 + j] = (bf16)f2bf(acc);
    }
}
__global__ void v0_usg(const bf16* A, const float* W, int ldw, bf16* USG) {
    extern __shared__ float arow[];
    const int m = blockIdx.x, b = m / SEQ, t = m % SEQ;
    for (int k = threadIdx.x; k < 1024; k += blockDim.x) arow[k] = bf2f(A[(size_t)m * 1024 + k]);
    __syncthreads();
    for (int c = threadIdx.x; c < 512; c += blockDim.x) { float acc = 0.f;
        for (int k = 0; k < 1024; ++k) acc += arow[k] * W[(size_t)k * ldw + c];
        USG[((size_t)(c >> 4) * 1024 + b * 512 + (t >> 4)) * 384 + (t & 15) * 16 + (c & 15)] = (bf16)f2bf(acc); }
}
__global__ void v0_cqn(const bf16* proj, const float* q_a_g, const float* kv_a_g, bf16* cqn, bf16* ckvn) {
    __shared__ float red[8];
    const int m = blockIdx.x, t = threadIdx.x;
    float a = 0.f, b2 = 0.f, ss = 0.f;
    if (t < 192) { a = bf2f(proj[(size_t)m * LDP + PC_CQ + t]); b2 = bf2f(proj[(size_t)m * LDP + PC_CQ + 192 + t]); ss = a * a + b2 * b2; }
    ss = block_sum_256(ss, red);
    float rstd = 1.f / sqrtf(ss / Q_LORA + EPS);
    if (t < 192) { cqn[(size_t)m * Q_LORA + t] = (bf16)f2bf(a * rstd * q_a_g[t]); cqn[(size_t)m * Q_LORA + 192 + t] = (bf16)f2bf(b2 * rstd * q_a_g[192 + t]); }
    const float cv = bf2f(proj[(size_t)m * LDP + PC_CKV + t]);
    ss = block_sum_256(cv * cv, red);
    rstd = 1.f / sqrtf(ss / KV_LORA + EPS);
    ckvn[(size_t)m * KV_LORA + t] = (bf16)f2bf(cv * rstd * kv_a_g[t]);
}
__device__ __forceinline__ int v0_vst(int k, int c) { const int kk = (k & ~0xC) | ((k & 4) << 1) | ((k & 8) >> 1); return ((kk >> 3) * 2 + (c >> 5)) * 512 + ((kk & 7) * 32 + (c & 31)) * 2; }
__global__ void __launch_bounds__(256) v0_qkv(const bf16* qraw, const bf16* kvraw, const bf16* proj, const int* positions, const float* q_norm_g, const float* k_norm_g, bf16* Q, bf16* K, bf16* V) {
    const int idx = blockIdx.x * blockDim.x + threadIdx.x; if (idx >= M * NH * 2) return;
    const int which = idx & 1, m = (idx >> 1) / NH, h = (idx >> 1) % NH;
    const float pos = (float)positions[m];
    const float* gn = which ? k_norm_g : q_norm_g;
    float q[96];
    float sq = 0.f;
    if (which == 0) {
#pragma unroll
        for (int d = 0; d < 96; ++d) q[d] = bf2f(qraw[(size_t)m * 1024 + h * 128 + d]);
    } else {
#pragma unroll
        for (int d = 0; d < 64; ++d) q[d] = bf2f(kvraw[(size_t)m * 1024 + h * 128 + d]);
#pragma unroll
        for (int d = 0; d < 32; ++d) q[64 + d] = bf2f(proj[(size_t)m * LDP + PC_KR + d]);
    }
#pragma unroll
    for (int d = 0; d < 96; ++d) sq += q[d] * q[d];
    const float rq = 1.f / sqrtf(sq / 96.f + EPS);
#pragma unroll
    for (int d = 0; d < 96; ++d) q[d] = q[d] * rq * gn[d];
#pragma unroll
    for (int i = 0; i < 16; ++i) {
        const float inv_freq = (float)pow(10000.0, -(double)i / 16.0);
        const float ang = pos * inv_freq;
        const double TWO_PI = 6.283185307179586476925286766559;
        const double r = (double)ang - TWO_PI * rint((double)ang / TWO_PI);
        const float rf = (float)r; const float cs = __cosf(rf), sn = __sinf(rf);
        const float q1 = q[64 + i], q2 = q[80 + i]; q[64 + i] = q1 * cs - q2 * sn; q[80 + i] = q2 * cs + q1 * sn;
    }
    if (which == 0) {
#pragma unroll
        for (int d = 0; d < 96; ++d) Q[(size_t)m * 768 + h * 96 + d] = (bf16)f2bf(q[d] * (0.10206207261596575f * 1.4426950408889634f));
    } else {
        const int bb = m / SEQ, tt = m % SEQ; const size_t tix = (size_t)(bb * 8 + h) * 128 + (tt >> 6); const int row = tt & 63;
#pragma unroll
        for (int d = 0; d < 96; ++d) K[tix * 6144 + (d >> 3) * 512 + row * 8 + (d & 7)] = (bf16)f2bf(q[d]);
        for (int d = 0; d < 64; ++d) V[tix * 4096 + v0_vst(row, d) / 2] = kvraw[(size_t)m * 1024 + h * 128 + 64 + d];
    }
}
__global__ void __launch_bounds__(64) v0_ssm(const bf16* proj, const float* log_dt, const float* lam_re, const float* lam_im, const float* b_re, const float* b_im,
                       const float* c_re, const float* c_im, const float* d_skip, bf16* ypre) {
    __shared__ float sre[64], sim[64], us[16];
    const int b = blockIdx.x / SSM_G, g = blockIdx.x % SSM_G, p = threadIdx.x;
    const double dt = exp((double)log_dt[g]);
    const double lr = lam_re[g * 64 + p], li = lam_im[g * 64 + p];
    const double er = exp(lr * dt), ar = er * cos(li * dt), ai = er * sin(li * dt);
    const double nr = ar - 1.0, ni = ai, den = lr * lr + li * li;
    const double cr = (nr * lr + ni * li) / den, ci = (ni * lr - nr * li) / den;
    float Br[16], Bi[16];
#pragma unroll
    for (int j = 0; j < 16; ++j) { const double br = b_re[(g * 64 + p) * 16 + j], bi = b_im[(g * 64 + p) * 16 + j];
        Br[j] = (float)(cr * br - ci * bi); Bi[j] = (float)(cr * bi + ci * br); }
    const float far = (float)ar, fai = (float)ai;
    float s_r = 0.f, s_i = 0.f;
    const float dsk = p < 16 ? d_skip[g * 16 + p] : 0.f;
    for (int t = 0; t < SEQ; ++t) {
        const size_t row = (size_t)(b * SEQ + t);
        if (p < 16) us[p] = bf2f(proj[((size_t)g * 1024 + b * 512 + (t >> 4)) * 384 + (t & 15) * 16 + p]);
        __syncthreads();
        float bur = 0.f, bui = 0.f;
#pragma unroll
        for (int j = 0; j < 16; ++j) { bur += Br[j] * us[j]; bui += Bi[j] * us[j]; }
        const float nr2 = far * s_r - fai * s_i + bur, ni2 = far * s_i + fai * s_r + bui;
        s_r = nr2; s_i = ni2; sre[p] = s_r; sim[p] = s_i;
        __syncthreads();
        if (p < 16) {
            float y = 0.f;
            for (int q = 0; q < 64; ++q) y += c_re[(g * 16 + p) * 64 + q] * sre[q] - c_im[(g * 16 + p) * 64 + q] * sim[q];
            y += dsk * us[p];
            ypre[row * SSM_W + g * 16 + p] = (bf16)f2bf(gelu_tanh(y));
        }
        __syncthreads();
    }
}
__global__ void __launch_bounds__(256) v0_attn(const bf16* Q, const bf16* K, const bf16* V, const bf16* zm, bf16* ycat) {
    const int qb = blockIdx.x % (SEQ / 256), bh = blockIdx.x / (SEQ / 256), b = bh / NH, h = bh % NH;
    const int qi = qb * 256 + threadIdx.x;
    const size_t qrow = (size_t)b * SEQ + qi;
    float q[96], o[64];
    const float sc = 0.10206207261596575f;
#pragma unroll
    for (int d = 0; d < 96; ++d) q[d] = bf2f(Q[qrow * 768 + h * 96 + d]) * sc;
#pragma unroll
    for (int d = 0; d < 64; ++d) o[d] = 0.f;
    float mx = -1e30f, l = 0.f;
    const int jmax = qb * 256 + 255;
    for (int j = 0; j <= jmax; ++j) {
        const size_t tix = (size_t)(b * 8 + h) * 128 + (j >> 6); const int jr = j & 63;
        const bf16* kp = K + tix * 6144 + jr * 8; const bf16* vp = V + tix * 4096;
        float s = 0.f;
#pragma unroll
        for (int d = 0; d < 96; ++d) s += q[d] * bf2f(kp[(d >> 3) * 512 + (d & 7)]);
        if (j <= qi) {
            const float mn = fmaxf(mx, s); const float al = exp2f(mx - mn), pp = exp2f(s - mn);
            l = l * al + pp;
#pragma unroll
            for (int d = 0; d < 64; ++d) o[d] = o[d] * al + pp * bf2f(vp[v0_vst(jr, d) / 2]);
            mx = mn;
        }
    }
    const float rl = 1.f / l;
#pragma unroll
    for (int d = 0; d < 64; ++d) {
        const float z = bf2f(zm[qrow * 512 + h * 64 + d]);
        ycat[qrow * 1024 + 512 + h * 64 + d] = (bf16)f2bf(o[d] * rl * silu_f(z));
    }
}
__global__ void v0_glu(const bf16* ypre, const float* w_glu, const float* b_glu, const bf16* proj, bf16* ycat) {
    __shared__ float arow[512];
    const int m = blockIdx.x;
    for (int k = threadIdx.x; k < 512; k += blockDim.x) arow[k] = bf2f(ypre[(size_t)m * 512 + k]);
    __syncthreads();
    for (int j = threadIdx.x; j < 512; j += blockDim.x) {
        float acc = b_glu[j];
        for (int k = 0; k < 512; ++k) acc += arow[k] * w_glu[(size_t)k * 512 + j];
        const float z = bf2f(proj[(size_t)m * LDP + PC_ZS + j]);
        ycat[(size_t)m * 1024 + j] = (bf16)f2bf(arow[j] * sigmoid_f(acc) * silu_f(z));
    }
}
__global__ void v0_out(const bf16* ycat, const float* w_out, const float* x, const float* mod, float* out) {
    __shared__ float arow[1024];
    const int m = blockIdx.x, b = m / SEQ;
    for (int k = threadIdx.x; k < 1024; k += blockDim.x) arow[k] = bf2f(ycat[(size_t)m * 1024 + k]);
    __syncthreads();
    for (int j = threadIdx.x; j < 1024; j += blockDim.x) {
        float acc = 0.f;
        for (int k = 0; k < 1024; ++k) acc += arow[k] * w_out[(size_t)k * 1024 + j];
        out[(size_t)m * DM + j] = x[(size_t)m * DM + j] + mod[b * 3 * DM + 2 * DM + j] * acc;
    }
}


typedef unsigned wt_u32x4 __attribute__((ext_vector_type(4)));
__device__ __forceinline__ void store16_wt(void* p, wt_u32x4 v) { asm volatile("global_store_dwordx4 %0, %1, off sc1\n\ts_nop 1" :: "v"(p), "v"(v) : "memory"); }

namespace pg8 {
#define PG8_LAS __attribute__((address_space(3)))
typedef unsigned short bf16_t;
typedef _Float16 bf16x8 __attribute__((ext_vector_type(8)));
typedef float f32x4 __attribute__((ext_vector_type(4)));
typedef unsigned u32x4 __attribute__((ext_vector_type(4)));
constexpr int BM = 256, BK = 64, HALF = 128, HTB = HALF * BK * 2  , STAGE_BYTES = 8 * HTB, NXCD = 8, WGM = 8;

__host__ __device__ __forceinline__ int lds_byte(int r, int c) { const int st = (r >> 4) * 2 + (c >> 5), rr = r & 15, cc = c & 31, ob = rr * 64 + cc * 2; return st * 1024 + (ob ^ (((ob >> 9) & 1) << 5)); }
__host__ __device__ __forceinline__ void stage_rc(int b, int& R, int& C) { const int st = b / 1024, sb = b % 1024, swz = sb ^ (((sb >> 9) & 1) << 5); R = (st >> 1) * 16 + swz / 64; C = (st & 1) * 32 + (swz % 64) / 2; }
__host__ __device__ __forceinline__ int perm32(int rho) { const int n = rho >> 4, i = rho & 15; return 8 * (i >> 2) + 4 * n + (i & 3); }

struct Unit { int pm, pn; };
struct Gemm { const bf16_t* A; const bf16_t* Bt; int M, N, K, lda; };

struct StaticOrder {
    int nM, nN, nwg, G, c;
    __host__ __device__ void init(int M, int N, int G_, int c_) { nM = M / BM; nN = N / BM; nwg = nM * nN; G = G_; c = c_; }
    __host__ __device__ bool next(int i, Unit& u) const {
        const long L = (long)i * G + c; if (L >= nwg) return false;
        int wgid = (int)L; { const int q = nwg / NXCD, r = nwg % NXCD, xcd = wgid % NXCD, off = wgid / NXCD; wgid = (xcd < r ? xcd * (q + 1) : r * (q + 1) + (xcd - r) * q) + off; }
        const int nig = WGM * nN, gid = wgid / nig, fm = gid * WGM, gsz = (nM - fm) < WGM ? (nM - fm) : WGM;
        u.pm = fm + ((wgid % nig) % gsz); u.pn = (wgid % nig) / gsz; return true;
    }
    __device__ __forceinline__ void a_ready(const Unit&) const {}
    __device__ __forceinline__ void done(const Unit&) const {}
};


struct DiagOrder {
    int nunits, per, G, c; unsigned* cnt; unsigned want; unsigned* tmo;
    __device__ __forceinline__ bool next(int i, Unit& u) const { const int L = i * G + c; if (L >= nunits) return false; u.pm = L; u.pn = L / per; return true; }
    __device__ __forceinline__ void a_ready(const Unit& u) const {
        if (!cnt) return;
        if (threadIdx.x < 64) { unsigned sp = 0;
            while (__hip_atomic_load(cnt + 64 * u.pm, __ATOMIC_RELAXED, __HIP_MEMORY_SCOPE_AGENT) < want) { __builtin_amdgcn_s_sleep(2);
                if (++sp > (1u << 22)) { if (threadIdx.x == 0) __hip_atomic_store(tmo, 1u, __ATOMIC_RELAXED, __HIP_MEMORY_SCOPE_AGENT); break; } }
            __builtin_amdgcn_fence(__ATOMIC_ACQUIRE, "agent"); asm volatile("s_waitcnt vmcnt(0)" ::: "memory"); }
        __syncthreads();
    }
    __device__ __forceinline__ void done(const Unit&) const {}
};
struct OneUnit { Unit u;
    __device__ __forceinline__ bool next(int i, Unit& x) const { if (i) return false; x = u; return true; }
    __device__ __forceinline__ void a_ready(const Unit&) const {}
    __device__ __forceinline__ void done(const Unit&) const {} };
struct PanelOrder : StaticOrder {
    unsigned* cnt; unsigned want; unsigned* tmo;
    __device__ __forceinline__ void a_ready(const Unit& u) const {
        if (threadIdx.x < 64) { unsigned sp = 0;
            while (__hip_atomic_load(cnt + 64 * u.pm, __ATOMIC_RELAXED, __HIP_MEMORY_SCOPE_AGENT) < want) { __builtin_amdgcn_s_sleep(2);
                if (++sp > (1u << 22)) { if (threadIdx.x == 0) __hip_atomic_store(tmo, 1u, __ATOMIC_RELAXED, __HIP_MEMORY_SCOPE_AGENT); break; } }
            __builtin_amdgcn_fence(__ATOMIC_ACQUIRE, "agent"); asm volatile("s_waitcnt vmcnt(0)" ::: "memory"); }
        __syncthreads();
    }
};

typedef float f32x2 __attribute__((ext_vector_type(2)));
typedef _Float16 f16x2 __attribute__((ext_vector_type(2)));
__device__ __forceinline__ unsigned cvt_pk_h(float lo, float hi) { const f16x2 v = __builtin_convertvector((f32x2){lo, hi}, f16x2); return __builtin_bit_cast(unsigned, v); }
__device__ __forceinline__ float h_lo(unsigned w) { return (float)__builtin_bit_cast(f16x2, w)[0]; }
__device__ __forceinline__ float h_hi(unsigned w) { return (float)__builtin_bit_cast(f16x2, w)[1]; }
__device__ __forceinline__ float fsilu(float v) { return v * __builtin_amdgcn_rcpf(1.f + __builtin_amdgcn_exp2f(-1.4426950408889634f * v)); }
__device__ __forceinline__ float fsigm(float v) { return __builtin_amdgcn_rcpf(1.f + __builtin_amdgcn_exp2f(-1.4426950408889634f * v)); }
__device__ __forceinline__ float fglu3(float y, float t, float z) {
    return y * z * __builtin_amdgcn_rcpf((1.f + __builtin_amdgcn_exp2f(-1.4426950408889634f * t)) * (1.f + __builtin_amdgcn_exp2f(-1.4426950408889634f * z))); }

struct EpiH16 {
    static constexpr bool PERM = true, AFTER_DRAIN = false;
    bf16_t* O; int ldc;
    __device__ __forceinline__ void operator()(const f32x4 (&acc)[2][2][4][2], const Unit& u, int wr, int wc, int fr, int fq) const {
        const int row0 = u.pm * BM + wr * 64 + fr, col0 = u.pn * BM + wc * 32 + 8 * fq;
#pragma unroll
        for (int ai = 0; ai < 2; ++ai)
#pragma unroll
            for (int m = 0; m < 4; ++m) { bf16_t* rowp = O + (size_t)(row0 + ai * HALF + m * 16) * ldc + col0;
#pragma unroll
                for (int bj = 0; bj < 2; ++bj) { const f32x4 v0 = acc[ai][bj][m][0], v1 = acc[ai][bj][m][1];
                    u32x4 w; w.x = cvt_pk_h(v0[0], v0[1]); w.y = cvt_pk_h(v0[2], v0[3]); w.z = cvt_pk_h(v1[0], v1[1]); w.w = cvt_pk_h(v1[2], v1[3]);
                    store16_wt(rowp + bj * HALF, w); } }
    }
};
struct EpiProj {
    static constexpr bool PERM = true, AFTER_DRAIN = false;
    bf16_t* O; int ldc; float* RS; int rs_pn0; bf16_t* USG; int seq;
    __device__ __forceinline__ void operator()(const f32x4 (&acc)[2][2][4][2], const Unit& u, int wr, int wc, int fr, int fq) const {
        const int row0 = u.pm * BM + wr * 64 + fr, col0 = u.pn * BM + wc * 32 + 8 * fq;
#pragma unroll
        for (int ai = 0; ai < 2; ++ai)
#pragma unroll
            for (int m = 0; m < 4; ++m) { const int grow = row0 + ai * HALF + m * 16; bf16_t* rowp = O + (size_t)grow * ldc + col0 - 512;
                const int bb = grow / seq, tt = grow % seq;
#pragma unroll
                for (int bj = 0; bj < 2; ++bj) { const f32x4 v0 = acc[ai][bj][m][0], v1 = acc[ai][bj][m][1];
                    u32x4 w; w.x = cvt_pk_h(v0[0], v0[1]); w.y = cvt_pk_h(v0[2], v0[3]); w.z = cvt_pk_h(v1[0], v1[1]); w.w = cvt_pk_h(v1[2], v1[3]);
                    if (u.pn < 2) { const int c = col0 + bj * HALF;
                        *(u32x4*)(USG + ((size_t)(c >> 4) * 1024 + bb * 512 + (tt >> 4)) * 384 + (tt & 15) * 16 + (c & 15)) = w;
                    }
                    else *(u32x4*)(rowp + bj * HALF) = w; } }
        if (u.pn >= rs_pn0) {
#pragma unroll
            for (int ai = 0; ai < 2; ++ai)
#pragma unroll
                for (int m = 0; m < 4; ++m)
#pragma unroll
                    for (int bj = 0; bj < 2; ++bj) { const f32x4 v0 = acc[ai][bj][m][0], v1 = acc[ai][bj][m][1];
                        float q = (v0[0] * v0[0] + v0[1] * v0[1]) + (v0[2] * v0[2] + v0[3] * v0[3]) + (v1[0] * v1[0] + v1[1] * v1[1]) + (v1[2] * v1[2] + v1[3] * v1[3]);
                        q += __shfl_xor(q, 16); q += __shfl_xor(q, 32);
                        if (fq == 0) RS[((size_t)(row0 + ai * HALF + m * 16) * 3 + (u.pn - rs_pn0)) * 8 + bj * 4 + wc] = q; }
        }
    }
};
struct MlaAux { const float* RS; const float* rope; const bf16_t* proj; int ldp, krcol0; };
constexpr int MLA_TBL = 8192, MLA_ROPE = 12288, MLA_KR = 45056;
__device__ __forceinline__ void mla_stage_rows(const MlaAux& A, const Unit& u, PG8_LAS unsigned char* lds, int tid, bool want_kr, float eps) {
    const size_t row0 = (size_t)u.pm * BM;
    u32x4 rp[4];
#pragma unroll
    for (int j = 0; j < 4; ++j) rp[j] = *(const u32x4*)((const char*)(A.rope + row0 * 32) + (size_t)(tid + 512 * j) * 16);
    u32x4 kr[2] = {{0u, 0u, 0u, 0u}, {0u, 0u, 0u, 0u}};
    if (want_kr) {
#pragma unroll
        for (int j = 0; j < 2; ++j) { const int c = tid + 512 * j; kr[j] = *(const u32x4*)(A.proj + (row0 + (c >> 2)) * A.ldp + A.krcol0 + 8 * (c & 3)); } }
    if (tid < 256) { const float* rs = A.RS + (row0 + tid) * 24;
        const f32x4 s6a = *(const f32x4*)rs, s6b = *(const f32x4*)(rs + 4), s7a = *(const f32x4*)(rs + 8), s7b = *(const f32x4*)(rs + 12), s8a = *(const f32x4*)(rs + 16); const float skr = rs[20];
        const float sq = ((s7a[0] + s7a[1]) + (s7a[2] + s7a[3])) + ((s7b[0] + s7b[1]) + (s7b[2] + s7b[3])) + ((s8a[0] + s8a[1]) + (s8a[2] + s8a[3]));
        const float skv = ((s6a[0] + s6a[1]) + (s6a[2] + s6a[3])) + ((s6b[0] + s6b[1]) + (s6b[2] + s6b[3]));
        *(PG8_LAS f32x4*)(lds + MLA_TBL + tid * 16) = (f32x4){1.f / sqrtf(sq * (1.f / 384.f) + eps), 1.f / sqrtf(skv * (1.f / 256.f) + eps), skr, 0.f}; }
#pragma unroll
    for (int j = 0; j < 4; ++j) *(PG8_LAS u32x4*)(lds + MLA_ROPE + (tid + 512 * j) * 16) = rp[j];
    if (want_kr) {
#pragma unroll
        for (int j = 0; j < 2; ++j) *(PG8_LAS u32x4*)(lds + MLA_KR + (tid + 512 * j) * 16) = kr[j]; }
}
struct EpiQ {
    static constexpr bool PERM = true, AFTER_DRAIN = true;
    MlaAux A; const float* gq; bf16_t* Q; float qscale, eps; int seq;
    __device__ __forceinline__ void fused(f32x4 (&acc)[2][2][4][2], const Unit& u, int wr, int wc, int fr, int fq, PG8_LAS unsigned char* lds, int wid, int lane) const {
        PG8_LAS float* P = (PG8_LAS float*)lds;
#pragma unroll
        for (int ai = 0; ai < 2; ++ai)
#pragma unroll
            for (int m = 0; m < 4; ++m)
#pragma unroll
                for (int bj = 0; bj < 2; ++bj) { const f32x4 v0 = acc[ai][bj][m][0], v1 = acc[ai][bj][m][1];
                    float q = (v0[0] * v0[0] + v0[1] * v0[1]) + (v0[2] * v0[2] + v0[3] * v0[3]) + (v1[0] * v1[0] + v1[1] * v1[1]) + (v1[2] * v1[2] + v1[3] * v1[3]);
                    q += __shfl_xor(q, 16); q += __shfl_xor(q, 32);
                    if (fq == 0) P[((ai * HALF + wr * 64 + m * 16 + fr) * 2 + bj) * 4 + wc] = q; }
        mla_stage_rows(A, u, lds, wid * 64 + lane, false, eps);
        asm volatile("s_waitcnt lgkmcnt(0)" ::: "memory"); __builtin_amdgcn_s_barrier(); asm volatile("" ::: "memory");
        if (wc == 3) return;
        const int d0 = 32 * wc + 8 * fq;
        const f32x4 g0 = *(const f32x4*)(gq + (wc == 2 ? 64 + 8 * fq : d0)), g1 = *(const f32x4*)(gq + (wc == 2 ? 64 + 8 * fq : d0) + 4);
#pragma unroll
        for (int ai = 0; ai < 2; ++ai)
#pragma unroll
            for (int m = 0; m < 4; ++m) { const int r = ai * HALF + wr * 64 + m * 16 + fr; const size_t grow = (size_t)u.pm * BM + r;
                const float rstd = (*(const PG8_LAS f32x4*)(lds + MLA_TBL + r * 16))[0];
                f32x4 cs0 = {0.f, 0.f, 0.f, 0.f}, cs1 = cs0, cs2 = cs0, cs3 = cs0;
                if (wc == 2) { const PG8_LAS float* rp = (const PG8_LAS float*)(lds + MLA_ROPE) + (r * 16 + 8 * (fq & 1)) * 2; cs0 = *(const PG8_LAS f32x4*)rp; cs1 = *(const PG8_LAS f32x4*)(rp + 4); cs2 = *(const PG8_LAS f32x4*)(rp + 8); cs3 = *(const PG8_LAS f32x4*)(rp + 12); }
#pragma unroll
                for (int bj = 0; bj < 2; ++bj) { const f32x4 pp = *(const PG8_LAS f32x4*)(P + (r * 2 + bj) * 4);
                    const float tot = (pp[0] + pp[1]) + pp[2];
                    const float rs = qscale * rstd * __builtin_amdgcn_rsqf(rstd * rstd * tot * (1.f / 96.f) + eps);
                    f32x4 v0 = acc[ai][bj][m][0] * rs * g0, v1 = acc[ai][bj][m][1] * rs * g1;
                    if (wc == 2) {
                        f32x4 o0, o1;
#pragma unroll
                        for (int e = 0; e < 4; ++e) { o0[e] = __shfl_xor(v0[e], 32); o1[e] = __shfl_xor(v1[e], 32); }
                        const float sg = (fq < 2) ? -1.f : 1.f;
                        v0[0] = v0[0] * cs0[0] + sg * o0[0] * cs0[1]; v0[1] = v0[1] * cs0[2] + sg * o0[1] * cs0[3]; v0[2] = v0[2] * cs1[0] + sg * o0[2] * cs1[1]; v0[3] = v0[3] * cs1[2] + sg * o0[3] * cs1[3];
                        v1[0] = v1[0] * cs2[0] + sg * o1[0] * cs2[1]; v1[1] = v1[1] * cs2[2] + sg * o1[1] * cs2[3]; v1[2] = v1[2] * cs3[0] + sg * o1[2] * cs3[1]; v1[3] = v1[3] * cs3[2] + sg * o1[3] * cs3[3]; }
                    u32x4 w; w.x = cvt_pk_h(v0[0], v0[1]); w.y = cvt_pk_h(v0[2], v0[3]); w.z = cvt_pk_h(v1[0], v1[1]); w.w = cvt_pk_h(v1[2], v1[3]);
                    *(u32x4*)(Q + grow * 768 + (2 * u.pn + bj) * 96 + d0) = w; } }
    }
};
struct EpiKV {
    static constexpr bool PERM = true, AFTER_DRAIN = true;
    MlaAux A; const float* gk; bf16_t* KIMG; bf16_t* VIMG; float eps; int seq;
    __device__ __forceinline__ static int vst(int k, int c) { return (c >> 5) * 4096 + k * 64 + (c & 31) * 2; }
    __device__ __forceinline__ void fused(f32x4 (&acc)[2][2][4][2], const Unit& u, int wr, int wc, int fr, int fq, PG8_LAS unsigned char* lds, int wid, int lane) const {
        PG8_LAS float* P = (PG8_LAS float*)lds;
        if (wc < 2) {
#pragma unroll
            for (int ai = 0; ai < 2; ++ai)
#pragma unroll
                for (int m = 0; m < 4; ++m)
#pragma unroll
                    for (int bj = 0; bj < 2; ++bj) { const f32x4 v0 = acc[ai][bj][m][0], v1 = acc[ai][bj][m][1];
                        float q = (v0[0] * v0[0] + v0[1] * v0[1]) + (v0[2] * v0[2] + v0[3] * v0[3]) + (v1[0] * v1[0] + v1[1] * v1[1]) + (v1[2] * v1[2] + v1[3] * v1[3]);
                        q += __shfl_xor(q, 16); q += __shfl_xor(q, 32);
                        if (fq == 0) P[((ai * HALF + wr * 64 + m * 16 + fr) * 2 + bj) * 2 + wc] = q; }
        }
        mla_stage_rows(A, u, lds, wid * 64 + lane, true, eps);
        asm volatile("s_waitcnt lgkmcnt(0)" ::: "memory"); __builtin_amdgcn_s_barrier(); asm volatile("" ::: "memory");
        const int q8 = 4 * (wc & 1) + fq;
        f32x4 g0 = {0.f, 0.f, 0.f, 0.f}, g1 = g0; float ga = 0.f, gb = 0.f, gc = 0.f, gd = 0.f;
        if (wc < 2) { g0 = *(const f32x4*)(gk + 32 * wc + 8 * fq); g1 = *(const f32x4*)(gk + 32 * wc + 8 * fq + 4); }
        else { ga = gk[64 + 2 * q8]; gb = gk[65 + 2 * q8]; gc = gk[80 + 2 * q8]; gd = gk[81 + 2 * q8]; }
#pragma unroll
        for (int ai = 0; ai < 2; ++ai)
#pragma unroll
            for (int m = 0; m < 4; ++m) { const int r = ai * HALF + wr * 64 + m * 16 + fr; const size_t grow = (size_t)u.pm * BM + r;
                const f32x4 tb = *(const PG8_LAS f32x4*)(lds + MLA_TBL + r * 16); const float rstd = tb[1], skr = tb[2];
                const int bb = (int)(grow / (size_t)seq), tt = (int)(grow % (size_t)seq), trow = tt & 63;
                float cA = 0.f, sA = 0.f, cB = 0.f, sB = 0.f, x1a = 0.f, x1b = 0.f, x2a = 0.f, x2b = 0.f;
                if (wc >= 2) { const f32x4 cs = *(const PG8_LAS f32x4*)((const PG8_LAS float*)(lds + MLA_ROPE) + (r * 16 + 2 * q8) * 2); cA = cs[0]; sA = cs[1]; cB = cs[2]; sB = cs[3];
                    const PG8_LAS bf16_t* krow = (const PG8_LAS bf16_t*)(lds + MLA_KR) + r * 32;
                    const unsigned ra = *(const PG8_LAS unsigned*)(krow + 2 * q8), rb = *(const PG8_LAS unsigned*)(krow + 16 + 2 * q8);
                    x1a = h_lo(ra); x1b = h_hi(ra); x2a = h_lo(rb); x2b = h_hi(rb); }
#pragma unroll
                for (int bj = 0; bj < 2; ++bj) { const f32x2 pp = *(const PG8_LAS f32x2*)(P + (r * 2 + bj) * 2);
                    const float rs = __builtin_amdgcn_rsqf((rstd * rstd * (pp[0] + pp[1]) + skr) * (1.f / 96.f) + eps);
                    const size_t tix = (size_t)(bb * 8 + 2 * u.pn + bj) * 128 + (tt >> 6);
                    if (wc < 2) { const float f = rstd * rs; const f32x4 v0 = acc[ai][bj][m][0] * f * g0, v1 = acc[ai][bj][m][1] * f * g1;
                        u32x4 w; w.x = cvt_pk_h(v0[0], v0[1]); w.y = cvt_pk_h(v0[2], v0[3]); w.z = cvt_pk_h(v1[0], v1[1]); w.w = cvt_pk_h(v1[2], v1[3]);
                        *(u32x4*)(KIMG + tix * 6144 + (4 * wc + fq) * 512 + trow * 8) = w; }
                    else { const f32x4 v0 = acc[ai][bj][m][0] * rstd, v1 = acc[ai][bj][m][1] * rstd;
                        u32x4 w; w.x = cvt_pk_h(v0[0], v0[1]); w.y = cvt_pk_h(v0[2], v0[3]); w.z = cvt_pk_h(v1[0], v1[1]); w.w = cvt_pk_h(v1[2], v1[3]);
                        *(u32x4*)(VIMG + tix * 4096 + vst(trow, 32 * (wc - 2) + 8 * fq) / 2) = w;
                        const float y1a = x1a * rs * ga, y1b = x1b * rs * gb, y2a = x2a * rs * gc, y2b = x2b * rs * gd;
                        bf16_t* kd = KIMG + tix * 6144 + trow * 8;
                        *(unsigned*)(kd + (8 + (q8 >> 2)) * 512 + ((2 * q8) & 7)) = cvt_pk_h(y1a * cA - y2a * sA, y1b * cB - y2b * sB);
                        *(unsigned*)(kd + (10 + (q8 >> 2)) * 512 + ((2 * q8) & 7)) = cvt_pk_h(y2a * cA + y1a * sA, y2b * cB + y1b * sB); } } }
    }
};
struct EpiELds {
    static constexpr bool PERM = true, AFTER_DRAIN = true;
    __device__ __forceinline__ void fused(f32x4 (&acc)[2][2][4][2], const Unit& u, int wr, int wc, int fr, int fq, PG8_LAS unsigned char* lds, int wid, int lane) const {
        PG8_LAS float* El = (PG8_LAS float*)lds;
#pragma unroll
        for (int ai = 0; ai < 2; ++ai)
#pragma unroll
            for (int m = 0; m < 4; ++m) { const int r = ai * HALF + wr * 64 + m * 16 + fr; PG8_LAS float* rp = El + r * 128 + wc * 32 + 8 * fq;
                *(PG8_LAS f32x4*)rp = acc[ai][0][m][0]; *(PG8_LAS f32x4*)(rp + 4) = acc[ai][0][m][1]; }
    }
};
__device__ __forceinline__ void ssm_chain_unit(const Unit& u, const PG8_LAS unsigned char* lds, bf16_t* USG, const float* AC, float* hand, unsigned* cnt, unsigned* tmo, int lane) {
        const PG8_LAS float* El = (const PG8_LAS float*)lds;
        const int g = u.pn, k4 = u.pm & 3, seqi = g * 2 + (k4 >> 1), p = lane;
        const f32x4 ac = *(const f32x4*)(AC + ((size_t)g * 64 + p) * 4);
        float sr = 0.f, si = 0.f;
        if (k4 & 1) { unsigned sp = 0;
            while (__hip_atomic_load(cnt + 64 * seqi, __ATOMIC_RELAXED, __HIP_MEMORY_SCOPE_AGENT) < 1u) { __builtin_amdgcn_s_sleep(2);
                if (++sp > (1u << 22)) { if (lane == 0) __hip_atomic_store(tmo, 1u, __ATOMIC_RELAXED, __HIP_MEMORY_SCOPE_AGENT); break; } }
            const unsigned long long hv = __hip_atomic_load((const unsigned long long*)(hand + ((size_t)seqi * 64 + p) * 2), __ATOMIC_RELAXED, __HIP_MEMORY_SCOPE_AGENT);
            sr = __uint_as_float((unsigned)hv); si = __uint_as_float((unsigned)(hv >> 32)); }
        bf16_t* srow = USG + (size_t)u.pm * BM * 384 + 256 + 2 * p;
#pragma unroll 8
        for (int t = 0; t < 256; ++t) { const f32x2 e = *(const PG8_LAS f32x2*)(El + t * 128 + 2 * p);
            *(unsigned*)(srow + (size_t)t * 384) = cvt_pk_h(sr, si);
            const float nr = ac[2] * sr - ac[3] * si + e[0], ni = ac[2] * si + ac[3] * sr + e[1]; sr = nr; si = ni; }
        if (!(k4 & 1)) { __hip_atomic_store((unsigned long long*)(hand + ((size_t)seqi * 64 + p) * 2), (unsigned long long)__float_as_uint(sr) | ((unsigned long long)__float_as_uint(si) << 32), __ATOMIC_RELAXED, __HIP_MEMORY_SCOPE_AGENT);
            asm volatile("s_waitcnt vmcnt(0)" ::: "memory");
            if (lane == 0) __hip_atomic_fetch_add(cnt + 64 * seqi, 1u, __ATOMIC_RELAXED, __HIP_MEMORY_SCOPE_AGENT); }
}
struct EpiY {
    static constexpr bool PERM = true, AFTER_DRAIN = false;
    const bf16_t* USG; const float* dskip; bf16_t* YPRE; int seq;
    __device__ __forceinline__ static float gelu_t(float v) { const float z = 0.7978845608028654f * (v + 0.044715f * v * v * v); return v * __builtin_amdgcn_rcpf(1.f + __builtin_amdgcn_exp2f(-2.885390081777927f * z)); }
    __device__ __forceinline__ void operator()(const f32x4 (&acc)[2][2][4][2], const Unit& u, int wr, int wc, int fr, int fq) const {
        const int g = u.pn, k4 = u.pm & 3, bb = k4 >> 1;
        const int i0 = (8 * fq) & 15;
        const f32x4 d0 = *(const f32x4*)(dskip + g * 16 + i0), d1 = *(const f32x4*)(dskip + g * 16 + i0 + 4);
#pragma unroll
        for (int ai = 0; ai < 2; ++ai)
#pragma unroll
            for (int m = 0; m < 4; ++m) { const int r = ai * HALF + wr * 64 + m * 16 + fr; const size_t arow = (size_t)u.pm * BM + r; const int tile = (k4 & 1) * 256 + r;
#pragma unroll
                for (int bj = 0; bj < 2; ++bj) { const int col = bj * HALF + wc * 32 + 8 * fq, t = col >> 4;
                    const u32x4 uv = *(const u32x4*)(USG + arow * 384 + col);
                    const f32x4 v0 = acc[ai][bj][m][0], v1 = acc[ai][bj][m][1];
                    u32x4 w;
                    w.x = cvt_pk_h(gelu_t(v0[0] + d0[0] * h_lo(uv.x)), gelu_t(v0[1] + d0[1] * h_hi(uv.x))); w.y = cvt_pk_h(gelu_t(v0[2] + d0[2] * h_lo(uv.y)), gelu_t(v0[3] + d0[3] * h_hi(uv.y)));
                    w.z = cvt_pk_h(gelu_t(v1[0] + d1[0] * h_lo(uv.z)), gelu_t(v1[1] + d1[1] * h_hi(uv.z))); w.w = cvt_pk_h(gelu_t(v1[2] + d1[2] * h_lo(uv.w)), gelu_t(v1[3] + d1[3] * h_hi(uv.w)));
                    store16_wt(YPRE + ((size_t)bb * seq + (size_t)tile * 16 + t) * 512 + g * 16 + i0, w); } }
    }
};
struct EpiGlu {
    static constexpr bool PERM = true, AFTER_DRAIN = false;
    const bf16_t* ypre; const bf16_t* proj; int ldp, zcol0; const float* bglu; bf16_t* ycat;
    __device__ __forceinline__ void operator()(const f32x4 (&acc)[2][2][4][2], const Unit& u, int wr, int wc, int fr, int fq) const {
        const int row0 = u.pm * BM + wr * 64 + fr, col0 = u.pn * BM + wc * 32 + 8 * fq;
        f32x4 bv[2][2];
#pragma unroll
        for (int bj = 0; bj < 2; ++bj)
#pragma unroll
            for (int n = 0; n < 2; ++n) bv[bj][n] = *(const f32x4*)(bglu + col0 + bj * HALF + 4 * n);
#pragma unroll
        for (int ai = 0; ai < 2; ++ai)
#pragma unroll
            for (int m = 0; m < 4; ++m) { const size_t row = (size_t)(row0 + ai * HALF + m * 16);
#pragma unroll
                for (int bj = 0; bj < 2; ++bj) { const int col = col0 + bj * HALF;
                    const u32x4 yv = __builtin_nontemporal_load((const u32x4*)(ypre + row * 512 + col)); const u32x4 zv = __builtin_nontemporal_load((const u32x4*)(proj + row * ldp + zcol0 + col));
                    const f32x4 t0 = acc[ai][bj][m][0] + bv[bj][0], t1 = acc[ai][bj][m][1] + bv[bj][1];
                    u32x4 w;
                    w.x = cvt_pk_h(fglu3(h_lo(yv.x), t0[0], h_lo(zv.x)), fglu3(h_hi(yv.x), t0[1], h_hi(zv.x)));
                    w.y = cvt_pk_h(fglu3(h_lo(yv.y), t0[2], h_lo(zv.y)), fglu3(h_hi(yv.y), t0[3], h_hi(zv.y)));
                    w.z = cvt_pk_h(fglu3(h_lo(yv.z), t1[0], h_lo(zv.z)), fglu3(h_hi(yv.z), t1[1], h_hi(zv.z)));
                    w.w = cvt_pk_h(fglu3(h_lo(yv.w), t1[2], h_lo(zv.w)), fglu3(h_hi(yv.w), t1[3], h_hi(zv.w)));
                    store16_wt(ycat + row * 1024 + col, w); } }
    }
};
struct EpiOutRows {
    static constexpr bool PERM = false, AFTER_DRAIN = true;
    const float* x; const float* gate; int gate_stride, rows_per_batch; float* out;
    __device__ __forceinline__ static int slot(int r, int s16) { return r * 1024 + ((s16 ^ (r & 15)) << 4); }
    __device__ __forceinline__ void fused(f32x4 (&acc)[2][2][4][2], const Unit& u, int wr, int wc, int fr, int fq, PG8_LAS unsigned char* lds, int wid, int lane) const {
        const int b = (u.pm * BM) / rows_per_batch;
        const f32x4 gv = *(const f32x4*)(gate + (size_t)b * gate_stride + u.pn * BM + 4 * lane);
#pragma unroll
        for (int ai = 0; ai < 2; ++ai) {
#pragma unroll
            for (int m = 0; m < 4; ++m) { const int rl = wr * 64 + m * 16 + fr;
#pragma unroll
                for (int bj = 0; bj < 2; ++bj)
#pragma unroll
                    for (int n = 0; n < 2; ++n) *(PG8_LAS f32x4*)(lds + slot(rl, 32 * bj + 8 * wc + 4 * n + fq)) = acc[ai][bj][m][n]; }
            asm volatile("s_waitcnt lgkmcnt(0)" ::: "memory"); __builtin_amdgcn_s_barrier(); asm volatile("" ::: "memory");
            const size_t g0 = ((size_t)u.pm * BM + ai * HALF + wid * 16) * 1024 + u.pn * BM + 4 * lane;
#pragma unroll
            for (int i0 = 0; i0 < 16; i0 += 8) { f32x4 xs[8];
#pragma unroll
                for (int i = 0; i < 8; ++i) xs[i] = __builtin_nontemporal_load((const f32x4*)(x + g0 + (size_t)(i0 + i) * 1024));
#pragma unroll
                for (int i = 0; i < 8; ++i) { const f32x4 v = *(const PG8_LAS f32x4*)(lds + slot(wid * 16 + i0 + i, lane)); __builtin_nontemporal_store(xs[i] + gv * v, (f32x4*)(out + g0 + (size_t)(i0 + i) * 1024)); } }
            if (ai == 0) { asm volatile("s_waitcnt lgkmcnt(0)" ::: "memory"); __builtin_amdgcn_s_barrier(); asm volatile("" ::: "memory"); }
        }
    }
};
template <class Epi, class Sched, bool ALIGN_EPI = false, bool SP2 = false>
__device__ __forceinline__ void gemm_phase(PG8_LAS unsigned char* lds, const Gemm g, const Sched& S, const Epi& E) {
    int tid_ = threadIdx.x; asm volatile("" : "+v"(tid_));
    const int tid = tid_, wid = __builtin_amdgcn_readfirstlane(tid >> 6), lane = tid & 63, wr = wid >> 2, wc = wid & 3, fr = lane & 15, fq = lane >> 4;
    const int K = g.K, nt = K / BK;
    unsigned voffA[2], voffB[2];
#pragma unroll
    for (int i = 0; i < 2; ++i) { int R, C; stage_rc(tid * 16 + i * 8192, R, C); const int Rb = Epi::PERM ? ((R & ~31) + perm32(R & 31)) : R;
        voffA[i] = (unsigned)(R * g.lda + C) * 2u; voffB[i] = (unsigned)(Rb * K + C) * 2u; }
    const size_t kstep = (size_t)(BK * 2);
    const size_t hstepA = (size_t)HALF * g.lda * 2, hstepB = (size_t)HALF * K * 2;
    const size_t tstepA = 2 * hstepA, tstepB = 2 * hstepB;
    const unsigned ldsw = (unsigned)wid * 1024u;
    const int aoff = lds_byte(wr * 64 + fr, fq * 8), boff = lds_byte(wc * 32 + fr, fq * 8);
#define PG8_SA(b, h) (((b) * 2 + (h)) * HTB)
#define PG8_SB(b, h) ((4 + (b) * 2 + (h)) * HTB)
#define PG8_STAGE(bufoff, gbase, voff) do { _Pragma("unroll") for (int _i = 0; _i < 2; ++_i) \
        __builtin_amdgcn_global_load_lds((const unsigned*)((const char*)(gbase) + (voff)[_i]), (PG8_LAS unsigned*)(lds + (bufoff) + ldsw + _i * 8192), 16, 0, 0); } while (0)
#define PG8_LDA(dst, b, h) do { _Pragma("unroll") for (int m = 0; m < 4; ++m) _Pragma("unroll") for (int k = 0; k < 2; ++k) dst[m][k] = *(const PG8_LAS bf16x8*)(lds + PG8_SA(b, h) + aoff + m * 2048 + k * 1024); } while (0)
#define PG8_LDB(dst, b, h) do { _Pragma("unroll") for (int n = 0; n < 2; ++n) _Pragma("unroll") for (int k = 0; k < 2; ++k) dst[n][k] = *(const PG8_LAS bf16x8*)(lds + PG8_SB(b, h) + boff + n * 2048 + k * 1024); } while (0)
#define PG8_MMA(ai, bj, At, Bt) do { __builtin_amdgcn_s_setprio(1); _Pragma("unroll") for (int m = 0; m < 4; ++m) _Pragma("unroll") for (int n = 0; n < 2; ++n) _Pragma("unroll") for (int k = 0; k < 2; ++k) \
        acc[ai][bj][m][n] = __builtin_amdgcn_mfma_f32_16x16x32_f16(Bt[n][k], At[m][k], acc[ai][bj][m][n], 0, 0, 0); __builtin_amdgcn_s_setprio(0); } while (0)
#define PG8_WAIT_V(n) asm volatile("s_waitcnt vmcnt(" #n ")" ::: "memory")
#define PG8_WAIT_L(n) asm volatile("s_waitcnt lgkmcnt(" #n ")" ::: "memory")
#define PG8_BAR __builtin_amdgcn_s_barrier()
#define PG8_SCHED __builtin_amdgcn_sched_barrier(0)
    Unit cur, nxt; int ui = 0;
    if (!S.next(0, cur)) return;
    f32x4 acc[2][2][4][2];
#pragma unroll
    for (int a = 0; a < 2; ++a)
#pragma unroll
        for (int b = 0; b < 2; ++b)
#pragma unroll
            for (int m = 0; m < 4; ++m)
#pragma unroll
                for (int n = 0; n < 2; ++n) acc[a][b][m][n] = (f32x4){0.f, 0.f, 0.f, 0.f};
    bf16x8 At[4][2], B0[2][2], B1[2][2];
    const char* cA = (const char*)g.A + (size_t)cur.pm * tstepA; const char* cB = (const char*)g.Bt + (size_t)cur.pn * tstepB;
    S.a_ready(cur);
    if constexpr (SP2) {
        PG8_STAGE(PG8_SB(0, 0), cB, voffB); PG8_STAGE(PG8_SB(0, 1), cB + hstepB, voffB); PG8_STAGE(PG8_SA(0, 0), cA, voffA); PG8_STAGE(PG8_SA(0, 1), cA + hstepA, voffA);
        if (wr == 1) PG8_BAR;
        PG8_WAIT_V(2); PG8_BAR;
        PG8_STAGE(PG8_SB(1, 0), cB + kstep, voffB); PG8_STAGE(PG8_SA(1, 0), cA + kstep, voffA); PG8_STAGE(PG8_SB(1, 1), cB + hstepB + kstep, voffB);
        PG8_WAIT_V(6); PG8_BAR;
    } else {
        PG8_STAGE(PG8_SB(0, 0), cB, voffB); PG8_STAGE(PG8_SA(0, 0), cA, voffA); PG8_STAGE(PG8_SB(0, 1), cB + hstepB, voffB); PG8_STAGE(PG8_SA(0, 1), cA + hstepA, voffA);
        if (wr == 1) PG8_BAR;
        PG8_WAIT_V(4); PG8_BAR;
        PG8_STAGE(PG8_SB(1, 0), cB + kstep, voffB); PG8_STAGE(PG8_SA(1, 0), cA + kstep, voffA); PG8_STAGE(PG8_SB(1, 1), cB + hstepB + kstep, voffB);
        PG8_WAIT_V(6); PG8_BAR;
    }
    for (;;) {
        const bool has_next = S.next(ui + 1, nxt);
        const char* nA = has_next ? (const char*)g.A + (size_t)nxt.pm * tstepA : cA; const char* nB = has_next ? (const char*)g.Bt + (size_t)nxt.pn * tstepB : cB;
        for (int t = 0; t < nt; t += 2) {
            const bool last = (t == nt - 2);
            const char* a1 = cA + (size_t)(t + 1) * kstep;
            const char* a2 = last ? nA : cA + (size_t)(t + 2) * kstep; const char* b2 = last ? nB : cB + (size_t)(t + 2) * kstep;
            const char* a3 = a2 + kstep; const char* b3 = b2 + kstep;
            if (last && has_next) S.a_ready(nxt);
            if constexpr (SP2) {
            PG8_LDB(B0, 0, 0); PG8_LDB(B1, 0, 1); PG8_SCHED; PG8_LDA(At, 0, 0); PG8_STAGE(PG8_SA(1, 1), a1 + hstepA, voffA);
            PG8_WAIT_V(8); PG8_WAIT_L(0); PG8_BAR; PG8_MMA(0, 0, At, B0); PG8_MMA(0, 1, At, B1); PG8_BAR; PG8_SCHED;
            PG8_LDA(At, 0, 1); PG8_STAGE(PG8_SB(0, 0), b2, voffB); PG8_STAGE(PG8_SB(0, 1), b2 + hstepB, voffB); PG8_STAGE(PG8_SA(0, 0), a2, voffA);
            PG8_WAIT_V(8); PG8_WAIT_L(0); PG8_BAR; PG8_MMA(1, 0, At, B0); PG8_MMA(1, 1, At, B1); PG8_BAR; PG8_SCHED;
            PG8_LDB(B0, 1, 0); PG8_LDB(B1, 1, 1); PG8_SCHED; PG8_LDA(At, 1, 0); PG8_STAGE(PG8_SA(0, 1), a2 + hstepA, voffA);
            PG8_WAIT_V(8); PG8_WAIT_L(0); PG8_BAR; PG8_MMA(0, 0, At, B0); PG8_MMA(0, 1, At, B1); PG8_BAR; PG8_SCHED;
            PG8_LDA(At, 1, 1); PG8_STAGE(PG8_SB(1, 0), b3, voffB); PG8_STAGE(PG8_SB(1, 1), b3 + hstepB, voffB); PG8_STAGE(PG8_SA(1, 0), a3, voffA);
            PG8_WAIT_V(8); PG8_WAIT_L(0); PG8_BAR; PG8_MMA(1, 0, At, B0); PG8_MMA(1, 1, At, B1); PG8_BAR; PG8_SCHED;
            } else {
            PG8_LDB(B0, 0, 0); PG8_SCHED; PG8_LDA(At, 0, 0); PG8_STAGE(PG8_SA(1, 1), a1 + hstepA, voffA);
            PG8_WAIT_L(8); PG8_BAR; PG8_WAIT_L(0); PG8_MMA(0, 0, At, B0); PG8_BAR; PG8_SCHED;
            PG8_LDB(B1, 0, 1); PG8_STAGE(PG8_SB(0, 0), b2, voffB);
            PG8_BAR; PG8_WAIT_L(0); PG8_MMA(0, 1, At, B1); PG8_BAR;
            PG8_LDA(At, 0, 1); PG8_STAGE(PG8_SA(0, 0), a2, voffA);
            PG8_BAR; PG8_WAIT_L(0); PG8_MMA(1, 0, At, B0); PG8_BAR; PG8_SCHED;
            PG8_STAGE(PG8_SB(0, 1), b2 + hstepB, voffB);
            PG8_WAIT_V(6); PG8_BAR; PG8_MMA(1, 1, At, B1); PG8_BAR;
            PG8_LDB(B0, 1, 0); PG8_SCHED; PG8_LDA(At, 1, 0); PG8_STAGE(PG8_SA(0, 1), a2 + hstepA, voffA);
            PG8_WAIT_L(8); PG8_BAR; PG8_WAIT_L(0); PG8_MMA(0, 0, At, B0); PG8_BAR; PG8_SCHED;
            PG8_LDB(B1, 1, 1); PG8_STAGE(PG8_SB(1, 0), b3, voffB);
            PG8_BAR; PG8_WAIT_L(0); PG8_MMA(0, 1, At, B1); PG8_BAR;
            PG8_LDA(At, 1, 1); PG8_STAGE(PG8_SA(1, 0), a3, voffA);
            PG8_BAR; PG8_WAIT_L(0); PG8_MMA(1, 0, At, B0); PG8_BAR; PG8_SCHED;
            PG8_STAGE(PG8_SB(1, 1), b3 + hstepB, voffB);
            PG8_WAIT_V(6); PG8_BAR; PG8_MMA(1, 1, At, B1); PG8_BAR;
            }
        }
        if constexpr (ALIGN_EPI) { if (wr == 0) PG8_BAR; }
        if constexpr (!Epi::AFTER_DRAIN) { E(acc, cur, wr, wc, fr, fq); S.done(cur); }
        if (!has_next) break;
#pragma unroll
        for (int a = 0; a < 2; ++a)
#pragma unroll
            for (int b = 0; b < 2; ++b)
#pragma unroll
                for (int m = 0; m < 4; ++m)
#pragma unroll
                    for (int n = 0; n < 2; ++n) acc[a][b][m][n] = (f32x4){0.f, 0.f, 0.f, 0.f};
        cur = nxt; cA = nA; cB = nB; ++ui;
        if constexpr (ALIGN_EPI) { if (wr == 1) PG8_BAR; }
    }
    PG8_WAIT_V(0);
    if constexpr (!ALIGN_EPI) { if (wr == 0) PG8_BAR; }
    PG8_BAR;
    if constexpr (Epi::AFTER_DRAIN) { E.fused(acc, cur, wr, wc, fr, fq, lds, wid, lane); S.done(cur); }
#undef PG8_SA
#undef PG8_SB
#undef PG8_STAGE
#undef PG8_LDA
#undef PG8_LDB
#undef PG8_MMA
#undef PG8_WAIT_V
#undef PG8_WAIT_L
#undef PG8_BAR
#undef PG8_SCHED
}
}

namespace att {
using h16x8 = __attribute__((ext_vector_type(8))) _Float16;
using s16x4 = __attribute__((ext_vector_type(4))) short;
using f32x16 = __attribute__((ext_vector_type(16))) float;
using u32x4 = __attribute__((ext_vector_type(4))) unsigned;
typedef float f32x2_t __attribute__((ext_vector_type(2))); typedef _Float16 f16x2_t __attribute__((ext_vector_type(2)));
constexpr int NW = 8, QBLK = 32, KVBLK = 64, QB = 256, ASEQ = 8192;
constexpr int LDQ = 768, LDK = 1024, LDV = 512;
constexpr float SCALE = 0.10206207261596575f;
constexpr float THR = 8.f;
#define SBAR() __builtin_amdgcn_sched_barrier(0)
__device__ __forceinline__ int crow(int r, int hi) { return (r & 3) + 8 * (r >> 2) + 4 * hi; }
__device__ __forceinline__ unsigned cvtpk(float lo, float hi) { const f16x2_t v = __builtin_convertvector((f32x2_t){lo, hi}, f16x2_t); return __builtin_bit_cast(unsigned, v); }

__device__ __forceinline__ void cmask(f32x16& p0, f32x16& p1, int jb, int qrel, int hi) {
  const float NEG = -INFINITY; const int kb = 64 * jb + 4 * hi;
#pragma unroll
  for (int r = 0; r < 16; ++r) { const int kv = kb + (r & 3) + 8 * (r >> 2); if (kv > qrel) p0[r] = NEG; if (kv + 32 > qrel) p1[r] = NEG; }
}
__device__ __forceinline__ void cmask0(f32x16& p0, int jb, int qrel, int hi) {
  const float NEG = -INFINITY; const int kb = 64 * jb + 4 * hi;
#pragma unroll
  for (int r = 0; r < 16; ++r) { const int kv = kb + (r & 3) + 8 * (r >> 2); if (kv > qrel) p0[r] = NEG; }
}
__device__ __forceinline__ void cmask1(f32x16& p1, int jb, int qrel, int hi) {
  const float NEG = -INFINITY; const int kb = 64 * jb + 4 * hi + 32;
#pragma unroll
  for (int r = 0; r < 16; ++r) { const int kv = kb + (r & 3) + 8 * (r >> 2); if (kv > qrel) p1[r] = NEG; }
}
constexpr int KT_BYTES = 12288, VT_BYTES = 8192, NKS = 3, NVS = 4;
constexpr int LDS_V0 = NKS * KT_BYTES, LDS_WSC = LDS_V0 + NVS * VT_BYTES;
constexpr int LDS_OST = LDS_WSC + NW * 64 * 4;
constexpr int LDS_ATT2 = LDS_OST + NW * 4096;
typedef __attribute__((address_space(3))) unsigned char* lds3_t;
__device__ __forceinline__ unsigned gate2(unsigned ow, unsigned zw) {
  const f16x2_t o2 = __builtin_bit_cast(f16x2_t, ow), z2 = __builtin_bit_cast(f16x2_t, zw); const float z0 = (float)z2[0], z1 = (float)z2[1];
  return cvtpk((float)o2[0] * (z0 * __builtin_amdgcn_rcpf(1.f + __builtin_amdgcn_exp2f(-1.4426950408889634f * z0))), (float)o2[1] * (z1 * __builtin_amdgcn_rcpf(1.f + __builtin_amdgcn_exp2f(-1.4426950408889634f * z1))));
}
#define PIN(x) asm volatile("" : "+v"(x))
#define MFMAH(a, b, c) __builtin_amdgcn_mfma_f32_32x32x16_f16(a, b, c, 0, 0, 0)
typedef __attribute__((address_space(3))) const char* lds_cptr;
typedef short v4i16_t __attribute__((ext_vector_type(4)));
__device__ __forceinline__ void kload2(h16x8* kf, lds_cptr kp, int d0) { kf[2 * d0] = *(const __attribute__((address_space(3))) h16x8*)(kp + d0 * 2048); kf[2 * d0 + 1] = *(const __attribute__((address_space(3))) h16x8*)(kp + d0 * 2048 + 512); }
__device__ __forceinline__ s16x4 vtr(lds_cptr p) { return __builtin_bit_cast(s16x4, __builtin_amdgcn_ds_read_tr16_b64_v4i16((__attribute__((address_space(3))) v4i16_t*)p)); }
#define MX3(a, b, c) __builtin_fmaxf(__builtin_fmaxf((a), (b)), (c))
__device__ __forceinline__ float rowmax(const f32x16& p0, const f32x16& p1) {
  float a = MX3(p0[0], p0[1], p1[0]), b = MX3(p0[2], p0[3], p1[1]); a = MX3(a, p1[2], p1[3]);
#pragma unroll
  for (int r = 4; r < 16; r += 4) { a = MX3(a, p0[r], p0[r + 1]); b = MX3(b, p0[r + 2], p0[r + 3]); a = MX3(a, p1[r], p1[r + 1]); b = MX3(b, p1[r + 2], p1[r + 3]); }
  float m = __builtin_fmaxf(a, b); auto rr = __builtin_amdgcn_permlane32_swap(__float_as_uint(m), __float_as_uint(m), false, false);
  return __builtin_fmaxf(__uint_as_float(rr[0]), __uint_as_float(rr[1])); }
template <bool FIXED> __device__ __forceinline__ void attn_unit(int b, int h, int qb, const unsigned short* __restrict__ Q, const unsigned short* __restrict__ KIMG, const unsigned short* __restrict__ VIMG,
                                          const unsigned short* __restrict__ PROJ, int ldp, int zcol0, unsigned short* __restrict__ YCAT, char* lds, lds3_t lds3, unsigned* done_cnt, unsigned* z_cnt, unsigned* tmo,
                                          int next_qword, int next_slot_off, float mfix, unsigned* pend_in) {
  int tid_ = threadIdx.x; asm volatile("" : "+v"(tid_));
  const int tid = tid_, lane = tid & 63, r32 = lane & 31, hi = lane >> 5; const int wid = __builtin_amdgcn_readfirstlane(tid >> 6);
  float* ws = (float*)(lds + LDS_WSC) + wid * 64; float* li_l = ws; float* al_l = ws + 32;
  const long rowbase = (long)b * ASEQ; const int q0 = qb * QB;
  const int NT = (q0 + QB) / KVBLK;
  const char* Kg = (const char*)KIMG + (size_t)(b * 8 + h) * 128 * KT_BYTES;
  const char* Vg = (const char*)VIMG + (size_t)(b * 8 + h) * 128 * VT_BYTES;
  const unsigned lo16 = (unsigned)lane * 16u;
  const unsigned lds_base_u = (unsigned)__builtin_amdgcn_readfirstlane((int)(unsigned)(size_t)lds3);
  const lds_cptr kp0 = (lds_cptr)lds3 + hi * 1024 + r32 * 16;
  const lds_cptr vp0 = (lds_cptr)lds3 + LDS_V0 + ((lane >> 4) & 1) * 32 + (lane & 3) * 8 + (4 * hi + ((lane & 15) >> 2)) * 64;
  constexpr float THRL = THR * 1.4426950408889634f;
#define GLDS(gp, loff) do { const char* gu_ = (gp); const unsigned lm_ = lds_base_u + (unsigned)(loff); asm volatile("s_mov_b32 m0, %0\n\ts_nop 0\n\tglobal_load_lds_dwordx4 %1, %2" :: "s"(lm_), "v"(lo16), "s"(gu_) : "memory", "m0"); } while (0)
#define DMA_K(t, slot) do { const char* kg_ = Kg + (size_t)(t) * KT_BYTES; const int ko_ = (slot) * KT_BYTES; GLDS(kg_ + wid * 1024, ko_ + wid * 1024); if (wid < 4) GLDS(kg_ + (8 + wid) * 1024, ko_ + (8 + wid) * 1024); } while (0)
#define DMA_V(t, slot) do { GLDS(Vg + (size_t)(t) * VT_BYTES + wid * 1024, LDS_V0 + (slot) * VT_BYTES + wid * 1024); } while (0)
#define WAITB(A, B) do { if (wid < 4) asm volatile("s_waitcnt vmcnt(" #A ") lgkmcnt(0)\n\ts_barrier" ::: "memory"); else asm volatile("s_waitcnt vmcnt(" #B ") lgkmcnt(0)\n\ts_barrier" ::: "memory"); } while (0)
  float mhat = 0.f, l_reg = 0.f; f32x16 o[2]; o[0] = f32x16{}; o[1] = f32x16{}; h16x8 qr[6]; f32x16 negm = {}; PIN(negm);
  if (FIXED) { float mf_ = -mfix; asm volatile("" : "+v"(mf_));
#pragma unroll
    for (int r = 0; r < 16; ++r) negm[r] = mf_;
    PIN(negm); }
  const int qrel = wid * QBLK + r32; bool resc = false;
  const f16x2_t ones2 = {(_Float16)1.f, (_Float16)1.f};
  f32x16 pA0, pA1, pB0, pB1; h16x8 kf[12]; s16x4 vlo[8], vhi[8]; u32x4 pw0, pw1, pw2, pw3;
  int s_prev = 0, s_cur = 0, s_next = 1;
#define ROT() do { s_prev = s_cur; s_cur = s_next; s_next = (s_next == 2) ? 0 : s_next + 1; } while (0)
#define RESC() do { if (resc) { _Pragma("unroll") for (int d_ = 0; d_ < 2; ++d_) _Pragma("unroll") for (int r = 0; r < 16; ++r) o[d_][r] *= al_l[crow(r, hi)]; } } while (0)
  DMA_K(0, 0); DMA_V(0, 0); DMA_K(1, 1);
  { const unsigned short* Qw = Q + (rowbase + q0 + wid * QBLK + r32) * LDQ + h * 96 + hi * 8;
#pragma unroll
    for (int d0 = 0; d0 < 6; ++d0) qr[d0] = __builtin_nontemporal_load(reinterpret_cast<const h16x8*>(Qw + d0 * 16)); }
  DMA_K(2, 2);
  WAITB(2, 1);
#pragma unroll
  for (int d0 = 0; d0 < 6; ++d0) kload2(kf, kp0, d0);
  pA0 = MFMAH(kf[0], qr[0], negm); pA1 = MFMAH(kf[1], qr[0], negm);
#pragma unroll
  for (int d0 = 1; d0 < 6; ++d0) { pA0 = MFMAH(kf[2 * d0], qr[d0], pA0); pA1 = MFMAH(kf[2 * d0 + 1], qr[d0], pA1); }
  if (NT == 4) cmask(pA0, pA1, 0, qrel, hi);
  if (FIXED) {
#pragma unroll
    for (int r = 0; r < 16; ++r) { pA0[r] = __builtin_amdgcn_exp2f(pA0[r]); pA1[r] = __builtin_amdgcn_exp2f(pA1[r]); } }
  else { const float rm = rowmax(pA0, pA1); mhat = rm;
#pragma unroll
    for (int r = 0; r < 16; ++r) negm[r] = -rm;
    PIN(negm);
#pragma unroll
    for (int r = 0; r < 16; ++r) { pA0[r] = __builtin_amdgcn_exp2f(pA0[r] - rm); pA1[r] = __builtin_amdgcn_exp2f(pA1[r] - rm); } }
  WAITB(0, 0);
  if (pend_in && tid == 0) __hip_atomic_fetch_add(pend_in, 1u, __ATOMIC_RELAXED, __HIP_MEMORY_SCOPE_AGENT);
  DMA_K(3, 0); DMA_V(1, 1); ROT();
#pragma unroll
  for (int d0 = 0; d0 < 6; ++d0) kload2(kf, kp0 + s_cur * KT_BYTES, d0);
  WAITB(3, 2);
#define PKW(P, i) cvtpk(P[i], P[i + 1])
#define PAF(k) __builtin_bit_cast(h16x8, pw##k)
#define VFR(i) __builtin_bit_cast(h16x8, (__attribute__((ext_vector_type(8))) short){vlo[i][0], vlo[i][1], vlo[i][2], vlo[i][3], vhi[i][0], vhi[i][1], vhi[i][2], vhi[i][3]})
#define VRD(i) do { vlo[i] = vtr(vp_ + (((i) >> 2) * 4096 + ((i) & 3) * 1024)); vhi[i] = vtr(vp_ + (((i) >> 2) * 4096 + ((i) & 3) * 1024 + 512)); } while (0)
#define KRD(G, d0) do { if (G) { kload2(kf, kp0 + s_next * KT_BYTES, d0); SBAR(); } } while (0)
#define GAPA(MF, a0, a1, a2, W0, W1, PW) do { MF; sacc += a0; sacc += a1; sacc += a2; W0; W1; PIN(PW); PIN(sacc); SBAR(); } while (0)
#define GAPA3(MF, a0, a1, a2) do { MF; sacc += a0; sacc += a1; sacc += a2; PIN(sacc); SBAR(); } while (0)
#define GAPB(MF, X, i) do { MF; X[i] = __builtin_amdgcn_exp2f(X[i]); X[i + 1] = __builtin_amdgcn_exp2f(X[i + 1]); X[i + 2] = __builtin_amdgcn_exp2f(X[i + 2]); X[i + 3] = __builtin_amdgcn_exp2f(X[i + 3]); PIN(X); SBAR(); } while (0)
#define STEP(C0, C1, P0, P1, t, MASK, GK, GV, GL) do { SBAR(); \
    const lds_cptr vp_ = vp0 + s_prev * VT_BYTES; \
    VRD(0); SBAR(); float sacc = P0[0] + P0[1]; \
                    GAPA(C0 = MFMAH(kf[0], qr[0], negm), P0[2], P0[3], P0[4],     pw0[0] = PKW(P0, 0),  pw0[1] = PKW(P0, 2),  pw0); \
    VRD(4); SBAR(); GAPA(C1 = MFMAH(kf[1], qr[0], negm), P0[5], P0[6], P0[7],     pw0[2] = PKW(P0, 4),  pw0[3] = PKW(P0, 6),  pw0); \
    VRD(1); SBAR(); GAPA(C0 = MFMAH(kf[2], qr[1], C0),   P0[8], P0[9], P0[10],    pw1[0] = PKW(P0, 8),  pw1[1] = PKW(P0, 10), pw1); \
    VRD(5); SBAR(); GAPA(C1 = MFMAH(kf[3], qr[1], C1),   P0[11], P0[12], P0[13],  pw1[2] = PKW(P0, 12), pw1[3] = PKW(P0, 14), pw1); \
    VRD(2); SBAR(); GAPA(C0 = MFMAH(kf[4], qr[2], C0),   P0[14], P0[15], P1[0],   pw2[0] = PKW(P1, 0),  pw2[1] = PKW(P1, 2),  pw2); \
    VRD(6); SBAR(); GAPA(C1 = MFMAH(kf[5], qr[2], C1),   P1[1], P1[2], P1[3],     pw2[2] = PKW(P1, 4),  pw2[3] = PKW(P1, 6),  pw2); \
                    GAPA(C0 = MFMAH(kf[6], qr[3], C0),   P1[4], P1[5], P1[6],     pw3[0] = PKW(P1, 8),  pw3[1] = PKW(P1, 10), pw3); \
                    GAPA(C1 = MFMAH(kf[7], qr[3], C1),   P1[7], P1[8], P1[9],     pw3[2] = PKW(P1, 12), pw3[3] = PKW(P1, 14), pw3); \
    GAPA3(C0 = MFMAH(kf[8], qr[4], C0), P1[10], P1[11], P1[12]); \
    GAPA3(C1 = MFMAH(kf[9], qr[4], C1), P1[13], P1[14], P1[15]); \
    C0 = MFMAH(kf[10], qr[5], C0); C1 = MFMAH(kf[11], qr[5], C1); \
    l_reg += sacc; \
    if (GK) DMA_K((t) + 3, s_cur); if (GV) DMA_V((t) + 1, s_next);                                                         \
    KRD(GL, 0); KRD(GL, 1);                                                                                                   \
    if (MASK) cmask(C0, C1, (t) - (NT - 4), qrel, hi); \
    if (!FIXED) { const float rm = rowmax(C0, C1); resc = false;                                                                       \
      if (__builtin_expect(__any(rm > THRL), 0)) { const float dl = __builtin_fmaxf(rm, 0.f); mhat += dl;                  \
          const float f = __builtin_amdgcn_exp2f(-dl); l_reg *= f; if (hi == 0) al_l[r32] = f; resc = true; \
          _Pragma("unroll") for (int r = 0; r < 16; ++r) { C0[r] -= dl; C1[r] -= dl; } \
          _Pragma("unroll") for (int r = 0; r < 16; ++r) negm[r] = -mhat; \
          PIN(negm); } } \
    SBAR(); \
    VRD(3); SBAR(); KRD(GL, 2); GAPB(o[0] = MFMAH(PAF(0), VFR(0), o[0]), C0, 0);  VRD(7); SBAR(); KRD(GL, 3); GAPB(o[1] = MFMAH(PAF(0), VFR(4), o[1]), C0, 4);     \
    KRD(GL, 4); GAPB(o[0] = MFMAH(PAF(1), VFR(1), o[0]), C0, 8);  KRD(GL, 5); GAPB(o[1] = MFMAH(PAF(1), VFR(5), o[1]), C0, 12); \
    GAPB(o[0] = MFMAH(PAF(2), VFR(2), o[0]), C1, 0);              GAPB(o[1] = MFMAH(PAF(2), VFR(6), o[1]), C1, 4); \
    GAPB(o[0] = MFMAH(PAF(3), VFR(3), o[0]), C1, 8);              GAPB(o[1] = MFMAH(PAF(3), VFR(7), o[1]), C1, 12); \
    } while (0)
#define EX1(X, i) X[i] = __builtin_amdgcn_exp2f(X[i])
#define GAPH(MF, PW, i0, P, j, TNEW, EXPR) do { MF; const unsigned wa_ = PKW(P, j), wb_ = PKW(P, (j) + 2); PW[i0] = wa_; PW[(i0) + 1] = wb_; \
    TNEW = __builtin_bit_cast(f16x2_t, wa_) + __builtin_bit_cast(f16x2_t, wb_); EXPR; PIN(PW); SBAR(); } while (0)
#define STEP_F(C0, C1, P0, P1, t, MASK, GK, GV, GL) do { SBAR(); \
    const lds_cptr vp_ = vp0 + s_prev * VT_BYTES; \
    VRD(0); SBAR(); f16x2_t hs, ta_, tb_, tc_; \
                    GAPH(C0 = MFMAH(kf[0], qr[0], negm), pw0, 0, P0, 0,  ta_, (void)0); \
    VRD(4); SBAR(); GAPH(C0 = MFMAH(kf[2], qr[1], C0),   pw0, 2, P0, 4,  tb_, (void)0); \
    VRD(1); SBAR(); GAPH(C0 = MFMAH(kf[4], qr[2], C0),   pw1, 0, P0, 8,  tc_, hs = ta_ + tb_); \
    VRD(5); SBAR(); GAPH(C0 = MFMAH(kf[6], qr[3], C0),   pw1, 2, P0, 12, ta_, hs = hs + tc_); \
    VRD(2); SBAR(); GAPH(C0 = MFMAH(kf[8], qr[4], C0),   pw2, 0, P1, 0,  tb_, hs = hs + ta_); \
    VRD(6); SBAR(); GAPH(C0 = MFMAH(kf[10], qr[5], C0),  pw2, 2, P1, 4,  tc_, hs = hs + tb_); \
                    GAPH(C1 = MFMAH(kf[1], qr[0], negm), pw3, 0, P1, 8,  ta_, hs = hs + tc_); \
                    GAPH(C1 = MFMAH(kf[3], qr[1], C1),   pw3, 2, P1, 12, tb_, hs = hs + ta_); \
    if (MASK) { cmask0(C0, (t) - (NT - 4), qrel, hi); PIN(C0); SBAR(); } \
    C1 = MFMAH(kf[5], qr[2], C1);  hs = hs + tb_; EX1(C0, 0);  EX1(C0, 1);  EX1(C0, 2);  EX1(C0, 3);  PIN(C0); SBAR(); \
    C1 = MFMAH(kf[7], qr[3], C1);  l_reg = __builtin_amdgcn_fdot2(hs, ones2, l_reg, false); EX1(C0, 4);  EX1(C0, 5);  EX1(C0, 6);  EX1(C0, 7);  PIN(C0); PIN(l_reg); SBAR(); \
    C1 = MFMAH(kf[9], qr[4], C1);  EX1(C0, 8);  EX1(C0, 9);  EX1(C0, 10); EX1(C0, 11); PIN(C0); SBAR(); \
    C1 = MFMAH(kf[11], qr[5], C1); EX1(C0, 12); EX1(C0, 13); EX1(C0, 14); EX1(C0, 15); PIN(C0); SBAR(); \
    if (GK) DMA_K((t) + 3, s_cur); if (GV) DMA_V((t) + 1, s_next);                                                         \
    KRD(GL, 0); KRD(GL, 1);                                                                                                   \
    if (MASK) { cmask1(C1, (t) - (NT - 4), qrel, hi); PIN(C1); } \
    SBAR(); \
    VRD(3); SBAR(); KRD(GL, 2); o[0] = MFMAH(PAF(0), VFR(0), o[0]); SBAR();  VRD(7); SBAR(); KRD(GL, 3); o[1] = MFMAH(PAF(0), VFR(4), o[1]); SBAR(); \
    KRD(GL, 4); o[0] = MFMAH(PAF(1), VFR(1), o[0]); EX1(C1, 0);  EX1(C1, 1);  EX1(C1, 2);  PIN(C1); SBAR();  KRD(GL, 5); o[1] = MFMAH(PAF(1), VFR(5), o[1]); EX1(C1, 3);  EX1(C1, 4);  EX1(C1, 5);  PIN(C1); SBAR(); \
    o[0] = MFMAH(PAF(2), VFR(2), o[0]); EX1(C1, 6);  EX1(C1, 7);  EX1(C1, 8);  PIN(C1); SBAR();              o[1] = MFMAH(PAF(2), VFR(6), o[1]); EX1(C1, 9);  EX1(C1, 10); EX1(C1, 11); PIN(C1); SBAR(); \
    o[0] = MFMAH(PAF(3), VFR(3), o[0]); EX1(C1, 12); EX1(C1, 13); PIN(C1); SBAR();                            o[1] = MFMAH(PAF(3), VFR(7), o[1]); EX1(C1, 14); EX1(C1, 15); PIN(C1); SBAR(); \
    } while (0)
#define STEPX(...) do { if (FIXED) STEP_F(__VA_ARGS__); else STEP(__VA_ARGS__); } while (0)
  int t = 1;
  for (; t + 5 < NT; t += 2) {
    STEPX(pB0, pB1, pA0, pA1, t, false, true, true, true);     WAITB(3, 2); RESC(); ROT();
    STEPX(pA0, pA1, pB0, pB1, t + 1, false, true, true, true); WAITB(3, 2); RESC(); ROT();
  }
#define ENDW(tt) do { if ((tt) + 3 < NT) { WAITB(3, 2); } else if ((tt) + 2 < NT) { WAITB(1, 1); } else { WAITB(0, 0); } } while (0)
  for (; t + 1 < NT; t += 2) {
    STEPX(pB0, pB1, pA0, pA1, t, true, (t + 3 < NT), (t + 1 < NT), (t + 1 < NT));         ENDW(t);     RESC(); ROT();
    STEPX(pA0, pA1, pB0, pB1, t + 1, true, (t + 4 < NT), (t + 2 < NT), (t + 2 < NT));     ENDW(t + 1); RESC(); ROT();
  }
  STEPX(pB0, pB1, pA0, pA1, NT - 1, true, false, false, false); RESC();
  { float sacc = pB0[0] + pB0[1];
#pragma unroll
    for (int r = 2; r < 16; ++r) sacc += pB0[r];
#pragma unroll
    for (int r = 0; r < 16; ++r) sacc += pB1[r];
    l_reg += sacc;
    pw0 = (u32x4){PKW(pB0, 0), PKW(pB0, 2), PKW(pB0, 4), PKW(pB0, 6)}; pw1 = (u32x4){PKW(pB0, 8), PKW(pB0, 10), PKW(pB0, 12), PKW(pB0, 14)};
    pw2 = (u32x4){PKW(pB1, 0), PKW(pB1, 2), PKW(pB1, 4), PKW(pB1, 6)}; pw3 = (u32x4){PKW(pB1, 8), PKW(pB1, 10), PKW(pB1, 12), PKW(pB1, 14)};
    const lds_cptr vp_ = vp0 + s_cur * VT_BYTES;
#pragma unroll
    for (int i = 0; i < 8; ++i) VRD(i);
    o[0] = MFMAH(PAF(0), VFR(0), o[0]); o[1] = MFMAH(PAF(0), VFR(4), o[1]); o[0] = MFMAH(PAF(1), VFR(1), o[0]); o[1] = MFMAH(PAF(1), VFR(5), o[1]);
    o[0] = MFMAH(PAF(2), VFR(2), o[0]); o[1] = MFMAH(PAF(2), VFR(6), o[1]); o[0] = MFMAH(PAF(3), VFR(3), o[0]); o[1] = MFMAH(PAF(3), VFR(7), o[1]); }
  { auto rr = __builtin_amdgcn_permlane32_swap(__float_as_uint(l_reg), __float_as_uint(l_reg), false, false); l_reg = __uint_as_float(rr[0]) + __uint_as_float(rr[1]); }
  if (hi == 0) li_l[r32] = l_reg; asm volatile("s_waitcnt lgkmcnt(0)" ::: "memory");
  float rli[16];
#pragma unroll
  for (int r = 0; r < 16; ++r) rli[r] = __builtin_amdgcn_rcpf(li_l[crow(r, hi)]);
  if (z_cnt && wid == 0) { unsigned sp = 0;
    while (__hip_atomic_load(z_cnt, __ATOMIC_RELAXED, __HIP_MEMORY_SCOPE_AGENT) < 2u) { __builtin_amdgcn_s_sleep(2); if (++sp > (1u << 22)) { if (lane == 0) __hip_atomic_store(tmo, 1u, __ATOMIC_RELAXED, __HIP_MEMORY_SCOPE_AGENT); break; } }
    __builtin_amdgcn_fence(__ATOMIC_ACQUIRE, "agent"); asm volatile("s_waitcnt vmcnt(0)" ::: "memory"); }
  unsigned nxt_ = 0u; if (next_qword >= 0 && tid == 0) nxt_ = __hip_atomic_fetch_add(tmo + next_qword + 64 * (blockIdx.x & 7u), 1u, __ATOMIC_RELAXED, __HIP_MEMORY_SCOPE_AGENT);
  asm volatile("s_waitcnt lgkmcnt(0)\n\ts_barrier" ::: "memory");
  const long orow0 = rowbase + q0 + wid * QBLK;
  { unsigned short* stg = (unsigned short*)(lds + LDS_OST) + wid * 2048;
#pragma unroll
    for (int r = 0; r < 16; ++r) { const int orow = crow(r, hi);
#pragma unroll
      for (int d0 = 0; d0 < 2; ++d0) stg[orow * 64 + d0 * 32 + r32] = __builtin_bit_cast(unsigned short, (_Float16)(o[d0][r] * rli[r])); }
    asm volatile("s_waitcnt lgkmcnt(0)" ::: "memory");
#pragma unroll
    for (int i = 0; i < 4; ++i) { const int row = i * 8 + (lane >> 3), ch = lane & 7; const long grow = orow0 + row;
      const u32x4 ov = *(const u32x4*)(stg + row * 64 + ch * 8); const u32x4 zv = __builtin_nontemporal_load((const u32x4*)(PROJ + grow * ldp + zcol0 + h * 64 + ch * 8));
      u32x4 w;
      w.x = gate2(ov.x, zv.x); w.y = gate2(ov.y, zv.y); w.z = gate2(ov.z, zv.z); w.w = gate2(ov.w, zv.w);
      store16_wt(YCAT + grow * 1024 + 512 + h * 64 + ch * 8, w); } }
  if (next_qword >= 0 && tid == 0) *(volatile __attribute__((address_space(3))) unsigned*)(lds3 + next_slot_off) = nxt_;
  asm volatile("s_waitcnt lgkmcnt(0)\n\ts_barrier" ::: "memory");
  (void)done_cnt;
#undef GLDS
#undef DMA_K
#undef DMA_V
#undef WAITB
#undef ROT
#undef RESC
#undef PKW
#undef PAF
#undef VFR
#undef VRD
#undef KRD
#undef GAPA
#undef GAPA3
#undef GAPB
#undef STEP
#undef STEP_F
#undef STEPX
#undef EX1
#undef GAPH
#undef ENDW
}
#undef PIN
#undef MFMAH
#undef MX3
#undef SBAR
}

#define GAS __attribute__((address_space(1)))
#define LAS __attribute__((address_space(3)))
typedef unsigned v4u __attribute__((ext_vector_type(4)));
typedef float f32x4 __attribute__((ext_vector_type(4)));
typedef short bf16x8 __attribute__((ext_vector_type(8)));
typedef GAS unsigned gu32;
typedef GAS unsigned long long gu64;
#define RLX_AGENT __ATOMIC_RELAXED, __HIP_MEMORY_SCOPE_AGENT
#define LDS_WAIT() asm volatile("s_waitcnt lgkmcnt(0)" ::: "memory")
#define VM_WAIT() asm volatile("s_waitcnt vmcnt(0)" ::: "memory")
__device__ __forceinline__ unsigned long long rt() { return __builtin_amdgcn_s_memrealtime(); }

#define XB_TMO      128
#define XB_XCNT(j)  (256  + 64 * (j))
#define XB_XSUB(j)  (1280 + 64 * (j))
#define XB_XGEN(j)  (2304 + 64 * (j))
#define XB_TOP      3328
#define XB_TOPGEN   3392
#define XCD_BAR_WORDS 3456
#define XB_SPIN_CAP (1u << 18)

__device__ __forceinline__ unsigned xb_ld(unsigned* p)              { return __hip_atomic_load(p, __ATOMIC_RELAXED, __HIP_MEMORY_SCOPE_AGENT); }
__device__ __forceinline__ unsigned xb_add(unsigned* p, unsigned v) { return __hip_atomic_fetch_add(p, v, __ATOMIC_RELAXED, __HIP_MEMORY_SCOPE_AGENT); }
__device__ __forceinline__ unsigned xb_xcc_id() { return (unsigned)__builtin_amdgcn_s_getreg((3 << 11) | 20) & 0xFu; }
#define XB_SPIN(cond, bar) do { unsigned _sp = 0; while (cond) { __builtin_amdgcn_s_sleep(1); \
    if ((++_sp & 255u) == 0u) { if (xb_ld(&(bar)[XB_TMO])) break; if (_sp > XB_SPIN_CAP) { atomicAdd(&(bar)[XB_TMO], 1u); break; } } } } while (0)

struct XcdBarrier {
    unsigned* bar; unsigned x;
    volatile LAS unsigned* st;
};

__device__ __forceinline__ XcdBarrier xcd_barrier_post(unsigned* bar, volatile LAS unsigned* st) {
    XcdBarrier b; b.bar = bar; b.x = xb_xcc_id(); b.st = st;
    if (threadIdx.x == 0) (void)xb_add(&bar[XB_XCNT(b.x)], 1u);
    return b;
}
__device__ __forceinline__ void xcd_barrier_complete(unsigned* bar, unsigned x, unsigned& nloc, unsigned& nx) {
    const unsigned G = gridDim.x * gridDim.y * gridDim.z;
    unsigned sum, cnt, mine, sp = 0u;
    for (;;) {
        sum = 0u; cnt = 0u; mine = 0u;
#pragma unroll
        for (unsigned j = 0; j < 16; ++j) { const unsigned c = xb_ld(&bar[XB_XCNT(j)]); sum += c; cnt += (c > 0u) ? 1u : 0u; mine = (j == x) ? c : mine; }
        if (sum == G) break;
        __builtin_amdgcn_s_sleep(1);
        if ((++sp & 255u) == 0u) { if (xb_ld(&bar[XB_TMO])) break; if (sp > XB_SPIN_CAP) { atomicAdd(&bar[XB_TMO], 1u); break; } }
    }
    nloc = mine > 0u ? mine : 1u; nx = cnt > 0u ? cnt : 1u;
}

__device__ __forceinline__ void xcd_barrier(const XcdBarrier& b) {
    asm volatile("s_waitcnt vmcnt(0)" ::: "memory");
    __syncthreads();
    if (threadIdx.x == 0) {
        unsigned* bar = b.bar;
        __builtin_amdgcn_s_waitcnt(0);
        unsigned nloc = b.st[0], nx = b.st[1];
        if (nloc == 0u) { xcd_barrier_complete(bar, b.x, nloc, nx); b.st[0] = nloc; b.st[1] = nx; }
        const unsigned old = xb_add(&bar[XB_XSUB(b.x)], 1u);
        const unsigned gen = old / nloc;
        if (old + 1u == (gen + 1u) * nloc) {
            __builtin_amdgcn_fence(__ATOMIC_RELEASE, "agent");
            asm volatile("s_waitcnt vmcnt(0)" ::: "memory");
            const unsigned og = xb_add(&bar[XB_TOP], 1u);
            const unsigned tg = og / nx;
            if (og + 1u == (tg + 1u) * nx) xb_add(&bar[XB_TOPGEN], 1u);
            else XB_SPIN(xb_ld(&bar[XB_TOPGEN]) == tg, bar);
            __builtin_amdgcn_fence(__ATOMIC_ACQUIRE, "agent");
            xb_add(&bar[XB_XGEN(b.x)], 1u);
            asm volatile("s_waitcnt vmcnt(0)" ::: "memory");
        } else {
            XB_SPIN(xb_ld(&bar[XB_XGEN(b.x)]) == gen, bar);
            __builtin_amdgcn_fence(__ATOMIC_ACQUIRE, "agent");
            asm volatile("s_waitcnt vmcnt(0)" ::: "memory");
        }
    }
    __syncthreads();
}

constexpr int NWAVES = 8;
constexpr int NPHASE = 4;
constexpr int CW_RDV = 98304;
constexpr int CW_TMO = 0, CW_CODE = 1, CW_MODC = 64, CW_OUTQ = 2048, CW_CHAIN = 81920, CW_ATTQ = 1024, CW_PANEL = 65536, CW_OUTP = 73728, CW_BAR = 4096;
constexpr int RING_OFF = 0, RING_BYTES = 131072;
constexpr int LDSCTL_OFF = RING_BYTES, MISC_OFF = LDSCTL_OFF + 320;
constexpr int SACT_OFF = LDSCTL_OFF + 1024;
constexpr int LDS_BYTES = 147456;
static_assert(MISC_OFF + 128 <= SACT_OFF && SACT_OFF + 8192 + 1024 <= LDS_BYTES, "LDS map");
static_assert(att::LDS_ATT2 <= RING_BYTES && pg8::STAGE_BYTES <= RING_BYTES, "phase scratch fits the ring");

struct Frame {
    LAS unsigned char* lds;
    volatile LAS unsigned* MISC;
    gu32* ctl;
    int tid, lane, wave, vcu, G;
};
__device__ __forceinline__ float wave_sum(float v) {
#pragma unroll
    for (int o = 1; o < 64; o <<= 1) v += __shfl_xor(v, o);
    return v;
}
__device__ __forceinline__ unsigned pk2h(float lo, float hi) { return pg8::cvt_pk_h(lo, hi); }

__device__ __forceinline__ void p0_transpose_item(const float* W, int ldw, int K, int src_n0, bf16* WT, int dst_row0, int k0, LAS float* scr, int lane, const float* gk = nullptr) {
    float t_[32];
#pragma unroll
    for (int i = 0; i < 32; ++i) t_[i] = __builtin_nontemporal_load(W + (size_t)(k0 + 2 * i + (lane >> 5)) * ldw + src_n0 + (lane & 31));
#pragma unroll
    for (int i = 0; i < 32; ++i) scr[(2 * i + (lane >> 5)) * 33 + (lane & 31)] = t_[i];
    LDS_WAIT(); asm volatile("" ::: "memory");
    const int c = lane & 7;
#pragma unroll
    for (int j = 0; j < 4; ++j) { const int n = (lane >> 3) + 8 * j; const LAS float* s = scr + (8 * c) * 33 + n;
        f32x4 g0 = {1.f, 1.f, 1.f, 1.f}, g1 = g0; if (gk) { g0 = *(const f32x4*)(gk + k0 + 8 * c); g1 = *(const f32x4*)(gk + k0 + 8 * c + 4); }
        v4u o; o.x = pk2h(s[0 * 33] * g0.x, s[1 * 33] * g0.y); o.y = pk2h(s[2 * 33] * g0.z, s[3 * 33] * g0.w); o.z = pk2h(s[4 * 33] * g1.x, s[5 * 33] * g1.y); o.w = pk2h(s[6 * 33] * g1.z, s[7 * 33] * g1.w);
        *(GAS v4u*)(WT + (size_t)(dst_row0 + n) * K + k0 + 8 * c) = o; }
    LDS_WAIT(); asm volatile("" ::: "memory");
}

struct Args {
    const float* in[24]; float* out; unsigned char* ws; int ph_lo, ph_hi, li, pad;
};

__device__ __forceinline__ void p0_mod_block(const LAS float* sact, LAS float* part, const float* w_ada, const float* b_ada, float* mod, gu32* cnt, int j, int wave, int lane) {
    const int kk = lane >> 2, c4 = lane & 3, col = 16 * j + 4 * c4;
    f32x4 w[8];
#pragma unroll
    for (int s = 0; s < 8; ++s) w[s] = __builtin_nontemporal_load((const GAS f32x4*)(w_ada + (size_t)(128 * wave + kk + 16 * s) * 3072 + col));
    f32x4 a0 = {0.f, 0.f, 0.f, 0.f}, a1 = {0.f, 0.f, 0.f, 0.f};
#pragma unroll
    for (int s = 0; s < 8; ++s) { const int k = 128 * wave + kk + 16 * s; a0 += w[s] * sact[k]; a1 += w[s] * sact[1024 + k]; }
#pragma unroll
    for (int o = 4; o < 64; o <<= 1) {
#pragma unroll
        for (int e = 0; e < 4; ++e) { a0[e] += __shfl_xor(a0[e], o); a1[e] += __shfl_xor(a1[e], o); } }
    if (lane < 4) {
#pragma unroll
        for (int e = 0; e < 4; ++e) { part[wave * 32 + 4 * c4 + e] = a0[e]; part[wave * 32 + 16 + 4 * c4 + e] = a1[e]; } }
    __syncthreads();
    if (wave == 0) {
        if (lane < 32) { float t = b_ada[16 * j + (lane & 15)];
#pragma unroll
            for (int ww = 0; ww < 8; ++ww) t += part[ww * 32 + lane];
            __hip_atomic_store((GAS float*)(mod + (lane >> 4) * 3072 + 16 * j + (lane & 15)), t, RLX_AGENT); }
        asm volatile("s_waitcnt vmcnt(0)" ::: "memory");
        if (lane == 0) __hip_atomic_fetch_add(cnt, 1u, RLX_AGENT);
    }
    __syncthreads();
}
__device__ __forceinline__ void cis_reduced(double ang, float& c, float& s) {
    const double TWO_PI = 6.283185307179586476925286766559;
    const float r = (float)(ang - TWO_PI * rint(ang / TWO_PI)); c = cosf(r); s = sinf(r);
}
__device__ __forceinline__ void ssm_pow(float lr, float li, float dtf, int n, float& pr, float& pi) {
    float c, s_; cis_reduced((double)n * (double)li * (double)dtf, c, s_); const float e = expf((float)n * lr * dtf); pr = e * c; pi = e * s_;
}
__device__ __forceinline__ void p0_ssm_item(const float* log_dt, const float* lam_re, const float* lam_im, float* AC, int g, int lane) {
    const float dtf = expf(log_dt[g]); const float lr = lam_re[g * 64 + lane], li = lam_im[g * 64 + lane];
    float a0, a1, a2, a3; ssm_pow(lr, li, dtf, 1, a0, a1); ssm_pow(lr, li, dtf, 16, a2, a3); const f32x4 v = {a0, a1, a2, a3};
    *(f32x4*)(AC + ((size_t)g * 64 + lane) * 4) = v;
}
__device__ __forceinline__ void ssm_coef_pow(const float* log_dt, const float* lam_re, const float* lam_im, int g, int lane, int n, float& cr, float& ci) {
    const float dtf = expf(log_dt[g]); const float lr = lam_re[g * 64 + lane], li = lam_im[g * 64 + lane];
    float ar, ai, pr, pi; ssm_pow(lr, li, dtf, 1, ar, ai); ssm_pow(lr, li, dtf, n, pr, pi);
    const float nr = ar - 1.f, ni = ai, den = lr * lr + li * li;
    const float kr = (nr * lr + ni * li) / den, ki = (ni * lr - nr * li) / den;
    cr = kr * pr - ki * pi; ci = kr * pi + ki * pr;
}
__device__ __forceinline__ void p0_ssm_K_item(const float* log_dt, const float* lam_re, const float* lam_im, const float* b_re, const float* b_im, const float* c_re, const float* c_im,
                                              bf16* TQ, int g, int d, LAS float* scr, int lane) {
    float cr, ci; ssm_coef_pow(log_dt, lam_re, lam_im, g, lane, d, cr, ci);
#pragma unroll
    for (int j = 0; j < 16; ++j) { const float br = b_re[(g * 64 + lane) * 16 + j], bi = b_im[(g * 64 + lane) * 16 + j];
        scr[(lane * 16 + j) * 2] = cr * br - ci * bi; scr[(lane * 16 + j) * 2 + 1] = cr * bi + ci * br; }
    LAS float* cl = scr + 2048;
#pragma unroll
    for (int q = 0; q < 16; ++q) { cl[(q * 64 + lane) * 2] = c_re[(g * 16 + q) * 64 + lane]; cl[(q * 64 + lane) * 2 + 1] = c_im[(g * 16 + q) * 64 + lane]; }
    LDS_WAIT(); asm volatile("" ::: "memory");
    const int i = lane & 15, jq = lane >> 4; float acc[4] = {0.f, 0.f, 0.f, 0.f};
#pragma unroll 8
    for (int p = 0; p < 64; ++p) { const float xr = cl[(i * 64 + p) * 2], xi = cl[(i * 64 + p) * 2 + 1];
#pragma unroll
        for (int e = 0; e < 4; ++e) acc[e] += xr * scr[(p * 16 + 4 * jq + e) * 2] - xi * scr[(p * 16 + 4 * jq + e) * 2 + 1]; }
    const unsigned long long kv = (unsigned long long)pk2h(acc[0], acc[1]) | ((unsigned long long)pk2h(acc[2], acc[3]) << 32);
    bf16* base = TQ + (size_t)g * 256 * 384;
    for (int t = d; t < 16; ++t) *(GAS unsigned long long*)(base + (size_t)(t * 16 + i) * 384 + (t - d) * 16 + 4 * jq) = kv;
    if (d > 0) for (int t = 0; t + d < 16; ++t) *(GAS unsigned long long*)(base + (size_t)(t * 16 + i) * 384 + (t + d) * 16 + 4 * jq) = 0ull;
    LDS_WAIT(); asm volatile("" ::: "memory");
}
__device__ __forceinline__ void p0_ssm_Q_item(const float* log_dt, const float* lam_re, const float* lam_im, const float* c_re, const float* c_im, bf16* TQ, int g, int t, int lane) {
    const float dtf = expf(log_dt[g]); float pr, pi; ssm_pow(lam_re[g * 64 + lane], lam_im[g * 64 + lane], dtf, t + 1, pr, pi);
#pragma unroll
    for (int i = 0; i < 16; ++i) { const float xr = c_re[(g * 16 + i) * 64 + lane], xi = c_im[(g * 16 + i) * 64 + lane];
        *(GAS unsigned*)(TQ + ((size_t)g * 256 + t * 16 + i) * 384 + 256 + 2 * lane) = pk2h(xr * pr - xi * pi, -(xr * pi + xi * pr)); }
}
__device__ __forceinline__ void p0_ssm_P_item(const float* log_dt, const float* lam_re, const float* lam_im, const float* b_re, const float* b_im, bf16* PP, int g, int s_, int lane) {
    float cr, ci; ssm_coef_pow(log_dt, lam_re, lam_im, g, lane, 15 - s_, cr, ci);
    float wr[16], wi[16];
#pragma unroll
    for (int j = 0; j < 16; ++j) { const float br = b_re[(g * 64 + lane) * 16 + j], bi = b_im[(g * 64 + lane) * 16 + j]; wr[j] = cr * br - ci * bi; wi[j] = cr * bi + ci * br; }
    bf16* r0 = PP + ((size_t)g * 256 + 2 * lane) * 256 + s_ * 16;
    v4u o; o.x = pk2h(wr[0], wr[1]); o.y = pk2h(wr[2], wr[3]); o.z = pk2h(wr[4], wr[5]); o.w = pk2h(wr[6], wr[7]); *(GAS v4u*)r0 = o;
    o.x = pk2h(wr[8], wr[9]); o.y = pk2h(wr[10], wr[11]); o.z = pk2h(wr[12], wr[13]); o.w = pk2h(wr[14], wr[15]); *(GAS v4u*)(r0 + 8) = o;
    o.x = pk2h(wi[0], wi[1]); o.y = pk2h(wi[2], wi[3]); o.z = pk2h(wi[4], wi[5]); o.w = pk2h(wi[6], wi[7]); *(GAS v4u*)(r0 + 256) = o;
    o.x = pk2h(wi[8], wi[9]); o.y = pk2h(wi[10], wi[11]); o.z = pk2h(wi[12], wi[13]); o.w = pk2h(wi[14], wi[15]); *(GAS v4u*)(r0 + 256 + 8) = o;
}

__global__ void __launch_bounds__(NWAVES * 64, 2) mega_fwd(Args args) {
    extern __shared__ __attribute__((aligned(16))) unsigned char lds[];
    Frame F;
    F.lds = (LAS unsigned char*)lds;
    F.MISC = (volatile LAS unsigned*)(F.lds + MISC_OFF);
    F.tid = threadIdx.x; F.lane = F.tid & 63; F.wave = __builtin_amdgcn_readfirstlane(F.tid >> 6);
    F.G = gridDim.x; { const int bx = blockIdx.x; F.vcu = (F.G % 8 == 0) ? (bx % 8) * (F.G / 8) + bx / 8 : bx; }
    unsigned char* ws = args.ws;
    F.ctl = (gu32*)(ws + WS_CTL);
    const float* x = args.in[0]; const float* cvec = args.in[1]; const int* positions = (const int*)args.in[2];
    const float* w_ada = args.in[3]; const float* b_ada = args.in[4]; const float* norm_g = args.in[5]; const float* w_in = args.in[6];
    const float* log_dt = args.in[7]; const float* lam_re = args.in[8]; const float* lam_im = args.in[9]; const float* b_re = args.in[10]; const float* b_im = args.in[11];
    const float* c_re = args.in[12]; const float* c_im = args.in[13]; const float* d_skip = args.in[14]; const float* w_glu = args.in[15]; const float* b_glu = args.in[16];
    const float* q_a_g = args.in[17]; const float* w_q_b = args.in[18]; const float* kv_a_g = args.in[19]; const float* w_kv_b = args.in[20];
    const float* q_norm_g = args.in[21]; const float* k_norm_g = args.in[22]; const float* w_out = args.in[23];
    float* MOD = (float*)(ws + WS_MOD); float* AC = (float*)(ws + WS_AC); bf16* BB = (bf16*)(ws + WS_BB); bf16* CB = (bf16*)(ws + WS_CB); float* EST = (float*)(ws + WS_E);
    bf16* WIN_T = (bf16*)(ws + WS_WIN); bf16* WQ_T = (bf16*)(ws + WS_WQ); bf16* WKV_T = (bf16*)(ws + WS_WKV); bf16* WGLU_T = (bf16*)(ws + WS_WGLU); bf16* WOUT_T = (bf16*)(ws + WS_WOUT);
    bf16* PROJ = (bf16*)(ws + WS_PROJ); bf16* HB = (bf16*)(ws + WS_HB); bf16* QRAW = (bf16*)(ws + WS_HB); bf16* YCAT = (bf16*)(ws + WS_YCAT); bf16* ZM = (bf16*)(ws + WS_ZM);
    bf16* KVRAW = (bf16*)(ws + WS_KVRAW); bf16* Qb = (bf16*)(ws + WS_Q); bf16* Kb = (bf16*)(ws + WS_K); bf16* Vb = (bf16*)(ws + WS_V);
    bf16* CQN = (bf16*)(ws + WS_CQN); bf16* CKVN = (bf16*)(ws + WS_CKVN); bf16* YPRE = (bf16*)(ws + WS_YPRE);
    float* RS = (float*)(ws + WS_RS); float* ROPE = (float*)(ws + WS_ROPE); bf16* USG = (bf16*)(ws + WS_USG); bf16* TQ = (bf16*)(ws + WS_TQ); bf16* PPM = (bf16*)(ws + WS_PP); float* HAND = (float*)(ws + WS_HAND); (void)BB; (void)CB; (void)EST; (void)CQN; (void)CKVN; (void)QRAW; (void)KVRAW;

    for (int u = F.tid; u < (LDS_BYTES - LDSCTL_OFF) / 4; u += NWAVES * 64) ((LAS unsigned*)(F.lds + LDSCTL_OFF))[u] = 0u;
    __syncthreads();
    const int lo = args.ph_lo, hi = args.ph_hi;
    const bool multi = (hi - lo) > 1;
    XcdBarrier bar; bar.bar = (unsigned*)(F.ctl + CW_BAR) + args.li * XCD_BAR_WORDS; bar.x = 0; bar.st = nullptr;
    if (multi) bar = xcd_barrier_post((unsigned*)(F.ctl + CW_BAR) + args.li * XCD_BAR_WORDS, F.MISC + 8);
#define IN(k) (lo <= (k) && (k) < hi)
#define SEAM(k) do { if (IN(k) && IN((k) + 1)) xcd_barrier(bar); } while (0)
    const int gw = F.vcu * NWAVES + F.wave, NGW = F.G * NWAVES;

    if (IN(0)) {
        LAS float* scr = (LAS float*)(F.lds + RING_OFF + F.wave * 16384);
        constexpr int I_MOD = 192, I_SSM = 32;
        constexpr int T_U = 256, T_ZS = 256, T_ZM = 256, T_CKV = 128, T_CQ = 192, T_KR = 16, T_WQ = 144, T_WKV = 128, T_WGLU = 128, T_WOUT = 512;
        constexpr int I_TR = T_U + T_ZS + T_ZM + T_CKV + T_CQ + T_KR + T_WQ + T_WKV + T_WGLU + T_WOUT;
        constexpr int I_Z1 = 96, I_Z2 = 256;
        constexpr int NITEMS = I_MOD + I_SSM + I_TR + I_Z1 + I_Z2;
        { LAS float* sact = (LAS float*)(F.lds + SACT_OFF); LAS float* part = (LAS float*)(F.lds + SACT_OFF + 8192);
          for (int e = F.tid; e < 2048; e += NWAVES * 64) { const float cv = cvec[e]; sact[e] = cv / (1.f + __expf(-cv)); }
          __syncthreads();
          for (int r = (int)blockIdx.x; r < I_MOD; r += F.G) p0_mod_block(sact, part, w_ada, b_ada, MOD, F.ctl + CW_MODC, r, F.wave, F.lane); }
        for (int it = I_MOD + gw; it < NITEMS; it += NGW) {
            int r = it - I_MOD;
            if (r < I_SSM) { p0_ssm_item(log_dt, lam_re, lam_im, AC, r, F.lane); continue; } r -= I_SSM;
            if (r < I_TR) {
                if (r < T_U)   { p0_transpose_item(w_in, D_IN, 1024, SC_U + 32 * (r % 16), WIN_T, 0 + 32 * (r % 16), 64 * (r / 16), scr, F.lane); continue; } r -= T_U;
                if (r < T_ZS)  { p0_transpose_item(w_in, D_IN, 1024, SC_ZS + 32 * (r % 16), WIN_T, 512 + 32 * (r % 16), 64 * (r / 16), scr, F.lane); continue; } r -= T_ZS;
                if (r < T_ZM)  { p0_transpose_item(w_in, D_IN, 1024, SC_ZM + 32 * (r % 16), WIN_T, WR_ZM + 32 * (r % 16), 64 * (r / 16), scr, F.lane); continue; } r -= T_ZM;
                if (r < T_CKV) { p0_transpose_item(w_in, D_IN, 1024, SC_CKV + 32 * (r % 8), WIN_T, 1024 + 32 * (r % 8), 64 * (r / 8), scr, F.lane); continue; } r -= T_CKV;
                if (r < T_CQ)  { p0_transpose_item(w_in, D_IN, 1024, SC_CQ + 32 * (r % 12), WIN_T, 1280 + 32 * (r % 12), 64 * (r / 12), scr, F.lane); continue; } r -= T_CQ;
                if (r < T_KR)  { p0_transpose_item(w_in, D_IN, 1024, SC_KR, WIN_T, GC_KR, 64 * r, scr, F.lane); continue; } r -= T_KR;
                if (r < T_WQ)  { const int nb = r % 24, kb = r / 24, n0 = 32 * nb;
                                 p0_transpose_item(w_q_b, 768, 384, n0, WQ_T, (n0 / 96) * 128 + (n0 % 96), 64 * kb, scr, F.lane, q_a_g); continue; } r -= T_WQ;
                if (r < T_WKV) { p0_transpose_item(w_kv_b, 1024, 256, 32 * (r % 32), WKV_T, 32 * (r % 32), 64 * (r / 32), scr, F.lane, kv_a_g); continue; } r -= T_WKV;
                if (r < T_WGLU){ p0_transpose_item(w_glu, 512, 512, 32 * (r % 16), WGLU_T, 32 * (r % 16), 64 * (r / 16), scr, F.lane); continue; } r -= T_WGLU;
                p0_transpose_item(w_out, 1024, 1024, 32 * (r % 32), WOUT_T, 32 * (r % 32), 64 * (r / 32), scr, F.lane); continue;
            }
            r -= I_TR;
            const v4u z = {0u, 0u, 0u, 0u};
            if (r < I_Z1) { GAS v4u* p = (GAS v4u*)(WIN_T + (size_t)(GC_KR + 32 + r) * 1024); p[F.lane] = z; p[64 + F.lane] = z; continue; } r -= I_Z1;
            { const int hh = r / 32, rr = r % 32; GAS v4u* p = (GAS v4u*)(WQ_T + (size_t)(hh * 128 + 96 + rr) * 384); if (F.lane < 48) p[F.lane] = z; }
        }
        f32x4 v0[4], v1[4], v2[4];
#define LDROW(dst, mm) do { const GAS f32x4* xr_ = (const GAS f32x4*)(x + (size_t)(mm) * DM) + F.lane; _Pragma("unroll") for (int j = 0; j < 4; ++j) dst[j] = __builtin_nontemporal_load(xr_ + 64 * j); } while (0)
        if (gw < M) LDROW(v0, gw);
        if (gw + NGW < M) LDROW(v1, gw + NGW);
        __syncthreads();
        if (F.wave == 0) { unsigned sp = 0;
            while (__hip_atomic_load(F.ctl + CW_MODC, RLX_AGENT) < 192u) { __builtin_amdgcn_s_sleep(2); if (++sp > (1u << 22)) { if (F.lane == 0) __hip_atomic_store(F.ctl + CW_TMO, 1u, RLX_AGENT); break; } }
            __builtin_amdgcn_fence(__ATOMIC_ACQUIRE, "agent"); asm volatile("s_waitcnt vmcnt(0)" ::: "memory"); }
        __syncthreads();
        { f32x4 PA[4], PB[4]; int curb = -1;
          const float ifq = (float)exp(-(double)(F.lane & 15) / 16.0 * 9.210340371976184);
          for (int m = gw; m < M; m += NGW) {
            if (m + 2 * NGW < M) LDROW(v2, m + 2 * NGW);
            const int b = m / SEQ;
            if (b != curb) { curb = b;
#pragma unroll
                for (int j = 0; j < 4; ++j) { const int e = 4 * F.lane + 256 * j;
                    const f32x4 g4 = *(const f32x4*)(norm_g + e), sc = *(const f32x4*)(MOD + b * 3072 + 1024 + e); PB[j] = *(const f32x4*)(MOD + b * 3072 + e); PA[j] = g4 * (sc + 1.f); } }
            if (F.lane < 16) { const double TWO_PI = 6.283185307179586476925286766559;
                const float ang = (float)positions[m] * ifq; const float kq = rintf(ang * 0.15915494309189535f);
                const float rr = fmaf(-kq, 0.0019353071795864769f, fmaf(-kq, 6.28125f, ang)); (void)TWO_PI;
                typedef float f32x2_ __attribute__((ext_vector_type(2))); *(f32x2_*)(ROPE + ((size_t)m * 16 + F.lane) * 2) = (f32x2_){__cosf(rr), __sinf(rr)}; }
            float s = 0.f;
#pragma unroll
            for (int j = 0; j < 4; ++j) s += (v0[j].x * v0[j].x + v0[j].y * v0[j].y) + (v0[j].z * v0[j].z + v0[j].w * v0[j].w);
            const float rstd = 1.f / sqrtf(wave_sum(s) * (1.f / DM) + EPS);
            GAS unsigned long long* o8 = (GAS unsigned long long*)(HB + (size_t)m * DM) + F.lane;
#pragma unroll
            for (int j = 0; j < 4; ++j) { const f32x4 hv = v0[j] * rstd * PA[j] + PB[j];
                o8[64 * j] = (unsigned long long)pk2h(hv.x, hv.y) | ((unsigned long long)pk2h(hv.z, hv.w) << 32); }
#pragma unroll
            for (int j = 0; j < 4; ++j) { v0[j] = v1[j]; v1[j] = v2[j]; }
          }
#undef LDROW
        }
    }
    SEAM(0);

    if (IN(1)) {
        pg8::Gemm g{HB, WIN_T, M, NPROJ, 1024, 1024}; pg8::StaticOrder S; S.init(M, NPROJ, F.G, (int)blockIdx.x);
        pg8::EpiProj E{PROJ, LDP, RS, 4, USG, SEQ};
        pg8::gemm_phase<pg8::EpiProj, pg8::StaticOrder, true, true>(F.lds + RING_OFF, g, S, E);
        if (F.G == 256 ? blockIdx.x >= 192 : true) { __syncthreads();
            LAS float* scr = (LAS float*)(F.lds + RING_OFF + F.wave * 16384);
            const int nw = (F.G == 256) ? 512 : NGW, w0 = (F.G == 256) ? ((int)blockIdx.x - 192) * NWAVES + F.wave : gw;
            for (int it = w0; it < 512 * 3 + 256; it += nw) { int r = it;
                if (r < 512) { p0_ssm_K_item(log_dt, lam_re, lam_im, b_re, b_im, c_re, c_im, TQ, r >> 4, r & 15, scr, F.lane); continue; } r -= 512;
                if (r < 512) { p0_ssm_Q_item(log_dt, lam_re, lam_im, c_re, c_im, TQ, r >> 4, r & 15, F.lane); continue; } r -= 512;
                if (r < 512) { p0_ssm_P_item(log_dt, lam_re, lam_im, b_re, b_im, PPM, r >> 4, r & 15, F.lane); continue; } r -= 512;
                { const v4u z0 = {0u, 0u, 0u, 0u}; GAS v4u* pz = (GAS v4u*)(PPM + ((size_t)(r >> 3) * 256 + 128 + (r & 7) * 16) * 256);
#pragma unroll
                  for (int q = 0; q < 8; ++q) pz[F.lane + 64 * q] = z0; } } }
    }
    SEAM(1);

    if (IN(2)) {
        { const pg8::MlaAux AUX{RS, ROPE, PROJ, LDP, PC_KR};
          if (F.G == 256) {
            { pg8::Gemm g{PROJ + PC_CQ, WQ_T, M, 1024, Q_LORA, LDP}; pg8::StaticOrder S; S.init(M, 1024, F.G, (int)blockIdx.x);
              pg8::EpiQ E{AUX, q_norm_g, Qb, 0.10206207261596575f * 1.4426950408889634f, EPS, SEQ};
              pg8::gemm_phase<pg8::EpiQ, pg8::StaticOrder, false, true>(F.lds + RING_OFF, g, S, E); }
            __syncthreads();
            { pg8::Gemm g{PROJ + PC_CKV, WKV_T, M, 1024, KV_LORA, LDP}; pg8::StaticOrder S; S.init(M, 1024, F.G, (int)blockIdx.x);
              pg8::EpiKV E{AUX, k_norm_g, Kb, Vb, EPS, SEQ};
              pg8::gemm_phase<pg8::EpiKV, pg8::StaticOrder, false, true>(F.lds + RING_OFF, g, S, E); }
          } else if (F.tid == 0) __hip_atomic_store(F.ctl + CW_TMO, 1u, RLX_AGENT);
        }
        __syncthreads();
        { pg8::Gemm g{USG, PPM, 32768, 8192, 256, 384}; pg8::DiagOrder S{128, 4, F.G, (int)blockIdx.x, nullptr, 0u, nullptr};
          pg8::EpiELds E{};
          if (F.G >= 128) { pg8::gemm_phase<pg8::EpiELds, pg8::DiagOrder, false, true>(F.lds + RING_OFF, g, S, E);
              pg8::Unit u; const bool has = S.next(0, u);
              __syncthreads();
              if (has && F.wave == 0) pg8::ssm_chain_unit(u, F.lds + RING_OFF, USG, AC, HAND, (unsigned*)(F.ctl + CW_CHAIN), (unsigned*)(F.ctl + CW_TMO), F.lane);
              __syncthreads(); }
          else if (F.tid == 0) __hip_atomic_store(F.ctl + CW_TMO, 1u, RLX_AGENT); }
        { pg8::Gemm g{HB, WIN_T + (size_t)WR_ZM * 1024, M, 512, 1024, 1024}; pg8::StaticOrder S; S.init(M, 512, F.G, (int)((blockIdx.x + 128u) % (unsigned)F.G));
          pg8::EpiH16 E{ZM, 512};
          pg8::gemm_phase<pg8::EpiH16, pg8::StaticOrder, true, true>(F.lds + RING_OFF, g, S, E); }
    }
    SEAM(2);

    if (IN(3)) {
        { pg8::Gemm g{USG, TQ, 32768, 8192, 384, 384}; pg8::DiagOrder S{128, 4, F.G, (int)blockIdx.x, nullptr, 0u, nullptr};
          pg8::EpiY E{USG, d_skip, YPRE, SEQ};
          pg8::gemm_phase<pg8::EpiY, pg8::DiagOrder, true, true>(F.lds + RING_OFF, g, S, E);
          if (F.tid == 0) { pg8::Unit u; for (int i = 0; S.next(i, u); ++i) { const int k4 = u.pm & 3;
              for (int q = 0; q < 16; ++q) __hip_atomic_fetch_add(F.ctl + CW_PANEL + 64 * ((k4 >> 1) * 32 + (k4 & 1) * 16 + q), 1u, RLX_AGENT); } } }
        __syncthreads();
        __syncthreads();
#define RUN_GLU_UNITS() do { \
        { pg8::Gemm g{YPRE, WGLU_T, M, 512, 512, 512}; pg8::PanelOrder S; S.init(M, 512, F.G, (int)((blockIdx.x + 128u) % (unsigned)F.G)); S.cnt = (unsigned*)(F.ctl + CW_PANEL); S.want = 32u; S.tmo = (unsigned*)(F.ctl + CW_TMO); \
          pg8::EpiGlu E{YPRE, PROJ, LDP, PC_ZS, b_glu, YCAT}; \
          pg8::gemm_phase<pg8::EpiGlu, pg8::PanelOrder, true, true>(F.lds + RING_OFF, g, S, E); \
          if (F.tid == 0) { pg8::Unit u; for (int i = 0; S.next(i, u); ++i) __hip_atomic_fetch_add(F.ctl + CW_OUTP + 64 * u.pm, 1u, RLX_AGENT); } } \
        __syncthreads(); } while (0)
#define OUT_UNIT_OF(k, uu) do { const int pk_ = (k) >> 2; (uu).pm = (pk_ & 1) * 32 + (24 - 8 * (pk_ >> 1)) + j; (uu).pn = (k) & 3; } while (0)
#define RUN_OUT_UNIT(uu) do { if (F.tid < 64) { __builtin_amdgcn_fence(__ATOMIC_ACQUIRE, "agent"); asm volatile("s_waitcnt vmcnt(0)" ::: "memory"); } __syncthreads(); \
            pg8::Gemm g_{YCAT, WOUT_T, M, 1024, 1024, 1024}; pg8::OneUnit S_; S_.u = (uu); pg8::EpiOutRows E_{x, MOD + 2048, 3072, SEQ, args.out}; \
            pg8::gemm_phase<pg8::EpiOutRows, pg8::OneUnit, false, true>(F.lds + RING_OFF, g_, S_, E_); __syncthreads(); } while (0)
        const int j = (int)(blockIdx.x & 7); bool glu_done = false;
        float gqm = 0.f, gkm = 0.f;
        for (int d = F.lane; d < 96; d += 64) { gqm = fmaxf(gqm, fabsf(q_norm_g[d])); gkm = fmaxf(gkm, fabsf(k_norm_g[d])); }
#pragma unroll
        for (int o_ = 32; o_ > 0; o_ >>= 1) { gqm = fmaxf(gqm, __shfl_xor(gqm, o_)); gkm = fmaxf(gkm, __shfl_xor(gkm, o_)); }
        const float sbound = __uint_as_float((unsigned)__builtin_amdgcn_readfirstlane((int)__float_as_uint(96.f * 0.14724445f * 1.01f * gqm * gkm + 0.1f)));
        const bool fixed_ok = sbound <= 17.0f; const float mfix = sbound - 10.f;
#define FLUSH_PEND() do { if (pend_) { asm volatile("s_waitcnt vmcnt(0)" ::: "memory"); __syncthreads(); if (F.tid == 0) __hip_atomic_fetch_add(pend_, 1u, RLX_AGENT); pend_ = nullptr; } } while (0)
        unsigned* pend_ = nullptr;
        bool popped = false;
        for (;;) {
            if (!popped && F.tid == 0) F.MISC[16] = __hip_atomic_fetch_add(F.ctl + CW_ATTQ + 64 * j, 1u, RLX_AGENT);
            __syncthreads();
            const unsigned ua = (unsigned)__builtin_amdgcn_readfirstlane((int)F.MISC[16]);
            __syncthreads();
            if (ua >= 64u) { FLUSH_PEND(); break; }
            const int bh = 2 * j + (int)(ua & 1u), qb = 31 - (int)(ua >> 1);
            const bool early = glu_done || ((blockIdx.x + 128u) % (unsigned)F.G) >= 128u;
            if (fixed_ok) att::attn_unit<true>(bh >> 3, bh & 7, qb, Qb, Kb, Vb, ZM, 512, 0, YCAT, (char*)lds + RING_OFF, F.lds + RING_OFF, (unsigned*)(F.ctl + CW_OUTP + 64 * ((bh >> 3) * 32 + qb)), nullptr, (unsigned*)(F.ctl + CW_TMO), early ? CW_ATTQ - CW_TMO : -1, MISC_OFF - RING_OFF + 16 * 4, mfix, pend_);
            else att::attn_unit<false>(bh >> 3, bh & 7, qb, Qb, Kb, Vb, ZM, 512, 0, YCAT, (char*)lds + RING_OFF, F.lds + RING_OFF, (unsigned*)(F.ctl + CW_OUTP + 64 * ((bh >> 3) * 32 + qb)), nullptr, (unsigned*)(F.ctl + CW_TMO), early ? CW_ATTQ - CW_TMO : -1, MISC_OFF - RING_OFF + 16 * 4, 0.f, pend_);
            pend_ = (unsigned*)(F.ctl + CW_OUTP + 64 * ((bh >> 3) * 32 + qb));
            popped = early;
            if (!glu_done) { glu_done = true; RUN_GLU_UNITS(); FLUSH_PEND(); }
            if (F.tid == 0) { unsigned k = __hip_atomic_load(F.ctl + CW_OUTQ + 64 * j, RLX_AGENT), got = 0xffffffffu;
                if (MK_CLAIM_BETWEEN && k < 32u) { pg8::Unit t; OUT_UNIT_OF((int)k, t);
                    if (__hip_atomic_load(F.ctl + CW_OUTP + 64 * t.pm, RLX_AGENT) >= 10u) { unsigned e = k;
                        if (__hip_atomic_compare_exchange_strong(F.ctl + CW_OUTQ + 64 * j, &e, k + 1u, __ATOMIC_RELAXED, __ATOMIC_RELAXED, __HIP_MEMORY_SCOPE_AGENT)) got = k; } }
                F.MISC[17] = got; }
            __syncthreads();
            const unsigned ko = (unsigned)__builtin_amdgcn_readfirstlane((int)F.MISC[17]);
            __syncthreads();
            if (ko != 0xffffffffu) { pg8::Unit uo; OUT_UNIT_OF((int)ko, uo); RUN_OUT_UNIT(uo); }
        }
        if (!glu_done) { glu_done = true; RUN_GLU_UNITS(); }
        for (;;) {
            if (F.tid == 0) F.MISC[17] = __hip_atomic_fetch_add(F.ctl + CW_OUTQ + 64 * j, 1u, RLX_AGENT);
            __syncthreads();
            const unsigned ko = (unsigned)__builtin_amdgcn_readfirstlane((int)F.MISC[17]);
            __syncthreads();
            if (ko >= 32u) break;
            pg8::Unit uo; OUT_UNIT_OF((int)ko, uo);
            if (F.tid < 64) { unsigned sp = 0;
                while (__hip_atomic_load(F.ctl + CW_OUTP + 64 * uo.pm, RLX_AGENT) < 10u) { __builtin_amdgcn_s_sleep(4);
                    if (++sp > (1u << 22)) { if (F.tid == 0) __hip_atomic_store(F.ctl + CW_TMO, 1u, RLX_AGENT); break; } }
                if (F.tid == 0) __hip_atomic_fetch_add(F.ctl + CW_RDV + 64 * uo.pm, 1u, RLX_AGENT);
                sp = 0; while (__hip_atomic_load(F.ctl + CW_RDV + 64 * uo.pm, RLX_AGENT) < 4u && ++sp < 20000u) __builtin_amdgcn_s_sleep(2); }
            RUN_OUT_UNIT(uo);
        }
#undef OUT_UNIT_OF
#undef RUN_GLU_UNITS
#undef RUN_OUT_UNIT
    }
#undef IN
#undef SEAM
}

#ifndef MK_MODE
#define MK_MODE 2
#endif
#ifndef MK_FAST_MASK
#define MK_FAST_MASK 0x7
#endif
extern "C" void kernel_launch(void* const* d_in, const int* in_sizes, int n_in, void* d_out, int out_size, void* d_ws, size_t ws_size, hipStream_t stream) {
    static int grid = 0;
    if (grid == 0) {
        if (n_in != 24 || in_sizes[0] != M * DM || out_size != M * DM || ws_size < WS_END) { fprintf(stderr, "kernel_launch: unexpected shapes (n_in %d, in0 %d, out %d, ws %zu)\n", n_in, n_in > 0 ? in_sizes[0] : -1, out_size, ws_size); grid = -1; return; }
        int dev = 0, cus = 0, per_cu = 0;
        if (hipGetDevice(&dev) != hipSuccess || hipDeviceGetAttribute(&cus, hipDeviceAttributeMultiprocessorCount, dev) != hipSuccess) { fprintf(stderr, "kernel_launch: device query failed\n"); grid = -1; return; }
        if (hipFuncSetAttribute((const void*)mega_fwd, hipFuncAttributeMaxDynamicSharedMemorySize, LDS_BYTES) != hipSuccess) { fprintf(stderr, "kernel_launch: hipFuncSetAttribute failed\n"); grid = -1; return; }
        if (hipOccupancyMaxActiveBlocksPerMultiprocessor(&per_cu, (const void*)mega_fwd, NWAVES * 64, LDS_BYTES) != hipSuccess || per_cu < 1)
            fprintf(stderr, "kernel_launch: note: occupancy query reports %d workgroups per CU\n", per_cu);
        (void)hipGetLastError();
        grid = cus;
    }
    if (grid < 0) return;
    const float* x = (const float*)d_in[0]; const float* c = (const float*)d_in[1]; const int* positions = (const int*)d_in[2];
    const float* w_ada = (const float*)d_in[3]; const float* b_ada = (const float*)d_in[4]; const float* norm_g = (const float*)d_in[5];
    const float* w_in = (const float*)d_in[6]; const float* log_dt = (const float*)d_in[7]; const float* lam_re = (const float*)d_in[8];
    const float* lam_im = (const float*)d_in[9]; const float* b_re = (const float*)d_in[10]; const float* b_im = (const float*)d_in[11];
    const float* c_re = (const float*)d_in[12]; const float* c_im = (const float*)d_in[13]; const float* d_skip = (const float*)d_in[14];
    const float* w_glu = (const float*)d_in[15]; const float* b_glu = (const float*)d_in[16]; const float* q_a_g = (const float*)d_in[17];
    const float* w_q_b = (const float*)d_in[18]; const float* kv_a_g = (const float*)d_in[19]; const float* w_kv_b = (const float*)d_in[20];
    const float* q_norm_g = (const float*)d_in[21]; const float* k_norm_g = (const float*)d_in[22]; const float* w_out = (const float*)d_in[23];
    unsigned char* ws = (unsigned char*)d_ws; float* out = (float*)d_out;
    float* MOD = (float*)(ws + WS_MOD); bf16* PROJ = (bf16*)(ws + WS_PROJ); bf16* HB = (bf16*)(ws + WS_HB); bf16* QRAW = (bf16*)(ws + WS_HB); bf16* YCAT = (bf16*)(ws + WS_YCAT); bf16* ZM = (bf16*)(ws + WS_ZM);
    bf16* KVRAW = (bf16*)(ws + WS_KVRAW); bf16* Qb = (bf16*)(ws + WS_Q); bf16* Kb = (bf16*)(ws + WS_K); bf16* Vb = (bf16*)(ws + WS_V);
    bf16* CQN = (bf16*)(ws + WS_CQN); bf16* CKVN = (bf16*)(ws + WS_CKVN); bf16* YPRE = (bf16*)(ws + WS_YPRE);
    (void)x; (void)c; (void)positions; (void)w_ada; (void)b_ada; (void)norm_g; (void)w_in; (void)log_dt; (void)lam_re; (void)lam_im; (void)b_re; (void)b_im; (void)c_re; (void)c_im; (void)d_skip;
    (void)w_glu; (void)b_glu; (void)q_a_g; (void)w_q_b; (void)kv_a_g; (void)w_kv_b; (void)q_norm_g; (void)k_norm_g; (void)w_out; (void)MOD; (void)PROJ; (void)HB; (void)QRAW; (void)YCAT;
    (void)KVRAW; (void)Qb; (void)Kb; (void)Vb; (void)CQN; (void)CKVN; (void)YPRE; (void)out;

    Args a{}; int n_mega = 0;
    for (int i = 0; i < 24; ++i) a.in[i] = (const float*)d_in[i];
    a.out = out; a.ws = ws;
#define MEGA(lo_, hi_) do { a.ph_lo = (lo_); a.ph_hi = (hi_); a.li = n_mega++; hipLaunchKernelGGL(mega_fwd, dim3(grid), dim3(NWAVES * 64), LDS_BYTES, stream, a); } while (0)
#if MK_MODE == 2
    if (hipMemsetAsync(ws + WS_CTL, 0, CTL_ZERO_BYTES, stream) != hipSuccess) { fprintf(stderr, "kernel_launch: memset failed\n"); return; }
#if MK_DOUBLE >= 0
    MEGA(0, MK_DOUBLE + 1); MEGA(MK_DOUBLE, NPHASE);
#else
    MEGA(0, NPHASE);
#endif
#else
    const unsigned fast = (MK_MODE == 0) ? 0u : (unsigned)MK_FAST_MASK;
    (void)hipMemsetAsync(ws + WS_CTL, 0, CTL_ZERO_BYTES, stream);
    if (MK_MODE != 0) MEGA(0, 1);
    if (!(fast & 1u)) { hipLaunchKernelGGL(v0_mod, dim3(24), dim3(256), 0, stream, c, w_ada, b_ada, MOD); hipLaunchKernelGGL(v0_h, dim3(M), dim3(256), 0, stream, x, norm_g, MOD, HB); }
    if (fast & 2u) MEGA(1, 2); else {
        const int seg[5][3] = {{PC_U, SC_U, 512}, {PC_ZS, SC_ZS, 512}, {PC_CKV, SC_CKV, 256}, {PC_CQ, SC_CQ, 384}, {PC_KR, SC_KR, 32}};
        for (int s = 1; s < 5; ++s) hipLaunchKernelGGL(v0_gemm, dim3(M), dim3(256), 1024 * 4, stream, HB, 1024, 1024, w_in, D_IN, seg[s][1], PROJ, LDP, seg[s][0], seg[s][2]);
        hipLaunchKernelGGL(v0_usg, dim3(M), dim3(256), 1024 * 4, stream, HB, w_in, D_IN, (bf16*)(ws + WS_USG));
        hipLaunchKernelGGL(v0_gemm, dim3(M), dim3(256), 1024 * 4, stream, HB, 1024, 1024, w_in, D_IN, SC_ZM, ZM, 512, 0, 512); }
    if (fast & 4u) { MEGA(2, 3); MEGA(3, 4); }
    else { hipLaunchKernelGGL(v0_cqn, dim3(M), dim3(256), 0, stream, PROJ, q_a_g, kv_a_g, CQN, CKVN);
        for (int h = 0; h < NH; ++h) hipLaunchKernelGGL(v0_gemm, dim3(M), dim3(128), 384 * 4, stream, CQN, 384, 384, w_q_b, 768, h * 96, QRAW, 1024, h * 128, 96);
        hipLaunchKernelGGL(v0_gemm, dim3(M), dim3(256), 256 * 4, stream, CKVN, 256, 256, w_kv_b, 1024, 0, KVRAW, 1024, 0, 1024);
        hipLaunchKernelGGL(v0_qkv, dim3(M * NH * 2 / 256), dim3(256), 0, stream, QRAW, KVRAW, PROJ, positions, q_norm_g, k_norm_g, Qb, Kb, Vb);
        hipLaunchKernelGGL(v0_ssm, dim3(BATCH * SSM_G), dim3(64), 0, stream, (bf16*)(ws + WS_USG), log_dt, lam_re, lam_im, b_re, b_im, c_re, c_im, d_skip, YPRE);
        hipLaunchKernelGGL(v0_attn, dim3(BATCH * NH * (SEQ / 256)), dim3(256), 0, stream, Qb, Kb, Vb, ZM, YCAT);
        hipLaunchKernelGGL(v0_glu, dim3(M), dim3(256), 0, stream, YPRE, w_glu, b_glu, PROJ, YCAT);
        hipLaunchKernelGGL(v0_out, dim3(M), dim3(256), 0, stream, YCAT, w_out, x, MOD, out); }
#endif
    const hipError_t le = hipPeekAtLastError();
    if (le != hipSuccess) fprintf(stderr, "kernel_launch: launch failed: %s\n", hipGetErrorName(le));
}
```
